# Optimizing an MI355X kernel written in HIP

```python
import math
import jax
import jax.numpy as jnp
from jax import lax
import numpy as np

D_MODEL = 1024
BATCH = 16
SEQ = 2048
DEPTH = 4

CTX_LEN = 256
GRID_W = 64
N_EVEN = (DEPTH + 1) // 2
N_ODD = DEPTH // 2
D_FF = 4 * D_MODEL
EPS = 1e-6
ROPE_BASE = 10000.0
MIX_A = D_MODEL // 2
MLSTM_HEADS = 4
MLSTM_HD = MIX_A // MLSTM_HEADS
MLSTM_CHUNK = 64
N_GATES = 4 * MLSTM_HEADS
FORGET_BIAS_LO = 3.0
FORGET_BIAS_HI = 6.0
MIX_B = D_MODEL - MIX_A
HYENA_ORDER = 2
HYENA_SHORT = 3
HYENA_EMB = 33
HYENA_FFN = 64
HYENA_TARGET = 1e-2
HYENA_FAST = 0.3
HYENA_SLOW = 1.5
E_IN = 4 * MIX_A + N_GATES + (HYENA_ORDER + 1) * MIX_B
NA_HEADS = 16
NA_HD = D_MODEL // NA_HEADS
NA_WIN_ROWS = 8
NA_WIN_COLS = 16

kernel_name = "hybrid_mlstm_hyena_natten_dit_trunk"


def rms_norm(x, gain=None):
    x32 = x.astype(jnp.float32)
    y = x32 * lax.rsqrt(jnp.mean(x32 * x32, axis=-1, keepdims=True) + EPS)
    if gain is not None:
        y = y * gain.astype(jnp.float32)
    return y.astype(x.dtype)


def rope_1d(xa, pos):
    nf = xa.shape[-1] // 2
    inv = ROPE_BASE ** (-jnp.arange(nf, dtype=jnp.float32) / nf)
    ang = pos.astype(jnp.float32)[:, None] * inv[None, :]
    cos, sin = jnp.cos(ang), jnp.sin(ang)
    x1, x2 = xa[..., :nf], xa[..., nf:]
    return jnp.concatenate([x1 * cos - x2 * sin, x1 * sin + x2 * cos], axis=-1)


def axial_rope(x, rows, cols):
    half = x.shape[-1] // 2
    return jnp.concatenate([rope_1d(x[..., :half], rows), rope_1d(x[..., half:], cols)], axis=-1)


def mlstm_zero_state(b):
    f32 = jnp.float32
    return (jnp.zeros((b, MLSTM_HEADS, MLSTM_HD, MLSTM_HD), f32),
            jnp.zeros((b, MLSTM_HEADS, MLSTM_HD), f32),
            jnp.zeros((b, MLSTM_HEADS), f32))


def mlstm_chunkwise(q, k, v, ig, lf, state):
    B, H, L, dh = q.shape
    nc = L // MLSTM_CHUNK

    def to_chunks(a):
        a = a.reshape(a.shape[:2] + (nc, MLSTM_CHUNK) + a.shape[3:])
        return jnp.moveaxis(a, 2, 0)

    tri = jnp.tril(jnp.ones((MLSTM_CHUNK, MLSTM_CHUNK), dtype=bool))

    def step(carry, inp):
        C, n, m = carry
        qc, kc, vc, ic, fc = inp
        b = jnp.cumsum(fc, axis=-1)
        dmat = b[..., :, None] - b[..., None, :] + ic[..., None, :]
        dmat = jnp.where(tri, dmat, -jnp.inf)
        inter = b + m[..., None]
        m_t = jnp.maximum(inter, jnp.max(dmat, axis=-1))
        w = jnp.exp(dmat - m_t[..., None])
        sc = jnp.exp(inter - m_t)
        qk = jnp.einsum('bhtd,bhsd->bhts', qc, kc) * w
        num = sc[..., None] * jnp.einsum('bhvk,bhtk->bhtv', C, qc) + jnp.einsum('bhts,bhsv->bhtv', qk, vc)
        den = sc * jnp.einsum('bhk,bhtk->bht', n, qc) + jnp.sum(qk, axis=-1)
        h = num / jnp.maximum(jnp.abs(den), jnp.exp(-m_t))[..., None]
        bl = b[..., -1]
        g = bl[..., None] - b + ic
        m_new = jnp.maximum(bl + m, jnp.max(g, axis=-1))
        decay = jnp.exp(bl + m - m_new)
        wk = jnp.exp(g - m_new[..., None])
        C_new = decay[..., None, None] * C + jnp.einsum('bhs,bhsv,bhsk->bhvk', wk, vc, kc)
        n_new = decay[..., None] * n + jnp.einsum('bhs,bhsk->bhk', wk, kc)
        return (C_new, n_new, m_new), h

    state, hs = lax.scan(step, state, tuple(to_chunks(a) for a in (q, k, v, ig, lf)))
    h = jnp.moveaxis(hs, 0, 2).reshape(B, H, L, dh)
    return h, state


def mlstm_bidir(q, k, v, gpre, init):
    B, L, _ = gpre.shape
    g = gpre.reshape(B, L, 4, MLSTM_HEADS).transpose(2, 0, 3, 1)
    h_f, s_f = mlstm_chunkwise(q, k, v, g[0], jax.nn.log_sigmoid(g[1]), init[0])
    fl = lambda a: jnp.flip(a, axis=2)
    h_b, s_b = mlstm_chunkwise(fl(q), fl(k), fl(v), fl(g[2]), fl(jax.nn.log_sigmoid(g[3])), init[1])
    return h_f + fl(h_b), (s_f, s_b)


def short_conv(x, w, b):
    L = x.shape[1]
    pad = HYENA_SHORT // 2
    xp = jnp.pad(x, ((0, 0), (pad, pad), (0, 0)))
    y = b
    for j in range(HYENA_SHORT):
        y = y + xp[:, j:j + L] * w[j]
    return y


def hyena_filters(L, w1, b1, w2, b2, w3, freq):
    f32 = jnp.float32
    t = jnp.linspace(0.0, 1.0, L, dtype=f32)[:, None]
    bands = (HYENA_EMB - 1) // 2
    wpos = 2.0 * math.pi * jnp.arange(L, dtype=f32) / L
    fr = jnp.linspace(1e-4, bands - 1, bands, dtype=f32)
    ang = wpos[:, None] * fr[None, :]
    emb = jnp.concatenate([t, jnp.cos(ang), -jnp.sin(ang)], axis=-1)
    h = jnp.sin(freq * (emb @ w1 + b1))
    h = jnp.sin(freq * (h @ w2 + b2))
    h = (h @ w3).astype(f32).reshape(L, HYENA_ORDER, 2, MIX_B)
    deltas = jnp.abs(jnp.linspace(math.log(HYENA_TARGET) / HYENA_SLOW, math.log(HYENA_TARGET) / HYENA_FAST, MIX_B, dtype=f32))
    h = h * jnp.exp(-t * deltas)[:, None, None, :]
    return h * lax.rsqrt(jnp.sum(h * h, axis=0, keepdims=True) + EPS)


def fft_conv(z, h):
    L = z.shape[1]
    n = 2 * L
    zf = jnp.fft.rfft(z, n=n, axis=1)
    hf = jnp.fft.rfft(h, n=n, axis=0)
    return jnp.fft.irfft(zf * hf[None], n=n, axis=1)[:, :L]


def bidir_long_conv(z, h_fwd, h_bwd):
    return fft_conv(z, h_fwd) + jnp.flip(fft_conv(jnp.flip(z, axis=1), h_bwd), axis=1)


def hyena(u, x1, x2, filt, dskip):
    z = u.astype(jnp.float32)
    for o, gate in enumerate((x1, x2)):
        z = gate.astype(jnp.float32) * (bidir_long_conv(z, filt[:, o, 0], filt[:, o, 1]) + dskip[o] * z)
    return z


def even_mixer(hx, hc, rows, cols, w_in, gate_b, hnorm, conv_w, conv_b, f_w1, f_b1, f_w2, f_b2, f_w3, f_freq, hy_d, w_out, ctx_out):
    f32 = jnp.float32
    cuts = [MIX_A, 2 * MIX_A, 3 * MIX_A, 4 * MIX_A, 4 * MIX_A + N_GATES]

    def heads(a):
        b_, l_, _ = a.shape
        return a.reshape(b_, l_, MLSTM_HEADS, MLSTM_HD).transpose(0, 2, 1, 3).astype(f32)

    def project(h, rope):
        q, k, v, o, g, hy = jnp.split(h @ w_in, cuts, axis=-1)
        q, k, v = heads(q), heads(k) * MLSTM_HD ** -0.5, heads(v)
        if rope:
            q, k = axial_rope(q, rows, cols), axial_rope(k, rows, cols)
        return q, k, v, o, g.astype(f32) + gate_b, hy

    def combine(hm, o, hy, dtype):
        b_, h_, l_, d_ = hm.shape
        hm = rms_norm(hm, hnorm.reshape(MLSTM_HEADS, 1, MLSTM_HD))
        a_out = hm.transpose(0, 2, 1, 3).reshape(b_, l_, h_ * d_) * jax.nn.sigmoid(o.astype(f32))
        u, x1, x2 = jnp.split(short_conv(hy, conv_w, conv_b), 3, axis=-1)
        filt = hyena_filters(l_, f_w1, f_b1, f_w2, f_b2, f_w3, f_freq)
        b_out = hyena(u, x1, x2, filt, hy_d)
        return (jnp.concatenate([a_out, b_out], axis=-1) @ w_out).astype(dtype)

    qc, kc, vc, oc, gc, hyc = project(hc, False)
    hm_c, ctx_states = mlstm_bidir(qc, kc, vc, gc, (mlstm_zero_state(hc.shape[0]), mlstm_zero_state(hc.shape[0])))
    q, k, v, o, g, hy = project(hx, True)
    hm_x, _ = mlstm_bidir(q, k, v, g, ctx_states)
    out_x = combine(hm_x, o, hy, hx.dtype)
    out_c = combine(hm_c, oc, hyc, hc.dtype) if ctx_out else None
    return out_x, out_c


def odd_mixer(hx, hc, w_qkv, qn, kn, rpb, w_out, ctx_out):
    f32 = jnp.float32

    def project(h):
        b_, l_, _ = h.shape
        p = (h @ w_qkv).reshape(b_, l_, 3, NA_HEADS, NA_HD)
        q = rms_norm(p[:, :, 0], qn) * NA_HD ** -0.5
        k = rms_norm(p[:, :, 1], kn)
        v = p[:, :, 2]
        return tuple(a.transpose(0, 2, 1, 3) for a in (q, k, v))

    qc, kc, vc = project(hc)
    q, k, v = project(hx)
    B, H, S, d = q.shape
    rows_n = S // GRID_W
    wr = min(NA_WIN_ROWS, rows_n)
    nk = wr * GRID_W
    q_g = q.reshape(B, H, rows_n, GRID_W, d)
    k_g = k.reshape(B, H, rows_n, GRID_W, d)
    v_g = v.reshape(B, H, rows_n, GRID_W, d)
    cidx = jnp.arange(GRID_W)
    cstart = jnp.clip(cidx - NA_WIN_COLS // 2, 0, GRID_W - NA_WIN_COLS)
    cmask = (cidx[None, :] >= cstart[:, None]) & (cidx[None, :] < cstart[:, None] + NA_WIN_COLS)
    blk_mask = jnp.broadcast_to(cmask[:, None, :], (GRID_W, wr, GRID_W)).reshape(GRID_W, nk)
    dc_idx = jnp.clip(cidx[None, :] - cidx[:, None] + NA_WIN_COLS - 1, 0, 2 * NA_WIN_COLS - 2)

    def row_block(args):
        q_r, r = args
        rs = jnp.clip(r - wr // 2, 0, rows_n - wr)
        k_blk = lax.dynamic_slice_in_dim(k_g, rs, wr, axis=2).reshape(B, H, nk, d)
        v_blk = lax.dynamic_slice_in_dim(v_g, rs, wr, axis=2).reshape(B, H, nk, d)
        dr_idx = rs + jnp.arange(wr) - r + NA_WIN_ROWS - 1
        bias = rpb[:, dr_idx[None, :, None], dc_idx[:, None, :]].reshape(H, GRID_W, nk)
        s_lat = jnp.einsum('bhqd,bhkd->bhqk', q_r, k_blk).astype(f32) + bias.astype(f32)
        s_lat = jnp.where(blk_mask, s_lat, -jnp.inf)
        s_ctx = jnp.einsum('bhqd,bhkd->bhqk', q_r, kc).astype(f32)
        p = jax.nn.softmax(jnp.concatenate([s_lat, s_ctx], axis=-1), axis=-1).astype(v.dtype)
        return (jnp.einsum('bhqk,bhkd->bhqd', p[..., :nk], v_blk)
                + jnp.einsum('bhqk,bhkd->bhqd', p[..., nk:], vc))

    o = lax.map(row_block, (jnp.moveaxis(q_g, 2, 0), jnp.arange(rows_n)))
    o = o.transpose(1, 0, 3, 2, 4).reshape(B, S, H * d)
    out_x = (o @ w_out).astype(hx.dtype)
    out_c = None
    if ctx_out:
        s = jnp.einsum('bhqd,bhkd->bhqk', qc, kc).astype(f32)
        pc = jax.nn.softmax(s, axis=-1).astype(vc.dtype)
        oc = jnp.einsum('bhqk,bhkd->bhqd', pc, vc).transpose(0, 2, 1, 3).reshape(B, -1, H * d)
        out_c = (oc @ w_out).astype(hc.dtype)
    return out_x, out_c


def sq_relu_mlp(h, w1, w2):
    return jnp.square(jax.nn.relu(h @ w1)) @ w2


def setup_inputs(seed: int = 0) -> dict:
    key = jax.random.key(seed)
    ks = iter(jax.random.split(key, 32))
    nrm = lambda shape, s: jax.random.normal(next(ks), shape, jnp.float32) * s
    D = D_MODEL
    H = MLSTM_HEADS
    f_lin = jnp.linspace(FORGET_BIAS_LO, FORGET_BIAS_HI, H, dtype=jnp.float32)
    gate_base = jnp.concatenate([jnp.zeros((H,), jnp.float32), f_lin, jnp.zeros((H,), jnp.float32), f_lin])
    return {
        "x": nrm((BATCH, SEQ, D), 1.0),
        "c": nrm((BATCH, D), 1.0),
        "ctx": nrm((BATCH, CTX_LEN, D), 1.0),
        "c_ctx": nrm((D,), 1.0),
        "w_mod": nrm((DEPTH, D, 6 * D), 0.5 * D ** -0.5),
        "b_mod": nrm((DEPTH, 6 * D), 0.01),
        "w_mlp_in": nrm((DEPTH, D, D_FF), D ** -0.5),
        "w_mlp_out": nrm((DEPTH, D_FF, D), D_FF ** -0.5),
        "e_w_in": nrm((N_EVEN, D, E_IN), D ** -0.5),
        "e_gate_b": gate_base[None, :] + nrm((N_EVEN, N_GATES), 0.1),
        "e_hnorm": 1.0 + nrm((N_EVEN, MIX_A), 0.02),
        "e_conv_w": nrm((N_EVEN, HYENA_SHORT, (HYENA_ORDER + 1) * MIX_B), HYENA_SHORT ** -0.5),
        "e_conv_b": nrm((N_EVEN, (HYENA_ORDER + 1) * MIX_B), 0.01),
        "e_f_w1": nrm((N_EVEN, HYENA_EMB, HYENA_FFN), HYENA_EMB ** -0.5),
        "e_f_b1": nrm((N_EVEN, HYENA_FFN), 0.1),
        "e_f_w2": nrm((N_EVEN, HYENA_FFN, HYENA_FFN), HYENA_FFN ** -0.5),
        "e_f_b2": nrm((N_EVEN, HYENA_FFN), 0.1),
        "e_f_w3": nrm((N_EVEN, HYENA_FFN, HYENA_ORDER * 2 * MIX_B), HYENA_FFN ** -0.5),
        "e_f_freq": 1.0 + nrm((N_EVEN, HYENA_FFN), 0.02),
        "e_hy_d": nrm((N_EVEN, HYENA_ORDER, MIX_B), 0.5),
        "e_w_out": nrm((N_EVEN, MIX_A + MIX_B, D), (MIX_A + MIX_B) ** -0.5),
        "o_w_qkv": nrm((N_ODD, D, 3 * D), D ** -0.5),
        "o_qn": 1.0 + nrm((N_ODD, NA_HD), 0.02),
        "o_kn": 1.0 + nrm((N_ODD, NA_HD), 0.02),
        "o_rpb": nrm((N_ODD, NA_HEADS, 2 * NA_WIN_ROWS - 1, 2 * NA_WIN_COLS - 1), 0.02),
        "o_w_out": nrm((N_ODD, D, D), D ** -0.5),
    }


def reference(x, c, ctx, c_ctx, w_mod, b_mod, w_mlp_in, w_mlp_out, e_w_in, e_gate_b, e_hnorm, e_conv_w, e_conv_b, e_f_w1, e_f_b1, e_f_w2, e_f_b2, e_f_w3, e_f_freq, e_hy_d, e_w_out, o_w_qkv, o_qn, o_kn, o_rpb, o_w_out):
    S = x.shape[1]
    t = jnp.arange(S)
    rows, cols = t // GRID_W, t % GRID_W
    silu_c = jax.nn.silu(c)
    silu_cc = jax.nn.silu(c_ctx)
    xc = ctx
    for l in range(DEPTH):
        last = l == DEPTH - 1
        mod_x = (silu_c @ w_mod[l] + b_mod[l])[:, None, :]
        mod_c = silu_cc @ w_mod[l] + b_mod[l]
        sh1, sc1, g1, sh2, sc2, g2 = jnp.split(mod_x, 6, axis=-1)
        csh1, csc1, cg1, csh2, csc2, cg2 = jnp.split(mod_c, 6, axis=-1)
        hx = rms_norm(x) * (1.0 + sc1) + sh1
        hc = rms_norm(xc) * (1.0 + csc1) + csh1
        i = l // 2
        if l % 2 == 0:
            mx, mc = even_mixer(hx, hc, rows, cols, e_w_in[i], e_gate_b[i], e_hnorm[i], e_conv_w[i], e_conv_b[i],
                                e_f_w1[i], e_f_b1[i], e_f_w2[i], e_f_b2[i], e_f_w3[i], e_f_freq[i], e_hy_d[i],
                                e_w_out[i], not last)
        else:
            mx, mc = odd_mixer(hx, hc, o_w_qkv[i], o_qn[i], o_kn[i], o_rpb[i], o_w_out[i], not last)
        x = x + g1 * mx
        x = x + g2 * sq_relu_mlp(rms_norm(x) * (1.0 + sc2) + sh2, w_mlp_in[l], w_mlp_out[l])
        if not last:
            xc = xc + cg1 * mc
            xc = xc + cg2 * sq_relu_mlp(rms_norm(xc) * (1.0 + csc2) + csh2, w_mlp_in[l], w_mlp_out[l])
    return x
```

```cpp
#include <hip/hip_runtime.h>
#include <hip/hip_cooperative_groups.h>
#include <cstdio>
#include <cstdint>
namespace cg = cooperative_groups;

typedef unsigned short bf16_t;
typedef short bf16x8 __attribute__((ext_vector_type(8)));
typedef float f32x4 __attribute__((ext_vector_type(4)));
typedef unsigned u32x4 __attribute__((ext_vector_type(4)));
typedef unsigned u32x2 __attribute__((ext_vector_type(2)));

#define NT 512
#define DBG_LAYER 0
#define DBG_CLS ((((row % 64) / 16) * 2) + ((ch % 32) / 16))
#ifndef PHMASK
#define PHMASK 0xFFFF
#endif
constexpr int BATCH = 16, SEQ = 2048, DM = 1024, CTXL = 256;
constexpr int NLAT = BATCH * SEQ, NCTX = BATCH * CTXL, MTOT = NLAT + NCTX;
constexpr int DFF = 4096;
constexpr float EPS = 1e-6f;
constexpr int LDS_BYTES = 147456;

constexpr size_t al256(size_t x) { return (x + 255) & ~(size_t)255; }
constexpr size_t WS_WIN = 0;
constexpr size_t WS_WOUT = al256(WS_WIN + (size_t)3840 * 1024 * 2);
constexpr size_t WS_WM1 = al256(WS_WOUT + (size_t)1024 * 1024 * 2);
constexpr size_t WS_WM2 = al256(WS_WM1 + (size_t)4096 * 1024 * 2);
constexpr size_t WS_MOD = al256(WS_WM2 + (size_t)4096 * 1024 * 2);
constexpr size_t WS_XC = al256(WS_MOD + (size_t)4 * 17 * 6144 * 4);
constexpr size_t WS_ACT = al256(WS_XC + (size_t)NCTX * 1024 * 4);
constexpr size_t WS_BIG = al256(WS_ACT + (size_t)MTOT * 1024 * 2);
constexpr size_t WS_P2 = WS_BIG + (size_t)MTOT * 2048 * 2;
constexpr size_t WS_GATES = WS_P2 + (size_t)1536 * MTOT * 2;
constexpr size_t WS_HFB = al256(WS_BIG + (size_t)MTOT * 4096 * 2);
constexpr size_t WS_FLAT = al256(WS_HFB + (size_t)2 * MTOT * 512 * 2);
constexpr size_t WS_FCTX = al256(WS_FLAT + (size_t)2 * 512 * 4096 * 2);
constexpr size_t WS_H2 = al256(WS_FCTX + (size_t)2 * 512 * 512 * 2);
constexpr size_t WS_ROPE = al256(WS_H2 + (size_t)2 * 2304 * 64 * 4);
constexpr size_t WS_END = al256(WS_ROPE + (size_t)2 * 64 * 32 * 4);
static_assert(WS_GATES + (size_t)MTOT * 16 * 4 <= WS_HFB, "projection overlay too large");

struct Params { const float* in[26]; float* out; unsigned char* ws; };

typedef float f32x2_ __attribute__((ext_vector_type(2)));
typedef __bf16 bf16x2_ __attribute__((ext_vector_type(2)));
__device__ __forceinline__ unsigned pk2(float lo, float hi) { f32x2_ v = {lo, hi}; bf16x2_ b = __builtin_convertvector(v, bf16x2_); return __builtin_bit_cast(unsigned, b); }
__device__ __forceinline__ bf16_t f2b(float x) { return (bf16_t)(pk2(x, 0.f) & 0xffffu); }
__device__ __forceinline__ float b2f(bf16_t b) { return __uint_as_float(((unsigned)b) << 16); }
__device__ __forceinline__ float blo(unsigned w) { return __uint_as_float(w << 16); }
__device__ __forceinline__ float bhi(unsigned w) { return __uint_as_float(w & 0xffff0000u); }
__device__ __forceinline__ void unpack8(u32x4 v, float* f) {
    f[0] = blo(v.x); f[1] = bhi(v.x); f[2] = blo(v.y); f[3] = bhi(v.y); f[4] = blo(v.z); f[5] = bhi(v.z); f[6] = blo(v.w); f[7] = bhi(v.w);
}
__device__ __forceinline__ u32x4 pack8(const float* f) { u32x4 r; r.x = pk2(f[0], f[1]); r.y = pk2(f[2], f[3]); r.z = pk2(f[4], f[5]); r.w = pk2(f[6], f[7]); return r; }
__device__ __forceinline__ float fsin_(float x) { float r = x * 0.15915494309189535f; r -= floorf(r); return __builtin_amdgcn_sinf(r); }
__device__ __forceinline__ float fcos_(float x) { float r = x * 0.15915494309189535f; r -= floorf(r); return __builtin_amdgcn_cosf(r); }
__device__ __forceinline__ float wave_sum(float v) {
#pragma unroll
    for (int o = 1; o < 64; o <<= 1) v += __shfl_xor(v, o);
    return v;
}
__device__ __forceinline__ f32x4 mfma16(bf16x8 a, bf16x8 b, f32x4 c) { return __builtin_amdgcn_mfma_f32_16x16x32_bf16(a, b, c, 0, 0, 0); }
__device__ __forceinline__ bf16x8 as_bf8(u32x4 v) { return __builtin_bit_cast(bf16x8, v); }

extern __shared__ __attribute__((aligned(16))) unsigned char dyn_lds[];
__device__ __forceinline__ int tid_l() { int t = threadIdx.x; asm volatile("" : "+v"(t)); return t; }

constexpr int G_BM = 256, G_BK = 64, G_HALF = 128, G_HT = G_HALF * G_BK;
__device__ __forceinline__ int lds_byte(int r, int c) {
    int st = (r >> 4) * 2 + (c >> 5), rr = r & 15, cc = c & 31, ob = rr * 64 + cc * 2;
    return st * 1024 + (ob ^ (((ob >> 9) & 1) << 5));
}
__device__ __forceinline__ void stage_rc(int b, int& R, int& C) {
    int st = b / 1024, sb = b % 1024, swz = sb ^ (((sb >> 9) & 1) << 5);
    R = (st >> 1) * 16 + swz / 64; C = (st & 1) * 32 + (swz % 64) / 2;
}

enum { EPI_INPROJ = 0, EPI_RESID = 1, EPI_RELU2 = 2 };
struct EpiArgs {
    bf16_t* o_rm; int ld_rm;
    bf16_t* o_dbg;
    bf16_t* o_cm;
    float* gates; int gate_pn;
    const float* res_lat; const float* res_ctx; float* out_lat; float* out_ctx; const float* modg;
};

#define WAIT_V_(n) asm volatile("s_waitcnt vmcnt(" #n ")" ::: "memory")
#define WAIT_V(n) WAIT_V_(n)
#ifndef GEMM_VM
#define GEMM_VM 8
#endif
#define WAIT_L(n) asm volatile("s_waitcnt lgkmcnt(" #n ")" ::: "memory")
#define BAR __builtin_amdgcn_s_barrier()
#define CFENCE asm volatile("" ::: "memory")

template <bool TR>
__device__ __forceinline__ void gemm_kloop(const bf16_t* __restrict__ A, const bf16_t* __restrict__ Bt, int K, int brow, int bcol, f32x4 (&acc)[2][2][4][2]) {
    bf16_t* shm = (bf16_t*)dyn_lds;
#define SA(b, h) (shm + ((b) * 2 + (h)) * G_HT)
#define SB(b, h) (shm + (4 + (b) * 2 + (h)) * G_HT)
    const int tidx = tid_l();
    const int wid = tidx >> 6, lane = tidx & 63, wr = wid >> 2, wc = wid & 3, fr = lane & 15, fq = lane >> 4;
    const int nt = K / G_BK;
    int goff[2];
#pragma unroll
    for (int i = 0; i < 2; ++i) { int r_, c_; stage_rc(tidx * 16 + i * 8192, r_, c_); goff[i] = r_ * K + c_; }
    const bf16_t* Ab = A + (long)brow * K; const bf16_t* Bb = Bt + (long)bcol * K;
#define STAGE2(P, BASEP, kt) do { _Pragma("unroll") for (int _i = 0; _i < 2; ++_i) \
      __builtin_amdgcn_global_load_lds((const unsigned*)((BASEP) + (kt) * G_BK + goff[_i]), (unsigned*)((char*)(P) + tidx * 16 + _i * 8192), 16, 0, 0); } while (0)
    STAGE2(SA(0, 0), Ab, 0); STAGE2(SA(0, 1), Ab + (long)G_HALF * K, 0); STAGE2(SB(0, 0), Bb, 0); STAGE2(SB(0, 1), Bb + (long)G_HALF * K, 0);
    for (int kt = 0; kt < nt; ++kt) {
        const int cur = kt & 1, nxt = cur ^ 1;
        if (kt + 1 < nt) {
            STAGE2(SA(nxt, 0), Ab, kt + 1); STAGE2(SA(nxt, 1), Ab + (long)G_HALF * K, kt + 1);
            STAGE2(SB(nxt, 0), Bb, kt + 1); STAGE2(SB(nxt, 1), Bb + (long)G_HALF * K, kt + 1);
            WAIT_V(GEMM_VM);
        } else { WAIT_V(0); }
        BAR; CFENCE;
#pragma unroll
        for (int k = 0; k < 2; ++k) {
            bf16x8 Bf[2][2];
#pragma unroll
            for (int bj = 0; bj < 2; ++bj)
#pragma unroll
                for (int n = 0; n < 2; ++n) Bf[bj][n] = *reinterpret_cast<const bf16x8*>((char*)SB(cur, bj) + lds_byte(wc * 32 + n * 16 + fr, k * 32 + fq * 8));
#pragma unroll
            for (int ai = 0; ai < 2; ++ai) {
                bf16x8 Af[4];
#pragma unroll
                for (int m = 0; m < 4; ++m) Af[m] = *reinterpret_cast<const bf16x8*>((char*)SA(cur, ai) + lds_byte(wr * 64 + m * 16 + fr, k * 32 + fq * 8));
#pragma unroll
                for (int m = 0; m < 4; ++m)
#pragma unroll
                    for (int bj = 0; bj < 2; ++bj)
#pragma unroll
                        for (int n = 0; n < 2; ++n)
                            acc[ai][bj][m][n] = TR ? mfma16(Bf[bj][n], Af[m], acc[ai][bj][m][n]) : mfma16(Af[m], Bf[bj][n], acc[ai][bj][m][n]);
            }
        }
        WAIT_L(0); BAR; CFENCE;
    }
}

template <int EPI>
__device__ __forceinline__ void gemm_phase(const bf16_t* A, const bf16_t* Bt, int M, int N, int K, const EpiArgs& ea) {
    const int nM = M / G_BM, nN = N / G_BM, nwg = nM * nN;
    const int tidx = tid_l(); const int wid = tidx >> 6, lane = tidx & 63, wr = wid >> 2, wc = wid & 3, fr = lane & 15, fq = lane >> 4;
    for (int L = blockIdx.x; L < nwg; L += gridDim.x) {
        int wgid = L;
        { int q = nwg / 8, r = nwg % 8, xcd = wgid % 8, off = wgid / 8; wgid = (xcd < r ? xcd * (q + 1) : r * (q + 1) + (xcd - r) * q) + off; }
        const int nig = 8 * nN, gid = wgid / nig, fm = gid * 8, gsz = min(nM - fm, 8);
        const int pm = fm + ((wgid % nig) % gsz), pn = (wgid % nig) / gsz, brow = pm * G_BM, bcol = pn * G_BM;
        f32x4 acc[2][2][4][2];
#pragma unroll
        for (int a = 0; a < 2; ++a)
#pragma unroll
            for (int b = 0; b < 2; ++b)
#pragma unroll
                for (int m = 0; m < 4; ++m)
#pragma unroll
                    for (int n = 0; n < 2; ++n) acc[a][b][m][n] = (f32x4){0.f, 0.f, 0.f, 0.f};
        const bool colmajor = (EPI == EPI_INPROJ) && pn >= 8 && pn != ea.gate_pn;
        if (colmajor) {
            gemm_kloop<true>(A, Bt, K, brow, bcol, acc);
#pragma unroll
            for (int ai = 0; ai < 2; ++ai)
#pragma unroll
                for (int bj = 0; bj < 2; ++bj)
#pragma unroll
                    for (int m = 0; m < 4; ++m)
#pragma unroll
                        for (int n = 0; n < 2; ++n) {
                            const int row = brow + ai * 128 + wr * 64 + m * 16 + fr, col = bcol + bj * 128 + wc * 32 + n * 16 + fq * 4;
                            const f32x4 v = acc[ai][bj][m][n];
#pragma unroll
                            for (int j = 0; j < 4; ++j) ea.o_cm[(size_t)(col + j - 2048) * MTOT + row] = f2b(v[j]);
                        }
        } else {
            gemm_kloop<true>(A, Bt, K, brow, bcol, acc);
#pragma unroll
            for (int ai = 0; ai < 2; ++ai)
#pragma unroll
                for (int m = 0; m < 4; ++m) {
                    const int row = brow + ai * 128 + wr * 64 + m * 16 + fr;
#pragma unroll
                    for (int bj = 0; bj < 2; ++bj)
#pragma unroll
                        for (int n = 0; n < 2; ++n) {
                            const int col = bcol + bj * 128 + wc * 32 + n * 16 + fq * 4;
                            const f32x4 v = acc[ai][bj][m][n];
                            if (EPI == EPI_INPROJ) {
                                if (pn == ea.gate_pn) {
                                    if (bj == 0 && wc == 0 && n == 0) *(f32x4*)(ea.gates + (size_t)row * 16 + fq * 4) = v;
                                } else {
                                    u32x2 o; o.x = pk2(v[0], v[1]); o.y = pk2(v[2], v[3]);
                                    *(u32x2*)(ea.o_rm + (size_t)row * ea.ld_rm + col) = o;
                                }
                            } else if (EPI == EPI_RELU2) {
                                float r0 = fmaxf(v[0], 0.f), r1 = fmaxf(v[1], 0.f), r2 = fmaxf(v[2], 0.f), r3 = fmaxf(v[3], 0.f);
                                u32x2 o; o.x = pk2(r0 * r0, r1 * r1); o.y = pk2(r2 * r2, r3 * r3);
                                *(u32x2*)(ea.o_rm + (size_t)row * ea.ld_rm + col) = o;
                            } else {
                                const float* rp; float* op; int mrow;
                                if (row < NLAT) { rp = ea.res_lat + (size_t)row * 1024 + col; op = ea.out_lat + (size_t)row * 1024 + col; mrow = row >> 11; }
                                else { rp = ea.res_ctx + (size_t)(row - NLAT) * 1024 + col; op = ea.out_ctx + (size_t)(row - NLAT) * 1024 + col; mrow = 16; }
                                const f32x4 g = *(const f32x4*)(ea.modg + (size_t)mrow * 6144 + col);
                                const f32x4 x = *(const f32x4*)rp;
                                f32x4 rr = x + g * v;
#ifdef SANITIZE
#pragma unroll
                                for (int q_ = 0; q_ < 4; ++q_) if (!(fabsf(rr[q_]) < 1e30f)) rr[q_] = 0.f;
#endif
                                *(f32x4*)op = rr;
                            }
                        }
                }
        }
        asm volatile("s_waitcnt vmcnt(0)" ::: "memory");
        __syncthreads();
    }
}

__device__ __forceinline__ void phase0(const Params& p) {
    const int tid = tid_l(), blk = blockIdx.x, nb = gridDim.x;
    float* MOD = (float*)(p.ws + WS_MOD);
    for (int it = blk; it < 193; it += nb) {
        if (it < 192) {
            float* sl = (float*)dyn_lds;
            float* red = sl + 17 * 1024;
            for (int i = tid; i < 17 * 1024; i += NT) { float v = (i < 16 * 1024) ? p.in[1][i] : p.in[3][i - 16 * 1024]; sl[i] = v / (1.f + __expf(-v)); }
            __syncthreads();
            const int l = it / 48, nc = it % 48, kp = tid >> 7, col = tid & 127;
            const float* W = p.in[4] + (size_t)l * 1024 * 6144 + nc * 128 + col;
            float acc[17];
#pragma unroll
            for (int r = 0; r < 17; ++r) acc[r] = 0.f;
            for (int k = kp * 256; k < kp * 256 + 256; ++k) {
                const float wv = W[(size_t)k * 6144];
#pragma unroll
                for (int r = 0; r < 17; ++r) acc[r] += sl[r * 1024 + k] * wv;
            }
#pragma unroll
            for (int r = 0; r < 17; ++r) red[(kp * 17 + r) * 128 + col] = acc[r];
            __syncthreads();
            for (int i = tid; i < 17 * 128; i += NT) {
                const int r = i >> 7, cc = i & 127;
                const float s = red[(0 * 17 + r) * 128 + cc] + red[(1 * 17 + r) * 128 + cc] + red[(2 * 17 + r) * 128 + cc] + red[(3 * 17 + r) * 128 + cc];
                MOD[((size_t)l * 17 + r) * 6144 + nc * 128 + cc] = s + p.in[5][l * 6144 + nc * 128 + cc];
            }
            __syncthreads();
        } else {
            float* ROPE = (float*)(p.ws + WS_ROPE);
            for (int i = tid; i < 2048; i += NT) {
                const int pos = i >> 5, j = i & 31;
                const float inv = exp2f(-(float)j * (13.287712379549449f / 32.f));
                const float ang = (float)pos * inv;
                ROPE[i] = fcos_(ang); ROPE[2048 + i] = fsin_(ang);
            }
        }
    }
    float* H2 = (float*)(p.ws + WS_H2);
    const int gw = blk * 8 + (tid >> 6), lane = tid & 63;
    for (int it = gw; it < 2 * 2304; it += nb * 8) {
        const int i = it / 2304, row = it % 2304;
        const int L = row < 2048 ? 2048 : 256, t = row < 2048 ? row : row - 2048;
        const float tn = (float)t / (float)(L - 1);
        const float wpos = 6.283185307179586f * (float)t / (float)L;
        float ev = 0.f;
        if (lane == 0) ev = tn;
        else if (lane <= 16) { const float fr = 1e-4f + (float)(lane - 1) * ((15.f - 1e-4f) / 15.f); ev = fcos_(wpos * fr); }
        else if (lane <= 32) { const float fr = 1e-4f + (float)(lane - 17) * ((15.f - 1e-4f) / 15.f); ev = -fsin_(wpos * fr); }
        const float* w1 = p.in[13] + i * 33 * 64; const float* b1 = p.in[14] + i * 64;
        const float* w2 = p.in[15] + i * 64 * 64; const float* b2 = p.in[16] + i * 64; const float* fq = p.in[18] + i * 64;
        float a = b1[lane];
        for (int e = 0; e < 33; ++e) a += __shfl(ev, e) * w1[e * 64 + lane];
        const float h1 = fsin_(fq[lane] * a);
        float a2 = b2[lane];
        for (int e = 0; e < 64; ++e) a2 += __shfl(h1, e) * w2[e * 64 + lane];
        H2[((size_t)i * 2304 + row) * 64 + lane] = fsin_(fq[lane] * a2);
    }
}

__device__ __forceinline__ void cvt_tile(const float* W, int N, int K, bf16_t* WT, int n0, int k0, int mapmode) {
    float* tl = (float*)dyn_lds;
    const int tid = tid_l(), nl = tid & 63, kb = tid >> 6;
    const int n = n0 + nl; int sc = n;
    if (mapmode == 1) sc = n < 2048 ? n : (n < 3584 ? n + 16 : (n < 3600 ? n - 3584 + 2048 : -1));
#pragma unroll
    for (int i = 0; i < 8; ++i) { const int kl = kb + 8 * i; tl[kl * 65 + nl] = sc >= 0 ? W[(size_t)(k0 + kl) * N + sc] : 0.f; }
    __syncthreads();
    const int nn = tid >> 3, kc = tid & 7;
    float f[8];
#pragma unroll
    for (int j = 0; j < 8; ++j) f[j] = tl[(kc * 8 + j) * 65 + nn];
    *(u32x4*)(WT + (size_t)(n0 + nn) * K + k0 + kc * 8) = pack8(f);
    __syncthreads();
}

__device__ __forceinline__ void convert_weights(const Params& p, int l) {
    const int blk = blockIdx.x, nb = gridDim.x, li = l >> 1; const bool even = !(l & 1);
    const int nin = even ? 60 : 48;
    const int t_in = nin * 16, t_out = 256, t_m1 = 1024, t_m2 = 1024;
    const int total = t_in + t_out + t_m1 + t_m2;
    for (int it = blk; it < total; it += nb) {
        int r = it;
        if (r < t_in) {
            const int nt = r / 16, kt = r % 16;
            if (even) cvt_tile(p.in[8] + (size_t)li * 1024 * 3600, 3600, 1024, (bf16_t*)(p.ws + WS_WIN), nt * 64, kt * 64, 1);
            else cvt_tile(p.in[21] + (size_t)li * 1024 * 3072, 3072, 1024, (bf16_t*)(p.ws + WS_WIN), nt * 64, kt * 64, 0);
            continue;
        }
        r -= t_in;
        if (r < t_out) {
            const int nt = r / 16, kt = r % 16;
            cvt_tile((even ? p.in[20] : p.in[25]) + (size_t)li * 1024 * 1024, 1024, 1024, (bf16_t*)(p.ws + WS_WOUT), nt * 64, kt * 64, 0);
            continue;
        }
        r -= t_out;
        if (r < t_m1) {
            const int nt = r / 16, kt = r % 16;
            cvt_tile(p.in[6] + (size_t)l * 1024 * 4096, 4096, 1024, (bf16_t*)(p.ws + WS_WM1), nt * 64, kt * 64, 0);
            continue;
        }
        r -= t_m1;
        { const int nt = r / 64, kt = r % 64;
          cvt_tile(p.in[7] + (size_t)l * 4096 * 1024, 1024, 4096, (bf16_t*)(p.ws + WS_WM2), nt * 64, kt * 64, 0); }
    }
}

__device__ __forceinline__ void norm_phase(const Params& p, int l, const float* xlat, const float* xctx, int shoff, int scoff, int M) {
    const int tid = tid_l(), lane = tid & 63, gw = blockIdx.x * 8 + (tid >> 6), ngw = gridDim.x * 8;
    const float* MOD = (const float*)(p.ws + WS_MOD) + (size_t)l * 17 * 6144;
    bf16_t* ACT = (bf16_t*)(p.ws + WS_ACT);
    for (int row = gw; row < M; row += ngw) {
        const float* xr = row < NLAT ? xlat + (size_t)row * 1024 : xctx + (size_t)(row - NLAT) * 1024;
        const int mrow = row < NLAT ? row >> 11 : 16;
        const float* mod = MOD + (size_t)mrow * 6144;
        f32x4 v[4]; float ss = 0.f;
#pragma unroll
        for (int j = 0; j < 4; ++j) { v[j] = *(const f32x4*)(xr + 4 * lane + 256 * j); ss += v[j][0] * v[j][0] + v[j][1] * v[j][1] + v[j][2] * v[j][2] + v[j][3] * v[j][3]; }
        ss = wave_sum(ss);
        const float rstd = rsqrtf(ss * (1.f / 1024.f) + EPS);
#pragma unroll
        for (int j = 0; j < 4; ++j) {
            const int col = 4 * lane + 256 * j;
            const f32x4 sh = *(const f32x4*)(mod + shoff + col), sc = *(const f32x4*)(mod + scoff + col);
            const f32x4 y = v[j] * rstd * (sc + 1.f) + sh;
            u32x2 o; o.x = pk2(y[0], y[1]); o.y = pk2(y[2], y[3]);
            *(u32x2*)(ACT + (size_t)row * 1024 + col) = o;
        }
    }
}

__device__ __forceinline__ void filter_gen(const Params& p, int li) {
    const int tid = tid_l(), lane = tid & 63, w = tid >> 6;
    float* wf = (float*)dyn_lds; float* wb = wf + 64; float* red = wb + 64;
    const float* H2 = (const float*)(p.ws + WS_H2);
    for (int it = blockIdx.x; it < 2048; it += gridDim.x) {
        const int ltype = it >> 10, o = (it >> 9) & 1, c = it & 511;
        const int L = ltype ? 256 : 2048;
        const float* H2r = H2 + ((size_t)li * 2304 + (ltype ? 2048 : 0)) * 64;
        const float* w3 = p.in[17] + (size_t)li * 64 * 2048;
        if (tid < 64) wf[tid] = w3[tid * 2048 + (o * 2 + 0) * 512 + c];
        else if (tid < 128) wb[tid - 64] = w3[(tid - 64) * 2048 + (o * 2 + 1) * 512 + c];
        __syncthreads();
        const float lo = -4.605170185988091f / 1.5f, hi = -4.605170185988091f / 0.3f;
        const float delta = fabsf(lo + (hi - lo) * (float)c / 511.f);
        float vf[4], vb[4]; float ssf = 0.f, ssb = 0.f;
#pragma unroll
        for (int q = 0; q < 4; ++q) {
            const int t = tid + 512 * q; vf[q] = 0.f; vb[q] = 0.f;
            if (t < L) {
                float df = 0.f, db = 0.f;
                const f32x4* hr = (const f32x4*)(H2r + (size_t)t * 64);
#pragma unroll
                for (int j = 0; j < 16; ++j) { const f32x4 hv = hr[j];
                    df += hv[0] * wf[4 * j] + hv[1] * wf[4 * j + 1] + hv[2] * wf[4 * j + 2] + hv[3] * wf[4 * j + 3];
                    db += hv[0] * wb[4 * j] + hv[1] * wb[4 * j + 1] + hv[2] * wb[4 * j + 2] + hv[3] * wb[4 * j + 3]; }
                const float dec = __expf(-((float)t / (float)(L - 1)) * delta);
                vf[q] = df * dec; vb[q] = db * dec; ssf += vf[q] * vf[q]; ssb += vb[q] * vb[q];
            }
        }
        ssf = wave_sum(ssf); ssb = wave_sum(ssb);
        if (lane == 0) { red[w] = ssf; red[8 + w] = ssb; }
        __syncthreads();
        float tf = 0.f, tb = 0.f;
#pragma unroll
        for (int i = 0; i < 8; ++i) { tf += red[i]; tb += red[8 + i]; }
        const float nf = rsqrtf(tf + EPS), nbk = rsqrtf(tb + EPS);
        bf16_t* dst = ltype ? (bf16_t*)(p.ws + WS_FCTX) + ((size_t)o * 512 + c) * 512 : (bf16_t*)(p.ws + WS_FLAT) + ((size_t)o * 512 + c) * 4096;
#pragma unroll
        for (int q = 0; q < 4; ++q) {
            const int t = tid + 512 * q;
            if (t < L) {
                if (t == 0) { dst[L] = f2b(vf[q] * nf + vb[q] * nbk); dst[0] = 0; }
                else { dst[L + t] = f2b(vf[q] * nf); dst[L - t] = f2b(vb[q] * nbk); }
            }
        }
        __syncthreads();
    }
}

__device__ __forceinline__ void mlstm_item(const Params& p, int li, int it) {
    const int tid = tid_l(), w = tid >> 6, lane = tid & 63, fr = lane & 15, fq = lane >> 4;
    const int b = it >> 3, h = (it >> 1) & 3, dir = it & 1;
    bf16_t* Qs = (bf16_t*)dyn_lds;
    bf16_t* Ks = Qs + 64 * 136;
    bf16_t* KT = Ks + 64 * 136;
    bf16_t* VT = KT + 128 * 72;
    bf16_t* Cb = VT + 144 * 72;
    bf16_t* Ps = Cb + 144 * 136;
    float* fl = (float*)(Ps + 64 * 72);
    float* a_s = fl; float* Mt = fl + 64; float* scs = fl + 128; float* emt = fl + 192; float* den = fl + 256; float* lfs = fl + 320; float* igs = fl + 384; float* scal = fl + 448;
    const bf16_t* QKVO = (const bf16_t*)(p.ws + WS_BIG);
    const float* GATES = (const float*)(p.ws + WS_GATES);
    bf16_t* HFB = (bf16_t*)(p.ws + WS_HFB) + (size_t)dir * MTOT * 512;
    const float* ROPE = (const float*)(p.ws + WS_ROPE);
    const float* gate_b = p.in[9] + li * 16;
    for (int i = tid; i < 144 * 136 / 2; i += NT) ((unsigned*)Cb)[i] = 0u;
    for (int i = tid; i < 16 * 72; i += NT) { const int r = i / 72, ci = i % 72; VT[(128 + r) * 72 + ci] = (r == 0 && ci < 64) ? (bf16_t)0x3F80 : (bf16_t)0; }
    f32x4 cacc[9];
#pragma unroll
    for (int i = 0; i < 9; ++i) cacc[i] = (f32x4){0.f, 0.f, 0.f, 0.f};
    float m = 0.f;
    __syncthreads();
    for (int step = 0; step < 36; ++step) {
        const bool isctx = step < 4;
        const int cj = isctx ? (dir ? 3 - step : step) : (dir ? 35 - step : step - 4);
        const int rowbase = isctx ? NLAT + b * 256 + cj * 64 : b * 2048 + cj * 64;
        {
            const int r = tid >> 3, seg = tid & 7; const int tl = dir ? 63 - r : r;
            const bf16_t* src = QKVO + (size_t)(rowbase + tl) * 2048 + h * 128;
            const int hb = seg >> 2, jb = (seg & 3) * 8, d1 = hb * 64 + jb, d2 = d1 + 32;
            const u32x4 q1 = *(const u32x4*)(src + d1), q2 = *(const u32x4*)(src + d2);
            const u32x4 k1 = *(const u32x4*)(src + 512 + d1), k2 = *(const u32x4*)(src + 512 + d2);
            const u32x4 v1 = *(const u32x4*)(src + 1024 + seg * 16), v2 = *(const u32x4*)(src + 1024 + seg * 16 + 8);
            float cs[8], sn[8];
            if (!isctx) {
                const int pos = hb ? tl : cj;
                const f32x4 c0 = *(const f32x4*)(ROPE + pos * 32 + jb), c1 = *(const f32x4*)(ROPE + pos * 32 + jb + 4);
                const f32x4 s0 = *(const f32x4*)(ROPE + 2048 + pos * 32 + jb), s1 = *(const f32x4*)(ROPE + 2048 + pos * 32 + jb + 4);
#pragma unroll
                for (int e = 0; e < 4; ++e) { cs[e] = c0[e]; cs[4 + e] = c1[e]; sn[e] = s0[e]; sn[4 + e] = s1[e]; }
            } else {
#pragma unroll
                for (int e = 0; e < 8; ++e) { cs[e] = 1.f; sn[e] = 0.f; }
            }
            float x1[8], x2[8], o1[8], o2[8];
            unpack8(q1, x1); unpack8(q2, x2);
#pragma unroll
            for (int e = 0; e < 8; ++e) { o1[e] = x1[e] * cs[e] - x2[e] * sn[e]; o2[e] = x1[e] * sn[e] + x2[e] * cs[e]; }
            *(u32x4*)(Qs + r * 136 + d1) = pack8(o1); *(u32x4*)(Qs + r * 136 + d2) = pack8(o2);
            unpack8(k1, x1); unpack8(k2, x2);
            const float ksc = 0.08838834764831845f;
#pragma unroll
            for (int e = 0; e < 8; ++e) { o1[e] = (x1[e] * cs[e] - x2[e] * sn[e]) * ksc; o2[e] = (x1[e] * sn[e] + x2[e] * cs[e]) * ksc; }
            const u32x4 ko1 = pack8(o1), ko2 = pack8(o2);
            *(u32x4*)(Ks + r * 136 + d1) = ko1; *(u32x4*)(Ks + r * 136 + d2) = ko2;
            {
                const unsigned kw1[4] = {ko1.x, ko1.y, ko1.z, ko1.w}, kw2[4] = {ko2.x, ko2.y, ko2.z, ko2.w};
#pragma unroll
                for (int e = 0; e < 4; ++e) {
                    KT[(d1 + 2 * e) * 72 + r] = (bf16_t)(kw1[e] & 0xffffu); KT[(d1 + 2 * e + 1) * 72 + r] = (bf16_t)(kw1[e] >> 16);
                    KT[(d2 + 2 * e) * 72 + r] = (bf16_t)(kw2[e] & 0xffffu); KT[(d2 + 2 * e + 1) * 72 + r] = (bf16_t)(kw2[e] >> 16);
                }
                const unsigned vw1[4] = {v1.x, v1.y, v1.z, v1.w}, vw2[4] = {v2.x, v2.y, v2.z, v2.w};
#pragma unroll
                for (int e = 0; e < 4; ++e) {
                    VT[(seg * 16 + 2 * e) * 72 + r] = (bf16_t)(vw1[e] & 0xffffu); VT[(seg * 16 + 2 * e + 1) * 72 + r] = (bf16_t)(vw1[e] >> 16);
                    VT[(seg * 16 + 8 + 2 * e) * 72 + r] = (bf16_t)(vw2[e] & 0xffffu); VT[(seg * 16 + 8 + 2 * e + 1) * 72 + r] = (bf16_t)(vw2[e] >> 16);
                }
            }
            if (tid < 64) {
                const int rr = tid, tl2 = dir ? 63 - rr : rr;
                const float* g = GATES + (size_t)(rowbase + tl2) * 16;
                const float ig = g[dir * 8 + h] + gate_b[dir * 8 + h];
                const float fg = g[dir * 8 + 4 + h] + gate_b[dir * 8 + 4 + h];
                igs[rr] = ig; lfs[rr] = fminf(fg, 0.f) - __logf(1.f + __expf(-fabsf(fg)));
            }
        }
        __syncthreads();
        if (w == 0) {
            float bcs = lfs[lane];
#pragma unroll
            for (int o = 1; o < 64; o <<= 1) { const float t = __shfl_up(bcs, o); if (lane >= o) bcs += t; }
            const float a = igs[lane] - bcs;
            float pm = a;
#pragma unroll
            for (int o = 1; o < 64; o <<= 1) { const float t = __shfl_up(pm, o); if (lane >= o) pm = fmaxf(pm, t); }
            const float Mx = fmaxf(m, pm);
            a_s[lane] = a; Mt[lane] = Mx; scs[lane] = __expf(m - Mx); emt[lane] = __expf(-bcs - Mx);
            if (lane == 63) { scal[0] = bcs; scal[1] = Mx; }
        }
        {
            const int st = w & 3, tt0 = (w >> 2) * 2;
            f32x4 sacc[2];
#pragma unroll
            for (int u = 0; u < 2; ++u) {
                sacc[u] = (f32x4){0.f, 0.f, 0.f, 0.f};
#pragma unroll
                for (int kk = 0; kk < 4; ++kk) {
                    const bf16x8 Ak = *(const bf16x8*)(Ks + (st * 16 + fr) * 136 + kk * 32 + fq * 8);
                    const bf16x8 Bq = *(const bf16x8*)(Qs + ((tt0 + u) * 16 + fr) * 136 + kk * 32 + fq * 8);
                    sacc[u] = mfma16(Ak, Bq, sacc[u]);
                }
            }
            __syncthreads();
#pragma unroll
            for (int u = 0; u < 2; ++u) {
                const int t = (tt0 + u) * 16 + fr, sb = st * 16 + fq * 4;
                const float Mv = Mt[t];
                float pv[4];
#pragma unroll
                for (int j = 0; j < 4; ++j) { const int s = sb + j; pv[j] = (s <= t) ? sacc[u][j] * __expf(a_s[s] - Mv) : 0.f; }
                u32x2 o; o.x = pk2(pv[0], pv[1]); o.y = pk2(pv[2], pv[3]);
                *(u32x2*)(Ps + t * 72 + sb) = o;
            }
        }
        __syncthreads();
        {
            const int tt = w & 3, up = w >> 2, vt0 = up ? 5 : 0, nvt = up ? 4 : 5;
            bf16x8 qf[4], pf[2];
#pragma unroll
            for (int kk = 0; kk < 4; ++kk) qf[kk] = *(const bf16x8*)(Qs + (tt * 16 + fr) * 136 + kk * 32 + fq * 8);
#pragma unroll
            for (int kk = 0; kk < 2; ++kk) pf[kk] = *(const bf16x8*)(Ps + (tt * 16 + fr) * 72 + kk * 32 + fq * 8);
            const float sct = scs[tt * 16 + fr];
            f32x4 hacc[5];
#pragma unroll
            for (int vi = 0; vi < 5; ++vi) {
                hacc[vi] = (f32x4){0.f, 0.f, 0.f, 0.f};
                if (vi < nvt) {
                    const int v0 = (vt0 + vi) * 16;
                    f32x4 ac = (f32x4){0.f, 0.f, 0.f, 0.f};
#pragma unroll
                    for (int kk = 0; kk < 4; ++kk) ac = mfma16(*(const bf16x8*)(Cb + (v0 + fr) * 136 + kk * 32 + fq * 8), qf[kk], ac);
                    ac = ac * sct;
#pragma unroll
                    for (int kk = 0; kk < 2; ++kk) ac = mfma16(*(const bf16x8*)(VT + (v0 + fr) * 72 + kk * 32 + fq * 8), pf[kk], ac);
                    hacc[vi] = ac;
                }
            }
            if (up && fq == 0) den[tt * 16 + fr] = hacc[3][0];
            __syncthreads();
            const int t = tt * 16 + fr, tl = dir ? 63 - t : t;
            const float dn = den[t];
            const float inv = 1.f / fmaxf(fabsf(dn), emt[t]);
            bf16_t* orow = HFB + (size_t)(rowbase + tl) * 512 + h * 128;
#pragma unroll
            for (int vi = 0; vi < 5; ++vi) {
                if (vi < nvt && (vt0 + vi) < 8) {
                    const int v0 = (vt0 + vi) * 16 + fq * 4;
                    u32x2 o; o.x = pk2(hacc[vi][0] * inv, hacc[vi][1] * inv); o.y = pk2(hacc[vi][2] * inv, hacc[vi][3] * inv);
                    *(u32x2*)(orow + v0) = o;
                }
            }
        }
        {
            const float bl = scal[0], M63 = scal[1];
            const float decay = __expf(m - M63);
            bf16x8 ka[2];
#pragma unroll
            for (int kk = 0; kk < 2; ++kk) {
                const u32x4 raw = *(const u32x4*)(KT + (w * 16 + fr) * 72 + kk * 32 + fq * 8);
                float f[8]; unpack8(raw, f);
#pragma unroll
                for (int j = 0; j < 8; ++j) f[j] *= __expf(a_s[kk * 32 + fq * 8 + j] - M63);
                ka[kk] = as_bf8(pack8(f));
            }
#pragma unroll
            for (int vt = 0; vt < 9; ++vt) {
                f32x4 ac = cacc[vt] * decay;
#pragma unroll
                for (int kk = 0; kk < 2; ++kk) ac = mfma16(ka[kk], *(const bf16x8*)(VT + (vt * 16 + fr) * 72 + kk * 32 + fq * 8), ac);
                cacc[vt] = ac;
                u32x2 o; o.x = pk2(ac[0], ac[1]); o.y = pk2(ac[2], ac[3]);
                *(u32x2*)(Cb + (vt * 16 + fr) * 136 + w * 16 + fq * 4) = o;
            }
            m = bl + M63;
        }
        __syncthreads();
    }
}

__device__ __forceinline__ void combine_phase(const Params& p, int li) {
    const int tid = tid_l(), lane = tid & 63, gw = blockIdx.x * 8 + (tid >> 6), ngw = gridDim.x * 8;
    const bf16_t* HF = (const bf16_t*)(p.ws + WS_HFB); const bf16_t* HB = HF + (size_t)MTOT * 512;
    const bf16_t* QKVO = (const bf16_t*)(p.ws + WS_BIG);
    bf16_t* MIX = (bf16_t*)(p.ws + WS_ACT);
    const float* hn = p.in[10] + li * 512 + lane * 8;
    float g[8];
#pragma unroll
    for (int e = 0; e < 8; ++e) g[e] = hn[e];
    for (int row = gw; row < MTOT; row += ngw) {
        float a[8], bq[8], og[8], y[8];
        unpack8(*(const u32x4*)(HF + (size_t)row * 512 + lane * 8), a);
        unpack8(*(const u32x4*)(HB + (size_t)row * 512 + lane * 8), bq);
        unpack8(*(const u32x4*)(QKVO + (size_t)row * 2048 + 1536 + lane * 8), og);
        float ss = 0.f;
#pragma unroll
        for (int e = 0; e < 8; ++e) { a[e] += bq[e]; ss += a[e] * a[e]; }
        ss += __shfl_xor(ss, 1); ss += __shfl_xor(ss, 2); ss += __shfl_xor(ss, 4); ss += __shfl_xor(ss, 8);
        const float rstd = rsqrtf(ss * (1.f / 128.f) + EPS);
#pragma unroll
        for (int e = 0; e < 8; ++e) y[e] = a[e] * rstd * g[e] / (1.f + __expf(-og[e]));
        *(u32x4*)(MIX + (size_t)row * 1024 + lane * 8) = pack8(y);
    }
}

template <int L>
__device__ __forceinline__ void hyena_item(const Params& p, int li, int c) {
    constexpr int ZS = L + 8, NI = L / 128, NS = L / 32;
    const int tid = tid_l(), w = tid >> 6, lane = tid & 63, fr = lane & 15, fq = lane >> 4;
    bf16_t* ZA = (bf16_t*)dyn_lds; bf16_t* ZB = ZA + 16 * ZS; bf16_t* HFl = ZB + 16 * ZS;
    const int segbase = (L == 2048) ? 0 : NLAT;
    const bf16_t* HYT = (const bf16_t*)(p.ws + WS_P2);
    bf16_t* MIX = (bf16_t*)(p.ws + WS_ACT);
    const float* cw = p.in[11] + (size_t)li * 3 * 1536; const float* cb = p.in[12] + (size_t)li * 1536; const float* hd = p.in[19] + (size_t)li * 2 * 512;
    const bf16_t* FIL = (L == 2048) ? (const bf16_t*)(p.ws + WS_FLAT) : (const bf16_t*)(p.ws + WS_FCTX);
    {
        const float w0 = cw[c], w1 = cw[1536 + c], w2 = cw[2 * 1536 + c], bb = cb[c];
        const bf16_t* src = HYT + (size_t)c * MTOT + segbase;
        for (int ch = tid; ch < 16 * L / 8; ch += NT) {
            const int b = ch / (L / 8), t0 = (ch % (L / 8)) * 8;
            const bf16_t* s = src + b * L + t0;
            float x[10], y[8];
            x[0] = t0 > 0 ? b2f(s[-1]) : 0.f;
            unpack8(*(const u32x4*)s, x + 1);
            x[9] = (t0 + 8 < L) ? b2f(s[8]) : 0.f;
#pragma unroll
            for (int e = 0; e < 8; ++e) y[e] = bb + w0 * x[e] + w1 * x[e + 1] + w2 * x[e + 2];
            *(u32x4*)(ZA + b * ZS + t0) = pack8(y);
        }
    }
#pragma unroll 1
    for (int o = 0; o < 2; ++o) {
        for (int i = tid; i < 2 * L / 8; i += NT) *(u32x4*)(HFl + i * 8) = *(const u32x4*)(FIL + ((size_t)o * 512 + c) * 2 * L + i * 8);
        __syncthreads();
        const bf16_t* Zin = o ? ZB : ZA;
        const int gc = (o + 1) * 512 + c;
        const float gw0 = cw[gc], gw1 = cw[1536 + gc], gw2 = cw[2 * 1536 + gc], gb = cb[gc], dsk = hd[o * 512 + c];
        const bf16_t* gs = HYT + (size_t)gc * MTOT + segbase + fr * L;
        constexpr int NIB = NI < 8 ? NI : 8;
#pragma unroll 1
        for (int hp = 0; hp < NI; hp += NIB) {
            f32x4 acc[NIB];
#pragma unroll
            for (int i = 0; i < NIB; ++i) acc[i] = (f32x4){0.f, 0.f, 0.f, 0.f};
#pragma unroll 1
            for (int e = 4 * hp - (NS - 1); e <= 4 * (hp + NIB - 1); ++e) {
                const int base = L + 16 * w + 32 * e + fr - fq * 8;
                bf16x8 Af;
#pragma unroll
                for (int j = 0; j < 8; ++j) Af[j] = (short)HFl[base - j];
                const bf16_t* zb = Zin + fr * ZS + (4 * hp - e) * 32 + fq * 8;
#pragma unroll
                for (int i = 0; i < NIB; ++i) {
                    const int sj = 4 * (hp + i) - e;
                    if (sj >= 0 && sj < NS) acc[i] = mfma16(Af, *(const bf16x8*)(zb + i * 128), acc[i]);
                }
            }
#pragma unroll
            for (int i = 0; i < NIB; ++i) {
                const int t0 = 16 * (w + 8 * (hp + i)) + fq * 4;
                float x[6];
                x[0] = t0 > 0 ? b2f(gs[t0 - 1]) : 0.f;
                const u32x2 gv = *(const u32x2*)(gs + t0);
                x[1] = blo(gv.x); x[2] = bhi(gv.x); x[3] = blo(gv.y); x[4] = bhi(gv.y);
                x[5] = (t0 + 4 < L) ? b2f(gs[t0 + 4]) : 0.f;
                const u32x2 zv = *(const u32x2*)(Zin + fr * ZS + t0);
                const float z[4] = {blo(zv.x), bhi(zv.x), blo(zv.y), bhi(zv.y)};
                float val[4];
#pragma unroll
                for (int j = 0; j < 4; ++j) val[j] = (gb + gw0 * x[j] + gw1 * x[j + 1] + gw2 * x[j + 2]) * (acc[i][j] + dsk * z[j]);
                if (o == 0) { u32x2 ov; ov.x = pk2(val[0], val[1]); ov.y = pk2(val[2], val[3]); *(u32x2*)(ZB + fr * ZS + t0) = ov; }
                else {
#pragma unroll
                    for (int j = 0; j < 4; ++j) MIX[(size_t)(segbase + fr * L + t0 + j) * 1024 + 512 + c] = f2b(val[j]);
                }
            }
        }
        __syncthreads();
    }
}

template <bool LAT>
__device__ __forceinline__ void attn_item(const Params& p, int li, int b, int h, int sub) {
    const int tid = tid_l(), w = tid >> 6, lane = tid & 63, fr = lane & 15, fq = lane >> 4;
    bf16_t* Pw = (bf16_t*)dyn_lds + w * (16 * 520);
    float* rpbs = (float*)(dyn_lds + 8 * 16 * 520 * 2);
    const bf16_t* QK = (const bf16_t*)(p.ws + WS_BIG);
    const bf16_t* VTg = (const bf16_t*)(p.ws + WS_P2);
    bf16_t* MIX = (bf16_t*)(p.ws + WS_ACT);
    if (LAT) { const float* rp = p.in[24] + ((size_t)li * 16 + h) * 465; for (int i = tid; i < 465; i += NT) rpbs[i] = rp[i]; }
    __syncthreads();
    int r = 0, c0 = 0, rs = 0, cw0 = 0, qtok0;
    if (LAT) { r = sub * 2 + (w >> 2); const int qt = w & 3; c0 = qt * 16; qtok0 = b * 2048 + r * 64 + c0; rs = min(max(r - 4, 0), 24); cw0 = (qt == 0) ? 0 : (qt == 1) ? 8 : (qt == 2) ? 24 : 32; }
    else { qtok0 = NLAT + b * 256 + (sub * 8 + w) * 16; }
    float qg[16], kg[16];
#pragma unroll
    for (int e = 0; e < 8; ++e) { qg[e] = p.in[22][li * 64 + fq * 8 + e]; qg[8 + e] = p.in[22][li * 64 + 32 + fq * 8 + e]; kg[e] = p.in[23][li * 64 + fq * 8 + e]; kg[8 + e] = p.in[23][li * 64 + 32 + fq * 8 + e]; }
    bf16x8 qf[2];
    {
        const bf16_t* qp = QK + (size_t)(qtok0 + fr) * 2048 + h * 64 + fq * 8;
        float f[16]; unpack8(*(const u32x4*)qp, f); unpack8(*(const u32x4*)(qp + 32), f + 8);
        float ss = 0.f;
#pragma unroll
        for (int e = 0; e < 16; ++e) ss += f[e] * f[e];
        ss += __shfl_xor(ss, 16); ss += __shfl_xor(ss, 32);
        const float rstd = rsqrtf(ss * (1.f / 64.f) + EPS) * 0.125f;
#pragma unroll
        for (int e = 0; e < 16; ++e) f[e] *= rstd * qg[e];
        qf[0] = as_bf8(pack8(f)); qf[1] = as_bf8(pack8(f + 8));
    }
    f32x4 sreg[32];
#define KTILE(KT_, KTOK0_) do { \
        const bf16_t* kp = QK + (size_t)((KTOK0_) + fr) * 2048 + 1024 + h * 64 + fq * 8; \
        float f[16]; unpack8(*(const u32x4*)kp, f); unpack8(*(const u32x4*)(kp + 32), f + 8); \
        float ss = 0.f; \
        _Pragma("unroll") for (int e = 0; e < 16; ++e) ss += f[e] * f[e]; \
        ss += __shfl_xor(ss, 16); ss += __shfl_xor(ss, 32); \
        const float rstd = rsqrtf(ss * (1.f / 64.f) + EPS); \
        _Pragma("unroll") for (int e = 0; e < 16; ++e) f[e] *= rstd * kg[e]; \
        f32x4 sa = (f32x4){0.f, 0.f, 0.f, 0.f}; \
        sa = mfma16(as_bf8(pack8(f)), qf[0], sa); sa = mfma16(as_bf8(pack8(f + 8)), qf[1], sa); \
        sreg[KT_] = sa; } while (0)
    if (LAT) {
        const int qc = c0 + fr; const int cstart = min(max(qc - 8, 0), 48);
#pragma unroll
        for (int kt = 0; kt < 16; ++kt) {
            const int kr = kt >> 1, kcb = cw0 + (kt & 1) * 16;
            KTILE(kt, b * 2048 + (rs + kr) * 64 + kcb);
            const int dri = (rs + kr - r + 7) * 31;
#pragma unroll
            for (int j = 0; j < 4; ++j) {
                const int kc = kcb + fq * 4 + j;
                const bool valid = (kc >= cstart) && (kc < cstart + 16);
                const int dci = min(max(kc - qc + 15, 0), 30);
                sreg[kt][j] = valid ? sreg[kt][j] + rpbs[dri + dci] : -1e30f;
            }
            if (kt & 1) __builtin_amdgcn_sched_barrier(0);
        }
    }
    constexpr int KT0 = LAT ? 0 : 16;
#pragma unroll
    for (int kt = 16; kt < 32; ++kt) { KTILE(kt, NLAT + b * 256 + (kt - 16) * 16); if (kt & 1) __builtin_amdgcn_sched_barrier(0); }
    float mx = -1e30f;
#pragma unroll
    for (int kt = KT0; kt < 32; ++kt)
#pragma unroll
        for (int j = 0; j < 4; ++j) mx = fmaxf(mx, sreg[kt][j]);
    mx = fmaxf(mx, __shfl_xor(mx, 16)); mx = fmaxf(mx, __shfl_xor(mx, 32));
    float lsum = 0.f;
#pragma unroll
    for (int kt = KT0; kt < 32; ++kt) {
        float pj[4];
#pragma unroll
        for (int j = 0; j < 4; ++j) { pj[j] = __expf(sreg[kt][j] - mx); lsum += pj[j]; }
        u32x2 o; o.x = pk2(pj[0], pj[1]); o.y = pk2(pj[2], pj[3]);
        *(u32x2*)(Pw + fr * 520 + kt * 16 + fq * 4) = o;
    }
    lsum += __shfl_xor(lsum, 16); lsum += __shfl_xor(lsum, 32);
    __syncthreads();
    f32x4 oacc[4];
#pragma unroll
    for (int dt = 0; dt < 4; ++dt) oacc[dt] = (f32x4){0.f, 0.f, 0.f, 0.f};
#pragma unroll
    for (int ks = (LAT ? 0 : 8); ks < 16; ++ks) {
        const int vtok0 = ks < 8 ? b * 2048 + (rs + ks) * 64 + cw0 : NLAT + b * 256 + (ks - 8) * 32;
        const bf16x8 pf = *(const bf16x8*)(Pw + fr * 520 + ks * 32 + fq * 8);
#pragma unroll
        for (int dt = 0; dt < 4; ++dt) {
            const bf16x8 vf = *(const bf16x8*)(VTg + (size_t)(h * 64 + dt * 16 + fr) * MTOT + vtok0 + fq * 8);
            oacc[dt] = mfma16(vf, pf, oacc[dt]);
        }
    }
    const float inv = 1.f / lsum;
#pragma unroll
    for (int dt = 0; dt < 4; ++dt) {
        u32x2 o; o.x = pk2(oacc[dt][0] * inv, oacc[dt][1] * inv); o.y = pk2(oacc[dt][2] * inv, oacc[dt][3] * inv);
        *(u32x2*)(MIX + (size_t)(qtok0 + fr) * 1024 + h * 64 + dt * 16 + fq * 4) = o;
    }
    __syncthreads();
#undef KTILE
}


#ifdef DBG_NAN
__device__ __forceinline__ bool bad16(bf16_t v) { return ((v >> 7) & 0xFF) >= 227; }
__device__ __forceinline__ bool bad32(float f) { return !(fabsf(f) < 1e30f); }
__device__ __forceinline__ void scan16(const bf16_t* p, size_t n, unsigned* flags, unsigned bit) {
    bool bad = false;
    for (size_t i = (size_t)blockIdx.x * NT + threadIdx.x; i < n; i += (size_t)gridDim.x * NT) bad |= bad16(p[i]);
    if (bad) atomicOr(flags, bit);
}
__device__ __forceinline__ void scan32(const float* p, size_t n, unsigned* flags, unsigned bit) {
    bool bad = false;
    for (size_t i = (size_t)blockIdx.x * NT + threadIdx.x; i < n; i += (size_t)gridDim.x * NT) bad |= bad32(p[i]);
    if (bad) atomicOr(flags, bit);
}
#endif
#define GSYNC() do { asm volatile("s_waitcnt vmcnt(0) lgkmcnt(0)" ::: "memory"); __builtin_amdgcn_fence(__ATOMIC_RELEASE, "agent"); grid.sync(); __builtin_amdgcn_fence(__ATOMIC_ACQUIRE, "agent"); } while (0)
__global__ void __launch_bounds__(NT) fwd_megakernel(Params p) {
    cg::grid_group grid = cg::this_grid();
    const int blk = blockIdx.x, G = gridDim.x;
    bf16_t* WIN = (bf16_t*)(p.ws + WS_WIN); bf16_t* WOUT = (bf16_t*)(p.ws + WS_WOUT); bf16_t* WM1 = (bf16_t*)(p.ws + WS_WM1); bf16_t* WM2 = (bf16_t*)(p.ws + WS_WM2);
    bf16_t* ACT = (bf16_t*)(p.ws + WS_ACT); bf16_t* BIG = (bf16_t*)(p.ws + WS_BIG);
    float* XC = (float*)(p.ws + WS_XC);
    const float* MOD = (const float*)(p.ws + WS_MOD);
    if (PHMASK & 1) phase0(p);
#ifdef DBG_NAN
    unsigned* dflags = (unsigned*)(p.ws + WS_END);
    if (blk == 0 && threadIdx.x < 64) dflags[threadIdx.x] = 0u;
#endif
    GSYNC();
#pragma unroll 1
    for (int l = 0; l < 4; ++l) {
        const bool even = !(l & 1), last = (l == 3); const int li = l >> 1;
        const float* xlat = (l == 0) ? p.in[0] : p.out; const float* xctx = (l == 0) ? p.in[2] : XC;
        const int Mtail = last ? NLAT : MTOT;
        if (PHMASK & 2) convert_weights(p, l);
        if (PHMASK & 4) norm_phase(p, l, xlat, xctx, 0, 1024, MTOT);
        if ((PHMASK & 8) && even) filter_gen(p, li);
        GSYNC();
        {
            EpiArgs ea{}; ea.o_rm = BIG; ea.ld_rm = 2048; ea.o_cm = (bf16_t*)(p.ws + WS_P2); ea.gates = (float*)(p.ws + WS_GATES); ea.gate_pn = even ? 14 : -1; ea.o_dbg = (bf16_t*)(p.ws + WS_HFB);
            if (PHMASK & 16) gemm_phase<EPI_INPROJ>(ACT, WIN, MTOT, even ? 3840 : 3072, 1024, ea);
        }
        GSYNC();
#ifdef DBG_NAN
        if (l == DBG_LAYER) {
            {
                const unsigned gid = blk * NT + threadIdx.x;
                unsigned hsh = gid * 2654435761u + 12345u; hsh ^= hsh >> 13; hsh *= 2246822519u; hsh ^= hsh >> 16;
                const int row = hsh % MTOT; const int col = (hsh >> 8) % 2048; const int ch = (hsh >> 4) % 1536;
                const bf16_t* ar = ACT + (size_t)row * 1024; const bf16_t* wq = WIN + (size_t)col * 1024; const bf16_t* wh = WIN + (size_t)(2048 + ch) * 1024;
                float sq = 0.f, sh_ = 0.f;
                for (int k = 0; k < 1024; ++k) { const float av = b2f(ar[k]); sq += av * b2f(wq[k]); sh_ += av * b2f(wh[k]); }
                const float gq = b2f(BIG[(size_t)row * 2048 + col]);
                const float gh = b2f(((const bf16_t*)(p.ws + WS_P2))[(size_t)ch * MTOT + row]);
                (void)gq; (void)sq;

                { const int cls = DBG_CLS; atomicAdd(dflags + 16 + cls, 1u);
                  if (!(fabsf(gh - sh_) <= 0.05f + 0.02f * fabsf(sh_))) { atomicAdd(dflags + 2, 1u); atomicAdd(dflags + 32 + cls, 1u); } }
            }
            GSYNC();
            if (blk == 0 && threadIdx.x == 0) {
                const float fQ = (float)__hip_atomic_load(dflags + 1, __ATOMIC_RELAXED, __HIP_MEMORY_SCOPE_AGENT) / (float)(G * NT);
                const float fH = (float)__hip_atomic_load(dflags + 2, __ATOMIC_RELAXED, __HIP_MEMORY_SCOPE_AGENT) / (float)(G * NT);
                unsigned mask = 0;
                for (int q_ = 0; q_ < 8; ++q_) { const unsigned tot = __hip_atomic_load(dflags + 16 + q_, __ATOMIC_RELAXED, __HIP_MEMORY_SCOPE_AGENT), bad = __hip_atomic_load(dflags + 32 + q_, __ATOMIC_RELAXED, __HIP_MEMORY_SCOPE_AGENT); if (bad * 4 > tot) mask |= 1u << q_; }
                float code = 1e5f; for (unsigned q_ = 0; q_ < (mask >> 4); ++q_) code *= 10.f;
                const unsigned n3 = __hip_atomic_load(dflags + 3, __ATOMIC_RELAXED, __HIP_MEMORY_SCOPE_AGENT), b1 = __hip_atomic_load(dflags + 1, __ATOMIC_RELAXED, __HIP_MEMORY_SCOPE_AGENT), b4 = __hip_atomic_load(dflags + 4, __ATOMIC_RELAXED, __HIP_MEMORY_SCOPE_AGENT);
                p.out[0] = code * (1.f + 0.5f * (float)(mask & 15)) + 0.f * (fQ + fH + (float)(n3 + b1 + b4));
            }
            return;
        }
#endif
        if (even) {
            if (G >= 256) {
                if (blk < 128) { if (PHMASK & 32) mlstm_item(p, li, blk); }
                else { const int hb = blk - 128, HG = G - 128;
                    if (PHMASK & 64) for (int it = hb; it < 512; it += HG) hyena_item<2048>(p, li, it);
                    if (PHMASK & 64) for (int it = hb; it < 512; it += HG) hyena_item<256>(p, li, it); }
            } else {
            }
            GSYNC();
            if (PHMASK & 128) combine_phase(p, li);
        } else {
            const int x = blk & 7, y = blk >> 3, ny = (G + 7) >> 3;
            for (int i = 0; ; ++i) {
                const int slot = i * ny + y;
                if (slot >= 512) break;
                const int bh = x * 32 + (slot >> 4), rp = slot & 15;
                if (PHMASK & 256) attn_item<true>(p, li, bh >> 4, bh & 15, rp);
            }
            if ((PHMASK & 512) && !last) for (int it = blk; it < 512; it += G) attn_item<false>(p, li, it >> 5, (it >> 1) & 15, it & 1);
        }
        GSYNC();
        {
            EpiArgs ea{}; ea.res_lat = xlat; ea.res_ctx = xctx; ea.out_lat = p.out; ea.out_ctx = XC; ea.modg = MOD + (size_t)l * 17 * 6144 + 2048;
            if (PHMASK & 1024) gemm_phase<EPI_RESID>(ACT, WOUT, Mtail, 1024, 1024, ea);
        }
        GSYNC();
        norm_phase(p, l, p.out, XC, 3072, 4096, Mtail);
        GSYNC();
        { EpiArgs ea{}; ea.o_rm = BIG; ea.ld_rm = 4096; ea.gate_pn = -1; if (PHMASK & 2048) gemm_phase<EPI_RELU2>(ACT, WM1, Mtail, 4096, 1024, ea); }
        GSYNC();
        {
            EpiArgs ea{}; ea.res_lat = p.out; ea.res_ctx = XC; ea.out_lat = p.out; ea.out_ctx = XC; ea.modg = MOD + (size_t)l * 17 * 6144 + 5120;
            if (PHMASK & 4096) gemm_phase<EPI_RESID>(BIG, WM2, Mtail, 1024, 4096, ea);
        }
        GSYNC();
    }
}

extern "C" void kernel_launch(void* const* d_in, const int* in_sizes, int n_in, void* d_out, int out_size, void* d_ws, size_t ws_size, hipStream_t stream) {
    static int grid_blocks = 0;
    if (grid_blocks == 0) {
        if (n_in != 26 || ws_size < WS_END + 256) { fprintf(stderr, "kernel_launch: unexpected n_in %d or ws_size %zu (< %zu)\n", n_in, ws_size, (size_t)WS_END); grid_blocks = -1; return; }
        int dev = 0, cus = 0, per_cu = 0;
        hipGetDevice(&dev);
        hipDeviceGetAttribute(&cus, hipDeviceAttributeMultiprocessorCount, dev);
        if (hipFuncSetAttribute((const void*)fwd_megakernel, hipFuncAttributeMaxDynamicSharedMemorySize, LDS_BYTES) != hipSuccess) fprintf(stderr, "kernel_launch: hipFuncSetAttribute failed\n");
        if (hipOccupancyMaxActiveBlocksPerMultiprocessor(&per_cu, (const void*)fwd_megakernel, NT, LDS_BYTES) != hipSuccess || per_cu < 1) { fprintf(stderr, "kernel_launch: occupancy query gave %d\n", per_cu); per_cu = 1; }
        (void)hipGetLastError();
        grid_blocks = cus * 1;
        fprintf(stderr, "kernel_launch: cus %d per_cu %d grid %d\n", cus, per_cu, grid_blocks);
    }
    if (grid_blocks < 0) return;
    Params p{};
    for (int i = 0; i < 26; ++i) p.in[i] = (const float*)d_in[i];
    p.out = (float*)d_out; p.ws = (unsigned char*)d_ws;
    void* args[] = {&p};
    hipError_t e = hipLaunchCooperativeKernel((void*)fwd_megakernel, dim3(grid_blocks), dim3(NT), args, LDS_BYTES, stream);
    if (e != hipSuccess) fprintf(stderr, "cooperative launch failed: %s (grid %d)\n", hipGetErrorString(e), grid_blocks);
}
```

```cpp
#include <hip/hip_runtime.h>
#include <hip/hip_cooperative_groups.h>
#include <cstdio>
#include <cstdint>
namespace cg = cooperative_groups;

typedef unsigned short bf16_t;
typedef short bf16x8 __attribute__((ext_vector_type(8)));
typedef float f32x4 __attribute__((ext_vector_type(4)));
typedef unsigned u32x4 __attribute__((ext_vector_type(4)));
typedef unsigned u32x2 __attribute__((ext_vector_type(2)));

#define NT 512
#define DBG_LAYER 0
#define DBG_CLS ((((row % 64) / 16) * 2) + ((ch % 32) / 16))
#ifndef PHMASK
#define PHMASK 0xFFFF
#endif
#ifndef DUPMASK
#define DUPMASK 0
#endif
#define REP(bit) for (int rep_ = 0; rep_ < (((DUPMASK) & (bit)) ? 2 : 1); ++rep_)
constexpr int BATCH = 16, SEQ = 2048, DM = 1024, CTXL = 256;
constexpr int NLAT = BATCH * SEQ, NCTX = BATCH * CTXL, MTOT = NLAT + NCTX;
constexpr int DFF = 4096;
constexpr float EPS = 1e-6f;
constexpr int LDS_BYTES = 147456;

constexpr size_t al256(size_t x) { return (x + 255) & ~(size_t)255; }
constexpr size_t WS_WIN = 0;
constexpr size_t WS_WOUT = al256(WS_WIN + (size_t)3840 * 1024 * 2);
constexpr size_t WS_WM1 = al256(WS_WOUT + (size_t)1024 * 1024 * 2);
constexpr size_t WS_WM2 = al256(WS_WM1 + (size_t)4096 * 1024 * 2);
constexpr size_t WS_MOD = al256(WS_WM2 + (size_t)4096 * 1024 * 2);
constexpr size_t WS_XC = al256(WS_MOD + (size_t)4 * 17 * 6144 * 4);
constexpr size_t WS_ACT = al256(WS_XC + (size_t)NCTX * 1024 * 4);
constexpr size_t WS_BIG = al256(WS_ACT + (size_t)MTOT * 1024 * 2);
constexpr size_t WS_P2 = WS_BIG + (size_t)MTOT * 2048 * 2;
constexpr size_t WS_GATES = WS_P2 + (size_t)1536 * MTOT * 2;
constexpr size_t WS_HFB = al256(WS_BIG + (size_t)MTOT * 4096 * 2);
constexpr size_t WS_FLAT = al256(WS_HFB + (size_t)2 * MTOT * 512 * 2);
constexpr size_t WS_FCTX = al256(WS_FLAT + (size_t)2 * 512 * 4096 * 2);
constexpr size_t WS_H2 = al256(WS_FCTX + (size_t)2 * 512 * 512 * 2);
constexpr size_t WS_ROPE = al256(WS_H2 + (size_t)2 * 2304 * 64 * 4);
constexpr size_t WS_END = al256(WS_ROPE + (size_t)2 * 64 * 32 * 4);
static_assert(WS_GATES + (size_t)MTOT * 16 * 4 <= WS_HFB, "projection overlay too large");

struct Params { const float* in[26]; float* out; unsigned char* ws; };

typedef float f32x2_ __attribute__((ext_vector_type(2)));
typedef __bf16 bf16x2_ __attribute__((ext_vector_type(2)));
__device__ __forceinline__ unsigned pk2(float lo, float hi) { f32x2_ v = {lo, hi}; bf16x2_ b = __builtin_convertvector(v, bf16x2_); return __builtin_bit_cast(unsigned, b); }
__device__ __forceinline__ bf16_t f2b(float x) { return (bf16_t)(pk2(x, 0.f) & 0xffffu); }
__device__ __forceinline__ float b2f(bf16_t b) { return __uint_as_float(((unsigned)b) << 16); }
__device__ __forceinline__ float blo(unsigned w) { return __uint_as_float(w << 16); }
__device__ __forceinline__ float bhi(unsigned w) { return __uint_as_float(w & 0xffff0000u); }
__device__ __forceinline__ void unpack8(u32x4 v, float* f) {
    f[0] = blo(v.x); f[1] = bhi(v.x); f[2] = blo(v.y); f[3] = bhi(v.y); f[4] = blo(v.z); f[5] = bhi(v.z); f[6] = blo(v.w); f[7] = bhi(v.w);
}
__device__ __forceinline__ u32x4 pack8(const float* f) { u32x4 r; r.x = pk2(f[0], f[1]); r.y = pk2(f[2], f[3]); r.z = pk2(f[4], f[5]); r.w = pk2(f[6], f[7]); return r; }
__device__ __forceinline__ float fsin_(float x) { float r = x * 0.15915494309189535f; r -= floorf(r); return __builtin_amdgcn_sinf(r); }
__device__ __forceinline__ float fcos_(float x) { float r = x * 0.15915494309189535f; r -= floorf(r); return __builtin_amdgcn_cosf(r); }
__device__ __forceinline__ float wave_sum(float v) {
#pragma unroll
    for (int o = 1; o < 64; o <<= 1) v += __shfl_xor(v, o);
    return v;
}
__device__ __forceinline__ f32x4 mfma16(bf16x8 a, bf16x8 b, f32x4 c) { return __builtin_amdgcn_mfma_f32_16x16x32_bf16(a, b, c, 0, 0, 0); }
__device__ __forceinline__ bf16x8 as_bf8(u32x4 v) { return __builtin_bit_cast(bf16x8, v); }

extern __shared__ __attribute__((aligned(16))) unsigned char dyn_lds[];
__device__ __forceinline__ int tid_l() { int t = threadIdx.x; asm volatile("" : "+v"(t)); return t; }

constexpr int G_BM = 256, G_BK = 64, G_HALF = 128, G_HT = G_HALF * G_BK;
__device__ __forceinline__ int lds_byte(int r, int c) {
    int st = (r >> 4) * 2 + (c >> 5), rr = r & 15, cc = c & 31, ob = rr * 64 + cc * 2;
    return st * 1024 + (ob ^ (((ob >> 9) & 1) << 5));
}
__device__ __forceinline__ void stage_rc(int b, int& R, int& C) {
    int st = b / 1024, sb = b % 1024, swz = sb ^ (((sb >> 9) & 1) << 5);
    R = (st >> 1) * 16 + swz / 64; C = (st & 1) * 32 + (swz % 64) / 2;
}

enum { EPI_INPROJ = 0, EPI_RESID = 1, EPI_RELU2 = 2, EPI_DRY = 3 };
struct EpiArgs {
    bf16_t* o_rm; int ld_rm;
    bf16_t* o_dbg;
    bf16_t* o_cm;
    float* gates; int gate_pn;
    const float* res_lat; const float* res_ctx; float* out_lat; float* out_ctx; const float* modg;
};

#define WAIT_V_(n) asm volatile("s_waitcnt vmcnt(" #n ")" ::: "memory")
#define WAIT_V(n) WAIT_V_(n)
#ifndef GEMM_VM
#define GEMM_VM 8
#endif
#define WAIT_L(n) asm volatile("s_waitcnt lgkmcnt(" #n ")" ::: "memory")
#define BAR __builtin_amdgcn_s_barrier()
#define CFENCE asm volatile("" ::: "memory")

template <bool TR>
__device__ __forceinline__ void gemm_kloop(const bf16_t* __restrict__ A, const bf16_t* __restrict__ Bt, int K, int brow, int bcol, f32x4 (&acc)[2][2][4][2]) {
    bf16_t* shm = (bf16_t*)dyn_lds;
#define SA(b, h) (shm + ((b) * 2 + (h)) * G_HT)
#define SB(b, h) (shm + (4 + (b) * 2 + (h)) * G_HT)
    const int tidx = tid_l();
    const int wid = tidx >> 6, lane = tidx & 63, wr = wid >> 2, wc = wid & 3, fr = lane & 15, fq = lane >> 4;
    const int nt = K / G_BK;
    int goff[2];
#pragma unroll
    for (int i = 0; i < 2; ++i) { int r_, c_; stage_rc(tidx * 16 + i * 8192, r_, c_); goff[i] = r_ * K + c_; }
    const bf16_t* Ab = A + (long)brow * K; const bf16_t* Bb = Bt + (long)bcol * K;
#define STAGE2(P, BASEP, kt) do { _Pragma("unroll") for (int _i = 0; _i < 2; ++_i) \
      __builtin_amdgcn_global_load_lds((const unsigned*)((BASEP) + (kt) * G_BK + goff[_i]), (unsigned*)((char*)(P) + tidx * 16 + _i * 8192), 16, 0, 0); } while (0)
    STAGE2(SA(0, 0), Ab, 0); STAGE2(SA(0, 1), Ab + (long)G_HALF * K, 0); STAGE2(SB(0, 0), Bb, 0); STAGE2(SB(0, 1), Bb + (long)G_HALF * K, 0);
    for (int kt = 0; kt < nt; ++kt) {
        const int cur = kt & 1, nxt = cur ^ 1;
        if (kt + 1 < nt) {
            STAGE2(SA(nxt, 0), Ab, kt + 1); STAGE2(SA(nxt, 1), Ab + (long)G_HALF * K, kt + 1);
            STAGE2(SB(nxt, 0), Bb, kt + 1); STAGE2(SB(nxt, 1), Bb + (long)G_HALF * K, kt + 1);
            WAIT_V(GEMM_VM);
        } else { WAIT_V(0); }
        BAR; CFENCE;
#pragma unroll
        for (int k = 0; k < 2; ++k) {
            bf16x8 Bf[2][2];
#pragma unroll
            for (int bj = 0; bj < 2; ++bj)
#pragma unroll
                for (int n = 0; n < 2; ++n) Bf[bj][n] = *reinterpret_cast<const bf16x8*>((char*)SB(cur, bj) + lds_byte(wc * 32 + n * 16 + fr, k * 32 + fq * 8));
#pragma unroll
            for (int ai = 0; ai < 2; ++ai) {
                bf16x8 Af[4];
#pragma unroll
                for (int m = 0; m < 4; ++m) Af[m] = *reinterpret_cast<const bf16x8*>((char*)SA(cur, ai) + lds_byte(wr * 64 + m * 16 + fr, k * 32 + fq * 8));
#pragma unroll
                for (int m = 0; m < 4; ++m)
#pragma unroll
                    for (int bj = 0; bj < 2; ++bj)
#pragma unroll
                        for (int n = 0; n < 2; ++n)
                            acc[ai][bj][m][n] = TR ? mfma16(Bf[bj][n], Af[m], acc[ai][bj][m][n]) : mfma16(Af[m], Bf[bj][n], acc[ai][bj][m][n]);
            }
        }
        WAIT_L(0); BAR; CFENCE;
    }
}

template <int EPI>
__device__ __forceinline__ void gemm_phase(const bf16_t* A, const bf16_t* Bt, int M, int N, int K, const EpiArgs& ea) {
    const int nM = M / G_BM, nN = N / G_BM, nwg = nM * nN;
    const int tidx = tid_l(); const int wid = tidx >> 6, lane = tidx & 63, wr = wid >> 2, wc = wid & 3, fr = lane & 15, fq = lane >> 4;
    for (int L = blockIdx.x; L < nwg; L += gridDim.x) {
        int wgid = L;
        { int q = nwg / 8, r = nwg % 8, xcd = wgid % 8, off = wgid / 8; wgid = (xcd < r ? xcd * (q + 1) : r * (q + 1) + (xcd - r) * q) + off; }
        const int nig = 8 * nN, gid = wgid / nig, fm = gid * 8, gsz = min(nM - fm, 8);
        const int pm = fm + ((wgid % nig) % gsz), pn = (wgid % nig) / gsz, brow = pm * G_BM, bcol = pn * G_BM;
        f32x4 acc[2][2][4][2];
#pragma unroll
        for (int a = 0; a < 2; ++a)
#pragma unroll
            for (int b = 0; b < 2; ++b)
#pragma unroll
                for (int m = 0; m < 4; ++m)
#pragma unroll
                    for (int n = 0; n < 2; ++n) acc[a][b][m][n] = (f32x4){0.f, 0.f, 0.f, 0.f};
        const bool colmajor = (EPI == EPI_INPROJ) && pn >= 8 && pn != ea.gate_pn;
        if (colmajor) {
            gemm_kloop<true>(A, Bt, K, brow, bcol, acc);
#pragma unroll
            for (int ai = 0; ai < 2; ++ai)
#pragma unroll
                for (int bj = 0; bj < 2; ++bj)
#pragma unroll
                    for (int m = 0; m < 4; ++m)
#pragma unroll
                        for (int n = 0; n < 2; ++n) {
                            const int row = brow + ai * 128 + wr * 64 + m * 16 + fr, col = bcol + bj * 128 + wc * 32 + n * 16 + fq * 4;
                            const f32x4 v = acc[ai][bj][m][n];
#pragma unroll
                            for (int j = 0; j < 4; ++j) ea.o_cm[(size_t)(col + j - 2048) * MTOT + row] = f2b(v[j]);
                        }
        } else {
            gemm_kloop<true>(A, Bt, K, brow, bcol, acc);
#pragma unroll
            for (int ai = 0; ai < 2; ++ai)
#pragma unroll
                for (int m = 0; m < 4; ++m) {
                    const int row = brow + ai * 128 + wr * 64 + m * 16 + fr;
#pragma unroll
                    for (int bj = 0; bj < 2; ++bj)
#pragma unroll
                        for (int n = 0; n < 2; ++n) {
                            const int col = bcol + bj * 128 + wc * 32 + n * 16 + fq * 4;
                            const f32x4 v = acc[ai][bj][m][n];
                            if (EPI == EPI_INPROJ) {
                                if (pn == ea.gate_pn) {
                                    if (bj == 0 && wc == 0 && n == 0) *(f32x4*)(ea.gates + (size_t)row * 16 + fq * 4) = v;
                                } else {
                                    u32x2 o; o.x = pk2(v[0], v[1]); o.y = pk2(v[2], v[3]);
                                    *(u32x2*)(ea.o_rm + (size_t)row * ea.ld_rm + col) = o;
                                }
                            } else if (EPI == EPI_DRY) {
                                if (v[0] == 123456.789f && v[1] == 3.25f) *(f32x4*)(ea.out_lat + (size_t)row * 1024 + (col & 1023)) = v;
                            } else if (EPI == EPI_RELU2) {
                                float r0 = fmaxf(v[0], 0.f), r1 = fmaxf(v[1], 0.f), r2 = fmaxf(v[2], 0.f), r3 = fmaxf(v[3], 0.f);
                                u32x2 o; o.x = pk2(r0 * r0, r1 * r1); o.y = pk2(r2 * r2, r3 * r3);
                                *(u32x2*)(ea.o_rm + (size_t)row * ea.ld_rm + col) = o;
                            } else {
                                const float* rp; float* op; int mrow;
                                if (row < NLAT) { rp = ea.res_lat + (size_t)row * 1024 + col; op = ea.out_lat + (size_t)row * 1024 + col; mrow = row >> 11; }
                                else { rp = ea.res_ctx + (size_t)(row - NLAT) * 1024 + col; op = ea.out_ctx + (size_t)(row - NLAT) * 1024 + col; mrow = 16; }
                                const f32x4 g = *(const f32x4*)(ea.modg + (size_t)mrow * 6144 + col);
                                const f32x4 x = *(const f32x4*)rp;
                                f32x4 rr = x + g * v;
#ifdef SANITIZE
#pragma unroll
                                for (int q_ = 0; q_ < 4; ++q_) if (!(fabsf(rr[q_]) < 1e30f)) rr[q_] = 0.f;
#endif
                                *(f32x4*)op = rr;
                            }
                        }
                }
        }
        asm volatile("s_waitcnt vmcnt(0)" ::: "memory");
        __syncthreads();
    }
}

__device__ __forceinline__ void phase0(const Params& p) {
    const int tid = tid_l(), blk = blockIdx.x, nb = gridDim.x;
    float* MOD = (float*)(p.ws + WS_MOD);
    for (int it = blk; it < 193; it += nb) {
        if (it < 192) {
            float* sl = (float*)dyn_lds;
            float* red = sl + 17 * 1024;
            for (int i = tid; i < 17 * 1024; i += NT) { float v = (i < 16 * 1024) ? p.in[1][i] : p.in[3][i - 16 * 1024]; sl[i] = v / (1.f + __expf(-v)); }
            __syncthreads();
            const int l = it / 48, nc = it % 48, kp = tid >> 7, col = tid & 127;
            const float* W = p.in[4] + (size_t)l * 1024 * 6144 + nc * 128 + col;
            float acc[17];
#pragma unroll
            for (int r = 0; r < 17; ++r) acc[r] = 0.f;
            for (int k = kp * 256; k < kp * 256 + 256; ++k) {
                const float wv = W[(size_t)k * 6144];
#pragma unroll
                for (int r = 0; r < 17; ++r) acc[r] += sl[r * 1024 + k] * wv;
            }
#pragma unroll
            for (int r = 0; r < 17; ++r) red[(kp * 17 + r) * 128 + col] = acc[r];
            __syncthreads();
            for (int i = tid; i < 17 * 128; i += NT) {
                const int r = i >> 7, cc = i & 127;
                const float s = red[(0 * 17 + r) * 128 + cc] + red[(1 * 17 + r) * 128 + cc] + red[(2 * 17 + r) * 128 + cc] + red[(3 * 17 + r) * 128 + cc];
                MOD[((size_t)l * 17 + r) * 6144 + nc * 128 + cc] = s + p.in[5][l * 6144 + nc * 128 + cc];
            }
            __syncthreads();
        } else {
            float* ROPE = (float*)(p.ws + WS_ROPE);
            for (int i = tid; i < 2048; i += NT) {
                const int pos = i >> 5, j = i & 31;
                const float inv = exp2f(-(float)j * (13.287712379549449f / 32.f));
                const float ang = (float)pos * inv;
                ROPE[i] = fcos_(ang); ROPE[2048 + i] = fsin_(ang);
            }
        }
    }
    float* H2 = (float*)(p.ws + WS_H2);
    const int gw = blk * 8 + (tid >> 6), lane = tid & 63;
    for (int it = gw; it < 2 * 2304; it += nb * 8) {
        const int i = it / 2304, row = it % 2304;
        const int L = row < 2048 ? 2048 : 256, t = row < 2048 ? row : row - 2048;
        const float tn = (float)t / (float)(L - 1);
        const float wpos = 6.283185307179586f * (float)t / (float)L;
        float ev = 0.f;
        if (lane == 0) ev = tn;
        else if (lane <= 16) { const float fr = 1e-4f + (float)(lane - 1) * ((15.f - 1e-4f) / 15.f); ev = fcos_(wpos * fr); }
        else if (lane <= 32) { const float fr = 1e-4f + (float)(lane - 17) * ((15.f - 1e-4f) / 15.f); ev = -fsin_(wpos * fr); }
        const float* w1 = p.in[13] + i * 33 * 64; const float* b1 = p.in[14] + i * 64;
        const float* w2 = p.in[15] + i * 64 * 64; const float* b2 = p.in[16] + i * 64; const float* fq = p.in[18] + i * 64;
        float a = b1[lane];
        for (int e = 0; e < 33; ++e) a += __shfl(ev, e) * w1[e * 64 + lane];
        const float h1 = fsin_(fq[lane] * a);
        float a2 = b2[lane];
        for (int e = 0; e < 64; ++e) a2 += __shfl(h1, e) * w2[e * 64 + lane];
        H2[((size_t)i * 2304 + row) * 64 + lane] = fsin_(fq[lane] * a2);
    }
}

__device__ __forceinline__ void cvt_tile(const float* W, int N, int K, bf16_t* WT, int n0, int k0, int mapmode) {
    float* tl = (float*)dyn_lds;
    const int tid = tid_l(), nl = tid & 63, kb = tid >> 6;
    const int n = n0 + nl; int sc = n;
    if (mapmode == 1) sc = n < 2048 ? n : (n < 3584 ? n + 16 : (n < 3600 ? n - 3584 + 2048 : -1));
#pragma unroll
    for (int i = 0; i < 8; ++i) { const int kl = kb + 8 * i; tl[kl * 65 + nl] = sc >= 0 ? W[(size_t)(k0 + kl) * N + sc] : 0.f; }
    __syncthreads();
    const int nn = tid >> 3, kc = tid & 7;
    float f[8];
#pragma unroll
    for (int j = 0; j < 8; ++j) f[j] = tl[(kc * 8 + j) * 65 + nn];
    *(u32x4*)(WT + (size_t)(n0 + nn) * K + k0 + kc * 8) = pack8(f);
    __syncthreads();
}

__device__ __forceinline__ void convert_weights(const Params& p, int l) {
    const int blk = blockIdx.x, nb = gridDim.x, li = l >> 1; const bool even = !(l & 1);
    const int nin = even ? 60 : 48;
    const int t_in = nin * 16, t_out = 256, t_m1 = 1024, t_m2 = 1024;
    const int total = t_in + t_out + t_m1 + t_m2;
    for (int it = blk; it < total; it += nb) {
        int r = it;
        if (r < t_in) {
            const int nt = r / 16, kt = r % 16;
            if (even) cvt_tile(p.in[8] + (size_t)li * 1024 * 3600, 3600, 1024, (bf16_t*)(p.ws + WS_WIN), nt * 64, kt * 64, 1);
            else cvt_tile(p.in[21] + (size_t)li * 1024 * 3072, 3072, 1024, (bf16_t*)(p.ws + WS_WIN), nt * 64, kt * 64, 0);
            continue;
        }
        r -= t_in;
        if (r < t_out) {
            const int nt = r / 16, kt = r % 16;
            cvt_tile((even ? p.in[20] : p.in[25]) + (size_t)li * 1024 * 1024, 1024, 1024, (bf16_t*)(p.ws + WS_WOUT), nt * 64, kt * 64, 0);
            continue;
        }
        r -= t_out;
        if (r < t_m1) {
            const int nt = r / 16, kt = r % 16;
            cvt_tile(p.in[6] + (size_t)l * 1024 * 4096, 4096, 1024, (bf16_t*)(p.ws + WS_WM1), nt * 64, kt * 64, 0);
            continue;
        }
        r -= t_m1;
        { const int nt = r / 64, kt = r % 64;
          cvt_tile(p.in[7] + (size_t)l * 4096 * 1024, 1024, 4096, (bf16_t*)(p.ws + WS_WM2), nt * 64, kt * 64, 0); }
    }
}

__device__ __forceinline__ void norm_phase(const Params& p, int l, const float* xlat, const float* xctx, int shoff, int scoff, int M) {
    const int tid = tid_l(), lane = tid & 63, gw = blockIdx.x * 8 + (tid >> 6), ngw = gridDim.x * 8;
    const float* MOD = (const float*)(p.ws + WS_MOD) + (size_t)l * 17 * 6144;
    bf16_t* ACT = (bf16_t*)(p.ws + WS_ACT);
    for (int row = gw; row < M; row += ngw) {
        const float* xr = row < NLAT ? xlat + (size_t)row * 1024 : xctx + (size_t)(row - NLAT) * 1024;
        const int mrow = row < NLAT ? row >> 11 : 16;
        const float* mod = MOD + (size_t)mrow * 6144;
        f32x4 v[4]; float ss = 0.f;
#pragma unroll
        for (int j = 0; j < 4; ++j) { v[j] = *(const f32x4*)(xr + 4 * lane + 256 * j); ss += v[j][0] * v[j][0] + v[j][1] * v[j][1] + v[j][2] * v[j][2] + v[j][3] * v[j][3]; }
        ss = wave_sum(ss);
        const float rstd = rsqrtf(ss * (1.f / 1024.f) + EPS);
#pragma unroll
        for (int j = 0; j < 4; ++j) {
            const int col = 4 * lane + 256 * j;
            const f32x4 sh = *(const f32x4*)(mod + shoff + col), sc = *(const f32x4*)(mod + scoff + col);
            const f32x4 y = v[j] * rstd * (sc + 1.f) + sh;
            u32x2 o; o.x = pk2(y[0], y[1]); o.y = pk2(y[2], y[3]);
            *(u32x2*)(ACT + (size_t)row * 1024 + col) = o;
        }
    }
}

__device__ __forceinline__ void filter_gen(const Params& p, int li) {
    const int tid = tid_l(), lane = tid & 63, w = tid >> 6;
    float* wf = (float*)dyn_lds; float* wb = wf + 64; float* red = wb + 64;
    const float* H2 = (const float*)(p.ws + WS_H2);
    for (int it = blockIdx.x; it < 2048; it += gridDim.x) {
        const int ltype = it >> 10, o = (it >> 9) & 1, c = it & 511;
        const int L = ltype ? 256 : 2048;
        const float* H2r = H2 + ((size_t)li * 2304 + (ltype ? 2048 : 0)) * 64;
        const float* w3 = p.in[17] + (size_t)li * 64 * 2048;
        if (tid < 64) wf[tid] = w3[tid * 2048 + (o * 2 + 0) * 512 + c];
        else if (tid < 128) wb[tid - 64] = w3[(tid - 64) * 2048 + (o * 2 + 1) * 512 + c];
        __syncthreads();
        const float lo = -4.605170185988091f / 1.5f, hi = -4.605170185988091f / 0.3f;
        const float delta = fabsf(lo + (hi - lo) * (float)c / 511.f);
        float vf[4], vb[4]; float ssf = 0.f, ssb = 0.f;
#pragma unroll
        for (int q = 0; q < 4; ++q) {
            const int t = tid + 512 * q; vf[q] = 0.f; vb[q] = 0.f;
            if (t < L) {
                float df = 0.f, db = 0.f;
                const f32x4* hr = (const f32x4*)(H2r + (size_t)t * 64);
#pragma unroll
                for (int j = 0; j < 16; ++j) { const f32x4 hv = hr[j];
                    df += hv[0] * wf[4 * j] + hv[1] * wf[4 * j + 1] + hv[2] * wf[4 * j + 2] + hv[3] * wf[4 * j + 3];
                    db += hv[0] * wb[4 * j] + hv[1] * wb[4 * j + 1] + hv[2] * wb[4 * j + 2] + hv[3] * wb[4 * j + 3]; }
                const float dec = __expf(-((float)t / (float)(L - 1)) * delta);
                vf[q] = df * dec; vb[q] = db * dec; ssf += vf[q] * vf[q]; ssb += vb[q] * vb[q];
            }
        }
        ssf = wave_sum(ssf); ssb = wave_sum(ssb);
        if (lane == 0) { red[w] = ssf; red[8 + w] = ssb; }
        __syncthreads();
        float tf = 0.f, tb = 0.f;
#pragma unroll
        for (int i = 0; i < 8; ++i) { tf += red[i]; tb += red[8 + i]; }
        const float nf = rsqrtf(tf + EPS), nbk = rsqrtf(tb + EPS);
        bf16_t* dst = ltype ? (bf16_t*)(p.ws + WS_FCTX) + ((size_t)o * 512 + c) * 512 : (bf16_t*)(p.ws + WS_FLAT) + ((size_t)o * 512 + c) * 4096;
#pragma unroll
        for (int q = 0; q < 4; ++q) {
            const int t = tid + 512 * q;
            if (t < L) {
                if (t == 0) { dst[L] = f2b(vf[q] * nf + vb[q] * nbk); dst[0] = 0; }
                else { dst[L + t] = f2b(vf[q] * nf); dst[L - t] = f2b(vb[q] * nbk); }
            }
        }
        __syncthreads();
    }
}

__device__ __forceinline__ void mlstm_item(const Params& p, int li, int it) {
    const int tid = tid_l(), w = tid >> 6, lane = tid & 63, fr = lane & 15, fq = lane >> 4;
    const int b = it >> 3, h = (it >> 1) & 3, dir = it & 1;
    bf16_t* Qs = (bf16_t*)dyn_lds;
    bf16_t* Ks = Qs + 64 * 136;
    bf16_t* KT = Ks + 64 * 136;
    bf16_t* VT = KT + 128 * 72;
    bf16_t* Cb = VT + 144 * 72;
    bf16_t* Ps = Cb + 144 * 136;
    float* fl = (float*)(Ps + 64 * 72);
    float* a_s = fl; float* Mt = fl + 64; float* scs = fl + 128; float* emt = fl + 192; float* den = fl + 256; float* lfs = fl + 320; float* igs = fl + 384; float* scal = fl + 448;
    const bf16_t* QKVO = (const bf16_t*)(p.ws + WS_BIG);
    const float* GATES = (const float*)(p.ws + WS_GATES);
    bf16_t* HFB = (bf16_t*)(p.ws + WS_HFB) + (size_t)dir * MTOT * 512;
    const float* ROPE = (const float*)(p.ws + WS_ROPE);
    const float* gate_b = p.in[9] + li * 16;
    for (int i = tid; i < 144 * 136 / 2; i += NT) ((unsigned*)Cb)[i] = 0u;
    for (int i = tid; i < 16 * 72; i += NT) { const int r = i / 72, ci = i % 72; VT[(128 + r) * 72 + ci] = (r == 0 && ci < 64) ? (bf16_t)0x3F80 : (bf16_t)0; }
    f32x4 cacc[9];
#pragma unroll
    for (int i = 0; i < 9; ++i) cacc[i] = (f32x4){0.f, 0.f, 0.f, 0.f};
    float m = 0.f;
    __syncthreads();
    for (int step = 0; step < 36; ++step) {
        const bool isctx = step < 4;
        const int cj = isctx ? (dir ? 3 - step : step) : (dir ? 35 - step : step - 4);
        const int rowbase = isctx ? NLAT + b * 256 + cj * 64 : b * 2048 + cj * 64;
        {
            const int r = tid >> 3, seg = tid & 7; const int tl = dir ? 63 - r : r;
            const bf16_t* src = QKVO + (size_t)(rowbase + tl) * 2048 + h * 128;
            const int hb = seg >> 2, jb = (seg & 3) * 8, d1 = hb * 64 + jb, d2 = d1 + 32;
            const u32x4 q1 = *(const u32x4*)(src + d1), q2 = *(const u32x4*)(src + d2);
            const u32x4 k1 = *(const u32x4*)(src + 512 + d1), k2 = *(const u32x4*)(src + 512 + d2);
            const u32x4 v1 = *(const u32x4*)(src + 1024 + seg * 16), v2 = *(const u32x4*)(src + 1024 + seg * 16 + 8);
            float cs[8], sn[8];
            if (!isctx) {
                const int pos = hb ? tl : cj;
                const f32x4 c0 = *(const f32x4*)(ROPE + pos * 32 + jb), c1 = *(const f32x4*)(ROPE + pos * 32 + jb + 4);
                const f32x4 s0 = *(const f32x4*)(ROPE + 2048 + pos * 32 + jb), s1 = *(const f32x4*)(ROPE + 2048 + pos * 32 + jb + 4);
#pragma unroll
                for (int e = 0; e < 4; ++e) { cs[e] = c0[e]; cs[4 + e] = c1[e]; sn[e] = s0[e]; sn[4 + e] = s1[e]; }
            } else {
#pragma unroll
                for (int e = 0; e < 8; ++e) { cs[e] = 1.f; sn[e] = 0.f; }
            }
            float x1[8], x2[8], o1[8], o2[8];
            unpack8(q1, x1); unpack8(q2, x2);
#pragma unroll
            for (int e = 0; e < 8; ++e) { o1[e] = x1[e] * cs[e] - x2[e] * sn[e]; o2[e] = x1[e] * sn[e] + x2[e] * cs[e]; }
            *(u32x4*)(Qs + r * 136 + d1) = pack8(o1); *(u32x4*)(Qs + r * 136 + d2) = pack8(o2);
            unpack8(k1, x1); unpack8(k2, x2);
            const float ksc = 0.08838834764831845f;
#pragma unroll
            for (int e = 0; e < 8; ++e) { o1[e] = (x1[e] * cs[e] - x2[e] * sn[e]) * ksc; o2[e] = (x1[e] * sn[e] + x2[e] * cs[e]) * ksc; }
            const u32x4 ko1 = pack8(o1), ko2 = pack8(o2);
            *(u32x4*)(Ks + r * 136 + d1) = ko1; *(u32x4*)(Ks + r * 136 + d2) = ko2;
            {
                const unsigned kw1[4] = {ko1.x, ko1.y, ko1.z, ko1.w}, kw2[4] = {ko2.x, ko2.y, ko2.z, ko2.w};
#pragma unroll
                for (int e = 0; e < 4; ++e) {
                    KT[(d1 + 2 * e) * 72 + r] = (bf16_t)(kw1[e] & 0xffffu); KT[(d1 + 2 * e + 1) * 72 + r] = (bf16_t)(kw1[e] >> 16);
                    KT[(d2 + 2 * e) * 72 + r] = (bf16_t)(kw2[e] & 0xffffu); KT[(d2 + 2 * e + 1) * 72 + r] = (bf16_t)(kw2[e] >> 16);
                }
                const unsigned vw1[4] = {v1.x, v1.y, v1.z, v1.w}, vw2[4] = {v2.x, v2.y, v2.z, v2.w};
#pragma unroll
                for (int e = 0; e < 4; ++e) {
                    VT[(seg * 16 + 2 * e) * 72 + r] = (bf16_t)(vw1[e] & 0xffffu); VT[(seg * 16 + 2 * e + 1) * 72 + r] = (bf16_t)(vw1[e] >> 16);
                    VT[(seg * 16 + 8 + 2 * e) * 72 + r] = (bf16_t)(vw2[e] & 0xffffu); VT[(seg * 16 + 8 + 2 * e + 1) * 72 + r] = (bf16_t)(vw2[e] >> 16);
                }
            }
            if (tid < 64) {
                const int rr = tid, tl2 = dir ? 63 - rr : rr;
                const float* g = GATES + (size_t)(rowbase + tl2) * 16;
                const float ig = g[dir * 8 + h] + gate_b[dir * 8 + h];
                const float fg = g[dir * 8 + 4 + h] + gate_b[dir * 8 + 4 + h];
                igs[rr] = ig; lfs[rr] = fminf(fg, 0.f) - __logf(1.f + __expf(-fabsf(fg)));
            }
        }
        __syncthreads();
        if (w == 0) {
            float bcs = lfs[lane];
#pragma unroll
            for (int o = 1; o < 64; o <<= 1) { const float t = __shfl_up(bcs, o); if (lane >= o) bcs += t; }
            const float a = igs[lane] - bcs;
            float pm = a;
#pragma unroll
            for (int o = 1; o < 64; o <<= 1) { const float t = __shfl_up(pm, o); if (lane >= o) pm = fmaxf(pm, t); }
            const float Mx = fmaxf(m, pm);
            a_s[lane] = a; Mt[lane] = Mx; scs[lane] = __expf(m - Mx); emt[lane] = __expf(-bcs - Mx);
            if (lane == 63) { scal[0] = bcs; scal[1] = Mx; }
        }
        {
            const int st = w & 3, tt0 = (w >> 2) * 2;
            f32x4 sacc[2];
#pragma unroll
            for (int u = 0; u < 2; ++u) {
                sacc[u] = (f32x4){0.f, 0.f, 0.f, 0.f};
#pragma unroll
                for (int kk = 0; kk < 4; ++kk) {
                    const bf16x8 Ak = *(const bf16x8*)(Ks + (st * 16 + fr) * 136 + kk * 32 + fq * 8);
                    const bf16x8 Bq = *(const bf16x8*)(Qs + ((tt0 + u) * 16 + fr) * 136 + kk * 32 + fq * 8);
                    sacc[u] = mfma16(Ak, Bq, sacc[u]);
                }
            }
            __syncthreads();
#pragma unroll
            for (int u = 0; u < 2; ++u) {
                const int t = (tt0 + u) * 16 + fr, sb = st * 16 + fq * 4;
                const float Mv = Mt[t];
                float pv[4];
#pragma unroll
                for (int j = 0; j < 4; ++j) { const int s = sb + j; pv[j] = (s <= t) ? sacc[u][j] * __expf(a_s[s] - Mv) : 0.f; }
                u32x2 o; o.x = pk2(pv[0], pv[1]); o.y = pk2(pv[2], pv[3]);
                *(u32x2*)(Ps + t * 72 + sb) = o;
            }
        }
        __syncthreads();
        {
            const int tt = w & 3, up = w >> 2, vt0 = up ? 5 : 0, nvt = up ? 4 : 5;
            bf16x8 qf[4], pf[2];
#pragma unroll
            for (int kk = 0; kk < 4; ++kk) qf[kk] = *(const bf16x8*)(Qs + (tt * 16 + fr) * 136 + kk * 32 + fq * 8);
#pragma unroll
            for (int kk = 0; kk < 2; ++kk) pf[kk] = *(const bf16x8*)(Ps + (tt * 16 + fr) * 72 + kk * 32 + fq * 8);
            const float sct = scs[tt * 16 + fr];
            f32x4 hacc[5];
#pragma unroll
            for (int vi = 0; vi < 5; ++vi) {
                hacc[vi] = (f32x4){0.f, 0.f, 0.f, 0.f};
                if (vi < nvt) {
                    const int v0 = (vt0 + vi) * 16;
                    f32x4 ac = (f32x4){0.f, 0.f, 0.f, 0.f};
#pragma unroll
                    for (int kk = 0; kk < 4; ++kk) ac = mfma16(*(const bf16x8*)(Cb + (v0 + fr) * 136 + kk * 32 + fq * 8), qf[kk], ac);
                    ac = ac * sct;
#pragma unroll
                    for (int kk = 0; kk < 2; ++kk) ac = mfma16(*(const bf16x8*)(VT + (v0 + fr) * 72 + kk * 32 + fq * 8), pf[kk], ac);
                    hacc[vi] = ac;
                }
            }
            if (up && fq == 0) den[tt * 16 + fr] = hacc[3][0];
            __syncthreads();
            const int t = tt * 16 + fr, tl = dir ? 63 - t : t;
            const float dn = den[t];
            const float inv = 1.f / fmaxf(fabsf(dn), emt[t]);
            bf16_t* orow = HFB + (size_t)(rowbase + tl) * 512 + h * 128;
#pragma unroll
            for (int vi = 0; vi < 5; ++vi) {
                if (vi < nvt && (vt0 + vi) < 8) {
                    const int v0 = (vt0 + vi) * 16 + fq * 4;
                    u32x2 o; o.x = pk2(hacc[vi][0] * inv, hacc[vi][1] * inv); o.y = pk2(hacc[vi][2] * inv, hacc[vi][3] * inv);
                    *(u32x2*)(orow + v0) = o;
                }
            }
        }
        {
            const float bl = scal[0], M63 = scal[1];
            const float decay = __expf(m - M63);
            bf16x8 ka[2];
#pragma unroll
            for (int kk = 0; kk < 2; ++kk) {
                const u32x4 raw = *(const u32x4*)(KT + (w * 16 + fr) * 72 + kk * 32 + fq * 8);
                float f[8]; unpack8(raw, f);
#pragma unroll
                for (int j = 0; j < 8; ++j) f[j] *= __expf(a_s[kk * 32 + fq * 8 + j] - M63);
                ka[kk] = as_bf8(pack8(f));
            }
#pragma unroll
            for (int vt = 0; vt < 9; ++vt) {
                f32x4 ac = cacc[vt] * decay;
#pragma unroll
                for (int kk = 0; kk < 2; ++kk) ac = mfma16(ka[kk], *(const bf16x8*)(VT + (vt * 16 + fr) * 72 + kk * 32 + fq * 8), ac);
                cacc[vt] = ac;
                u32x2 o; o.x = pk2(ac[0], ac[1]); o.y = pk2(ac[2], ac[3]);
                *(u32x2*)(Cb + (vt * 16 + fr) * 136 + w * 16 + fq * 4) = o;
            }
            m = bl + M63;
        }
        __syncthreads();
    }
}

__device__ __forceinline__ void combine_phase(const Params& p, int li) {
    const int tid = tid_l(), lane = tid & 63, gw = blockIdx.x * 8 + (tid >> 6), ngw = gridDim.x * 8;
    const bf16_t* HF = (const bf16_t*)(p.ws + WS_HFB); const bf16_t* HB = HF + (size_t)MTOT * 512;
    const bf16_t* QKVO = (const bf16_t*)(p.ws + WS_BIG);
    bf16_t* MIX = (bf16_t*)(p.ws + WS_ACT);
    const float* hn = p.in[10] + li * 512 + lane * 8;
    float g[8];
#pragma unroll
    for (int e = 0; e < 8; ++e) g[e] = hn[e];
    for (int row = gw; row < MTOT; row += ngw) {
        float a[8], bq[8], og[8], y[8];
        unpack8(*(const u32x4*)(HF + (size_t)row * 512 + lane * 8), a);
        unpack8(*(const u32x4*)(HB + (size_t)row * 512 + lane * 8), bq);
        unpack8(*(const u32x4*)(QKVO + (size_t)row * 2048 + 1536 + lane * 8), og);
        float ss = 0.f;
#pragma unroll
        for (int e = 0; e < 8; ++e) { a[e] += bq[e]; ss += a[e] * a[e]; }
        ss += __shfl_xor(ss, 1); ss += __shfl_xor(ss, 2); ss += __shfl_xor(ss, 4); ss += __shfl_xor(ss, 8);
        const float rstd = rsqrtf(ss * (1.f / 128.f) + EPS);
#pragma unroll
        for (int e = 0; e < 8; ++e) y[e] = a[e] * rstd * g[e] / (1.f + __expf(-og[e]));
        *(u32x4*)(MIX + (size_t)row * 1024 + lane * 8) = pack8(y);
    }
}

template <int L>
__device__ __forceinline__ void hyena_item(const Params& p, int li, int c) {
    constexpr int ZS = L + 8, NI = L / 128, NS = L / 32;
    const int tid = tid_l(), w = tid >> 6, lane = tid & 63, fr = lane & 15, fq = lane >> 4;
    bf16_t* ZA = (bf16_t*)dyn_lds; bf16_t* ZB = ZA + 16 * ZS; bf16_t* HFl = ZB + 16 * ZS;
    const int segbase = (L == 2048) ? 0 : NLAT;
    const bf16_t* HYT = (const bf16_t*)(p.ws + WS_P2);
    bf16_t* MIX = (bf16_t*)(p.ws + WS_ACT);
    const float* cw = p.in[11] + (size_t)li * 3 * 1536; const float* cb = p.in[12] + (size_t)li * 1536; const float* hd = p.in[19] + (size_t)li * 2 * 512;
    const bf16_t* FIL = (L == 2048) ? (const bf16_t*)(p.ws + WS_FLAT) : (const bf16_t*)(p.ws + WS_FCTX);
    {
        const float w0 = cw[c], w1 = cw[1536 + c], w2 = cw[2 * 1536 + c], bb = cb[c];
        const bf16_t* src = HYT + (size_t)c * MTOT + segbase;
        for (int ch = tid; ch < 16 * L / 8; ch += NT) {
            const int b = ch / (L / 8), t0 = (ch % (L / 8)) * 8;
            const bf16_t* s = src + b * L + t0;
            float x[10], y[8];
            x[0] = t0 > 0 ? b2f(s[-1]) : 0.f;
            unpack8(*(const u32x4*)s, x + 1);
            x[9] = (t0 + 8 < L) ? b2f(s[8]) : 0.f;
#pragma unroll
            for (int e = 0; e < 8; ++e) y[e] = bb + w0 * x[e] + w1 * x[e + 1] + w2 * x[e + 2];
            *(u32x4*)(ZA + b * ZS + t0) = pack8(y);
        }
    }
#pragma unroll 1
    for (int o = 0; o < 2; ++o) {
        for (int i = tid; i < 2 * L / 8; i += NT) *(u32x4*)(HFl + i * 8) = *(const u32x4*)(FIL + ((size_t)o * 512 + c) * 2 * L + i * 8);
        __syncthreads();
        const bf16_t* Zin = o ? ZB : ZA;
        const int gc = (o + 1) * 512 + c;
        const float gw0 = cw[gc], gw1 = cw[1536 + gc], gw2 = cw[2 * 1536 + gc], gb = cb[gc], dsk = hd[o * 512 + c];
        const bf16_t* gs = HYT + (size_t)gc * MTOT + segbase + fr * L;
        constexpr int NIB = NI < 8 ? NI : 8;
#pragma unroll 1
        for (int hp = 0; hp < NI; hp += NIB) {
            f32x4 acc[NIB];
#pragma unroll
            for (int i = 0; i < NIB; ++i) acc[i] = (f32x4){0.f, 0.f, 0.f, 0.f};
#pragma unroll 1
            for (int e = 4 * hp - (NS - 1); e <= 4 * (hp + NIB - 1); ++e) {
                const int base = L + 16 * w + 32 * e + fr - fq * 8;
                bf16x8 Af;
#pragma unroll
                for (int j = 0; j < 8; ++j) Af[j] = (short)HFl[base - j];
                const bf16_t* zb = Zin + fr * ZS + (4 * hp - e) * 32 + fq * 8;
#pragma unroll
                for (int i = 0; i < NIB; ++i) {
                    const int sj = 4 * (hp + i) - e;
                    if (sj >= 0 && sj < NS) acc[i] = mfma16(Af, *(const bf16x8*)(zb + i * 128), acc[i]);
                }
            }
#pragma unroll
            for (int i = 0; i < NIB; ++i) {
                const int t0 = 16 * (w + 8 * (hp + i)) + fq * 4;
                float x[6];
                x[0] = t0 > 0 ? b2f(gs[t0 - 1]) : 0.f;
                const u32x2 gv = *(const u32x2*)(gs + t0);
                x[1] = blo(gv.x); x[2] = bhi(gv.x); x[3] = blo(gv.y); x[4] = bhi(gv.y);
                x[5] = (t0 + 4 < L) ? b2f(gs[t0 + 4]) : 0.f;
                const u32x2 zv = *(const u32x2*)(Zin + fr * ZS + t0);
                const float z[4] = {blo(zv.x), bhi(zv.x), blo(zv.y), bhi(zv.y)};
                float val[4];
#pragma unroll
                for (int j = 0; j < 4; ++j) val[j] = (gb + gw0 * x[j] + gw1 * x[j + 1] + gw2 * x[j + 2]) * (acc[i][j] + dsk * z[j]);
                if (o == 0) { u32x2 ov; ov.x = pk2(val[0], val[1]); ov.y = pk2(val[2], val[3]); *(u32x2*)(ZB + fr * ZS + t0) = ov; }
                else {
#pragma unroll
                    for (int j = 0; j < 4; ++j) MIX[(size_t)(segbase + fr * L + t0 + j) * 1024 + 512 + c] = f2b(val[j]);
                }
            }
        }
        __syncthreads();
    }
}

template <bool LAT>
__device__ __forceinline__ void attn_item(const Params& p, int li, int b, int h, int sub) {
    const int tid = tid_l(), w = tid >> 6, lane = tid & 63, fr = lane & 15, fq = lane >> 4;
    bf16_t* Pw = (bf16_t*)dyn_lds + w * (16 * 520);
    float* rpbs = (float*)(dyn_lds + 8 * 16 * 520 * 2);
    const bf16_t* QK = (const bf16_t*)(p.ws + WS_BIG);
    const bf16_t* VTg = (const bf16_t*)(p.ws + WS_P2);
    bf16_t* MIX = (bf16_t*)(p.ws + WS_ACT);
    if (LAT) { const float* rp = p.in[24] + ((size_t)li * 16 + h) * 465; for (int i = tid; i < 465; i += NT) rpbs[i] = rp[i]; }
    __syncthreads();
    int r = 0, c0 = 0, rs = 0, cw0 = 0, qtok0;
    if (LAT) { r = sub * 2 + (w >> 2); const int qt = w & 3; c0 = qt * 16; qtok0 = b * 2048 + r * 64 + c0; rs = min(max(r - 4, 0), 24); cw0 = (qt == 0) ? 0 : (qt == 1) ? 8 : (qt == 2) ? 24 : 32; }
    else { qtok0 = NLAT + b * 256 + (sub * 8 + w) * 16; }
    float qg[16], kg[16];
#pragma unroll
    for (int e = 0; e < 8; ++e) { qg[e] = p.in[22][li * 64 + fq * 8 + e]; qg[8 + e] = p.in[22][li * 64 + 32 + fq * 8 + e]; kg[e] = p.in[23][li * 64 + fq * 8 + e]; kg[8 + e] = p.in[23][li * 64 + 32 + fq * 8 + e]; }
    bf16x8 qf[2];
    {
        const bf16_t* qp = QK + (size_t)(qtok0 + fr) * 2048 + h * 64 + fq * 8;
        float f[16]; unpack8(*(const u32x4*)qp, f); unpack8(*(const u32x4*)(qp + 32), f + 8);
        float ss = 0.f;
#pragma unroll
        for (int e = 0; e < 16; ++e) ss += f[e] * f[e];
        ss += __shfl_xor(ss, 16); ss += __shfl_xor(ss, 32);
        const float rstd = rsqrtf(ss * (1.f / 64.f) + EPS) * 0.125f;
#pragma unroll
        for (int e = 0; e < 16; ++e) f[e] *= rstd * qg[e];
        qf[0] = as_bf8(pack8(f)); qf[1] = as_bf8(pack8(f + 8));
    }
    f32x4 sreg[32];
#define KTILE(KT_, KTOK0_) do { \
        const bf16_t* kp = QK + (size_t)((KTOK0_) + fr) * 2048 + 1024 + h * 64 + fq * 8; \
        float f[16]; unpack8(*(const u32x4*)kp, f); unpack8(*(const u32x4*)(kp + 32), f + 8); \
        float ss = 0.f; \
        _Pragma("unroll") for (int e = 0; e < 16; ++e) ss += f[e] * f[e]; \
        ss += __shfl_xor(ss, 16); ss += __shfl_xor(ss, 32); \
        const float rstd = rsqrtf(ss * (1.f / 64.f) + EPS); \
        _Pragma("unroll") for (int e = 0; e < 16; ++e) f[e] *= rstd * kg[e]; \
        f32x4 sa = (f32x4){0.f, 0.f, 0.f, 0.f}; \
        sa = mfma16(as_bf8(pack8(f)), qf[0], sa); sa = mfma16(as_bf8(pack8(f + 8)), qf[1], sa); \
        sreg[KT_] = sa; } while (0)
    if (LAT) {
        const int qc = c0 + fr; const int cstart = min(max(qc - 8, 0), 48);
#pragma unroll
        for (int kt = 0; kt < 16; ++kt) {
            const int kr = kt >> 1, kcb = cw0 + (kt & 1) * 16;
            KTILE(kt, b * 2048 + (rs + kr) * 64 + kcb);
            const int dri = (rs + kr - r + 7) * 31;
#pragma unroll
            for (int j = 0; j < 4; ++j) {
                const int kc = kcb + fq * 4 + j;
                const bool valid = (kc >= cstart) && (kc < cstart + 16);
                const int dci = min(max(kc - qc + 15, 0), 30);
                sreg[kt][j] = valid ? sreg[kt][j] + rpbs[dri + dci] : -1e30f;
            }
            if (kt & 1) __builtin_amdgcn_sched_barrier(0);
        }
    }
    constexpr int KT0 = LAT ? 0 : 16;
#pragma unroll
    for (int kt = 16; kt < 32; ++kt) { KTILE(kt, NLAT + b * 256 + (kt - 16) * 16); if (kt & 1) __builtin_amdgcn_sched_barrier(0); }
    float mx = -1e30f;
#pragma unroll
    for (int kt = KT0; kt < 32; ++kt)
#pragma unroll
        for (int j = 0; j < 4; ++j) mx = fmaxf(mx, sreg[kt][j]);
    mx = fmaxf(mx, __shfl_xor(mx, 16)); mx = fmaxf(mx, __shfl_xor(mx, 32));
    float lsum = 0.f;
#pragma unroll
    for (int kt = KT0; kt < 32; ++kt) {
        float pj[4];
#pragma unroll
        for (int j = 0; j < 4; ++j) { pj[j] = __expf(sreg[kt][j] - mx); lsum += pj[j]; }
        u32x2 o; o.x = pk2(pj[0], pj[1]); o.y = pk2(pj[2], pj[3]);
        *(u32x2*)(Pw + fr * 520 + kt * 16 + fq * 4) = o;
    }
    lsum += __shfl_xor(lsum, 16); lsum += __shfl_xor(lsum, 32);
    __syncthreads();
    f32x4 oacc[4];
#pragma unroll
    for (int dt = 0; dt < 4; ++dt) oacc[dt] = (f32x4){0.f, 0.f, 0.f, 0.f};
#pragma unroll
    for (int ks = (LAT ? 0 : 8); ks < 16; ++ks) {
        const int vtok0 = ks < 8 ? b * 2048 + (rs + ks) * 64 + cw0 : NLAT + b * 256 + (ks - 8) * 32;
        const bf16x8 pf = *(const bf16x8*)(Pw + fr * 520 + ks * 32 + fq * 8);
#pragma unroll
        for (int dt = 0; dt < 4; ++dt) {
            const bf16x8 vf = *(const bf16x8*)(VTg + (size_t)(h * 64 + dt * 16 + fr) * MTOT + vtok0 + fq * 8);
            oacc[dt] = mfma16(vf, pf, oacc[dt]);
        }
    }
    const float inv = 1.f / lsum;
#pragma unroll
    for (int dt = 0; dt < 4; ++dt) {
        u32x2 o; o.x = pk2(oacc[dt][0] * inv, oacc[dt][1] * inv); o.y = pk2(oacc[dt][2] * inv, oacc[dt][3] * inv);
        *(u32x2*)(MIX + (size_t)(qtok0 + fr) * 1024 + h * 64 + dt * 16 + fq * 4) = o;
    }
    __syncthreads();
#undef KTILE
}


#ifdef DBG_NAN
__device__ __forceinline__ bool bad16(bf16_t v) { return ((v >> 7) & 0xFF) >= 227; }
__device__ __forceinline__ bool bad32(float f) { return !(fabsf(f) < 1e30f); }
__device__ __forceinline__ void scan16(const bf16_t* p, size_t n, unsigned* flags, unsigned bit) {
    bool bad = false;
    for (size_t i = (size_t)blockIdx.x * NT + threadIdx.x; i < n; i += (size_t)gridDim.x * NT) bad |= bad16(p[i]);
    if (bad) atomicOr(flags, bit);
}
__device__ __forceinline__ void scan32(const float* p, size_t n, unsigned* flags, unsigned bit) {
    bool bad = false;
    for (size_t i = (size_t)blockIdx.x * NT + threadIdx.x; i < n; i += (size_t)gridDim.x * NT) bad |= bad32(p[i]);
    if (bad) atomicOr(flags, bit);
}
#endif
#define GSYNC() do { asm volatile("s_waitcnt vmcnt(0) lgkmcnt(0)" ::: "memory"); grid.sync(); } while (0)
__global__ void __launch_bounds__(NT) fwd_megakernel(Params p) {
    cg::grid_group grid = cg::this_grid();
    const int blk = blockIdx.x, G = gridDim.x;
    bf16_t* WIN = (bf16_t*)(p.ws + WS_WIN); bf16_t* WOUT = (bf16_t*)(p.ws + WS_WOUT); bf16_t* WM1 = (bf16_t*)(p.ws + WS_WM1); bf16_t* WM2 = (bf16_t*)(p.ws + WS_WM2);
    bf16_t* ACT = (bf16_t*)(p.ws + WS_ACT); bf16_t* BIG = (bf16_t*)(p.ws + WS_BIG);
    float* XC = (float*)(p.ws + WS_XC);
    const float* MOD = (const float*)(p.ws + WS_MOD);
    REP(64) if (PHMASK & 1) phase0(p);
#ifdef DBG_NAN
    unsigned* dflags = (unsigned*)(p.ws + WS_END);
    if (blk == 0 && threadIdx.x < 64) dflags[threadIdx.x] = 0u;
#endif
    GSYNC();
#pragma unroll 1
    for (int l = 0; l < 4; ++l) {
        const bool even = !(l & 1), last = (l == 3); const int li = l >> 1;
        const float* xlat = (l == 0) ? p.in[0] : p.out; const float* xctx = (l == 0) ? p.in[2] : XC;
        const int Mtail = last ? NLAT : MTOT;
        REP(1) {
        if (PHMASK & 2) convert_weights(p, l);
        if (PHMASK & 4) norm_phase(p, l, xlat, xctx, 0, 1024, MTOT);
        if ((PHMASK & 8) && even) filter_gen(p, li);
        }
        GSYNC();
        {
            EpiArgs ea{}; ea.o_rm = BIG; ea.ld_rm = 2048; ea.o_cm = (bf16_t*)(p.ws + WS_P2); ea.gates = (float*)(p.ws + WS_GATES); ea.gate_pn = even ? 14 : -1; ea.o_dbg = (bf16_t*)(p.ws + WS_HFB);
            REP(2) if (PHMASK & 16) gemm_phase<EPI_INPROJ>(ACT, WIN, MTOT, even ? 3840 : 3072, 1024, ea);
        }
        GSYNC();
#ifdef DBG_NAN
        if (l == DBG_LAYER) {
            {
                const unsigned gid = blk * NT + threadIdx.x;
                unsigned hsh = gid * 2654435761u + 12345u; hsh ^= hsh >> 13; hsh *= 2246822519u; hsh ^= hsh >> 16;
                const int row = hsh % MTOT; const int col = (hsh >> 8) % 2048; const int ch = (hsh >> 4) % 1536;
                const bf16_t* ar = ACT + (size_t)row * 1024; const bf16_t* wq = WIN + (size_t)col * 1024; const bf16_t* wh = WIN + (size_t)(2048 + ch) * 1024;
                float sq = 0.f, sh_ = 0.f;
                for (int k = 0; k < 1024; ++k) { const float av = b2f(ar[k]); sq += av * b2f(wq[k]); sh_ += av * b2f(wh[k]); }
                const float gq = b2f(BIG[(size_t)row * 2048 + col]);
                const float gh = b2f(((const bf16_t*)(p.ws + WS_P2))[(size_t)ch * MTOT + row]);
                (void)gq; (void)sq;

                { const int cls = DBG_CLS; atomicAdd(dflags + 16 + cls, 1u);
                  if (!(fabsf(gh - sh_) <= 0.05f + 0.02f * fabsf(sh_))) { atomicAdd(dflags + 2, 1u); atomicAdd(dflags + 32 + cls, 1u); } }
            }
            GSYNC();
            if (blk == 0 && threadIdx.x == 0) {
                const float fQ = (float)__hip_atomic_load(dflags + 1, __ATOMIC_RELAXED, __HIP_MEMORY_SCOPE_AGENT) / (float)(G * NT);
                const float fH = (float)__hip_atomic_load(dflags + 2, __ATOMIC_RELAXED, __HIP_MEMORY_SCOPE_AGENT) / (float)(G * NT);
                unsigned mask = 0;
                for (int q_ = 0; q_ < 8; ++q_) { const unsigned tot = __hip_atomic_load(dflags + 16 + q_, __ATOMIC_RELAXED, __HIP_MEMORY_SCOPE_AGENT), bad = __hip_atomic_load(dflags + 32 + q_, __ATOMIC_RELAXED, __HIP_MEMORY_SCOPE_AGENT); if (bad * 4 > tot) mask |= 1u << q_; }
                float code = 1e5f; for (unsigned q_ = 0; q_ < (mask >> 4); ++q_) code *= 10.f;
                const unsigned n3 = __hip_atomic_load(dflags + 3, __ATOMIC_RELAXED, __HIP_MEMORY_SCOPE_AGENT), b1 = __hip_atomic_load(dflags + 1, __ATOMIC_RELAXED, __HIP_MEMORY_SCOPE_AGENT), b4 = __hip_atomic_load(dflags + 4, __ATOMIC_RELAXED, __HIP_MEMORY_SCOPE_AGENT);
                p.out[0] = code * (1.f + 0.5f * (float)(mask & 15)) + 0.f * (fQ + fH + (float)(n3 + b1 + b4));
            }
            return;
        }
#endif
        if (even) {
            REP(4) if (G >= 256) {
                if (blk < 128) { if (PHMASK & 32) mlstm_item(p, li, blk); }
                else { const int hb = blk - 128, HG = G - 128;
                    if (PHMASK & 64) for (int it = hb; it < 512; it += HG) hyena_item<2048>(p, li, it);
                    if (PHMASK & 64) for (int it = hb; it < 512; it += HG) hyena_item<256>(p, li, it); }
            } else {
            }
            GSYNC();
            if (PHMASK & 128) combine_phase(p, li);
        } else {
            const int x = blk & 7, y = blk >> 3, ny = (G + 7) >> 3;
            REP(4) for (int i = 0; ; ++i) {
                const int slot = i * ny + y;
                if (slot >= 512) break;
                const int bh = x * 32 + (slot >> 4), rp = slot & 15;
                if (PHMASK & 256) attn_item<true>(p, li, bh >> 4, bh & 15, rp);
            }
            if ((PHMASK & 512) && !last) for (int it = blk; it < 512; it += G) attn_item<false>(p, li, it >> 5, (it >> 1) & 15, it & 1);
        }
        GSYNC();
        {
            EpiArgs ea{}; ea.res_lat = xlat; ea.res_ctx = xctx; ea.out_lat = p.out; ea.out_ctx = XC; ea.modg = MOD + (size_t)l * 17 * 6144 + 2048;
            if (DUPMASK & 32) gemm_phase<EPI_DRY>(ACT, WOUT, Mtail, 1024, 1024, ea);
            if (PHMASK & 1024) gemm_phase<EPI_RESID>(ACT, WOUT, Mtail, 1024, 1024, ea);
        }
        GSYNC();
        REP(8) norm_phase(p, l, p.out, XC, 3072, 4096, Mtail);
        GSYNC();
        { EpiArgs ea{}; ea.o_rm = BIG; ea.ld_rm = 4096; ea.gate_pn = -1; REP(16) if (PHMASK & 2048) gemm_phase<EPI_RELU2>(ACT, WM1, Mtail, 4096, 1024, ea); }
        GSYNC();
        {
            EpiArgs ea{}; ea.res_lat = p.out; ea.res_ctx = XC; ea.out_lat = p.out; ea.out_ctx = XC; ea.modg = MOD + (size_t)l * 17 * 6144 + 5120;
            if (DUPMASK & 32) gemm_phase<EPI_DRY>(BIG, WM2, Mtail, 1024, 4096, ea);
            if (PHMASK & 4096) gemm_phase<EPI_RESID>(BIG, WM2, Mtail, 1024, 4096, ea);
        }
        GSYNC();
    }
}

extern "C" void kernel_launch(void* const* d_in, const int* in_sizes, int n_in, void* d_out, int out_size, void* d_ws, size_t ws_size, hipStream_t stream) {
    static int grid_blocks = 0;
    if (grid_blocks == 0) {
        if (n_in != 26 || ws_size < WS_END + 256) { fprintf(stderr, "kernel_launch: unexpected n_in %d or ws_size %zu (< %zu)\n", n_in, ws_size, (size_t)WS_END); grid_blocks = -1; return; }
        int dev = 0, cus = 0, per_cu = 0;
        hipGetDevice(&dev);
        hipDeviceGetAttribute(&cus, hipDeviceAttributeMultiprocessorCount, dev);
        if (hipFuncSetAttribute((const void*)fwd_megakernel, hipFuncAttributeMaxDynamicSharedMemorySize, LDS_BYTES) != hipSuccess) fprintf(stderr, "kernel_launch: hipFuncSetAttribute failed\n");
        if (hipOccupancyMaxActiveBlocksPerMultiprocessor(&per_cu, (const void*)fwd_megakernel, NT, LDS_BYTES) != hipSuccess || per_cu < 1) { fprintf(stderr, "kernel_launch: occupancy query gave %d\n", per_cu); per_cu = 1; }
        (void)hipGetLastError();
        grid_blocks = cus * 1;
        fprintf(stderr, "kernel_launch: cus %d per_cu %d grid %d\n", cus, per_cu, grid_blocks);
    }
    if (grid_blocks < 0) return;
    Params p{};
    for (int i = 0; i < 26; ++i) p.in[i] = (const float*)d_in[i];
    p.out = (float*)d_out; p.ws = (unsigned char*)d_ws;
    void* args[] = {&p};
    hipError_t e = hipLaunchCooperativeKernel((void*)fwd_megakernel, dim3(grid_blocks), dim3(NT), args, LDS_BYTES, stream);
    if (e != hipSuccess) fprintf(stderr, "cooperative launch failed: %s (grid %d)\n", hipGetErrorString(e), grid_blocks);
}
```

```cpp
#include <hip/hip_runtime.h>
#include <hip/hip_cooperative_groups.h>
#include <cstdio>
#include <cstdint>
namespace cg = cooperative_groups;

typedef unsigned short bf16_t;
typedef short bf16x8 __attribute__((ext_vector_type(8)));
typedef float f32x4 __attribute__((ext_vector_type(4)));
typedef unsigned u32x4 __attribute__((ext_vector_type(4)));
typedef unsigned u32x2 __attribute__((ext_vector_type(2)));

#define NT 512
#define DBG_LAYER 0
#define DBG_CLS ((((row % 64) / 16) * 2) + ((ch % 32) / 16))
#ifndef PHMASK
#define PHMASK 0xFFFF
#endif
#ifndef DUPMASK
#define DUPMASK 0
#endif
#define REP(bit) for (int rep_ = 0; rep_ < (((DUPMASK) & (bit)) ? 2 : 1); ++rep_)
constexpr int BATCH = 16, SEQ = 2048, DM = 1024, CTXL = 256;
constexpr int NLAT = BATCH * SEQ, NCTX = BATCH * CTXL, MTOT = NLAT + NCTX;
constexpr int DFF = 4096;
constexpr float EPS = 1e-6f;
constexpr int LDS_BYTES = 147456;

constexpr size_t al256(size_t x) { return (x + 255) & ~(size_t)255; }
constexpr size_t WS_WIN = 0;
constexpr size_t WS_WOUT = al256(WS_WIN + (size_t)3840 * 1024 * 2);
constexpr size_t WS_WM1 = al256(WS_WOUT + (size_t)1024 * 1024 * 2);
constexpr size_t WS_WM2 = al256(WS_WM1 + (size_t)4096 * 1024 * 2);
constexpr size_t WS_MOD = al256(WS_WM2 + (size_t)4096 * 1024 * 2);
constexpr size_t WS_XC = al256(WS_MOD + (size_t)4 * 17 * 6144 * 4);
constexpr size_t WS_ACT = al256(WS_XC + (size_t)NCTX * 1024 * 4);
constexpr size_t WS_BIG = al256(WS_ACT + (size_t)MTOT * 1024 * 2);
constexpr size_t WS_P2 = WS_BIG + (size_t)MTOT * 2048 * 2;
constexpr size_t WS_GATES = WS_P2 + (size_t)1536 * MTOT * 2;
constexpr size_t WS_HFB = al256(WS_BIG + (size_t)MTOT * 4096 * 2);
constexpr size_t WS_FLAT = al256(WS_HFB + (size_t)2 * MTOT * 512 * 2);
constexpr size_t WS_FCTX = al256(WS_FLAT + (size_t)2 * 512 * 4096 * 2);
constexpr size_t WS_H2 = al256(WS_FCTX + (size_t)2 * 512 * 512 * 2);
constexpr size_t WS_ROPE = al256(WS_H2 + (size_t)2 * 2304 * 64 * 4);
constexpr size_t WS_END = al256(WS_ROPE + (size_t)2 * 64 * 32 * 4);
static_assert(WS_GATES + (size_t)MTOT * 16 * 4 <= WS_HFB, "projection overlay too large");

struct Params { const float* in[26]; float* out; unsigned char* ws; };

typedef float f32x2_ __attribute__((ext_vector_type(2)));
typedef __bf16 bf16x2_ __attribute__((ext_vector_type(2)));
__device__ __forceinline__ unsigned pk2(float lo, float hi) { f32x2_ v = {lo, hi}; bf16x2_ b = __builtin_convertvector(v, bf16x2_); return __builtin_bit_cast(unsigned, b); }
__device__ __forceinline__ bf16_t f2b(float x) { return (bf16_t)(pk2(x, 0.f) & 0xffffu); }
__device__ __forceinline__ float b2f(bf16_t b) { return __uint_as_float(((unsigned)b) << 16); }
__device__ __forceinline__ float blo(unsigned w) { return __uint_as_float(w << 16); }
__device__ __forceinline__ float bhi(unsigned w) { return __uint_as_float(w & 0xffff0000u); }
__device__ __forceinline__ void unpack8(u32x4 v, float* f) {
    f[0] = blo(v.x); f[1] = bhi(v.x); f[2] = blo(v.y); f[3] = bhi(v.y); f[4] = blo(v.z); f[5] = bhi(v.z); f[6] = blo(v.w); f[7] = bhi(v.w);
}
__device__ __forceinline__ u32x4 pack8(const float* f) { u32x4 r; r.x = pk2(f[0], f[1]); r.y = pk2(f[2], f[3]); r.z = pk2(f[4], f[5]); r.w = pk2(f[6], f[7]); return r; }
__device__ __forceinline__ float fsin_(float x) { float r = x * 0.15915494309189535f; r -= floorf(r); return __builtin_amdgcn_sinf(r); }
__device__ __forceinline__ float fcos_(float x) { float r = x * 0.15915494309189535f; r -= floorf(r); return __builtin_amdgcn_cosf(r); }
__device__ __forceinline__ float wave_sum(float v) {
#pragma unroll
    for (int o = 1; o < 64; o <<= 1) v += __shfl_xor(v, o);
    return v;
}
__device__ __forceinline__ f32x4 mfma16(bf16x8 a, bf16x8 b, f32x4 c) { return __builtin_amdgcn_mfma_f32_16x16x32_bf16(a, b, c, 0, 0, 0); }
__device__ __forceinline__ bf16x8 as_bf8(u32x4 v) { return __builtin_bit_cast(bf16x8, v); }

extern __shared__ __attribute__((aligned(16))) unsigned char dyn_lds[];
__device__ __forceinline__ int tid_l() { int t = threadIdx.x; asm volatile("" : "+v"(t)); return t; }

constexpr int G_BM = 256, G_BK = 64, G_HALF = 128, G_HT = G_HALF * G_BK;
__device__ __forceinline__ int lds_byte(int r, int c) {
    int st = (r >> 4) * 2 + (c >> 5), rr = r & 15, cc = c & 31, ob = rr * 64 + cc * 2;
    return st * 1024 + (ob ^ (((ob >> 9) & 1) << 5));
}
__device__ __forceinline__ void stage_rc(int b, int& R, int& C) {
    int st = b / 1024, sb = b % 1024, swz = sb ^ (((sb >> 9) & 1) << 5);
    R = (st >> 1) * 16 + swz / 64; C = (st & 1) * 32 + (swz % 64) / 2;
}

enum { EPI_INPROJ = 0, EPI_RESID = 1, EPI_RELU2 = 2, EPI_DRY = 3 };
struct EpiArgs {
    bf16_t* o_rm; int ld_rm;
    bf16_t* o_dbg;
    bf16_t* o_cm;
    float* gates; int gate_pn;
    const float* res_lat; const float* res_ctx; float* out_lat; float* out_ctx; const float* modg;
};

#define WAIT_V_(n) asm volatile("s_waitcnt vmcnt(" #n ")" ::: "memory")
#define WAIT_V(n) WAIT_V_(n)
#ifndef GEMM_VM
#define GEMM_VM 8
#endif
#define WAIT_L(n) asm volatile("s_waitcnt lgkmcnt(" #n ")" ::: "memory")
#define BAR __builtin_amdgcn_s_barrier()
#define CFENCE asm volatile("" ::: "memory")

template <bool TR>
__device__ __forceinline__ void gemm_kloop(const bf16_t* __restrict__ A, const bf16_t* __restrict__ Bt, int K, int brow, int bcol, f32x4 (&acc)[2][2][4][2]) {
    bf16_t* shm = (bf16_t*)dyn_lds;
#define SA(b, h) (shm + ((b) * 2 + (h)) * G_HT)
#define SB(b, h) (shm + (4 + (b) * 2 + (h)) * G_HT)
    const int tidx = tid_l();
    const int wid = tidx >> 6, lane = tidx & 63, wr = wid >> 2, wc = wid & 3, fr = lane & 15, fq = lane >> 4;
    const int nt = K / G_BK;
    int goff[2];
#pragma unroll
    for (int i = 0; i < 2; ++i) { int r_, c_; stage_rc(tidx * 16 + i * 8192, r_, c_); goff[i] = r_ * K + c_; }
    const bf16_t* Ab = A + (long)brow * K; const bf16_t* Bb = Bt + (long)bcol * K;
#define STAGE2(P, BASEP, kt) do { _Pragma("unroll") for (int _i = 0; _i < 2; ++_i) \
      __builtin_amdgcn_global_load_lds((const unsigned*)((BASEP) + (kt) * G_BK + goff[_i]), (unsigned*)((char*)(P) + tidx * 16 + _i * 8192), 16, 0, 0); } while (0)
    STAGE2(SA(0, 0), Ab, 0); STAGE2(SA(0, 1), Ab + (long)G_HALF * K, 0); STAGE2(SB(0, 0), Bb, 0); STAGE2(SB(0, 1), Bb + (long)G_HALF * K, 0);
    for (int kt = 0; kt < nt; ++kt) {
        const int cur = kt & 1, nxt = cur ^ 1;
        if (kt + 1 < nt) {
            STAGE2(SA(nxt, 0), Ab, kt + 1); STAGE2(SA(nxt, 1), Ab + (long)G_HALF * K, kt + 1);
            STAGE2(SB(nxt, 0), Bb, kt + 1); STAGE2(SB(nxt, 1), Bb + (long)G_HALF * K, kt + 1);
            WAIT_V(GEMM_VM);
        } else { WAIT_V(0); }
        BAR; CFENCE;
#pragma unroll
        for (int k = 0; k < 2; ++k) {
            bf16x8 Bf[2][2];
#pragma unroll
            for (int bj = 0; bj < 2; ++bj)
#pragma unroll
                for (int n = 0; n < 2; ++n) Bf[bj][n] = *reinterpret_cast<const bf16x8*>((char*)SB(cur, bj) + lds_byte(wc * 32 + n * 16 + fr, k * 32 + fq * 8));
#pragma unroll
            for (int ai = 0; ai < 2; ++ai) {
                bf16x8 Af[4];
#pragma unroll
                for (int m = 0; m < 4; ++m) Af[m] = *reinterpret_cast<const bf16x8*>((char*)SA(cur, ai) + lds_byte(wr * 64 + m * 16 + fr, k * 32 + fq * 8));
#pragma unroll
                for (int m = 0; m < 4; ++m)
#pragma unroll
                    for (int bj = 0; bj < 2; ++bj)
#pragma unroll
                        for (int n = 0; n < 2; ++n)
                            acc[ai][bj][m][n] = TR ? mfma16(Bf[bj][n], Af[m], acc[ai][bj][m][n]) : mfma16(Af[m], Bf[bj][n], acc[ai][bj][m][n]);
            }
        }
        WAIT_L(0); BAR; CFENCE;
    }
}

template <int EPI>
__device__ __forceinline__ void gemm_phase(const bf16_t* A, const bf16_t* Bt, int M, int N, int K, const EpiArgs& ea) {
    const int nM = M / G_BM, nN = N / G_BM, nwg = nM * nN;
    const int tidx = tid_l(); const int wid = tidx >> 6, lane = tidx & 63, wr = wid >> 2, wc = wid & 3, fr = lane & 15, fq = lane >> 4;
    for (int L = blockIdx.x; L < nwg; L += gridDim.x) {
        int wgid = L;
        { int q = nwg / 8, r = nwg % 8, xcd = wgid % 8, off = wgid / 8; wgid = (xcd < r ? xcd * (q + 1) : r * (q + 1) + (xcd - r) * q) + off; }
        const int nig = 8 * nN, gid = wgid / nig, fm = gid * 8, gsz = min(nM - fm, 8);
        const int pm = fm + ((wgid % nig) % gsz), pn = (wgid % nig) / gsz, brow = pm * G_BM, bcol = pn * G_BM;
        f32x4 acc[2][2][4][2];
#pragma unroll
        for (int a = 0; a < 2; ++a)
#pragma unroll
            for (int b = 0; b < 2; ++b)
#pragma unroll
                for (int m = 0; m < 4; ++m)
#pragma unroll
                    for (int n = 0; n < 2; ++n) acc[a][b][m][n] = (f32x4){0.f, 0.f, 0.f, 0.f};
        const bool colmajor = (EPI == EPI_INPROJ) && pn >= 8 && pn != ea.gate_pn;
        if (colmajor) {
            gemm_kloop<true>(A, Bt, K, brow, bcol, acc);
#pragma unroll
            for (int ai = 0; ai < 2; ++ai)
#pragma unroll
                for (int bj = 0; bj < 2; ++bj)
#pragma unroll
                    for (int m = 0; m < 4; ++m)
#pragma unroll
                        for (int n = 0; n < 2; ++n) {
                            const int row = brow + ai * 128 + wr * 64 + m * 16 + fr, col = bcol + bj * 128 + wc * 32 + n * 16 + fq * 4;
                            const f32x4 v = acc[ai][bj][m][n];
#pragma unroll
                            for (int j = 0; j < 4; ++j) ea.o_cm[(size_t)(col + j - 2048) * MTOT + row] = f2b(v[j]);
                        }
        } else {
            gemm_kloop<true>(A, Bt, K, brow, bcol, acc);
#pragma unroll
            for (int ai = 0; ai < 2; ++ai)
#pragma unroll
                for (int m = 0; m < 4; ++m) {
                    const int row = brow + ai * 128 + wr * 64 + m * 16 + fr;
#pragma unroll
                    for (int bj = 0; bj < 2; ++bj)
#pragma unroll
                        for (int n = 0; n < 2; ++n) {
                            const int col = bcol + bj * 128 + wc * 32 + n * 16 + fq * 4;
                            const f32x4 v = acc[ai][bj][m][n];
                            if (EPI == EPI_INPROJ) {
                                if (pn == ea.gate_pn) {
                                    if (bj == 0 && wc == 0 && n == 0) *(f32x4*)(ea.gates + (size_t)row * 16 + fq * 4) = v;
                                } else {
                                    u32x2 o; o.x = pk2(v[0], v[1]); o.y = pk2(v[2], v[3]);
                                    *(u32x2*)(ea.o_rm + (size_t)row * ea.ld_rm + col) = o;
                                }
                            } else if (EPI == EPI_DRY) {
                                if (v[0] == 123456.789f && v[1] == 3.25f) *(f32x4*)(ea.out_lat + (size_t)row * 1024 + (col & 1023)) = v;
                            } else if (EPI == EPI_RELU2) {
                                float r0 = fmaxf(v[0], 0.f), r1 = fmaxf(v[1], 0.f), r2 = fmaxf(v[2], 0.f), r3 = fmaxf(v[3], 0.f);
                                u32x2 o; o.x = pk2(r0 * r0, r1 * r1); o.y = pk2(r2 * r2, r3 * r3);
                                *(u32x2*)(ea.o_rm + (size_t)row * ea.ld_rm + col) = o;
                            } else {
                                const float* rp; float* op; int mrow;
                                if (row < NLAT) { rp = ea.res_lat + (size_t)row * 1024 + col; op = ea.out_lat + (size_t)row * 1024 + col; mrow = row >> 11; }
                                else { rp = ea.res_ctx + (size_t)(row - NLAT) * 1024 + col; op = ea.out_ctx + (size_t)(row - NLAT) * 1024 + col; mrow = 16; }
                                const f32x4 g = *(const f32x4*)(ea.modg + (size_t)mrow * 6144 + col);
                                const f32x4 x = *(const f32x4*)rp;
                                f32x4 rr = x + g * v;
#ifdef SANITIZE
#pragma unroll
                                for (int q_ = 0; q_ < 4; ++q_) if (!(fabsf(rr[q_]) < 1e30f)) rr[q_] = 0.f;
#endif
                                *(f32x4*)op = rr;
                            }
                        }
                }
        }
        asm volatile("s_waitcnt vmcnt(0)" ::: "memory");
        __syncthreads();
    }
}

__device__ __forceinline__ void phase0(const Params& p) {
    const int tid = tid_l(), blk = blockIdx.x, nb = gridDim.x;
    float* MOD = (float*)(p.ws + WS_MOD);
    for (int it = blk; it < 193; it += nb) {
        if (it < 192) {
            float* sl = (float*)dyn_lds;
            float* red = sl + 17 * 1024;
            for (int i = tid; i < 17 * 1024; i += NT) { float v = (i < 16 * 1024) ? p.in[1][i] : p.in[3][i - 16 * 1024]; sl[i] = v / (1.f + __expf(-v)); }
            __syncthreads();
            const int l = it / 48, nc = it % 48, kp = tid >> 7, col = tid & 127;
            const float* W = p.in[4] + (size_t)l * 1024 * 6144 + nc * 128 + col;
            float acc[17];
#pragma unroll
            for (int r = 0; r < 17; ++r) acc[r] = 0.f;
            for (int k = kp * 256; k < kp * 256 + 256; ++k) {
                const float wv = W[(size_t)k * 6144];
#pragma unroll
                for (int r = 0; r < 17; ++r) acc[r] += sl[r * 1024 + k] * wv;
            }
#pragma unroll
            for (int r = 0; r < 17; ++r) red[(kp * 17 + r) * 128 + col] = acc[r];
            __syncthreads();
            for (int i = tid; i < 17 * 128; i += NT) {
                const int r = i >> 7, cc = i & 127;
                const float s = red[(0 * 17 + r) * 128 + cc] + red[(1 * 17 + r) * 128 + cc] + red[(2 * 17 + r) * 128 + cc] + red[(3 * 17 + r) * 128 + cc];
                MOD[((size_t)l * 17 + r) * 6144 + nc * 128 + cc] = s + p.in[5][l * 6144 + nc * 128 + cc];
            }
            __syncthreads();
        } else {
            float* ROPE = (float*)(p.ws + WS_ROPE);
            for (int i = tid; i < 2048; i += NT) {
                const int pos = i >> 5, j = i & 31;
                const float inv = exp2f(-(float)j * (13.287712379549449f / 32.f));
                const float ang = (float)pos * inv;
                ROPE[i] = fcos_(ang); ROPE[2048 + i] = fsin_(ang);
            }
        }
    }
    float* H2 = (float*)(p.ws + WS_H2);
    const int gw = blk * 8 + (tid >> 6), lane = tid & 63;
    for (int it = gw; it < 2 * 2304; it += nb * 8) {
        const int i = it / 2304, row = it % 2304;
        const int L = row < 2048 ? 2048 : 256, t = row < 2048 ? row : row - 2048;
        const float tn = (float)t / (float)(L - 1);
        const float wpos = 6.283185307179586f * (float)t / (float)L;
        float ev = 0.f;
        if (lane == 0) ev = tn;
        else if (lane <= 16) { const float fr = 1e-4f + (float)(lane - 1) * ((15.f - 1e-4f) / 15.f); ev = fcos_(wpos * fr); }
        else if (lane <= 32) { const float fr = 1e-4f + (float)(lane - 17) * ((15.f - 1e-4f) / 15.f); ev = -fsin_(wpos * fr); }
        const float* w1 = p.in[13] + i * 33 * 64; const float* b1 = p.in[14] + i * 64;
        const float* w2 = p.in[15] + i * 64 * 64; const float* b2 = p.in[16] + i * 64; const float* fq = p.in[18] + i * 64;
        float a = b1[lane];
        for (int e = 0; e < 33; ++e) a += __shfl(ev, e) * w1[e * 64 + lane];
        const float h1 = fsin_(fq[lane] * a);
        float a2 = b2[lane];
        for (int e = 0; e < 64; ++e) a2 += __shfl(h1, e) * w2[e * 64 + lane];
        H2[((size_t)i * 2304 + row) * 64 + lane] = fsin_(fq[lane] * a2);
    }
}

__device__ __forceinline__ void cvt_tile(const float* W, int N, int K, bf16_t* WT, int n0, int k0, int mapmode) {
    float* tl = (float*)dyn_lds;
    const int tid = tid_l(), nl = tid & 63, kb = tid >> 6;
    const int n = n0 + nl; int sc = n;
    if (mapmode == 1) sc = n < 2048 ? n : (n < 3584 ? n + 16 : (n < 3600 ? n - 3584 + 2048 : -1));
#pragma unroll
    for (int i = 0; i < 8; ++i) { const int kl = kb + 8 * i; tl[kl * 65 + nl] = sc >= 0 ? W[(size_t)(k0 + kl) * N + sc] : 0.f; }
    __syncthreads();
    const int nn = tid >> 3, kc = tid & 7;
    float f[8];
#pragma unroll
    for (int j = 0; j < 8; ++j) f[j] = tl[(kc * 8 + j) * 65 + nn];
    *(u32x4*)(WT + (size_t)(n0 + nn) * K + k0 + kc * 8) = pack8(f);
    __syncthreads();
}

__device__ __forceinline__ void convert_weights(const Params& p, int l) {
    const int blk = blockIdx.x, nb = gridDim.x, li = l >> 1; const bool even = !(l & 1);
    const int nin = even ? 60 : 48;
    const int t_in = nin * 16, t_out = 256, t_m1 = 1024, t_m2 = 1024;
    const int total = t_in + t_out + t_m1 + t_m2;
    for (int it = blk; it < total; it += nb) {
        int r = it;
        if (r < t_in) {
            const int nt = r / 16, kt = r % 16;
            if (even) cvt_tile(p.in[8] + (size_t)li * 1024 * 3600, 3600, 1024, (bf16_t*)(p.ws + WS_WIN), nt * 64, kt * 64, 1);
            else cvt_tile(p.in[21] + (size_t)li * 1024 * 3072, 3072, 1024, (bf16_t*)(p.ws + WS_WIN), nt * 64, kt * 64, 0);
            continue;
        }
        r -= t_in;
        if (r < t_out) {
            const int nt = r / 16, kt = r % 16;
            cvt_tile((even ? p.in[20] : p.in[25]) + (size_t)li * 1024 * 1024, 1024, 1024, (bf16_t*)(p.ws + WS_WOUT), nt * 64, kt * 64, 0);
            continue;
        }
        r -= t_out;
        if (r < t_m1) {
            const int nt = r / 16, kt = r % 16;
            cvt_tile(p.in[6] + (size_t)l * 1024 * 4096, 4096, 1024, (bf16_t*)(p.ws + WS_WM1), nt * 64, kt * 64, 0);
            continue;
        }
        r -= t_m1;
        { const int nt = r / 64, kt = r % 64;
          cvt_tile(p.in[7] + (size_t)l * 4096 * 1024, 1024, 4096, (bf16_t*)(p.ws + WS_WM2), nt * 64, kt * 64, 0); }
    }
}

__device__ __forceinline__ void norm_phase(const Params& p, int l, const float* xlat, const float* xctx, int shoff, int scoff, int M) {
    const int tid = tid_l(), lane = tid & 63, gw = blockIdx.x * 8 + (tid >> 6), ngw = gridDim.x * 8;
    const float* MOD = (const float*)(p.ws + WS_MOD) + (size_t)l * 17 * 6144;
    bf16_t* ACT = (bf16_t*)(p.ws + WS_ACT);
    for (int row = gw; row < M; row += ngw) {
        const float* xr = row < NLAT ? xlat + (size_t)row * 1024 : xctx + (size_t)(row - NLAT) * 1024;
        const int mrow = row < NLAT ? row >> 11 : 16;
        const float* mod = MOD + (size_t)mrow * 6144;
        f32x4 v[4]; float ss = 0.f;
#pragma unroll
        for (int j = 0; j < 4; ++j) { v[j] = *(const f32x4*)(xr + 4 * lane + 256 * j); ss += v[j][0] * v[j][0] + v[j][1] * v[j][1] + v[j][2] * v[j][2] + v[j][3] * v[j][3]; }
        ss = wave_sum(ss);
        const float rstd = rsqrtf(ss * (1.f / 1024.f) + EPS);
#pragma unroll
        for (int j = 0; j < 4; ++j) {
            const int col = 4 * lane + 256 * j;
            const f32x4 sh = *(const f32x4*)(mod + shoff + col), sc = *(const f32x4*)(mod + scoff + col);
            const f32x4 y = v[j] * rstd * (sc + 1.f) + sh;
            u32x2 o; o.x = pk2(y[0], y[1]); o.y = pk2(y[2], y[3]);
            *(u32x2*)(ACT + (size_t)row * 1024 + col) = o;
        }
    }
}

__device__ __forceinline__ void filter_gen(const Params& p, int li) {
    const int tid = tid_l(), lane = tid & 63, w = tid >> 6;
    float* wf = (float*)dyn_lds; float* wb = wf + 64; float* red = wb + 64;
    const float* H2 = (const float*)(p.ws + WS_H2);
    for (int it = blockIdx.x; it < 2048; it += gridDim.x) {
        const int ltype = it >> 10, o = (it >> 9) & 1, c = it & 511;
        const int L = ltype ? 256 : 2048;
        const float* H2r = H2 + ((size_t)li * 2304 + (ltype ? 2048 : 0)) * 64;
        const float* w3 = p.in[17] + (size_t)li * 64 * 2048;
        if (tid < 64) wf[tid] = w3[tid * 2048 + (o * 2 + 0) * 512 + c];
        else if (tid < 128) wb[tid - 64] = w3[(tid - 64) * 2048 + (o * 2 + 1) * 512 + c];
        __syncthreads();
        const float lo = -4.605170185988091f / 1.5f, hi = -4.605170185988091f / 0.3f;
        const float delta = fabsf(lo + (hi - lo) * (float)c / 511.f);
        float vf[4], vb[4]; float ssf = 0.f, ssb = 0.f;
#pragma unroll
        for (int q = 0; q < 4; ++q) {
            const int t = tid + 512 * q; vf[q] = 0.f; vb[q] = 0.f;
            if (t < L) {
                float df = 0.f, db = 0.f;
                const f32x4* hr = (const f32x4*)(H2r + (size_t)t * 64);
#pragma unroll
                for (int j = 0; j < 16; ++j) { const f32x4 hv = hr[j];
                    df += hv[0] * wf[4 * j] + hv[1] * wf[4 * j + 1] + hv[2] * wf[4 * j + 2] + hv[3] * wf[4 * j + 3];
                    db += hv[0] * wb[4 * j] + hv[1] * wb[4 * j + 1] + hv[2] * wb[4 * j + 2] + hv[3] * wb[4 * j + 3]; }
                const float dec = __expf(-((float)t / (float)(L - 1)) * delta);
                vf[q] = df * dec; vb[q] = db * dec; ssf += vf[q] * vf[q]; ssb += vb[q] * vb[q];
            }
        }
        ssf = wave_sum(ssf); ssb = wave_sum(ssb);
        if (lane == 0) { red[w] = ssf; red[8 + w] = ssb; }
        __syncthreads();
        float tf = 0.f, tb = 0.f;
#pragma unroll
        for (int i = 0; i < 8; ++i) { tf += red[i]; tb += red[8 + i]; }
        const float nf = rsqrtf(tf + EPS), nbk = rsqrtf(tb + EPS);
        bf16_t* dst = ltype ? (bf16_t*)(p.ws + WS_FCTX) + ((size_t)o * 512 + c) * 512 : (bf16_t*)(p.ws + WS_FLAT) + ((size_t)o * 512 + c) * 4096;
#pragma unroll
        for (int q = 0; q < 4; ++q) {
            const int t = tid + 512 * q;
            if (t < L) {
                if (t == 0) { dst[L] = f2b(vf[q] * nf + vb[q] * nbk); dst[0] = 0; }
                else { dst[L + t] = f2b(vf[q] * nf); dst[L - t] = f2b(vb[q] * nbk); }
            }
        }
        __syncthreads();
    }
}

__device__ __forceinline__ void mlstm_item(const Params& p, int li, int it) {
    const int tid = tid_l(), w = tid >> 6, lane = tid & 63, fr = lane & 15, fq = lane >> 4;
    const int b = it >> 3, h = (it >> 1) & 3, dir = it & 1;
    bf16_t* Qs = (bf16_t*)dyn_lds;
    bf16_t* Ks = Qs + 64 * 136;
    bf16_t* KT = Ks + 64 * 136;
    bf16_t* VT = KT + 128 * 72;
    bf16_t* Cb = VT + 144 * 72;
    bf16_t* Ps = Cb + 144 * 136;
    float* fl = (float*)(Ps + 64 * 72);
    float* a_s = fl; float* Mt = fl + 64; float* scs = fl + 128; float* emt = fl + 192; float* den = fl + 256; float* lfs = fl + 320; float* igs = fl + 384; float* scal = fl + 448;
    const bf16_t* QKVO = (const bf16_t*)(p.ws + WS_BIG);
    const float* GATES = (const float*)(p.ws + WS_GATES);
    bf16_t* HFB = (bf16_t*)(p.ws + WS_HFB) + (size_t)dir * MTOT * 512;
    const float* ROPE = (const float*)(p.ws + WS_ROPE);
    const float* gate_b = p.in[9] + li * 16;
    for (int i = tid; i < 144 * 136 / 2; i += NT) ((unsigned*)Cb)[i] = 0u;
    for (int i = tid; i < 16 * 72; i += NT) { const int r = i / 72, ci = i % 72; VT[(128 + r) * 72 + ci] = (r == 0 && ci < 64) ? (bf16_t)0x3F80 : (bf16_t)0; }
    f32x4 cacc[9];
#pragma unroll
    for (int i = 0; i < 9; ++i) cacc[i] = (f32x4){0.f, 0.f, 0.f, 0.f};
    float m = 0.f;
    __syncthreads();
    for (int step = 0; step < 36; ++step) {
        const bool isctx = step < 4;
        const int cj = isctx ? (dir ? 3 - step : step) : (dir ? 35 - step : step - 4);
        const int rowbase = isctx ? NLAT + b * 256 + cj * 64 : b * 2048 + cj * 64;
        {
            const int r = tid >> 3, seg = tid & 7; const int tl = dir ? 63 - r : r;
            const bf16_t* src = QKVO + (size_t)(rowbase + tl) * 2048 + h * 128;
            const int hb = seg >> 2, jb = (seg & 3) * 8, d1 = hb * 64 + jb, d2 = d1 + 32;
            const u32x4 q1 = *(const u32x4*)(src + d1), q2 = *(const u32x4*)(src + d2);
            const u32x4 k1 = *(const u32x4*)(src + 512 + d1), k2 = *(const u32x4*)(src + 512 + d2);
            const u32x4 v1 = *(const u32x4*)(src + 1024 + seg * 16), v2 = *(const u32x4*)(src + 1024 + seg * 16 + 8);
            float cs[8], sn[8];
            if (!isctx) {
                const int pos = hb ? tl : cj;
                const f32x4 c0 = *(const f32x4*)(ROPE + pos * 32 + jb), c1 = *(const f32x4*)(ROPE + pos * 32 + jb + 4);
                const f32x4 s0 = *(const f32x4*)(ROPE + 2048 + pos * 32 + jb), s1 = *(const f32x4*)(ROPE + 2048 + pos * 32 + jb + 4);
#pragma unroll
                for (int e = 0; e < 4; ++e) { cs[e] = c0[e]; cs[4 + e] = c1[e]; sn[e] = s0[e]; sn[4 + e] = s1[e]; }
            } else {
#pragma unroll
                for (int e = 0; e < 8; ++e) { cs[e] = 1.f; sn[e] = 0.f; }
            }
            float x1[8], x2[8], o1[8], o2[8];
            unpack8(q1, x1); unpack8(q2, x2);
#pragma unroll
            for (int e = 0; e < 8; ++e) { o1[e] = x1[e] * cs[e] - x2[e] * sn[e]; o2[e] = x1[e] * sn[e] + x2[e] * cs[e]; }
            *(u32x4*)(Qs + r * 136 + d1) = pack8(o1); *(u32x4*)(Qs + r * 136 + d2) = pack8(o2);
            unpack8(k1, x1); unpack8(k2, x2);
            const float ksc = 0.08838834764831845f;
#pragma unroll
            for (int e = 0; e < 8; ++e) { o1[e] = (x1[e] * cs[e] - x2[e] * sn[e]) * ksc; o2[e] = (x1[e] * sn[e] + x2[e] * cs[e]) * ksc; }
            const u32x4 ko1 = pack8(o1), ko2 = pack8(o2);
            *(u32x4*)(Ks + r * 136 + d1) = ko1; *(u32x4*)(Ks + r * 136 + d2) = ko2;
            {
                const unsigned kw1[4] = {ko1.x, ko1.y, ko1.z, ko1.w}, kw2[4] = {ko2.x, ko2.y, ko2.z, ko2.w};
#pragma unroll
                for (int e = 0; e < 4; ++e) {
                    KT[(d1 + 2 * e) * 72 + r] = (bf16_t)(kw1[e] & 0xffffu); KT[(d1 + 2 * e + 1) * 72 + r] = (bf16_t)(kw1[e] >> 16);
                    KT[(d2 + 2 * e) * 72 + r] = (bf16_t)(kw2[e] & 0xffffu); KT[(d2 + 2 * e + 1) * 72 + r] = (bf16_t)(kw2[e] >> 16);
                }
                const unsigned vw1[4] = {v1.x, v1.y, v1.z, v1.w}, vw2[4] = {v2.x, v2.y, v2.z, v2.w};
#pragma unroll
                for (int e = 0; e < 4; ++e) {
                    VT[(seg * 16 + 2 * e) * 72 + r] = (bf16_t)(vw1[e] & 0xffffu); VT[(seg * 16 + 2 * e + 1) * 72 + r] = (bf16_t)(vw1[e] >> 16);
                    VT[(seg * 16 + 8 + 2 * e) * 72 + r] = (bf16_t)(vw2[e] & 0xffffu); VT[(seg * 16 + 8 + 2 * e + 1) * 72 + r] = (bf16_t)(vw2[e] >> 16);
                }
            }
            if (tid < 64) {
                const int rr = tid, tl2 = dir ? 63 - rr : rr;
                const float* g = GATES + (size_t)(rowbase + tl2) * 16;
                const float ig = g[dir * 8 + h] + gate_b[dir * 8 + h];
                const float fg = g[dir * 8 + 4 + h] + gate_b[dir * 8 + 4 + h];
                igs[rr] = ig; lfs[rr] = fminf(fg, 0.f) - __logf(1.f + __expf(-fabsf(fg)));
            }
        }
        __syncthreads();
        if (w == 0) {
            float bcs = lfs[lane];
#pragma unroll
            for (int o = 1; o < 64; o <<= 1) { const float t = __shfl_up(bcs, o); if (lane >= o) bcs += t; }
            const float a = igs[lane] - bcs;
            float pm = a;
#pragma unroll
            for (int o = 1; o < 64; o <<= 1) { const float t = __shfl_up(pm, o); if (lane >= o) pm = fmaxf(pm, t); }
            const float Mx = fmaxf(m, pm);
            a_s[lane] = a; Mt[lane] = Mx; scs[lane] = __expf(m - Mx); emt[lane] = __expf(-bcs - Mx);
            if (lane == 63) { scal[0] = bcs; scal[1] = Mx; }
        }
        {
            const int st = w & 3, tt0 = (w >> 2) * 2;
            f32x4 sacc[2];
#pragma unroll
            for (int u = 0; u < 2; ++u) {
                sacc[u] = (f32x4){0.f, 0.f, 0.f, 0.f};
#pragma unroll
                for (int kk = 0; kk < 4; ++kk) {
                    const bf16x8 Ak = *(const bf16x8*)(Ks + (st * 16 + fr) * 136 + kk * 32 + fq * 8);
                    const bf16x8 Bq = *(const bf16x8*)(Qs + ((tt0 + u) * 16 + fr) * 136 + kk * 32 + fq * 8);
                    sacc[u] = mfma16(Ak, Bq, sacc[u]);
                }
            }
            __syncthreads();
#pragma unroll
            for (int u = 0; u < 2; ++u) {
                const int t = (tt0 + u) * 16 + fr, sb = st * 16 + fq * 4;
                const float Mv = Mt[t];
                float pv[4];
#pragma unroll
                for (int j = 0; j < 4; ++j) { const int s = sb + j; pv[j] = (s <= t) ? sacc[u][j] * __expf(a_s[s] - Mv) : 0.f; }
                u32x2 o; o.x = pk2(pv[0], pv[1]); o.y = pk2(pv[2], pv[3]);
                *(u32x2*)(Ps + t * 72 + sb) = o;
            }
        }
        __syncthreads();
        {
            const int tt = w & 3, up = w >> 2, vt0 = up ? 5 : 0, nvt = up ? 4 : 5;
            bf16x8 qf[4], pf[2];
#pragma unroll
            for (int kk = 0; kk < 4; ++kk) qf[kk] = *(const bf16x8*)(Qs + (tt * 16 + fr) * 136 + kk * 32 + fq * 8);
#pragma unroll
            for (int kk = 0; kk < 2; ++kk) pf[kk] = *(const bf16x8*)(Ps + (tt * 16 + fr) * 72 + kk * 32 + fq * 8);
            const float sct = scs[tt * 16 + fr];
            f32x4 hacc[5];
#pragma unroll
            for (int vi = 0; vi < 5; ++vi) {
                hacc[vi] = (f32x4){0.f, 0.f, 0.f, 0.f};
                if (vi < nvt) {
                    const int v0 = (vt0 + vi) * 16;
                    f32x4 ac = (f32x4){0.f, 0.f, 0.f, 0.f};
#pragma unroll
                    for (int kk = 0; kk < 4; ++kk) ac = mfma16(*(const bf16x8*)(Cb + (v0 + fr) * 136 + kk * 32 + fq * 8), qf[kk], ac);
                    ac = ac * sct;
#pragma unroll
                    for (int kk = 0; kk < 2; ++kk) ac = mfma16(*(const bf16x8*)(VT + (v0 + fr) * 72 + kk * 32 + fq * 8), pf[kk], ac);
                    hacc[vi] = ac;
                }
            }
            if (up && fq == 0) den[tt * 16 + fr] = hacc[3][0];
            __syncthreads();
            const int t = tt * 16 + fr, tl = dir ? 63 - t : t;
            const float dn = den[t];
            const float inv = 1.f / fmaxf(fabsf(dn), emt[t]);
            bf16_t* orow = HFB + (size_t)(rowbase + tl) * 512 + h * 128;
#pragma unroll
            for (int vi = 0; vi < 5; ++vi) {
                if (vi < nvt && (vt0 + vi) < 8) {
                    const int v0 = (vt0 + vi) * 16 + fq * 4;
                    u32x2 o; o.x = pk2(hacc[vi][0] * inv, hacc[vi][1] * inv); o.y = pk2(hacc[vi][2] * inv, hacc[vi][3] * inv);
                    *(u32x2*)(orow + v0) = o;
                }
            }
        }
        {
            const float bl = scal[0], M63 = scal[1];
            const float decay = __expf(m - M63);
            bf16x8 ka[2];
#pragma unroll
            for (int kk = 0; kk < 2; ++kk) {
                const u32x4 raw = *(const u32x4*)(KT + (w * 16 + fr) * 72 + kk * 32 + fq * 8);
                float f[8]; unpack8(raw, f);
#pragma unroll
                for (int j = 0; j < 8; ++j) f[j] *= __expf(a_s[kk * 32 + fq * 8 + j] - M63);
                ka[kk] = as_bf8(pack8(f));
            }
#pragma unroll
            for (int vt = 0; vt < 9; ++vt) {
                f32x4 ac = cacc[vt] * decay;
#pragma unroll
                for (int kk = 0; kk < 2; ++kk) ac = mfma16(ka[kk], *(const bf16x8*)(VT + (vt * 16 + fr) * 72 + kk * 32 + fq * 8), ac);
                cacc[vt] = ac;
                u32x2 o; o.x = pk2(ac[0], ac[1]); o.y = pk2(ac[2], ac[3]);
                *(u32x2*)(Cb + (vt * 16 + fr) * 136 + w * 16 + fq * 4) = o;
            }
            m = bl + M63;
        }
        __syncthreads();
    }
}

__device__ __forceinline__ void combine_phase(const Params& p, int li) {
    const int tid = tid_l(), lane = tid & 63, gw = blockIdx.x * 8 + (tid >> 6), ngw = gridDim.x * 8;
    const bf16_t* HF = (const bf16_t*)(p.ws + WS_HFB); const bf16_t* HB = HF + (size_t)MTOT * 512;
    const bf16_t* QKVO = (const bf16_t*)(p.ws + WS_BIG);
    bf16_t* MIX = (bf16_t*)(p.ws + WS_ACT);
    const float* hn = p.in[10] + li * 512 + lane * 8;
    float g[8];
#pragma unroll
    for (int e = 0; e < 8; ++e) g[e] = hn[e];
    for (int row = gw; row < MTOT; row += ngw) {
        float a[8], bq[8], og[8], y[8];
        unpack8(*(const u32x4*)(HF + (size_t)row * 512 + lane * 8), a);
        unpack8(*(const u32x4*)(HB + (size_t)row * 512 + lane * 8), bq);
        unpack8(*(const u32x4*)(QKVO + (size_t)row * 2048 + 1536 + lane * 8), og);
        float ss = 0.f;
#pragma unroll
        for (int e = 0; e < 8; ++e) { a[e] += bq[e]; ss += a[e] * a[e]; }
        ss += __shfl_xor(ss, 1); ss += __shfl_xor(ss, 2); ss += __shfl_xor(ss, 4); ss += __shfl_xor(ss, 8);
        const float rstd = rsqrtf(ss * (1.f / 128.f) + EPS);
#pragma unroll
        for (int e = 0; e < 8; ++e) y[e] = a[e] * rstd * g[e] / (1.f + __expf(-og[e]));
        *(u32x4*)(MIX + (size_t)row * 1024 + lane * 8) = pack8(y);
    }
}

template <int L>
__device__ __forceinline__ void hyena_item(const Params& p, int li, int c) {
    constexpr int ZS = L + 8, NI = L / 128, NS = L / 32;
    const int tid = tid_l(), w = tid >> 6, lane = tid & 63, fr = lane & 15, fq = lane >> 4;
    bf16_t* ZA = (bf16_t*)dyn_lds; bf16_t* ZB = ZA + 16 * ZS; bf16_t* HFl = ZB + 16 * ZS;
    const bf16_t* zpad = HFl + 2 * L;
    if (tid < 8) HFl[2 * L + tid] = 0;
    const int segbase = (L == 2048) ? 0 : NLAT;
    const bf16_t* HYT = (const bf16_t*)(p.ws + WS_P2);
    bf16_t* MIX = (bf16_t*)(p.ws + WS_ACT);
    const float* cw = p.in[11] + (size_t)li * 3 * 1536; const float* cb = p.in[12] + (size_t)li * 1536; const float* hd = p.in[19] + (size_t)li * 2 * 512;
    const bf16_t* FIL = (L == 2048) ? (const bf16_t*)(p.ws + WS_FLAT) : (const bf16_t*)(p.ws + WS_FCTX);
    {
        const float w0 = cw[c], w1 = cw[1536 + c], w2 = cw[2 * 1536 + c], bb = cb[c];
        const bf16_t* src = HYT + (size_t)c * MTOT + segbase;
        for (int ch = tid; ch < 16 * L / 8; ch += NT) {
            const int b = ch / (L / 8), t0 = (ch % (L / 8)) * 8;
            const bf16_t* s = src + b * L + t0;
            float x[10], y[8];
            x[0] = t0 > 0 ? b2f(s[-1]) : 0.f;
            unpack8(*(const u32x4*)s, x + 1);
            x[9] = (t0 + 8 < L) ? b2f(s[8]) : 0.f;
#pragma unroll
            for (int e = 0; e < 8; ++e) y[e] = bb + w0 * x[e] + w1 * x[e + 1] + w2 * x[e + 2];
            *(u32x4*)(ZA + b * ZS + t0) = pack8(y);
        }
    }
#pragma unroll 1
    for (int o = 0; o < 2; ++o) {
        for (int i = tid; i < 2 * L / 8; i += NT) *(u32x4*)(HFl + i * 8) = *(const u32x4*)(FIL + ((size_t)o * 512 + c) * 2 * L + i * 8);
        __syncthreads();
        const bf16_t* Zin = o ? ZB : ZA;
        const int gc = (o + 1) * 512 + c;
        const float gw0 = cw[gc], gw1 = cw[1536 + gc], gw2 = cw[2 * 1536 + gc], gb = cb[gc], dsk = hd[o * 512 + c];
        const bf16_t* gs = HYT + (size_t)gc * MTOT + segbase + fr * L;
        constexpr int NIB = NI < 8 ? NI : 8;
#pragma unroll 1
        for (int hp = 0; hp < NI; hp += NIB) {
            f32x4 acc[NIB];
#pragma unroll
            for (int i = 0; i < NIB; ++i) acc[i] = (f32x4){0.f, 0.f, 0.f, 0.f};
#pragma unroll 2
            for (int e = 4 * hp - (NS - 1); e <= 4 * (hp + NIB - 1); ++e) {
                const int base = L + 16 * w + 32 * e + fr - fq * 8;
                bf16x8 Af;
#pragma unroll
                for (int j = 0; j < 8; ++j) Af[j] = (short)HFl[base - j];
                const bf16_t* zb = Zin + fr * ZS + (4 * hp - e) * 32 + fq * 8;
#pragma unroll
                for (int i = 0; i < NIB; ++i) {
                    const int sj = 4 * (hp + i) - e;
                    const bf16_t* bp = (sj >= 0 && sj < NS) ? (zb + i * 128) : zpad;
                    acc[i] = mfma16(Af, *(const bf16x8*)bp, acc[i]);
                }
            }
#pragma unroll
            for (int i = 0; i < NIB; ++i) {
                const int t0 = 16 * (w + 8 * (hp + i)) + fq * 4;
                float x[6];
                x[0] = t0 > 0 ? b2f(gs[t0 - 1]) : 0.f;
                const u32x2 gv = *(const u32x2*)(gs + t0);
                x[1] = blo(gv.x); x[2] = bhi(gv.x); x[3] = blo(gv.y); x[4] = bhi(gv.y);
                x[5] = (t0 + 4 < L) ? b2f(gs[t0 + 4]) : 0.f;
                const u32x2 zv = *(const u32x2*)(Zin + fr * ZS + t0);
                const float z[4] = {blo(zv.x), bhi(zv.x), blo(zv.y), bhi(zv.y)};
                float val[4];
#pragma unroll
                for (int j = 0; j < 4; ++j) val[j] = (gb + gw0 * x[j] + gw1 * x[j + 1] + gw2 * x[j + 2]) * (acc[i][j] + dsk * z[j]);
                { u32x2 ov; ov.x = pk2(val[0], val[1]); ov.y = pk2(val[2], val[3]); *(u32x2*)((o == 0 ? ZB : ZA) + fr * ZS + t0) = ov; }
            }
        }
        __syncthreads();
    }
    {
        bf16_t* dstp = (bf16_t*)(p.ws + WS_P2) + (size_t)c * MTOT + segbase;
        for (int ch = tid; ch < 16 * L / 8; ch += NT) {
            const int b = ch / (L / 8), t0 = (ch % (L / 8)) * 8;
            *(u32x4*)(dstp + b * L + t0) = *(const u32x4*)(ZA + b * ZS + t0);
        }
        __syncthreads();
    }
}

__device__ __forceinline__ void hy_transpose(const Params& p) {
    const int tid = tid_l();
    bf16_t* T = (bf16_t*)dyn_lds;
    const bf16_t* HYO = (const bf16_t*)(p.ws + WS_P2);
    bf16_t* MIX = (bf16_t*)(p.ws + WS_ACT);
    for (int it = blockIdx.x; it < (MTOT / 64) * 8; it += gridDim.x) {
        const int tt = it >> 3, cg_ = it & 7, tok0 = tt * 64, c0 = cg_ * 64;
        {
            const int ch = tid >> 3, t8 = (tid & 7) * 8;
            const u32x4 v = *(const u32x4*)(HYO + (size_t)(c0 + ch) * MTOT + tok0 + t8);
            const unsigned wv[4] = {v.x, v.y, v.z, v.w};
#pragma unroll
            for (int e = 0; e < 4; ++e) { T[(t8 + 2 * e) * 72 + ch] = (bf16_t)(wv[e] & 0xffffu); T[(t8 + 2 * e + 1) * 72 + ch] = (bf16_t)(wv[e] >> 16); }
        }
        __syncthreads();
        {
            const int tk = tid >> 3, c8 = (tid & 7) * 8;
            *(u32x4*)(MIX + (size_t)(tok0 + tk) * 1024 + 512 + c0 + c8) = *(const u32x4*)(T + tk * 72 + c8);
        }
        __syncthreads();
    }
}

template <bool LAT>
__device__ __forceinline__ void attn_item(const Params& p, int li, int b, int h, int sub) {
    const int tid = tid_l(), w = tid >> 6, lane = tid & 63, fr = lane & 15, fq = lane >> 4;
    bf16_t* Pw = (bf16_t*)dyn_lds + w * (16 * 520);
    float* rpbs = (float*)(dyn_lds + 8 * 16 * 520 * 2);
    const bf16_t* QK = (const bf16_t*)(p.ws + WS_BIG);
    const bf16_t* VTg = (const bf16_t*)(p.ws + WS_P2);
    bf16_t* MIX = (bf16_t*)(p.ws + WS_ACT);
    if (LAT) { const float* rp = p.in[24] + ((size_t)li * 16 + h) * 465; for (int i = tid; i < 465; i += NT) rpbs[i] = rp[i]; }
    __syncthreads();
    int r = 0, c0 = 0, rs = 0, cw0 = 0, qtok0;
    if (LAT) { r = sub * 2 + (w >> 2); const int qt = w & 3; c0 = qt * 16; qtok0 = b * 2048 + r * 64 + c0; rs = min(max(r - 4, 0), 24); cw0 = (qt == 0) ? 0 : (qt == 1) ? 8 : (qt == 2) ? 24 : 32; }
    else { qtok0 = NLAT + b * 256 + (sub * 8 + w) * 16; }
    float qg[16], kg[16];
#pragma unroll
    for (int e = 0; e < 8; ++e) { qg[e] = p.in[22][li * 64 + fq * 8 + e]; qg[8 + e] = p.in[22][li * 64 + 32 + fq * 8 + e]; kg[e] = p.in[23][li * 64 + fq * 8 + e]; kg[8 + e] = p.in[23][li * 64 + 32 + fq * 8 + e]; }
    bf16x8 qf[2];
    {
        const bf16_t* qp = QK + (size_t)(qtok0 + fr) * 2048 + h * 64 + fq * 8;
        float f[16]; unpack8(*(const u32x4*)qp, f); unpack8(*(const u32x4*)(qp + 32), f + 8);
        float ss = 0.f;
#pragma unroll
        for (int e = 0; e < 16; ++e) ss += f[e] * f[e];
        ss += __shfl_xor(ss, 16); ss += __shfl_xor(ss, 32);
        const float rstd = rsqrtf(ss * (1.f / 64.f) + EPS) * 0.125f;
#pragma unroll
        for (int e = 0; e < 16; ++e) f[e] *= rstd * qg[e];
        qf[0] = as_bf8(pack8(f)); qf[1] = as_bf8(pack8(f + 8));
    }
    f32x4 sreg[32];
#define KTILE(KT_, KTOK0_) do { \
        const bf16_t* kp = QK + (size_t)((KTOK0_) + fr) * 2048 + 1024 + h * 64 + fq * 8; \
        float f[16]; unpack8(*(const u32x4*)kp, f); unpack8(*(const u32x4*)(kp + 32), f + 8); \
        float ss = 0.f; \
        _Pragma("unroll") for (int e = 0; e < 16; ++e) ss += f[e] * f[e]; \
        ss += __shfl_xor(ss, 16); ss += __shfl_xor(ss, 32); \
        const float rstd = rsqrtf(ss * (1.f / 64.f) + EPS); \
        _Pragma("unroll") for (int e = 0; e < 16; ++e) f[e] *= rstd * kg[e]; \
        f32x4 sa = (f32x4){0.f, 0.f, 0.f, 0.f}; \
        sa = mfma16(as_bf8(pack8(f)), qf[0], sa); sa = mfma16(as_bf8(pack8(f + 8)), qf[1], sa); \
        sreg[KT_] = sa; } while (0)
    if (LAT) {
        const int qc = c0 + fr; const int cstart = min(max(qc - 8, 0), 48);
#pragma unroll
        for (int kt = 0; kt < 16; ++kt) {
            const int kr = kt >> 1, kcb = cw0 + (kt & 1) * 16;
            KTILE(kt, b * 2048 + (rs + kr) * 64 + kcb);
            const int dri = (rs + kr - r + 7) * 31;
#pragma unroll
            for (int j = 0; j < 4; ++j) {
                const int kc = kcb + fq * 4 + j;
                const bool valid = (kc >= cstart) && (kc < cstart + 16);
                const int dci = min(max(kc - qc + 15, 0), 30);
                sreg[kt][j] = valid ? sreg[kt][j] + rpbs[dri + dci] : -1e30f;
            }
            if (kt & 1) __builtin_amdgcn_sched_barrier(0);
        }
    }
    constexpr int KT0 = LAT ? 0 : 16;
#pragma unroll
    for (int kt = 16; kt < 32; ++kt) { KTILE(kt, NLAT + b * 256 + (kt - 16) * 16); if (kt & 1) __builtin_amdgcn_sched_barrier(0); }
    float mx = -1e30f;
#pragma unroll
    for (int kt = KT0; kt < 32; ++kt)
#pragma unroll
        for (int j = 0; j < 4; ++j) mx = fmaxf(mx, sreg[kt][j]);
    mx = fmaxf(mx, __shfl_xor(mx, 16)); mx = fmaxf(mx, __shfl_xor(mx, 32));
    float lsum = 0.f;
#pragma unroll
    for (int kt = KT0; kt < 32; ++kt) {
        float pj[4];
#pragma unroll
        for (int j = 0; j < 4; ++j) { pj[j] = __expf(sreg[kt][j] - mx); lsum += pj[j]; }
        u32x2 o; o.x = pk2(pj[0], pj[1]); o.y = pk2(pj[2], pj[3]);
        *(u32x2*)(Pw + fr * 520 + kt * 16 + fq * 4) = o;
    }
    lsum += __shfl_xor(lsum, 16); lsum += __shfl_xor(lsum, 32);
    __syncthreads();
    f32x4 oacc[4];
#pragma unroll
    for (int dt = 0; dt < 4; ++dt) oacc[dt] = (f32x4){0.f, 0.f, 0.f, 0.f};
#pragma unroll
    for (int ks = (LAT ? 0 : 8); ks < 16; ++ks) {
        const int vtok0 = ks < 8 ? b * 2048 + (rs + ks) * 64 + cw0 : NLAT + b * 256 + (ks - 8) * 32;
        const bf16x8 pf = *(const bf16x8*)(Pw + fr * 520 + ks * 32 + fq * 8);
#pragma unroll
        for (int dt = 0; dt < 4; ++dt) {
            const bf16x8 vf = *(const bf16x8*)(VTg + (size_t)(h * 64 + dt * 16 + fr) * MTOT + vtok0 + fq * 8);
            oacc[dt] = mfma16(vf, pf, oacc[dt]);
        }
    }
    const float inv = 1.f / lsum;
#pragma unroll
    for (int dt = 0; dt < 4; ++dt) {
        u32x2 o; o.x = pk2(oacc[dt][0] * inv, oacc[dt][1] * inv); o.y = pk2(oacc[dt][2] * inv, oacc[dt][3] * inv);
        *(u32x2*)(MIX + (size_t)(qtok0 + fr) * 1024 + h * 64 + dt * 16 + fq * 4) = o;
    }
    __syncthreads();
#undef KTILE
}


#ifdef DBG_NAN
__device__ __forceinline__ bool bad16(bf16_t v) { return ((v >> 7) & 0xFF) >= 227; }
__device__ __forceinline__ bool bad32(float f) { return !(fabsf(f) < 1e30f); }
__device__ __forceinline__ void scan16(const bf16_t* p, size_t n, unsigned* flags, unsigned bit) {
    bool bad = false;
    for (size_t i = (size_t)blockIdx.x * NT + threadIdx.x; i < n; i += (size_t)gridDim.x * NT) bad |= bad16(p[i]);
    if (bad) atomicOr(flags, bit);
}
__device__ __forceinline__ void scan32(const float* p, size_t n, unsigned* flags, unsigned bit) {
    bool bad = false;
    for (size_t i = (size_t)blockIdx.x * NT + threadIdx.x; i < n; i += (size_t)gridDim.x * NT) bad |= bad32(p[i]);
    if (bad) atomicOr(flags, bit);
}
#endif
#define GSYNC() do { asm volatile("s_waitcnt vmcnt(0) lgkmcnt(0)" ::: "memory"); grid.sync(); } while (0)
__global__ void __launch_bounds__(NT) fwd_megakernel(Params p) {
    cg::grid_group grid = cg::this_grid();
    const int blk = blockIdx.x, G = gridDim.x;
    bf16_t* WIN = (bf16_t*)(p.ws + WS_WIN); bf16_t* WOUT = (bf16_t*)(p.ws + WS_WOUT); bf16_t* WM1 = (bf16_t*)(p.ws + WS_WM1); bf16_t* WM2 = (bf16_t*)(p.ws + WS_WM2);
    bf16_t* ACT = (bf16_t*)(p.ws + WS_ACT); bf16_t* BIG = (bf16_t*)(p.ws + WS_BIG);
    float* XC = (float*)(p.ws + WS_XC);
    const float* MOD = (const float*)(p.ws + WS_MOD);
    REP(64) if (PHMASK & 1) phase0(p);
#ifdef DBG_NAN
    unsigned* dflags = (unsigned*)(p.ws + WS_END);
    if (blk == 0 && threadIdx.x < 64) dflags[threadIdx.x] = 0u;
#endif
    GSYNC();
#pragma unroll 1
    for (int l = 0; l < 4; ++l) {
        const bool even = !(l & 1), last = (l == 3); const int li = l >> 1;
        const float* xlat = (l == 0) ? p.in[0] : p.out; const float* xctx = (l == 0) ? p.in[2] : XC;
        const int Mtail = last ? NLAT : MTOT;
        REP(1) {
        if (PHMASK & 2) convert_weights(p, l);
        if (PHMASK & 4) norm_phase(p, l, xlat, xctx, 0, 1024, MTOT);
        if ((PHMASK & 8) && even) filter_gen(p, li);
        }
        GSYNC();
        {
            EpiArgs ea{}; ea.o_rm = BIG; ea.ld_rm = 2048; ea.o_cm = (bf16_t*)(p.ws + WS_P2); ea.gates = (float*)(p.ws + WS_GATES); ea.gate_pn = even ? 14 : -1; ea.o_dbg = (bf16_t*)(p.ws + WS_HFB);
            REP(2) if (PHMASK & 16) gemm_phase<EPI_INPROJ>(ACT, WIN, MTOT, even ? 3840 : 3072, 1024, ea);
        }
        GSYNC();
#ifdef DBG_NAN
        if (l == DBG_LAYER) {
            {
                const unsigned gid = blk * NT + threadIdx.x;
                unsigned hsh = gid * 2654435761u + 12345u; hsh ^= hsh >> 13; hsh *= 2246822519u; hsh ^= hsh >> 16;
                const int row = hsh % MTOT; const int col = (hsh >> 8) % 2048; const int ch = (hsh >> 4) % 1536;
                const bf16_t* ar = ACT + (size_t)row * 1024; const bf16_t* wq = WIN + (size_t)col * 1024; const bf16_t* wh = WIN + (size_t)(2048 + ch) * 1024;
                float sq = 0.f, sh_ = 0.f;
                for (int k = 0; k < 1024; ++k) { const float av = b2f(ar[k]); sq += av * b2f(wq[k]); sh_ += av * b2f(wh[k]); }
                const float gq = b2f(BIG[(size_t)row * 2048 + col]);
                const float gh = b2f(((const bf16_t*)(p.ws + WS_P2))[(size_t)ch * MTOT + row]);
                (void)gq; (void)sq;

                { const int cls = DBG_CLS; atomicAdd(dflags + 16 + cls, 1u);
                  if (!(fabsf(gh - sh_) <= 0.05f + 0.02f * fabsf(sh_))) { atomicAdd(dflags + 2, 1u); atomicAdd(dflags + 32 + cls, 1u); } }
            }
            GSYNC();
            if (blk == 0 && threadIdx.x == 0) {
                const float fQ = (float)__hip_atomic_load(dflags + 1, __ATOMIC_RELAXED, __HIP_MEMORY_SCOPE_AGENT) / (float)(G * NT);
                const float fH = (float)__hip_atomic_load(dflags + 2, __ATOMIC_RELAXED, __HIP_MEMORY_SCOPE_AGENT) / (float)(G * NT);
                unsigned mask = 0;
                for (int q_ = 0; q_ < 8; ++q_) { const unsigned tot = __hip_atomic_load(dflags + 16 + q_, __ATOMIC_RELAXED, __HIP_MEMORY_SCOPE_AGENT), bad = __hip_atomic_load(dflags + 32 + q_, __ATOMIC_RELAXED, __HIP_MEMORY_SCOPE_AGENT); if (bad * 4 > tot) mask |= 1u << q_; }
                float code = 1e5f; for (unsigned q_ = 0; q_ < (mask >> 4); ++q_) code *= 10.f;
                const unsigned n3 = __hip_atomic_load(dflags + 3, __ATOMIC_RELAXED, __HIP_MEMORY_SCOPE_AGENT), b1 = __hip_atomic_load(dflags + 1, __ATOMIC_RELAXED, __HIP_MEMORY_SCOPE_AGENT), b4 = __hip_atomic_load(dflags + 4, __ATOMIC_RELAXED, __HIP_MEMORY_SCOPE_AGENT);
                p.out[0] = code * (1.f + 0.5f * (float)(mask & 15)) + 0.f * (fQ + fH + (float)(n3 + b1 + b4));
            }
            return;
        }
#endif
        if (even) {
            REP(4) if (G >= 256) {
                if (blk < 128) { REP(512) if (PHMASK & 32) mlstm_item(p, li, blk); }
                else { const int hb = blk - 128, HG = G - 128;
                    REP(1024) { if (PHMASK & 64) for (int it = hb; it < 512; it += HG) hyena_item<2048>(p, li, it);
                    if (PHMASK & 64) for (int it = hb; it < 512; it += HG) hyena_item<256>(p, li, it); } }
            } else {
            }
            GSYNC();
            if (PHMASK & 128) { combine_phase(p, li); hy_transpose(p); }
        } else {
            const int x = blk & 7, y = blk >> 3, ny = (G + 7) >> 3;
            REP(256) for (int i = 0; ; ++i) {
                const int slot = i * ny + y;
                if (slot >= 512) break;
                const int bh = x * 32 + (slot >> 4), rp = slot & 15;
                if (PHMASK & 256) attn_item<true>(p, li, bh >> 4, bh & 15, rp);
            }
            if ((PHMASK & 512) && !last) for (int it = blk; it < 512; it += G) attn_item<false>(p, li, it >> 5, (it >> 1) & 15, it & 1);
        }
        GSYNC();
        {
            EpiArgs ea{}; ea.res_lat = xlat; ea.res_ctx = xctx; ea.out_lat = p.out; ea.out_ctx = XC; ea.modg = MOD + (size_t)l * 17 * 6144 + 2048;
            if (DUPMASK & 32) gemm_phase<EPI_DRY>(ACT, WOUT, Mtail, 1024, 1024, ea);
            if (PHMASK & 1024) gemm_phase<EPI_RESID>(ACT, WOUT, Mtail, 1024, 1024, ea);
        }
        GSYNC();
        REP(8) norm_phase(p, l, p.out, XC, 3072, 4096, Mtail);
        GSYNC();
        { EpiArgs ea{}; ea.o_rm = BIG; ea.ld_rm = 4096; ea.gate_pn = -1; REP(16) if (PHMASK & 2048) gemm_phase<EPI_RELU2>(ACT, WM1, Mtail, 4096, 1024, ea); }
        GSYNC();
        {
            EpiArgs ea{}; ea.res_lat = p.out; ea.res_ctx = XC; ea.out_lat = p.out; ea.out_ctx = XC; ea.modg = MOD + (size_t)l * 17 * 6144 + 5120;
            if (DUPMASK & 32) gemm_phase<EPI_DRY>(BIG, WM2, Mtail, 1024, 4096, ea);
            if (PHMASK & 4096) gemm_phase<EPI_RESID>(BIG, WM2, Mtail, 1024, 4096, ea);
        }
        GSYNC();
    }
}

extern "C" void kernel_launch(void* const* d_in, const int* in_sizes, int n_in, void* d_out, int out_size, void* d_ws, size_t ws_size, hipStream_t stream) {
    static int grid_blocks = 0;
    if (grid_blocks == 0) {
        if (n_in != 26 || ws_size < WS_END + 256) { fprintf(stderr, "kernel_launch: unexpected n_in %d or ws_size %zu (< %zu)\n", n_in, ws_size, (size_t)WS_END); grid_blocks = -1; return; }
        int dev = 0, cus = 0, per_cu = 0;
        hipGetDevice(&dev);
        hipDeviceGetAttribute(&cus, hipDeviceAttributeMultiprocessorCount, dev);
        if (hipFuncSetAttribute((const void*)fwd_megakernel, hipFuncAttributeMaxDynamicSharedMemorySize, LDS_BYTES) != hipSuccess) fprintf(stderr, "kernel_launch: hipFuncSetAttribute failed\n");
        if (hipOccupancyMaxActiveBlocksPerMultiprocessor(&per_cu, (const void*)fwd_megakernel, NT, LDS_BYTES) != hipSuccess || per_cu < 1) { fprintf(stderr, "kernel_launch: occupancy query gave %d\n", per_cu); per_cu = 1; }
        (void)hipGetLastError();
        grid_blocks = cus * 1;
        fprintf(stderr, "kernel_launch: cus %d per_cu %d grid %d\n", cus, per_cu, grid_blocks);
    }
    if (grid_blocks < 0) return;
    Params p{};
    for (int i = 0; i < 26; ++i) p.in[i] = (const float*)d_in[i];
    p.out = (float*)d_out; p.ws = (unsigned char*)d_ws;
    void* args[] = {&p};
    hipError_t e = hipLaunchCooperativeKernel((void*)fwd_megakernel, dim3(grid_blocks), dim3(NT), args, LDS_BYTES, stream);
    if (e != hipSuccess) fprintf(stderr, "cooperative launch failed: %s (grid %d)\n", hipGetErrorString(e), grid_blocks);
}
```

```cpp
#include <hip/hip_runtime.h>
#include <hip/hip_cooperative_groups.h>
#include <cstdio>
#include <cstdint>
namespace cg = cooperative_groups;

typedef unsigned short bf16_t;
typedef short bf16x8 __attribute__((ext_vector_type(8)));
typedef float f32x4 __attribute__((ext_vector_type(4)));
typedef unsigned u32x4 __attribute__((ext_vector_type(4)));
typedef unsigned u32x2 __attribute__((ext_vector_type(2)));

#define NT 512
#define DBG_LAYER 0
#define DBG_CLS ((((row % 64) / 16) * 2) + ((ch % 32) / 16))
#ifndef PHMASK
#define PHMASK 0xFFFF
#endif
#ifndef DUPMASK
#define DUPMASK 0
#endif
#define REP(bit) for (int rep_ = 0; rep_ < (((DUPMASK) & (bit)) ? 2 : 1); ++rep_)
constexpr int BATCH = 16, SEQ = 2048, DM = 1024, CTXL = 256;
constexpr int NLAT = BATCH * SEQ, NCTX = BATCH * CTXL, MTOT = NLAT + NCTX;
constexpr int DFF = 4096;
constexpr float EPS = 1e-6f;
constexpr int LDS_BYTES = 147456;

constexpr size_t al256(size_t x) { return (x + 255) & ~(size_t)255; }
constexpr size_t WS_WIN = 0;
constexpr size_t WS_WOUT = al256(WS_WIN + (size_t)3840 * 1024 * 2);
constexpr size_t WS_WM1 = al256(WS_WOUT + (size_t)1024 * 1024 * 2);
constexpr size_t WS_WM2 = al256(WS_WM1 + (size_t)4096 * 1024 * 2);
constexpr size_t WS_MOD = al256(WS_WM2 + (size_t)4096 * 1024 * 2);
constexpr size_t WS_XC = al256(WS_MOD + (size_t)4 * 17 * 6144 * 4);
constexpr size_t WS_ACT = al256(WS_XC + (size_t)NCTX * 1024 * 4);
constexpr size_t WS_BIG = al256(WS_ACT + (size_t)MTOT * 1024 * 2);
constexpr size_t WS_P2 = WS_BIG + (size_t)MTOT * 2048 * 2;
constexpr size_t WS_GATES = WS_P2 + (size_t)1536 * MTOT * 2;
constexpr size_t WS_HFB = al256(WS_BIG + (size_t)MTOT * 4096 * 2);
constexpr size_t WS_FLAT = al256(WS_HFB + (size_t)2 * MTOT * 512 * 2);
constexpr size_t WS_FCTX = al256(WS_FLAT + (size_t)2 * 512 * 4096 * 2);
constexpr size_t WS_H2 = al256(WS_FCTX + (size_t)2 * 512 * 512 * 2);
constexpr size_t WS_ROPE = al256(WS_H2 + (size_t)2 * 2304 * 64 * 4);
constexpr size_t WS_END = al256(WS_ROPE + (size_t)2 * 64 * 32 * 4);
static_assert(WS_GATES + (size_t)MTOT * 16 * 4 <= WS_HFB, "projection overlay too large");

struct Params { const float* in[26]; float* out; unsigned char* ws; };

typedef float f32x2_ __attribute__((ext_vector_type(2)));
typedef __bf16 bf16x2_ __attribute__((ext_vector_type(2)));
__device__ __forceinline__ unsigned pk2(float lo, float hi) { f32x2_ v = {lo, hi}; bf16x2_ b = __builtin_convertvector(v, bf16x2_); return __builtin_bit_cast(unsigned, b); }
__device__ __forceinline__ bf16_t f2b(float x) { return (bf16_t)(pk2(x, 0.f) & 0xffffu); }
__device__ __forceinline__ float b2f(bf16_t b) { return __uint_as_float(((unsigned)b) << 16); }
__device__ __forceinline__ float blo(unsigned w) { return __uint_as_float(w << 16); }
__device__ __forceinline__ float bhi(unsigned w) { return __uint_as_float(w & 0xffff0000u); }
__device__ __forceinline__ void unpack8(u32x4 v, float* f) {
    f[0] = blo(v.x); f[1] = bhi(v.x); f[2] = blo(v.y); f[3] = bhi(v.y); f[4] = blo(v.z); f[5] = bhi(v.z); f[6] = blo(v.w); f[7] = bhi(v.w);
}
__device__ __forceinline__ u32x4 pack8(const float* f) { u32x4 r; r.x = pk2(f[0], f[1]); r.y = pk2(f[2], f[3]); r.z = pk2(f[4], f[5]); r.w = pk2(f[6], f[7]); return r; }
__device__ __forceinline__ float fsin_(float x) { float r = x * 0.15915494309189535f; r -= floorf(r); return __builtin_amdgcn_sinf(r); }
__device__ __forceinline__ float fcos_(float x) { float r = x * 0.15915494309189535f; r -= floorf(r); return __builtin_amdgcn_cosf(r); }
__device__ __forceinline__ float wave_sum(float v) {
#pragma unroll
    for (int o = 1; o < 64; o <<= 1) v += __shfl_xor(v, o);
    return v;
}
__device__ __forceinline__ f32x4 mfma16(bf16x8 a, bf16x8 b, f32x4 c) { return __builtin_amdgcn_mfma_f32_16x16x32_bf16(a, b, c, 0, 0, 0); }
__device__ __forceinline__ bf16x8 as_bf8(u32x4 v) { return __builtin_bit_cast(bf16x8, v); }

extern __shared__ __attribute__((aligned(16))) unsigned char dyn_lds[];
__device__ __forceinline__ int tid_l() { int t = threadIdx.x; asm volatile("" : "+v"(t)); return t; }

constexpr int G_BM = 256, G_BK = 64, G_HALF = 128, G_HT = G_HALF * G_BK;
__device__ __forceinline__ int lds_byte(int r, int c) {
    int st = (r >> 4) * 2 + (c >> 5), rr = r & 15, cc = c & 31, ob = rr * 64 + cc * 2;
    return st * 1024 + (ob ^ (((ob >> 9) & 1) << 5));
}
__device__ __forceinline__ void stage_rc(int b, int& R, int& C) {
    int st = b / 1024, sb = b % 1024, swz = sb ^ (((sb >> 9) & 1) << 5);
    R = (st >> 1) * 16 + swz / 64; C = (st & 1) * 32 + (swz % 64) / 2;
}

enum { EPI_INPROJ = 0, EPI_RESID = 1, EPI_RELU2 = 2, EPI_DRY = 3 };
struct EpiArgs {
    bf16_t* o_rm; int ld_rm;
    bf16_t* o_dbg;
    bf16_t* o_cm;
    float* gates; int gate_pn;
    const float* res_lat; const float* res_ctx; float* out_lat; float* out_ctx; const float* modg;
};

#define WAIT_V_(n) asm volatile("s_waitcnt vmcnt(" #n ")" ::: "memory")
#define WAIT_V(n) WAIT_V_(n)
#ifndef GEMM_VM
#define GEMM_VM 8
#endif
#define WAIT_L(n) asm volatile("s_waitcnt lgkmcnt(" #n ")" ::: "memory")
#define BAR __builtin_amdgcn_s_barrier()
#define CFENCE asm volatile("" ::: "memory")

template <bool TR>
__device__ __forceinline__ void gemm_kloop(const bf16_t* __restrict__ A, const bf16_t* __restrict__ Bt, int K, int brow, int bcol, f32x4 (&acc)[2][2][4][2]) {
    bf16_t* shm = (bf16_t*)dyn_lds;
#define SA(b, h) (shm + ((b) * 2 + (h)) * G_HT)
#define SB(b, h) (shm + (4 + (b) * 2 + (h)) * G_HT)
    const int tidx = tid_l();
    const int wid = tidx >> 6, lane = tidx & 63, wr = wid >> 2, wc = wid & 3, fr = lane & 15, fq = lane >> 4;
    const int nt = K / G_BK;
    int goff[2];
#pragma unroll
    for (int i = 0; i < 2; ++i) { int r_, c_; stage_rc(tidx * 16 + i * 8192, r_, c_); goff[i] = r_ * K + c_; }
    const bf16_t* Ab = A + (long)brow * K; const bf16_t* Bb = Bt + (long)bcol * K;
#define STAGE2(P, BASEP, kt) do { _Pragma("unroll") for (int _i = 0; _i < 2; ++_i) \
      __builtin_amdgcn_global_load_lds((const unsigned*)((BASEP) + (kt) * G_BK + goff[_i]), (unsigned*)((char*)(P) + tidx * 16 + _i * 8192), 16, 0, 0); } while (0)
    STAGE2(SA(0, 0), Ab, 0); STAGE2(SA(0, 1), Ab + (long)G_HALF * K, 0); STAGE2(SB(0, 0), Bb, 0); STAGE2(SB(0, 1), Bb + (long)G_HALF * K, 0);
    for (int kt = 0; kt < nt; ++kt) {
        const int cur = kt & 1, nxt = cur ^ 1;
        WAIT_V(0); WAIT_L(0);
        BAR; CFENCE;
        if (kt + 1 < nt) {
            STAGE2(SA(nxt, 0), Ab, kt + 1); STAGE2(SA(nxt, 1), Ab + (long)G_HALF * K, kt + 1);
            STAGE2(SB(nxt, 0), Bb, kt + 1); STAGE2(SB(nxt, 1), Bb + (long)G_HALF * K, kt + 1);
        }
#pragma unroll
        for (int k = 0; k < 2; ++k) {
            bf16x8 Bf[2][2];
#pragma unroll
            for (int bj = 0; bj < 2; ++bj)
#pragma unroll
                for (int n = 0; n < 2; ++n) Bf[bj][n] = *reinterpret_cast<const bf16x8*>((char*)SB(cur, bj) + lds_byte(wc * 32 + n * 16 + fr, k * 32 + fq * 8));
#pragma unroll
            for (int ai = 0; ai < 2; ++ai) {
                bf16x8 Af[4];
#pragma unroll
                for (int m = 0; m < 4; ++m) Af[m] = *reinterpret_cast<const bf16x8*>((char*)SA(cur, ai) + lds_byte(wr * 64 + m * 16 + fr, k * 32 + fq * 8));
                __builtin_amdgcn_s_setprio(1);
#pragma unroll
                for (int m = 0; m < 4; ++m)
#pragma unroll
                    for (int bj = 0; bj < 2; ++bj)
#pragma unroll
                        for (int n = 0; n < 2; ++n)
                            acc[ai][bj][m][n] = TR ? mfma16(Bf[bj][n], Af[m], acc[ai][bj][m][n]) : mfma16(Af[m], Bf[bj][n], acc[ai][bj][m][n]);
                __builtin_amdgcn_s_setprio(0);
            }
        }
    }
    WAIT_L(0); BAR; CFENCE;
}

template <int EPI>
__device__ __forceinline__ void gemm_phase(const bf16_t* A, const bf16_t* Bt, int M, int N, int K, const EpiArgs& ea) {
    const int nM = M / G_BM, nN = N / G_BM, nwg = nM * nN;
    const int tidx = tid_l(); const int wid = tidx >> 6, lane = tidx & 63, wr = wid >> 2, wc = wid & 3, fr = lane & 15, fq = lane >> 4;
    for (int L = blockIdx.x; L < nwg; L += gridDim.x) {
        int wgid = L;
        { int q = nwg / 8, r = nwg % 8, xcd = wgid % 8, off = wgid / 8; wgid = (xcd < r ? xcd * (q + 1) : r * (q + 1) + (xcd - r) * q) + off; }
        const int nig = 8 * nN, gid = wgid / nig, fm = gid * 8, gsz = min(nM - fm, 8);
        const int pm = fm + ((wgid % nig) % gsz), pn = (wgid % nig) / gsz, brow = pm * G_BM, bcol = pn * G_BM;
        f32x4 acc[2][2][4][2];
#pragma unroll
        for (int a = 0; a < 2; ++a)
#pragma unroll
            for (int b = 0; b < 2; ++b)
#pragma unroll
                for (int m = 0; m < 4; ++m)
#pragma unroll
                    for (int n = 0; n < 2; ++n) acc[a][b][m][n] = (f32x4){0.f, 0.f, 0.f, 0.f};
        const bool colmajor = (EPI == EPI_INPROJ) && pn >= 8 && pn != ea.gate_pn;
        if (colmajor) {
            gemm_kloop<true>(A, Bt, K, brow, bcol, acc);
#pragma unroll
            for (int ai = 0; ai < 2; ++ai)
#pragma unroll
                for (int bj = 0; bj < 2; ++bj)
#pragma unroll
                    for (int m = 0; m < 4; ++m)
#pragma unroll
                        for (int n = 0; n < 2; ++n) {
                            const int row = brow + ai * 128 + wr * 64 + m * 16 + fr, col = bcol + bj * 128 + wc * 32 + n * 16 + fq * 4;
                            const f32x4 v = acc[ai][bj][m][n];
#pragma unroll
                            for (int j = 0; j < 4; ++j) ea.o_cm[(size_t)(col + j - 2048) * MTOT + row] = f2b(v[j]);
                        }
        } else {
            gemm_kloop<true>(A, Bt, K, brow, bcol, acc);
#pragma unroll
            for (int ai = 0; ai < 2; ++ai)
#pragma unroll
                for (int m = 0; m < 4; ++m) {
                    const int row = brow + ai * 128 + wr * 64 + m * 16 + fr;
#pragma unroll
                    for (int bj = 0; bj < 2; ++bj)
#pragma unroll
                        for (int n = 0; n < 2; ++n) {
                            const int col = bcol + bj * 128 + wc * 32 + n * 16 + fq * 4;
                            const f32x4 v = acc[ai][bj][m][n];
                            if (EPI == EPI_INPROJ) {
                                if (pn == ea.gate_pn) {
                                    if (bj == 0 && wc == 0 && n == 0) *(f32x4*)(ea.gates + (size_t)row * 16 + fq * 4) = v;
                                } else {
                                    u32x2 o; o.x = pk2(v[0], v[1]); o.y = pk2(v[2], v[3]);
                                    *(u32x2*)(ea.o_rm + (size_t)row * ea.ld_rm + col) = o;
                                }
                            } else if (EPI == EPI_DRY) {
                                if (v[0] == 123456.789f && v[1] == 3.25f) *(f32x4*)(ea.out_lat + (size_t)row * 1024 + (col & 1023)) = v;
                            } else if (EPI == EPI_RELU2) {
                                float r0 = fmaxf(v[0], 0.f), r1 = fmaxf(v[1], 0.f), r2 = fmaxf(v[2], 0.f), r3 = fmaxf(v[3], 0.f);
                                u32x2 o; o.x = pk2(r0 * r0, r1 * r1); o.y = pk2(r2 * r2, r3 * r3);
                                *(u32x2*)(ea.o_rm + (size_t)row * ea.ld_rm + col) = o;
                            } else {
                                const float* rp; float* op; int mrow;
                                if (row < NLAT) { rp = ea.res_lat + (size_t)row * 1024 + col; op = ea.out_lat + (size_t)row * 1024 + col; mrow = row >> 11; }
                                else { rp = ea.res_ctx + (size_t)(row - NLAT) * 1024 + col; op = ea.out_ctx + (size_t)(row - NLAT) * 1024 + col; mrow = 16; }
                                const f32x4 g = *(const f32x4*)(ea.modg + (size_t)mrow * 6144 + col);
                                const f32x4 x = *(const f32x4*)rp;
                                f32x4 rr = x + g * v;
#ifdef SANITIZE
#pragma unroll
                                for (int q_ = 0; q_ < 4; ++q_) if (!(fabsf(rr[q_]) < 1e30f)) rr[q_] = 0.f;
#endif
                                *(f32x4*)op = rr;
                            }
                        }
                }
        }
        asm volatile("s_waitcnt vmcnt(0)" ::: "memory");
        __syncthreads();
    }
}

__device__ __forceinline__ void phase0(const Params& p) {
    const int tid = tid_l(), blk = blockIdx.x, nb = gridDim.x;
    float* MOD = (float*)(p.ws + WS_MOD);
    for (int it = blk; it < 193; it += nb) {
        if (it < 192) {
            float* sl = (float*)dyn_lds;
            float* red = sl + 17 * 1024;
            for (int i = tid; i < 17 * 1024; i += NT) { float v = (i < 16 * 1024) ? p.in[1][i] : p.in[3][i - 16 * 1024]; sl[i] = v / (1.f + __expf(-v)); }
            __syncthreads();
            const int l = it / 48, nc = it % 48, kp = tid >> 7, col = tid & 127;
            const float* W = p.in[4] + (size_t)l * 1024 * 6144 + nc * 128 + col;
            float acc[17];
#pragma unroll
            for (int r = 0; r < 17; ++r) acc[r] = 0.f;
            for (int k = kp * 256; k < kp * 256 + 256; ++k) {
                const float wv = W[(size_t)k * 6144];
#pragma unroll
                for (int r = 0; r < 17; ++r) acc[r] += sl[r * 1024 + k] * wv;
            }
#pragma unroll
            for (int r = 0; r < 17; ++r) red[(kp * 17 + r) * 128 + col] = acc[r];
            __syncthreads();
            for (int i = tid; i < 17 * 128; i += NT) {
                const int r = i >> 7, cc = i & 127;
                const float s = red[(0 * 17 + r) * 128 + cc] + red[(1 * 17 + r) * 128 + cc] + red[(2 * 17 + r) * 128 + cc] + red[(3 * 17 + r) * 128 + cc];
                MOD[((size_t)l * 17 + r) * 6144 + nc * 128 + cc] = s + p.in[5][l * 6144 + nc * 128 + cc];
            }
            __syncthreads();
        } else {
            float* ROPE = (float*)(p.ws + WS_ROPE);
            for (int i = tid; i < 2048; i += NT) {
                const int pos = i >> 5, j = i & 31;
                const float inv = exp2f(-(float)j * (13.287712379549449f / 32.f));
                const float ang = (float)pos * inv;
                ROPE[i] = fcos_(ang); ROPE[2048 + i] = fsin_(ang);
            }
        }
    }
    float* H2 = (float*)(p.ws + WS_H2);
    const int gw = blk * 8 + (tid >> 6), lane = tid & 63;
    for (int it = gw; it < 2 * 2304; it += nb * 8) {
        const int i = it / 2304, row = it % 2304;
        const int L = row < 2048 ? 2048 : 256, t = row < 2048 ? row : row - 2048;
        const float tn = (float)t / (float)(L - 1);
        const float wpos = 6.283185307179586f * (float)t / (float)L;
        float ev = 0.f;
        if (lane == 0) ev = tn;
        else if (lane <= 16) { const float fr = 1e-4f + (float)(lane - 1) * ((15.f - 1e-4f) / 15.f); ev = fcos_(wpos * fr); }
        else if (lane <= 32) { const float fr = 1e-4f + (float)(lane - 17) * ((15.f - 1e-4f) / 15.f); ev = -fsin_(wpos * fr); }
        const float* w1 = p.in[13] + i * 33 * 64; const float* b1 = p.in[14] + i * 64;
        const float* w2 = p.in[15] + i * 64 * 64; const float* b2 = p.in[16] + i * 64; const float* fq = p.in[18] + i * 64;
        float a = b1[lane];
        for (int e = 0; e < 33; ++e) a += __shfl(ev, e) * w1[e * 64 + lane];
        const float h1 = fsin_(fq[lane] * a);
        float a2 = b2[lane];
        for (int e = 0; e < 64; ++e) a2 += __shfl(h1, e) * w2[e * 64 + lane];
        H2[((size_t)i * 2304 + row) * 64 + lane] = fsin_(fq[lane] * a2);
    }
}

__device__ __forceinline__ void cvt_tile(const float* W, int N, int K, bf16_t* WT, int n0, int k0, int mapmode) {
    float* tl = (float*)dyn_lds;
    const int tid = tid_l(), nl = tid & 63, kb = tid >> 6;
    const int n = n0 + nl; int sc = n;
    if (mapmode == 1) sc = n < 2048 ? n : (n < 3584 ? n + 16 : (n < 3600 ? n - 3584 + 2048 : -1));
#pragma unroll
    for (int i = 0; i < 8; ++i) { const int kl = kb + 8 * i; tl[kl * 65 + nl] = sc >= 0 ? W[(size_t)(k0 + kl) * N + sc] : 0.f; }
    __syncthreads();
    const int nn = tid >> 3, kc = tid & 7;
    float f[8];
#pragma unroll
    for (int j = 0; j < 8; ++j) f[j] = tl[(kc * 8 + j) * 65 + nn];
    *(u32x4*)(WT + (size_t)(n0 + nn) * K + k0 + kc * 8) = pack8(f);
    __syncthreads();
}

__device__ __forceinline__ void convert_weights(const Params& p, int l) {
    const int blk = blockIdx.x, nb = gridDim.x, li = l >> 1; const bool even = !(l & 1);
    const int nin = even ? 60 : 48;
    const int t_in = nin * 16, t_out = 256, t_m1 = 1024, t_m2 = 1024;
    const int total = t_in + t_out + t_m1 + t_m2;
    for (int it = blk; it < total; it += nb) {
        int r = it;
        if (r < t_in) {
            const int nt = r / 16, kt = r % 16;
            if (even) cvt_tile(p.in[8] + (size_t)li * 1024 * 3600, 3600, 1024, (bf16_t*)(p.ws + WS_WIN), nt * 64, kt * 64, 1);
            else cvt_tile(p.in[21] + (size_t)li * 1024 * 3072, 3072, 1024, (bf16_t*)(p.ws + WS_WIN), nt * 64, kt * 64, 0);
            continue;
        }
        r -= t_in;
        if (r < t_out) {
            const int nt = r / 16, kt = r % 16;
            cvt_tile((even ? p.in[20] : p.in[25]) + (size_t)li * 1024 * 1024, 1024, 1024, (bf16_t*)(p.ws + WS_WOUT), nt * 64, kt * 64, 0);
            continue;
        }
        r -= t_out;
        if (r < t_m1) {
            const int nt = r / 16, kt = r % 16;
            cvt_tile(p.in[6] + (size_t)l * 1024 * 4096, 4096, 1024, (bf16_t*)(p.ws + WS_WM1), nt * 64, kt * 64, 0);
            continue;
        }
        r -= t_m1;
        { const int nt = r / 64, kt = r % 64;
          cvt_tile(p.in[7] + (size_t)l * 4096 * 1024, 1024, 4096, (bf16_t*)(p.ws + WS_WM2), nt * 64, kt * 64, 0); }
    }
}

__device__ __forceinline__ void norm_phase(const Params& p, int l, const float* xlat, const float* xctx, int shoff, int scoff, int M) {
    const int tid = tid_l(), lane = tid & 63, gw = blockIdx.x * 8 + (tid >> 6), ngw = gridDim.x * 8;
    const float* MOD = (const float*)(p.ws + WS_MOD) + (size_t)l * 17 * 6144;
    bf16_t* ACT = (bf16_t*)(p.ws + WS_ACT);
    for (int row = gw; row < M; row += ngw) {
        const float* xr = row < NLAT ? xlat + (size_t)row * 1024 : xctx + (size_t)(row - NLAT) * 1024;
        const int mrow = row < NLAT ? row >> 11 : 16;
        const float* mod = MOD + (size_t)mrow * 6144;
        f32x4 v[4]; float ss = 0.f;
#pragma unroll
        for (int j = 0; j < 4; ++j) { v[j] = *(const f32x4*)(xr + 4 * lane + 256 * j); ss += v[j][0] * v[j][0] + v[j][1] * v[j][1] + v[j][2] * v[j][2] + v[j][3] * v[j][3]; }
        ss = wave_sum(ss);
        const float rstd = rsqrtf(ss * (1.f / 1024.f) + EPS);
#pragma unroll
        for (int j = 0; j < 4; ++j) {
            const int col = 4 * lane + 256 * j;
            const f32x4 sh = *(const f32x4*)(mod + shoff + col), sc = *(const f32x4*)(mod + scoff + col);
            const f32x4 y = v[j] * rstd * (sc + 1.f) + sh;
            u32x2 o; o.x = pk2(y[0], y[1]); o.y = pk2(y[2], y[3]);
            *(u32x2*)(ACT + (size_t)row * 1024 + col) = o;
        }
    }
}

__device__ __forceinline__ void filter_gen(const Params& p, int li) {
    const int tid = tid_l(), lane = tid & 63, w = tid >> 6;
    float* wf = (float*)dyn_lds; float* wb = wf + 64; float* red = wb + 64;
    const float* H2 = (const float*)(p.ws + WS_H2);
    for (int it = blockIdx.x; it < 2048; it += gridDim.x) {
        const int ltype = it >> 10, o = (it >> 9) & 1, c = it & 511;
        const int L = ltype ? 256 : 2048;
        const float* H2r = H2 + ((size_t)li * 2304 + (ltype ? 2048 : 0)) * 64;
        const float* w3 = p.in[17] + (size_t)li * 64 * 2048;
        if (tid < 64) wf[tid] = w3[tid * 2048 + (o * 2 + 0) * 512 + c];
        else if (tid < 128) wb[tid - 64] = w3[(tid - 64) * 2048 + (o * 2 + 1) * 512 + c];
        __syncthreads();
        const float lo = -4.605170185988091f / 1.5f, hi = -4.605170185988091f / 0.3f;
        const float delta = fabsf(lo + (hi - lo) * (float)c / 511.f);
        float vf[4], vb[4]; float ssf = 0.f, ssb = 0.f;
#pragma unroll
        for (int q = 0; q < 4; ++q) {
            const int t = tid + 512 * q; vf[q] = 0.f; vb[q] = 0.f;
            if (t < L) {
                float df = 0.f, db = 0.f;
                const f32x4* hr = (const f32x4*)(H2r + (size_t)t * 64);
#pragma unroll
                for (int j = 0; j < 16; ++j) { const f32x4 hv = hr[j];
                    df += hv[0] * wf[4 * j] + hv[1] * wf[4 * j + 1] + hv[2] * wf[4 * j + 2] + hv[3] * wf[4 * j + 3];
                    db += hv[0] * wb[4 * j] + hv[1] * wb[4 * j + 1] + hv[2] * wb[4 * j + 2] + hv[3] * wb[4 * j + 3]; }
                const float dec = __expf(-((float)t / (float)(L - 1)) * delta);
                vf[q] = df * dec; vb[q] = db * dec; ssf += vf[q] * vf[q]; ssb += vb[q] * vb[q];
            }
        }
        ssf = wave_sum(ssf); ssb = wave_sum(ssb);
        if (lane == 0) { red[w] = ssf; red[8 + w] = ssb; }
        __syncthreads();
        float tf = 0.f, tb = 0.f;
#pragma unroll
        for (int i = 0; i < 8; ++i) { tf += red[i]; tb += red[8 + i]; }
        const float nf = rsqrtf(tf + EPS), nbk = rsqrtf(tb + EPS);
        bf16_t* dst = ltype ? (bf16_t*)(p.ws + WS_FCTX) + ((size_t)o * 512 + c) * 512 : (bf16_t*)(p.ws + WS_FLAT) + ((size_t)o * 512 + c) * 4096;
#pragma unroll
        for (int q = 0; q < 4; ++q) {
            const int t = tid + 512 * q;
            if (t < L) {
                if (t == 0) { dst[L] = f2b(vf[q] * nf + vb[q] * nbk); dst[0] = 0; }
                else { dst[L + t] = f2b(vf[q] * nf); dst[L - t] = f2b(vb[q] * nbk); }
            }
        }
        __syncthreads();
    }
}

__device__ __forceinline__ void mlstm_item(const Params& p, int li, int it) {
    const int tid = tid_l(), w = tid >> 6, lane = tid & 63, fr = lane & 15, fq = lane >> 4;
    const int b = it >> 3, h = (it >> 1) & 3, dir = it & 1;
    bf16_t* Qs = (bf16_t*)dyn_lds;
    bf16_t* Ks = Qs + 64 * 136;
    bf16_t* KT = Ks + 64 * 136;
    bf16_t* VT = KT + 128 * 72;
    bf16_t* Cb = VT + 144 * 72;
    bf16_t* Ps = Cb + 144 * 136;
    float* fl = (float*)(Ps + 64 * 72);
    float* a_s = fl; float* Mt = fl + 64; float* scs = fl + 128; float* emt = fl + 192; float* den = fl + 256; float* lfs = fl + 320; float* igs = fl + 384; float* scal = fl + 448;
    const bf16_t* QKVO = (const bf16_t*)(p.ws + WS_BIG);
    const float* GATES = (const float*)(p.ws + WS_GATES);
    bf16_t* HFB = (bf16_t*)(p.ws + WS_HFB) + (size_t)dir * MTOT * 512;
    const float* ROPE = (const float*)(p.ws + WS_ROPE);
    const float* gate_b = p.in[9] + li * 16;
    for (int i = tid; i < 144 * 136 / 2; i += NT) ((unsigned*)Cb)[i] = 0u;
    for (int i = tid; i < 16 * 72; i += NT) { const int r = i / 72, ci = i % 72; VT[(128 + r) * 72 + ci] = (r == 0 && ci < 64) ? (bf16_t)0x3F80 : (bf16_t)0; }
    f32x4 cacc[9];
#pragma unroll
    for (int i = 0; i < 9; ++i) cacc[i] = (f32x4){0.f, 0.f, 0.f, 0.f};
    float m = 0.f;
    __syncthreads();
    for (int step = 0; step < 36; ++step) {
        const bool isctx = step < 4;
        const int cj = isctx ? (dir ? 3 - step : step) : (dir ? 35 - step : step - 4);
        const int rowbase = isctx ? NLAT + b * 256 + cj * 64 : b * 2048 + cj * 64;
        {
            const int r = tid >> 3, seg = tid & 7; const int tl = dir ? 63 - r : r;
            const bf16_t* src = QKVO + (size_t)(rowbase + tl) * 2048 + h * 128;
            const int hb = seg >> 2, jb = (seg & 3) * 8, d1 = hb * 64 + jb, d2 = d1 + 32;
            const u32x4 q1 = *(const u32x4*)(src + d1), q2 = *(const u32x4*)(src + d2);
            const u32x4 k1 = *(const u32x4*)(src + 512 + d1), k2 = *(const u32x4*)(src + 512 + d2);
            const u32x4 v1 = *(const u32x4*)(src + 1024 + seg * 16), v2 = *(const u32x4*)(src + 1024 + seg * 16 + 8);
            float cs[8], sn[8];
            if (!isctx) {
                const int pos = hb ? tl : cj;
                const f32x4 c0 = *(const f32x4*)(ROPE + pos * 32 + jb), c1 = *(const f32x4*)(ROPE + pos * 32 + jb + 4);
                const f32x4 s0 = *(const f32x4*)(ROPE + 2048 + pos * 32 + jb), s1 = *(const f32x4*)(ROPE + 2048 + pos * 32 + jb + 4);
#pragma unroll
                for (int e = 0; e < 4; ++e) { cs[e] = c0[e]; cs[4 + e] = c1[e]; sn[e] = s0[e]; sn[4 + e] = s1[e]; }
            } else {
#pragma unroll
                for (int e = 0; e < 8; ++e) { cs[e] = 1.f; sn[e] = 0.f; }
            }
            float x1[8], x2[8], o1[8], o2[8];
            unpack8(q1, x1); unpack8(q2, x2);
#pragma unroll
            for (int e = 0; e < 8; ++e) { o1[e] = x1[e] * cs[e] - x2[e] * sn[e]; o2[e] = x1[e] * sn[e] + x2[e] * cs[e]; }
            *(u32x4*)(Qs + r * 136 + d1) = pack8(o1); *(u32x4*)(Qs + r * 136 + d2) = pack8(o2);
            unpack8(k1, x1); unpack8(k2, x2);
            const float ksc = 0.08838834764831845f;
#pragma unroll
            for (int e = 0; e < 8; ++e) { o1[e] = (x1[e] * cs[e] - x2[e] * sn[e]) * ksc; o2[e] = (x1[e] * sn[e] + x2[e] * cs[e]) * ksc; }
            const u32x4 ko1 = pack8(o1), ko2 = pack8(o2);
            *(u32x4*)(Ks + r * 136 + d1) = ko1; *(u32x4*)(Ks + r * 136 + d2) = ko2;
            {
                const unsigned kw1[4] = {ko1.x, ko1.y, ko1.z, ko1.w}, kw2[4] = {ko2.x, ko2.y, ko2.z, ko2.w};
#pragma unroll
                for (int e = 0; e < 4; ++e) {
                    KT[(d1 + 2 * e) * 72 + r] = (bf16_t)(kw1[e] & 0xffffu); KT[(d1 + 2 * e + 1) * 72 + r] = (bf16_t)(kw1[e] >> 16);
                    KT[(d2 + 2 * e) * 72 + r] = (bf16_t)(kw2[e] & 0xffffu); KT[(d2 + 2 * e + 1) * 72 + r] = (bf16_t)(kw2[e] >> 16);
                }
                const unsigned vw1[4] = {v1.x, v1.y, v1.z, v1.w}, vw2[4] = {v2.x, v2.y, v2.z, v2.w};
#pragma unroll
                for (int e = 0; e < 4; ++e) {
                    VT[(seg * 16 + 2 * e) * 72 + r] = (bf16_t)(vw1[e] & 0xffffu); VT[(seg * 16 + 2 * e + 1) * 72 + r] = (bf16_t)(vw1[e] >> 16);
                    VT[(seg * 16 + 8 + 2 * e) * 72 + r] = (bf16_t)(vw2[e] & 0xffffu); VT[(seg * 16 + 8 + 2 * e + 1) * 72 + r] = (bf16_t)(vw2[e] >> 16);
                }
            }
            if (tid < 64) {
                const int rr = tid, tl2 = dir ? 63 - rr : rr;
                const float* g = GATES + (size_t)(rowbase + tl2) * 16;
                const float ig = g[dir * 8 + h] + gate_b[dir * 8 + h];
                const float fg = g[dir * 8 + 4 + h] + gate_b[dir * 8 + 4 + h];
                igs[rr] = ig; lfs[rr] = fminf(fg, 0.f) - __logf(1.f + __expf(-fabsf(fg)));
            }
        }
        __syncthreads();
        if (w == 0) {
            float bcs = lfs[lane];
#pragma unroll
            for (int o = 1; o < 64; o <<= 1) { const float t = __shfl_up(bcs, o); if (lane >= o) bcs += t; }
            const float a = igs[lane] - bcs;
            float pm = a;
#pragma unroll
            for (int o = 1; o < 64; o <<= 1) { const float t = __shfl_up(pm, o); if (lane >= o) pm = fmaxf(pm, t); }
            const float Mx = fmaxf(m, pm);
            a_s[lane] = a; Mt[lane] = Mx; scs[lane] = __expf(m - Mx); emt[lane] = __expf(-bcs - Mx);
            if (lane == 63) { scal[0] = bcs; scal[1] = Mx; }
        }
        {
            const int st = w & 3, tt0 = (w >> 2) * 2;
            f32x4 sacc[2];
#pragma unroll
            for (int u = 0; u < 2; ++u) {
                sacc[u] = (f32x4){0.f, 0.f, 0.f, 0.f};
#pragma unroll
                for (int kk = 0; kk < 4; ++kk) {
                    const bf16x8 Ak = *(const bf16x8*)(Ks + (st * 16 + fr) * 136 + kk * 32 + fq * 8);
                    const bf16x8 Bq = *(const bf16x8*)(Qs + ((tt0 + u) * 16 + fr) * 136 + kk * 32 + fq * 8);
                    sacc[u] = mfma16(Ak, Bq, sacc[u]);
                }
            }
            __syncthreads();
#pragma unroll
            for (int u = 0; u < 2; ++u) {
                const int t = (tt0 + u) * 16 + fr, sb = st * 16 + fq * 4;
                const float Mv = Mt[t];
                float pv[4];
#pragma unroll
                for (int j = 0; j < 4; ++j) { const int s = sb + j; pv[j] = (s <= t) ? sacc[u][j] * __expf(a_s[s] - Mv) : 0.f; }
                u32x2 o; o.x = pk2(pv[0], pv[1]); o.y = pk2(pv[2], pv[3]);
                *(u32x2*)(Ps + t * 72 + sb) = o;
            }
        }
        __syncthreads();
        {
            const int tt = w & 3, up = w >> 2, vt0 = up ? 5 : 0, nvt = up ? 4 : 5;
            bf16x8 qf[4], pf[2];
#pragma unroll
            for (int kk = 0; kk < 4; ++kk) qf[kk] = *(const bf16x8*)(Qs + (tt * 16 + fr) * 136 + kk * 32 + fq * 8);
#pragma unroll
            for (int kk = 0; kk < 2; ++kk) pf[kk] = *(const bf16x8*)(Ps + (tt * 16 + fr) * 72 + kk * 32 + fq * 8);
            const float sct = scs[tt * 16 + fr];
            f32x4 hacc[5];
#pragma unroll
            for (int vi = 0; vi < 5; ++vi) {
                hacc[vi] = (f32x4){0.f, 0.f, 0.f, 0.f};
                if (vi < nvt) {
                    const int v0 = (vt0 + vi) * 16;
                    f32x4 ac = (f32x4){0.f, 0.f, 0.f, 0.f};
#pragma unroll
                    for (int kk = 0; kk < 4; ++kk) ac = mfma16(*(const bf16x8*)(Cb + (v0 + fr) * 136 + kk * 32 + fq * 8), qf[kk], ac);
                    ac = ac * sct;
#pragma unroll
                    for (int kk = 0; kk < 2; ++kk) ac = mfma16(*(const bf16x8*)(VT + (v0 + fr) * 72 + kk * 32 + fq * 8), pf[kk], ac);
                    hacc[vi] = ac;
                }
            }
            if (up && fq == 0) den[tt * 16 + fr] = hacc[3][0];
            __syncthreads();
            const int t = tt * 16 + fr, tl = dir ? 63 - t : t;
            const float dn = den[t];
            const float inv = 1.f / fmaxf(fabsf(dn), emt[t]);
            bf16_t* orow = HFB + (size_t)(rowbase + tl) * 512 + h * 128;
#pragma unroll
            for (int vi = 0; vi < 5; ++vi) {
                if (vi < nvt && (vt0 + vi) < 8) {
                    const int v0 = (vt0 + vi) * 16 + fq * 4;
                    u32x2 o; o.x = pk2(hacc[vi][0] * inv, hacc[vi][1] * inv); o.y = pk2(hacc[vi][2] * inv, hacc[vi][3] * inv);
                    *(u32x2*)(orow + v0) = o;
                }
            }
        }
        {
            const float bl = scal[0], M63 = scal[1];
            const float decay = __expf(m - M63);
            bf16x8 ka[2];
#pragma unroll
            for (int kk = 0; kk < 2; ++kk) {
                const u32x4 raw = *(const u32x4*)(KT + (w * 16 + fr) * 72 + kk * 32 + fq * 8);
                float f[8]; unpack8(raw, f);
#pragma unroll
                for (int j = 0; j < 8; ++j) f[j] *= __expf(a_s[kk * 32 + fq * 8 + j] - M63);
                ka[kk] = as_bf8(pack8(f));
            }
#pragma unroll
            for (int vt = 0; vt < 9; ++vt) {
                f32x4 ac = cacc[vt] * decay;
#pragma unroll
                for (int kk = 0; kk < 2; ++kk) ac = mfma16(ka[kk], *(const bf16x8*)(VT + (vt * 16 + fr) * 72 + kk * 32 + fq * 8), ac);
                cacc[vt] = ac;
                u32x2 o; o.x = pk2(ac[0], ac[1]); o.y = pk2(ac[2], ac[3]);
                *(u32x2*)(Cb + (vt * 16 + fr) * 136 + w * 16 + fq * 4) = o;
            }
            m = bl + M63;
        }
        __syncthreads();
    }
}

__device__ __forceinline__ void combine_phase(const Params& p, int li) {
    const int tid = tid_l(), lane = tid & 63, gw = blockIdx.x * 8 + (tid >> 6), ngw = gridDim.x * 8;
    const bf16_t* HF = (const bf16_t*)(p.ws + WS_HFB); const bf16_t* HB = HF + (size_t)MTOT * 512;
    const bf16_t* QKVO = (const bf16_t*)(p.ws + WS_BIG);
    bf16_t* MIX = (bf16_t*)(p.ws + WS_ACT);
    const float* hn = p.in[10] + li * 512 + lane * 8;
    float g[8];
#pragma unroll
    for (int e = 0; e < 8; ++e) g[e] = hn[e];
    for (int row = gw; row < MTOT; row += ngw) {
        float a[8], bq[8], og[8], y[8];
        unpack8(*(const u32x4*)(HF + (size_t)row * 512 + lane * 8), a);
        unpack8(*(const u32x4*)(HB + (size_t)row * 512 + lane * 8), bq);
        unpack8(*(const u32x4*)(QKVO + (size_t)row * 2048 + 1536 + lane * 8), og);
        float ss = 0.f;
#pragma unroll
        for (int e = 0; e < 8; ++e) { a[e] += bq[e]; ss += a[e] * a[e]; }
        ss += __shfl_xor(ss, 1); ss += __shfl_xor(ss, 2); ss += __shfl_xor(ss, 4); ss += __shfl_xor(ss, 8);
        const float rstd = rsqrtf(ss * (1.f / 128.f) + EPS);
#pragma unroll
        for (int e = 0; e < 8; ++e) y[e] = a[e] * rstd * g[e] / (1.f + __expf(-og[e]));
        *(u32x4*)(MIX + (size_t)row * 1024 + lane * 8) = pack8(y);
    }
}

template <int L>
__device__ __forceinline__ void hyena_item(const Params& p, int li, int c) {
    constexpr int ZS = L + 8, NI = L / 128, NS = L / 32;
    const int tid = tid_l(), w = tid >> 6, lane = tid & 63, fr = lane & 15, fq = lane >> 4;
    bf16_t* ZA = (bf16_t*)dyn_lds; bf16_t* ZB = ZA + 16 * ZS; bf16_t* HFl = ZB + 16 * ZS;
    const bf16_t* zpad = HFl + 2 * L;
    if (tid < 8) HFl[2 * L + tid] = 0;
    const int segbase = (L == 2048) ? 0 : NLAT;
    const bf16_t* HYT = (const bf16_t*)(p.ws + WS_P2);
    bf16_t* MIX = (bf16_t*)(p.ws + WS_ACT);
    const float* cw = p.in[11] + (size_t)li * 3 * 1536; const float* cb = p.in[12] + (size_t)li * 1536; const float* hd = p.in[19] + (size_t)li * 2 * 512;
    const bf16_t* FIL = (L == 2048) ? (const bf16_t*)(p.ws + WS_FLAT) : (const bf16_t*)(p.ws + WS_FCTX);
    {
        const float w0 = cw[c], w1 = cw[1536 + c], w2 = cw[2 * 1536 + c], bb = cb[c];
        const bf16_t* src = HYT + (size_t)c * MTOT + segbase;
        for (int ch = tid; ch < 16 * L / 8; ch += NT) {
            const int b = ch / (L / 8), t0 = (ch % (L / 8)) * 8;
            const bf16_t* s = src + b * L + t0;
            float x[10], y[8];
            x[0] = t0 > 0 ? b2f(s[-1]) : 0.f;
            unpack8(*(const u32x4*)s, x + 1);
            x[9] = (t0 + 8 < L) ? b2f(s[8]) : 0.f;
#pragma unroll
            for (int e = 0; e < 8; ++e) y[e] = bb + w0 * x[e] + w1 * x[e + 1] + w2 * x[e + 2];
            *(u32x4*)(ZA + b * ZS + t0) = pack8(y);
        }
    }
#pragma unroll 1
    for (int o = 0; o < 2; ++o) {
        for (int i = tid; i < 2 * L / 8; i += NT) *(u32x4*)(HFl + i * 8) = *(const u32x4*)(FIL + ((size_t)o * 512 + c) * 2 * L + i * 8);
        __syncthreads();
        const bf16_t* Zin = o ? ZB : ZA;
        const int gc = (o + 1) * 512 + c;
        const float gw0 = cw[gc], gw1 = cw[1536 + gc], gw2 = cw[2 * 1536 + gc], gb = cb[gc], dsk = hd[o * 512 + c];
        const bf16_t* gs = HYT + (size_t)gc * MTOT + segbase + fr * L;
        constexpr int NIB = NI < 8 ? NI : 8;
#pragma unroll 1
        for (int hp = 0; hp < NI; hp += NIB) {
            f32x4 acc[NIB];
#pragma unroll
            for (int i = 0; i < NIB; ++i) acc[i] = (f32x4){0.f, 0.f, 0.f, 0.f};
#pragma unroll 2
            for (int e = 4 * hp - (NS - 1); e <= 4 * (hp + NIB - 1); ++e) {
                const int base = L + 16 * w + 32 * e + fr - fq * 8;
                bf16x8 Af;
#pragma unroll
                for (int j = 0; j < 8; ++j) Af[j] = (short)HFl[base - j];
                const bf16_t* zb = Zin + fr * ZS + (4 * hp - e) * 32 + fq * 8;
#pragma unroll
                for (int i = 0; i < NIB; ++i) {
                    const int sj = 4 * (hp + i) - e;
                    const bf16_t* bp = (sj >= 0 && sj < NS) ? (zb + i * 128) : zpad;
                    acc[i] = mfma16(Af, *(const bf16x8*)bp, acc[i]);
                }
            }
#pragma unroll
            for (int i = 0; i < NIB; ++i) {
                const int t0 = 16 * (w + 8 * (hp + i)) + fq * 4;
                float x[6];
                x[0] = t0 > 0 ? b2f(gs[t0 - 1]) : 0.f;
                const u32x2 gv = *(const u32x2*)(gs + t0);
                x[1] = blo(gv.x); x[2] = bhi(gv.x); x[3] = blo(gv.y); x[4] = bhi(gv.y);
                x[5] = (t0 + 4 < L) ? b2f(gs[t0 + 4]) : 0.f;
                const u32x2 zv = *(const u32x2*)(Zin + fr * ZS + t0);
                const float z[4] = {blo(zv.x), bhi(zv.x), blo(zv.y), bhi(zv.y)};
                float val[4];
#pragma unroll
                for (int j = 0; j < 4; ++j) val[j] = (gb + gw0 * x[j] + gw1 * x[j + 1] + gw2 * x[j + 2]) * (acc[i][j] + dsk * z[j]);
                { u32x2 ov; ov.x = pk2(val[0], val[1]); ov.y = pk2(val[2], val[3]); *(u32x2*)((o == 0 ? ZB : ZA) + fr * ZS + t0) = ov; }
            }
        }
        __syncthreads();
    }
    {
        bf16_t* dstp = (bf16_t*)(p.ws + WS_P2) + (size_t)c * MTOT + segbase;
        for (int ch = tid; ch < 16 * L / 8; ch += NT) {
            const int b = ch / (L / 8), t0 = (ch % (L / 8)) * 8;
            *(u32x4*)(dstp + b * L + t0) = *(const u32x4*)(ZA + b * ZS + t0);
        }
        __syncthreads();
    }
}

__device__ __forceinline__ void hy_transpose(const Params& p) {
    const int tid = tid_l();
    bf16_t* T = (bf16_t*)dyn_lds;
    const bf16_t* HYO = (const bf16_t*)(p.ws + WS_P2);
    bf16_t* MIX = (bf16_t*)(p.ws + WS_ACT);
    for (int it = blockIdx.x; it < (MTOT / 64) * 8; it += gridDim.x) {
        const int tt = it >> 3, cg_ = it & 7, tok0 = tt * 64, c0 = cg_ * 64;
        {
            const int ch = tid >> 3, t8 = (tid & 7) * 8;
            const u32x4 v = *(const u32x4*)(HYO + (size_t)(c0 + ch) * MTOT + tok0 + t8);
            const unsigned wv[4] = {v.x, v.y, v.z, v.w};
#pragma unroll
            for (int e = 0; e < 4; ++e) { T[(t8 + 2 * e) * 72 + ch] = (bf16_t)(wv[e] & 0xffffu); T[(t8 + 2 * e + 1) * 72 + ch] = (bf16_t)(wv[e] >> 16); }
        }
        __syncthreads();
        {
            const int tk = tid >> 3, c8 = (tid & 7) * 8;
            *(u32x4*)(MIX + (size_t)(tok0 + tk) * 1024 + 512 + c0 + c8) = *(const u32x4*)(T + tk * 72 + c8);
        }
        __syncthreads();
    }
}

template <bool LAT>
__device__ __forceinline__ void attn_item(const Params& p, int li, int b, int h, int sub) {
    const int tid = tid_l(), w = tid >> 6, lane = tid & 63, fr = lane & 15, fq = lane >> 4;
    bf16_t* Pw = (bf16_t*)dyn_lds + w * (16 * 520);
    float* rpbs = (float*)(dyn_lds + 8 * 16 * 520 * 2);
    const bf16_t* QK = (const bf16_t*)(p.ws + WS_BIG);
    const bf16_t* VTg = (const bf16_t*)(p.ws + WS_P2);
    bf16_t* MIX = (bf16_t*)(p.ws + WS_ACT);
    if (LAT) { const float* rp = p.in[24] + ((size_t)li * 16 + h) * 465; for (int i = tid; i < 465; i += NT) rpbs[i] = rp[i]; }
    __syncthreads();
    int r = 0, c0 = 0, rs = 0, cw0 = 0, qtok0;
    if (LAT) { r = sub * 2 + (w >> 2); const int qt = w & 3; c0 = qt * 16; qtok0 = b * 2048 + r * 64 + c0; rs = min(max(r - 4, 0), 24); cw0 = (qt == 0) ? 0 : (qt == 1) ? 8 : (qt == 2) ? 24 : 32; }
    else { qtok0 = NLAT + b * 256 + (sub * 8 + w) * 16; }
    float qg[16], kg[16];
#pragma unroll
    for (int e = 0; e < 8; ++e) { qg[e] = p.in[22][li * 64 + fq * 8 + e]; qg[8 + e] = p.in[22][li * 64 + 32 + fq * 8 + e]; kg[e] = p.in[23][li * 64 + fq * 8 + e]; kg[8 + e] = p.in[23][li * 64 + 32 + fq * 8 + e]; }
    bf16x8 qf[2];
    {
        const bf16_t* qp = QK + (size_t)(qtok0 + fr) * 2048 + h * 64 + fq * 8;
        float f[16]; unpack8(*(const u32x4*)qp, f); unpack8(*(const u32x4*)(qp + 32), f + 8);
        float ss = 0.f;
#pragma unroll
        for (int e = 0; e < 16; ++e) ss += f[e] * f[e];
        ss += __shfl_xor(ss, 16); ss += __shfl_xor(ss, 32);
        const float rstd = rsqrtf(ss * (1.f / 64.f) + EPS) * 0.125f;
#pragma unroll
        for (int e = 0; e < 16; ++e) f[e] *= rstd * qg[e];
        qf[0] = as_bf8(pack8(f)); qf[1] = as_bf8(pack8(f + 8));
    }
    f32x4 sreg[32];
#define KTILE(KT_, KTOK0_) do { \
        const bf16_t* kp = QK + (size_t)((KTOK0_) + fr) * 2048 + 1024 + h * 64 + fq * 8; \
        float f[16]; unpack8(*(const u32x4*)kp, f); unpack8(*(const u32x4*)(kp + 32), f + 8); \
        float ss = 0.f; \
        _Pragma("unroll") for (int e = 0; e < 16; ++e) ss += f[e] * f[e]; \
        ss += __shfl_xor(ss, 16); ss += __shfl_xor(ss, 32); \
        const float rstd = rsqrtf(ss * (1.f / 64.f) + EPS); \
        _Pragma("unroll") for (int e = 0; e < 16; ++e) f[e] *= rstd * kg[e]; \
        f32x4 sa = (f32x4){0.f, 0.f, 0.f, 0.f}; \
        sa = mfma16(as_bf8(pack8(f)), qf[0], sa); sa = mfma16(as_bf8(pack8(f + 8)), qf[1], sa); \
        sreg[KT_] = sa; } while (0)
    if (LAT) {
        const int qc = c0 + fr; const int cstart = min(max(qc - 8, 0), 48);
#pragma unroll
        for (int kt = 0; kt < 16; ++kt) {
            const int kr = kt >> 1, kcb = cw0 + (kt & 1) * 16;
            KTILE(kt, b * 2048 + (rs + kr) * 64 + kcb);
            const int dri = (rs + kr - r + 7) * 31;
#pragma unroll
            for (int j = 0; j < 4; ++j) {
                const int kc = kcb + fq * 4 + j;
                const bool valid = (kc >= cstart) && (kc < cstart + 16);
                const int dci = min(max(kc - qc + 15, 0), 30);
                sreg[kt][j] = valid ? sreg[kt][j] + rpbs[dri + dci] : -1e30f;
            }
            if (kt & 1) __builtin_amdgcn_sched_barrier(0);
        }
    }
    constexpr int KT0 = LAT ? 0 : 16;
#pragma unroll
    for (int kt = 16; kt < 32; ++kt) { KTILE(kt, NLAT + b * 256 + (kt - 16) * 16); if (kt & 1) __builtin_amdgcn_sched_barrier(0); }
    float mx = -1e30f;
#pragma unroll
    for (int kt = KT0; kt < 32; ++kt)
#pragma unroll
        for (int j = 0; j < 4; ++j) mx = fmaxf(mx, sreg[kt][j]);
    mx = fmaxf(mx, __shfl_xor(mx, 16)); mx = fmaxf(mx, __shfl_xor(mx, 32));
    float lsum = 0.f;
#pragma unroll
    for (int kt = KT0; kt < 32; ++kt) {
        float pj[4];
#pragma unroll
        for (int j = 0; j < 4; ++j) { pj[j] = __expf(sreg[kt][j] - mx); lsum += pj[j]; }
        u32x2 o; o.x = pk2(pj[0], pj[1]); o.y = pk2(pj[2], pj[3]);
        *(u32x2*)(Pw + fr * 520 + kt * 16 + fq * 4) = o;
    }
    lsum += __shfl_xor(lsum, 16); lsum += __shfl_xor(lsum, 32);
    __syncthreads();
    f32x4 oacc[4];
#pragma unroll
    for (int dt = 0; dt < 4; ++dt) oacc[dt] = (f32x4){0.f, 0.f, 0.f, 0.f};
#pragma unroll
    for (int ks = (LAT ? 0 : 8); ks < 16; ++ks) {
        const int vtok0 = ks < 8 ? b * 2048 + (rs + ks) * 64 + cw0 : NLAT + b * 256 + (ks - 8) * 32;
        const bf16x8 pf = *(const bf16x8*)(Pw + fr * 520 + ks * 32 + fq * 8);
#pragma unroll
        for (int dt = 0; dt < 4; ++dt) {
            const bf16x8 vf = *(const bf16x8*)(VTg + (size_t)(h * 64 + dt * 16 + fr) * MTOT + vtok0 + fq * 8);
            oacc[dt] = mfma16(vf, pf, oacc[dt]);
        }
    }
    const float inv = 1.f / lsum;
#pragma unroll
    for (int dt = 0; dt < 4; ++dt) {
        u32x2 o; o.x = pk2(oacc[dt][0] * inv, oacc[dt][1] * inv); o.y = pk2(oacc[dt][2] * inv, oacc[dt][3] * inv);
        *(u32x2*)(MIX + (size_t)(qtok0 + fr) * 1024 + h * 64 + dt * 16 + fq * 4) = o;
    }
    __syncthreads();
#undef KTILE
}


#ifdef DBG_NAN
__device__ __forceinline__ bool bad16(bf16_t v) { return ((v >> 7) & 0xFF) >= 227; }
__device__ __forceinline__ bool bad32(float f) { return !(fabsf(f) < 1e30f); }
__device__ __forceinline__ void scan16(const bf16_t* p, size_t n, unsigned* flags, unsigned bit) {
    bool bad = false;
    for (size_t i = (size_t)blockIdx.x * NT + threadIdx.x; i < n; i += (size_t)gridDim.x * NT) bad |= bad16(p[i]);
    if (bad) atomicOr(flags, bit);
}
__device__ __forceinline__ void scan32(const float* p, size_t n, unsigned* flags, unsigned bit) {
    bool bad = false;
    for (size_t i = (size_t)blockIdx.x * NT + threadIdx.x; i < n; i += (size_t)gridDim.x * NT) bad |= bad32(p[i]);
    if (bad) atomicOr(flags, bit);
}
#endif
#define GSYNC() do { asm volatile("s_waitcnt vmcnt(0) lgkmcnt(0)" ::: "memory"); grid.sync(); } while (0)
__global__ void __launch_bounds__(NT) fwd_megakernel(Params p) {
    cg::grid_group grid = cg::this_grid();
    const int blk = blockIdx.x, G = gridDim.x;
    bf16_t* WIN = (bf16_t*)(p.ws + WS_WIN); bf16_t* WOUT = (bf16_t*)(p.ws + WS_WOUT); bf16_t* WM1 = (bf16_t*)(p.ws + WS_WM1); bf16_t* WM2 = (bf16_t*)(p.ws + WS_WM2);
    bf16_t* ACT = (bf16_t*)(p.ws + WS_ACT); bf16_t* BIG = (bf16_t*)(p.ws + WS_BIG);
    float* XC = (float*)(p.ws + WS_XC);
    const float* MOD = (const float*)(p.ws + WS_MOD);
    REP(64) if (PHMASK & 1) phase0(p);
#ifdef DBG_NAN
    unsigned* dflags = (unsigned*)(p.ws + WS_END);
    if (blk == 0 && threadIdx.x < 64) dflags[threadIdx.x] = 0u;
#endif
    GSYNC();
#pragma unroll 1
    for (int l = 0; l < 4; ++l) {
        const bool even = !(l & 1), last = (l == 3); const int li = l >> 1;
        const float* xlat = (l == 0) ? p.in[0] : p.out; const float* xctx = (l == 0) ? p.in[2] : XC;
        const int Mtail = last ? NLAT : MTOT;
        REP(1) {
        if (PHMASK & 2) convert_weights(p, l);
        if (PHMASK & 4) norm_phase(p, l, xlat, xctx, 0, 1024, MTOT);
        if ((PHMASK & 8) && even) filter_gen(p, li);
        }
        GSYNC();
        {
            EpiArgs ea{}; ea.o_rm = BIG; ea.ld_rm = 2048; ea.o_cm = (bf16_t*)(p.ws + WS_P2); ea.gates = (float*)(p.ws + WS_GATES); ea.gate_pn = even ? 14 : -1; ea.o_dbg = (bf16_t*)(p.ws + WS_HFB);
            REP(2) if (PHMASK & 16) gemm_phase<EPI_INPROJ>(ACT, WIN, MTOT, even ? 3840 : 3072, 1024, ea);
        }
        GSYNC();
#ifdef DBG_NAN
        if (l == DBG_LAYER) {
            {
                const unsigned gid = blk * NT + threadIdx.x;
                unsigned hsh = gid * 2654435761u + 12345u; hsh ^= hsh >> 13; hsh *= 2246822519u; hsh ^= hsh >> 16;
                const int row = hsh % MTOT; const int col = (hsh >> 8) % 2048; const int ch = (hsh >> 4) % 1536;
                const bf16_t* ar = ACT + (size_t)row * 1024; const bf16_t* wq = WIN + (size_t)col * 1024; const bf16_t* wh = WIN + (size_t)(2048 + ch) * 1024;
                float sq = 0.f, sh_ = 0.f;
                for (int k = 0; k < 1024; ++k) { const float av = b2f(ar[k]); sq += av * b2f(wq[k]); sh_ += av * b2f(wh[k]); }
                const float gq = b2f(BIG[(size_t)row * 2048 + col]);
                const float gh = b2f(((const bf16_t*)(p.ws + WS_P2))[(size_t)ch * MTOT + row]);
                (void)gq; (void)sq;

                { const int cls = DBG_CLS; atomicAdd(dflags + 16 + cls, 1u);
                  if (!(fabsf(gh - sh_) <= 0.05f + 0.02f * fabsf(sh_))) { atomicAdd(dflags + 2, 1u); atomicAdd(dflags + 32 + cls, 1u); } }
            }
            GSYNC();
            if (blk == 0 && threadIdx.x == 0) {
                const float fQ = (float)__hip_atomic_load(dflags + 1, __ATOMIC_RELAXED, __HIP_MEMORY_SCOPE_AGENT) / (float)(G * NT);
                const float fH = (float)__hip_atomic_load(dflags + 2, __ATOMIC_RELAXED, __HIP_MEMORY_SCOPE_AGENT) / (float)(G * NT);
                unsigned mask = 0;
                for (int q_ = 0; q_ < 8; ++q_) { const unsigned tot = __hip_atomic_load(dflags + 16 + q_, __ATOMIC_RELAXED, __HIP_MEMORY_SCOPE_AGENT), bad = __hip_atomic_load(dflags + 32 + q_, __ATOMIC_RELAXED, __HIP_MEMORY_SCOPE_AGENT); if (bad * 4 > tot) mask |= 1u << q_; }
                float code = 1e5f; for (unsigned q_ = 0; q_ < (mask >> 4); ++q_) code *= 10.f;
                const unsigned n3 = __hip_atomic_load(dflags + 3, __ATOMIC_RELAXED, __HIP_MEMORY_SCOPE_AGENT), b1 = __hip_atomic_load(dflags + 1, __ATOMIC_RELAXED, __HIP_MEMORY_SCOPE_AGENT), b4 = __hip_atomic_load(dflags + 4, __ATOMIC_RELAXED, __HIP_MEMORY_SCOPE_AGENT);
                p.out[0] = code * (1.f + 0.5f * (float)(mask & 15)) + 0.f * (fQ + fH + (float)(n3 + b1 + b4));
            }
            return;
        }
#endif
        if (even) {
            REP(4) if (G >= 256) {
                if (blk < 128) { REP(512) if (PHMASK & 32) mlstm_item(p, li, blk);
                    if (PHMASK & 64) { hyena_item<2048>(p, li, 384 + blk); hyena_item<256>(p, li, 384 + blk); } }
                else { const int hb = blk - 128;
                    if (PHMASK & 64) for (int it = hb; it < 384; it += 128) { hyena_item<2048>(p, li, it); hyena_item<256>(p, li, it); } }
            } else {
            }
            GSYNC();
            if (PHMASK & 128) { combine_phase(p, li); hy_transpose(p); }
        } else {
            const int x = blk & 7, y = blk >> 3, ny = (G + 7) >> 3;
            REP(256) for (int i = 0; ; ++i) {
                const int slot = i * ny + y;
                if (slot >= 512) break;
                const int bh = x * 32 + (slot >> 4), rp = slot & 15;
                if (PHMASK & 256) attn_item<true>(p, li, bh >> 4, bh & 15, rp);
            }
            if ((PHMASK & 512) && !last) for (int it = blk; it < 512; it += G) attn_item<false>(p, li, it >> 5, (it >> 1) & 15, it & 1);
        }
        GSYNC();
        {
            EpiArgs ea{}; ea.res_lat = xlat; ea.res_ctx = xctx; ea.out_lat = p.out; ea.out_ctx = XC; ea.modg = MOD + (size_t)l * 17 * 6144 + 2048;
            if (DUPMASK & 32) gemm_phase<EPI_DRY>(ACT, WOUT, Mtail, 1024, 1024, ea);
            if (PHMASK & 1024) gemm_phase<EPI_RESID>(ACT, WOUT, Mtail, 1024, 1024, ea);
        }
        GSYNC();
        REP(8) norm_phase(p, l, p.out, XC, 3072, 4096, Mtail);
        GSYNC();
        { EpiArgs ea{}; ea.o_rm = BIG; ea.ld_rm = 4096; ea.gate_pn = -1; REP(16) if (PHMASK & 2048) gemm_phase<EPI_RELU2>(ACT, WM1, Mtail, 4096, 1024, ea); }
        GSYNC();
        {
            EpiArgs ea{}; ea.res_lat = p.out; ea.res_ctx = XC; ea.out_lat = p.out; ea.out_ctx = XC; ea.modg = MOD + (size_t)l * 17 * 6144 + 5120;
            if (DUPMASK & 32) gemm_phase<EPI_DRY>(BIG, WM2, Mtail, 1024, 4096, ea);
            if (PHMASK & 4096) gemm_phase<EPI_RESID>(BIG, WM2, Mtail, 1024, 4096, ea);
        }
        GSYNC();
    }
}

extern "C" void kernel_launch(void* const* d_in, const int* in_sizes, int n_in, void* d_out, int out_size, void* d_ws, size_t ws_size, hipStream_t stream) {
    static int grid_blocks = 0;
    if (grid_blocks == 0) {
        if (n_in != 26 || ws_size < WS_END + 256) { fprintf(stderr, "kernel_launch: unexpected n_in %d or ws_size %zu (< %zu)\n", n_in, ws_size, (size_t)WS_END); grid_blocks = -1; return; }
        int dev = 0, cus = 0, per_cu = 0;
        hipGetDevice(&dev);
        hipDeviceGetAttribute(&cus, hipDeviceAttributeMultiprocessorCount, dev);
        if (hipFuncSetAttribute((const void*)fwd_megakernel, hipFuncAttributeMaxDynamicSharedMemorySize, LDS_BYTES) != hipSuccess) fprintf(stderr, "kernel_launch: hipFuncSetAttribute failed\n");
        if (hipOccupancyMaxActiveBlocksPerMultiprocessor(&per_cu, (const void*)fwd_megakernel, NT, LDS_BYTES) != hipSuccess || per_cu < 1) { fprintf(stderr, "kernel_launch: occupancy query gave %d\n", per_cu); per_cu = 1; }
        (void)hipGetLastError();
        grid_blocks = cus * 1;
        fprintf(stderr, "kernel_launch: cus %d per_cu %d grid %d\n", cus, per_cu, grid_blocks);
    }
    if (grid_blocks < 0) return;
    Params p{};
    for (int i = 0; i < 26; ++i) p.in[i] = (const float*)d_in[i];
    p.out = (float*)d_out; p.ws = (unsigned char*)d_ws;
    void* args[] = {&p};
    hipError_t e = hipLaunchCooperativeKernel((void*)fwd_megakernel, dim3(grid_blocks), dim3(NT), args, LDS_BYTES, stream);
    if (e != hipSuccess) fprintf(stderr, "cooperative launch failed: %s (grid %d)\n", hipGetErrorString(e), grid_blocks);
}
```

```cpp
#include <hip/hip_runtime.h>
#include <hip/hip_cooperative_groups.h>
#include <cstdio>
#include <cstdint>
namespace cg = cooperative_groups;

typedef unsigned short bf16_t;
typedef short bf16x8 __attribute__((ext_vector_type(8)));
typedef float f32x4 __attribute__((ext_vector_type(4)));
typedef unsigned u32x4 __attribute__((ext_vector_type(4)));
typedef unsigned u32x2 __attribute__((ext_vector_type(2)));

#define NT 512
#define DBG_LAYER 0
#define DBG_CLS ((((row % 64) / 16) * 2) + ((ch % 32) / 16))
#ifndef PHMASK
#define PHMASK 0xFFFF
#endif
#ifndef DUPMASK
#define DUPMASK 0
#endif
#define REP(bit) for (int rep_ = 0; rep_ < (((DUPMASK) & (bit)) ? 2 : 1); ++rep_)
constexpr int BATCH = 16, SEQ = 2048, DM = 1024, CTXL = 256;
constexpr int NLAT = BATCH * SEQ, NCTX = BATCH * CTXL, MTOT = NLAT + NCTX;
constexpr int DFF = 4096;
constexpr float EPS = 1e-6f;
constexpr int LDS_BYTES = 147456;

constexpr size_t al256(size_t x) { return (x + 255) & ~(size_t)255; }
constexpr size_t WS_WIN = 0;
constexpr size_t WS_WOUT = al256(WS_WIN + (size_t)3840 * 1024 * 2);
constexpr size_t WS_WM1 = al256(WS_WOUT + (size_t)1024 * 1024 * 2);
constexpr size_t WS_WM2 = al256(WS_WM1 + (size_t)4096 * 1024 * 2);
constexpr size_t WS_MOD = al256(WS_WM2 + (size_t)4096 * 1024 * 2);
constexpr size_t WS_XC = al256(WS_MOD + (size_t)4 * 17 * 6144 * 4);
constexpr size_t WS_ACT = al256(WS_XC + (size_t)NCTX * 1024 * 4);
constexpr size_t WS_BIG = al256(WS_ACT + (size_t)MTOT * 1024 * 2);
constexpr size_t WS_P2 = WS_BIG + (size_t)MTOT * 2048 * 2;
constexpr size_t WS_GATES = WS_P2 + (size_t)1536 * MTOT * 2;
constexpr size_t WS_HFB = al256(WS_BIG + (size_t)MTOT * 4096 * 2);
constexpr size_t WS_FLAT = al256(WS_HFB + (size_t)2 * MTOT * 512 * 2);
constexpr size_t WS_FCTX = al256(WS_FLAT + (size_t)2 * 512 * 4096 * 2);
constexpr size_t WS_H2 = al256(WS_FCTX + (size_t)2 * 512 * 512 * 2);
constexpr size_t WS_ROPE = al256(WS_H2 + (size_t)2 * 2304 * 64 * 4);
constexpr size_t WS_END = al256(WS_ROPE + (size_t)2 * 64 * 32 * 4);
static_assert(WS_GATES + (size_t)MTOT * 16 * 4 <= WS_HFB, "projection overlay too large");

struct Params { const float* in[26]; float* out; unsigned char* ws; };

typedef float f32x2_ __attribute__((ext_vector_type(2)));
typedef __bf16 bf16x2_ __attribute__((ext_vector_type(2)));
__device__ __forceinline__ unsigned pk2(float lo, float hi) { f32x2_ v = {lo, hi}; bf16x2_ b = __builtin_convertvector(v, bf16x2_); return __builtin_bit_cast(unsigned, b); }
__device__ __forceinline__ bf16_t f2b(float x) { return (bf16_t)(pk2(x, 0.f) & 0xffffu); }
__device__ __forceinline__ float b2f(bf16_t b) { return __uint_as_float(((unsigned)b) << 16); }
__device__ __forceinline__ float blo(unsigned w) { return __uint_as_float(w << 16); }
__device__ __forceinline__ float bhi(unsigned w) { return __uint_as_float(w & 0xffff0000u); }
__device__ __forceinline__ void unpack8(u32x4 v, float* f) {
    f[0] = blo(v.x); f[1] = bhi(v.x); f[2] = blo(v.y); f[3] = bhi(v.y); f[4] = blo(v.z); f[5] = bhi(v.z); f[6] = blo(v.w); f[7] = bhi(v.w);
}
__device__ __forceinline__ u32x4 pack8(const float* f) { u32x4 r; r.x = pk2(f[0], f[1]); r.y = pk2(f[2], f[3]); r.z = pk2(f[4], f[5]); r.w = pk2(f[6], f[7]); return r; }
__device__ __forceinline__ float fsin_(float x) { float r = x * 0.15915494309189535f; r -= floorf(r); return __builtin_amdgcn_sinf(r); }
__device__ __forceinline__ float fcos_(float x) { float r = x * 0.15915494309189535f; r -= floorf(r); return __builtin_amdgcn_cosf(r); }
__device__ __forceinline__ float wave_sum(float v) {
#pragma unroll
    for (int o = 1; o < 64; o <<= 1) v += __shfl_xor(v, o);
    return v;
}
__device__ __forceinline__ f32x4 mfma16(bf16x8 a, bf16x8 b, f32x4 c) { return __builtin_amdgcn_mfma_f32_16x16x32_bf16(a, b, c, 0, 0, 0); }
__device__ __forceinline__ bf16x8 as_bf8(u32x4 v) { return __builtin_bit_cast(bf16x8, v); }

extern __shared__ __attribute__((aligned(16))) unsigned char dyn_lds[];
__device__ __forceinline__ int tid_l() { int t = threadIdx.x; asm volatile("" : "+v"(t)); return t; }

constexpr int G_BM = 256, G_BK = 64, G_HALF = 128, G_HT = G_HALF * G_BK;
__device__ __forceinline__ int lds_byte(int r, int c) {
    int st = (r >> 4) * 2 + (c >> 5), rr = r & 15, cc = c & 31, ob = rr * 64 + cc * 2;
    return st * 1024 + (ob ^ (((ob >> 9) & 1) << 5));
}
__device__ __forceinline__ void stage_rc(int b, int& R, int& C) {
    int st = b / 1024, sb = b % 1024, swz = sb ^ (((sb >> 9) & 1) << 5);
    R = (st >> 1) * 16 + swz / 64; C = (st & 1) * 32 + (swz % 64) / 2;
}

enum { EPI_INPROJ = 0, EPI_RESID = 1, EPI_RELU2 = 2, EPI_DRY = 3 };
struct EpiArgs {
    bf16_t* o_rm; int ld_rm;
    bf16_t* o_dbg;
    bf16_t* o_cm;
    float* gates; int gate_pn;
    const float* res_lat; const float* res_ctx; float* out_lat; float* out_ctx; const float* modg;
};

#define WAIT_V_(n) asm volatile("s_waitcnt vmcnt(" #n ")" ::: "memory")
#define WAIT_V(n) WAIT_V_(n)
#ifndef GEMM_VM
#define GEMM_VM 8
#endif
#define WAIT_L(n) asm volatile("s_waitcnt lgkmcnt(" #n ")" ::: "memory")
#define BAR __builtin_amdgcn_s_barrier()
#define CFENCE asm volatile("" ::: "memory")

template <bool TR>
__device__ __forceinline__ void gemm_kloop(const bf16_t* __restrict__ A, const bf16_t* __restrict__ Bt, int K, int brow, int bcol, f32x4 (&acc)[2][2][4][2]) {
    bf16_t* shm = (bf16_t*)dyn_lds;
#define SA(b, h) (shm + ((b) * 2 + (h)) * G_HT)
#define SB(b, h) (shm + (4 + (b) * 2 + (h)) * G_HT)
    const int tidx = tid_l();
    const int wid = tidx >> 6, lane = tidx & 63, wr = wid >> 2, wc = wid & 3, fr = lane & 15, fq = lane >> 4;
    const int nt = K / G_BK;
    int goff[2];
#pragma unroll
    for (int i = 0; i < 2; ++i) { int r_, c_; stage_rc(tidx * 16 + i * 8192, r_, c_); goff[i] = r_ * K + c_; }
    const bf16_t* Ab = A + (long)brow * K; const bf16_t* Bb = Bt + (long)bcol * K;
#define STAGE2(P, BASEP, kt) do { _Pragma("unroll") for (int _i = 0; _i < 2; ++_i) \
      __builtin_amdgcn_global_load_lds((const unsigned*)((BASEP) + (kt) * G_BK + goff[_i]), (unsigned*)((char*)(P) + tidx * 16 + _i * 8192), 16, 0, 0); } while (0)
    STAGE2(SA(0, 0), Ab, 0); STAGE2(SA(0, 1), Ab + (long)G_HALF * K, 0); STAGE2(SB(0, 0), Bb, 0); STAGE2(SB(0, 1), Bb + (long)G_HALF * K, 0);
    for (int kt = 0; kt < nt; ++kt) {
        const int cur = kt & 1, nxt = cur ^ 1;
        WAIT_V(0); WAIT_L(0);
        BAR; CFENCE;
        if (kt + 1 < nt) {
            STAGE2(SA(nxt, 0), Ab, kt + 1); STAGE2(SA(nxt, 1), Ab + (long)G_HALF * K, kt + 1);
            STAGE2(SB(nxt, 0), Bb, kt + 1); STAGE2(SB(nxt, 1), Bb + (long)G_HALF * K, kt + 1);
        }
#pragma unroll
        for (int k = 0; k < 2; ++k) {
            bf16x8 Bf[2][2];
#pragma unroll
            for (int bj = 0; bj < 2; ++bj)
#pragma unroll
                for (int n = 0; n < 2; ++n) Bf[bj][n] = *reinterpret_cast<const bf16x8*>((char*)SB(cur, bj) + lds_byte(wc * 32 + n * 16 + fr, k * 32 + fq * 8));
#pragma unroll
            for (int ai = 0; ai < 2; ++ai) {
                bf16x8 Af[4];
#pragma unroll
                for (int m = 0; m < 4; ++m) Af[m] = *reinterpret_cast<const bf16x8*>((char*)SA(cur, ai) + lds_byte(wr * 64 + m * 16 + fr, k * 32 + fq * 8));
                __builtin_amdgcn_s_setprio(1);
#pragma unroll
                for (int m = 0; m < 4; ++m)
#pragma unroll
                    for (int bj = 0; bj < 2; ++bj)
#pragma unroll
                        for (int n = 0; n < 2; ++n)
                            acc[ai][bj][m][n] = TR ? mfma16(Bf[bj][n], Af[m], acc[ai][bj][m][n]) : mfma16(Af[m], Bf[bj][n], acc[ai][bj][m][n]);
                __builtin_amdgcn_s_setprio(0);
            }
        }
    }
    WAIT_L(0); BAR; CFENCE;
}

template <int EPI>
__device__ __forceinline__ void gemm_phase(const bf16_t* A, const bf16_t* Bt, int M, int N, int K, const EpiArgs& ea) {
    const int nM = M / G_BM, nN = N / G_BM, nwg = nM * nN;
    const int tidx = tid_l(); const int wid = tidx >> 6, lane = tidx & 63, wr = wid >> 2, wc = wid & 3, fr = lane & 15, fq = lane >> 4;
    for (int L = blockIdx.x; L < nwg; L += gridDim.x) {
        int wgid = L;
        { int q = nwg / 8, r = nwg % 8, xcd = wgid % 8, off = wgid / 8; wgid = (xcd < r ? xcd * (q + 1) : r * (q + 1) + (xcd - r) * q) + off; }
        const int nig = 8 * nN, gid = wgid / nig, fm = gid * 8, gsz = min(nM - fm, 8);
        const int pm = fm + ((wgid % nig) % gsz), pn = (wgid % nig) / gsz, brow = pm * G_BM, bcol = pn * G_BM;
        f32x4 acc[2][2][4][2];
#pragma unroll
        for (int a = 0; a < 2; ++a)
#pragma unroll
            for (int b = 0; b < 2; ++b)
#pragma unroll
                for (int m = 0; m < 4; ++m)
#pragma unroll
                    for (int n = 0; n < 2; ++n) acc[a][b][m][n] = (f32x4){0.f, 0.f, 0.f, 0.f};
        const bool colmajor = (EPI == EPI_INPROJ) && pn >= 8 && pn != ea.gate_pn;
        if (colmajor) {
            gemm_kloop<true>(A, Bt, K, brow, bcol, acc);
#pragma unroll
            for (int ai = 0; ai < 2; ++ai)
#pragma unroll
                for (int bj = 0; bj < 2; ++bj)
#pragma unroll
                    for (int m = 0; m < 4; ++m)
#pragma unroll
                        for (int n = 0; n < 2; ++n) {
                            const int row = brow + ai * 128 + wr * 64 + m * 16 + fr, col = bcol + bj * 128 + wc * 32 + n * 16 + fq * 4;
                            const f32x4 v = acc[ai][bj][m][n];
#pragma unroll
                            for (int j = 0; j < 4; ++j) ea.o_cm[(size_t)(col + j - 2048) * MTOT + row] = f2b(v[j]);
                        }
        } else {
            gemm_kloop<true>(A, Bt, K, brow, bcol, acc);
#pragma unroll
            for (int ai = 0; ai < 2; ++ai)
#pragma unroll
                for (int m = 0; m < 4; ++m) {
                    const int row = brow + ai * 128 + wr * 64 + m * 16 + fr;
#pragma unroll
                    for (int bj = 0; bj < 2; ++bj)
#pragma unroll
                        for (int n = 0; n < 2; ++n) {
                            const int col = bcol + bj * 128 + wc * 32 + n * 16 + fq * 4;
                            const f32x4 v = acc[ai][bj][m][n];
                            if (EPI == EPI_INPROJ) {
                                if (pn == ea.gate_pn) {
                                    if (bj == 0 && wc == 0 && n == 0) *(f32x4*)(ea.gates + (size_t)row * 16 + fq * 4) = v;
                                } else {
                                    u32x2 o; o.x = pk2(v[0], v[1]); o.y = pk2(v[2], v[3]);
                                    *(u32x2*)(ea.o_rm + (size_t)row * ea.ld_rm + col) = o;
                                }
                            } else if (EPI == EPI_DRY) {
                                if (v[0] == 123456.789f && v[1] == 3.25f) *(f32x4*)(ea.out_lat + (size_t)row * 1024 + (col & 1023)) = v;
                            } else if (EPI == EPI_RELU2) {
                                float r0 = fmaxf(v[0], 0.f), r1 = fmaxf(v[1], 0.f), r2 = fmaxf(v[2], 0.f), r3 = fmaxf(v[3], 0.f);
                                u32x2 o; o.x = pk2(r0 * r0, r1 * r1); o.y = pk2(r2 * r2, r3 * r3);
                                *(u32x2*)(ea.o_rm + (size_t)row * ea.ld_rm + col) = o;
                            } else {
                                const float* rp; float* op; int mrow;
                                if (row < NLAT) { rp = ea.res_lat + (size_t)row * 1024 + col; op = ea.out_lat + (size_t)row * 1024 + col; mrow = row >> 11; }
                                else { rp = ea.res_ctx + (size_t)(row - NLAT) * 1024 + col; op = ea.out_ctx + (size_t)(row - NLAT) * 1024 + col; mrow = 16; }
                                const f32x4 g = *(const f32x4*)(ea.modg + (size_t)mrow * 6144 + col);
                                const f32x4 x = *(const f32x4*)rp;
                                f32x4 rr = x + g * v;
#ifdef SANITIZE
#pragma unroll
                                for (int q_ = 0; q_ < 4; ++q_) if (!(fabsf(rr[q_]) < 1e30f)) rr[q_] = 0.f;
#endif
                                *(f32x4*)op = rr;
                            }
                        }
                }
        }
        asm volatile("s_waitcnt vmcnt(0)" ::: "memory");
        __syncthreads();
    }
}

__device__ __forceinline__ void phase0(const Params& p) {
    const int tid = tid_l(), blk = blockIdx.x, nb = gridDim.x;
    float* MOD = (float*)(p.ws + WS_MOD);
    for (int it = blk; it < 193; it += nb) {
        if (it < 192) {
            float* sl = (float*)dyn_lds;
            float* red = sl + 17 * 1024;
            for (int i = tid; i < 17 * 1024; i += NT) { float v = (i < 16 * 1024) ? p.in[1][i] : p.in[3][i - 16 * 1024]; sl[i] = v / (1.f + __expf(-v)); }
            __syncthreads();
            const int l = it / 48, nc = it % 48, kp = tid >> 7, col = tid & 127;
            const float* W = p.in[4] + (size_t)l * 1024 * 6144 + nc * 128 + col;
            float acc[17];
#pragma unroll
            for (int r = 0; r < 17; ++r) acc[r] = 0.f;
            for (int k = kp * 256; k < kp * 256 + 256; ++k) {
                const float wv = W[(size_t)k * 6144];
#pragma unroll
                for (int r = 0; r < 17; ++r) acc[r] += sl[r * 1024 + k] * wv;
            }
#pragma unroll
            for (int r = 0; r < 17; ++r) red[(kp * 17 + r) * 128 + col] = acc[r];
            __syncthreads();
            for (int i = tid; i < 17 * 128; i += NT) {
                const int r = i >> 7, cc = i & 127;
                const float s = red[(0 * 17 + r) * 128 + cc] + red[(1 * 17 + r) * 128 + cc] + red[(2 * 17 + r) * 128 + cc] + red[(3 * 17 + r) * 128 + cc];
                MOD[((size_t)l * 17 + r) * 6144 + nc * 128 + cc] = s + p.in[5][l * 6144 + nc * 128 + cc];
            }
            __syncthreads();
        } else {
            float* ROPE = (float*)(p.ws + WS_ROPE);
            for (int i = tid; i < 2048; i += NT) {
                const int pos = i >> 5, j = i & 31;
                const float inv = exp2f(-(float)j * (13.287712379549449f / 32.f));
                const float ang = (float)pos * inv;
                ROPE[i] = fcos_(ang); ROPE[2048 + i] = fsin_(ang);
            }
        }
    }
    float* H2 = (float*)(p.ws + WS_H2);
    const int gw = blk * 8 + (tid >> 6), lane = tid & 63;
    for (int it = gw; it < 2 * 2304; it += nb * 8) {
        const int i = it / 2304, row = it % 2304;
        const int L = row < 2048 ? 2048 : 256, t = row < 2048 ? row : row - 2048;
        const float tn = (float)t / (float)(L - 1);
        const float wpos = 6.283185307179586f * (float)t / (float)L;
        float ev = 0.f;
        if (lane == 0) ev = tn;
        else if (lane <= 16) { const float fr = 1e-4f + (float)(lane - 1) * ((15.f - 1e-4f) / 15.f); ev = fcos_(wpos * fr); }
        else if (lane <= 32) { const float fr = 1e-4f + (float)(lane - 17) * ((15.f - 1e-4f) / 15.f); ev = -fsin_(wpos * fr); }
        const float* w1 = p.in[13] + i * 33 * 64; const float* b1 = p.in[14] + i * 64;
        const float* w2 = p.in[15] + i * 64 * 64; const float* b2 = p.in[16] + i * 64; const float* fq = p.in[18] + i * 64;
        float a = b1[lane];
        for (int e = 0; e < 33; ++e) a += __shfl(ev, e) * w1[e * 64 + lane];
        const float h1 = fsin_(fq[lane] * a);
        float a2 = b2[lane];
        for (int e = 0; e < 64; ++e) a2 += __shfl(h1, e) * w2[e * 64 + lane];
        H2[((size_t)i * 2304 + row) * 64 + lane] = fsin_(fq[lane] * a2);
    }
}

__device__ __forceinline__ void cvt_tile(const float* W, int N, int K, bf16_t* WT, int n0, int k0, int mapmode) {
    float* tl = (float*)dyn_lds;
    const int tid = tid_l(), nl = tid & 63, kb = tid >> 6;
    const int n = n0 + nl; int sc = n;
    if (mapmode == 1) sc = n < 2048 ? n : (n < 3584 ? n + 16 : (n < 3600 ? n - 3584 + 2048 : -1));
#pragma unroll
    for (int i = 0; i < 8; ++i) { const int kl = kb + 8 * i; tl[kl * 65 + nl] = sc >= 0 ? W[(size_t)(k0 + kl) * N + sc] : 0.f; }
    __syncthreads();
    const int nn = tid >> 3, kc = tid & 7;
    float f[8];
#pragma unroll
    for (int j = 0; j < 8; ++j) f[j] = tl[(kc * 8 + j) * 65 + nn];
    *(u32x4*)(WT + (size_t)(n0 + nn) * K + k0 + kc * 8) = pack8(f);
    __syncthreads();
}

__device__ __forceinline__ void convert_weights(const Params& p, int l) {
    const int blk = blockIdx.x, nb = gridDim.x, li = l >> 1; const bool even = !(l & 1);
    const int nin = even ? 60 : 48;
    const int t_in = nin * 16, t_out = 256, t_m1 = 1024, t_m2 = 1024;
    const int total = t_in + t_out + t_m1 + t_m2;
    for (int it = blk; it < total; it += nb) {
        int r = it;
        if (r < t_in) {
            const int nt = r / 16, kt = r % 16;
            if (even) cvt_tile(p.in[8] + (size_t)li * 1024 * 3600, 3600, 1024, (bf16_t*)(p.ws + WS_WIN), nt * 64, kt * 64, 1);
            else cvt_tile(p.in[21] + (size_t)li * 1024 * 3072, 3072, 1024, (bf16_t*)(p.ws + WS_WIN), nt * 64, kt * 64, 0);
            continue;
        }
        r -= t_in;
        if (r < t_out) {
            const int nt = r / 16, kt = r % 16;
            cvt_tile((even ? p.in[20] : p.in[25]) + (size_t)li * 1024 * 1024, 1024, 1024, (bf16_t*)(p.ws + WS_WOUT), nt * 64, kt * 64, 0);
            continue;
        }
        r -= t_out;
        if (r < t_m1) {
            const int nt = r / 16, kt = r % 16;
            cvt_tile(p.in[6] + (size_t)l * 1024 * 4096, 4096, 1024, (bf16_t*)(p.ws + WS_WM1), nt * 64, kt * 64, 0);
            continue;
        }
        r -= t_m1;
        { const int nt = r / 64, kt = r % 64;
          cvt_tile(p.in[7] + (size_t)l * 4096 * 1024, 1024, 4096, (bf16_t*)(p.ws + WS_WM2), nt * 64, kt * 64, 0); }
    }
}

__device__ __forceinline__ void norm_phase(const Params& p, int l, const float* xlat, const float* xctx, int shoff, int scoff, int M) {
    const int tid = tid_l(), lane = tid & 63, gw = blockIdx.x * 8 + (tid >> 6), ngw = gridDim.x * 8;
    const float* MOD = (const float*)(p.ws + WS_MOD) + (size_t)l * 17 * 6144;
    bf16_t* ACT = (bf16_t*)(p.ws + WS_ACT);
    for (int row = gw; row < M; row += ngw) {
        const float* xr = row < NLAT ? xlat + (size_t)row * 1024 : xctx + (size_t)(row - NLAT) * 1024;
        const int mrow = row < NLAT ? row >> 11 : 16;
        const float* mod = MOD + (size_t)mrow * 6144;
        f32x4 v[4]; float ss = 0.f;
#pragma unroll
        for (int j = 0; j < 4; ++j) { v[j] = *(const f32x4*)(xr + 4 * lane + 256 * j); ss += v[j][0] * v[j][0] + v[j][1] * v[j][1] + v[j][2] * v[j][2] + v[j][3] * v[j][3]; }
        ss = wave_sum(ss);
        const float rstd = rsqrtf(ss * (1.f / 1024.f) + EPS);
#pragma unroll
        for (int j = 0; j < 4; ++j) {
            const int col = 4 * lane + 256 * j;
            const f32x4 sh = *(const f32x4*)(mod + shoff + col), sc = *(const f32x4*)(mod + scoff + col);
            const f32x4 y = v[j] * rstd * (sc + 1.f) + sh;
            u32x2 o; o.x = pk2(y[0], y[1]); o.y = pk2(y[2], y[3]);
            *(u32x2*)(ACT + (size_t)row * 1024 + col) = o;
        }
    }
}

__device__ __forceinline__ void filter_gen(const Params& p, int li) {
    const int tid = tid_l(), lane = tid & 63, w = tid >> 6;
    float* wf = (float*)dyn_lds; float* wb = wf + 64; float* red = wb + 64;
    const float* H2 = (const float*)(p.ws + WS_H2);
    for (int it = blockIdx.x; it < 2048; it += gridDim.x) {
        const int ltype = it >> 10, o = (it >> 9) & 1, c = it & 511;
        const int L = ltype ? 256 : 2048;
        const float* H2r = H2 + ((size_t)li * 2304 + (ltype ? 2048 : 0)) * 64;
        const float* w3 = p.in[17] + (size_t)li * 64 * 2048;
        if (tid < 64) wf[tid] = w3[tid * 2048 + (o * 2 + 0) * 512 + c];
        else if (tid < 128) wb[tid - 64] = w3[(tid - 64) * 2048 + (o * 2 + 1) * 512 + c];
        __syncthreads();
        const float lo = -4.605170185988091f / 1.5f, hi = -4.605170185988091f / 0.3f;
        const float delta = fabsf(lo + (hi - lo) * (float)c / 511.f);
        float vf[4], vb[4]; float ssf = 0.f, ssb = 0.f;
#pragma unroll
        for (int q = 0; q < 4; ++q) {
            const int t = tid + 512 * q; vf[q] = 0.f; vb[q] = 0.f;
            if (t < L) {
                float df = 0.f, db = 0.f;
                const f32x4* hr = (const f32x4*)(H2r + (size_t)t * 64);
#pragma unroll
                for (int j = 0; j < 16; ++j) { const f32x4 hv = hr[j];
                    df += hv[0] * wf[4 * j] + hv[1] * wf[4 * j + 1] + hv[2] * wf[4 * j + 2] + hv[3] * wf[4 * j + 3];
                    db += hv[0] * wb[4 * j] + hv[1] * wb[4 * j + 1] + hv[2] * wb[4 * j + 2] + hv[3] * wb[4 * j + 3]; }
                const float dec = __expf(-((float)t / (float)(L - 1)) * delta);
                vf[q] = df * dec; vb[q] = db * dec; ssf += vf[q] * vf[q]; ssb += vb[q] * vb[q];
            }
        }
        ssf = wave_sum(ssf); ssb = wave_sum(ssb);
        if (lane == 0) { red[w] = ssf; red[8 + w] = ssb; }
        __syncthreads();
        float tf = 0.f, tb = 0.f;
#pragma unroll
        for (int i = 0; i < 8; ++i) { tf += red[i]; tb += red[8 + i]; }
        const float nf = rsqrtf(tf + EPS), nbk = rsqrtf(tb + EPS);
        bf16_t* dst = ltype ? (bf16_t*)(p.ws + WS_FCTX) + ((size_t)o * 512 + c) * 512 : (bf16_t*)(p.ws + WS_FLAT) + ((size_t)o * 512 + c) * 4096;
#pragma unroll
        for (int q = 0; q < 4; ++q) {
            const int t = tid + 512 * q;
            if (t < L) {
                if (t == 0) { dst[L] = f2b(vf[q] * nf + vb[q] * nbk); dst[0] = 0; }
                else { dst[L + t] = f2b(vf[q] * nf); dst[L - t] = f2b(vb[q] * nbk); }
            }
        }
        __syncthreads();
    }
}

__device__ __forceinline__ void mlstm_item(const Params& p, int li, int it) {
    const int tid = tid_l(), w = tid >> 6, lane = tid & 63, fr = lane & 15, fq = lane >> 4;
    const int b = it >> 3, h = (it >> 1) & 3, dir = it & 1;
    bf16_t* Qs = (bf16_t*)dyn_lds;
    bf16_t* Ks = Qs + 64 * 136;
    bf16_t* KT = Ks + 64 * 136;
    bf16_t* VT = KT + 128 * 72;
    bf16_t* Cb = VT + 144 * 72;
    bf16_t* Ps = Cb + 144 * 136;
    float* fl = (float*)(Ps + 64 * 72);
    float* a_s = fl; float* Mt = fl + 64; float* scs = fl + 128; float* emt = fl + 192; float* den = fl + 256; float* lfs = fl + 320; float* igs = fl + 384; float* scal = fl + 448;
    const bf16_t* QKVO = (const bf16_t*)(p.ws + WS_BIG);
    const float* GATES = (const float*)(p.ws + WS_GATES);
    bf16_t* HFB = (bf16_t*)(p.ws + WS_HFB) + (size_t)dir * MTOT * 512;
    const float* ROPE = (const float*)(p.ws + WS_ROPE);
    const float* gate_b = p.in[9] + li * 16;
    for (int i = tid; i < 144 * 136 / 2; i += NT) ((unsigned*)Cb)[i] = 0u;
    for (int i = tid; i < 16 * 72; i += NT) { const int r = i / 72, ci = i % 72; VT[(128 + r) * 72 + ci] = (r == 0 && ci < 64) ? (bf16_t)0x3F80 : (bf16_t)0; }
    f32x4 cacc[9];
#pragma unroll
    for (int i = 0; i < 9; ++i) cacc[i] = (f32x4){0.f, 0.f, 0.f, 0.f};
    float m = 0.f;
    __syncthreads();
    for (int step = 0; step < 36; ++step) {
        const bool isctx = step < 4;
        const int cj = isctx ? (dir ? 3 - step : step) : (dir ? 35 - step : step - 4);
        const int rowbase = isctx ? NLAT + b * 256 + cj * 64 : b * 2048 + cj * 64;
        {
            const int r = tid >> 3, seg = tid & 7; const int tl = dir ? 63 - r : r;
            const bf16_t* src = QKVO + (size_t)(rowbase + tl) * 2048 + h * 128;
            const int hb = seg >> 2, jb = (seg & 3) * 8, d1 = hb * 64 + jb, d2 = d1 + 32;
            const u32x4 q1 = *(const u32x4*)(src + d1), q2 = *(const u32x4*)(src + d2);
            const u32x4 k1 = *(const u32x4*)(src + 512 + d1), k2 = *(const u32x4*)(src + 512 + d2);
            const u32x4 v1 = *(const u32x4*)(src + 1024 + seg * 16), v2 = *(const u32x4*)(src + 1024 + seg * 16 + 8);
            float cs[8], sn[8];
            if (!isctx) {
                const int pos = hb ? tl : cj;
                const f32x4 c0 = *(const f32x4*)(ROPE + pos * 32 + jb), c1 = *(const f32x4*)(ROPE + pos * 32 + jb + 4);
                const f32x4 s0 = *(const f32x4*)(ROPE + 2048 + pos * 32 + jb), s1 = *(const f32x4*)(ROPE + 2048 + pos * 32 + jb + 4);
#pragma unroll
                for (int e = 0; e < 4; ++e) { cs[e] = c0[e]; cs[4 + e] = c1[e]; sn[e] = s0[e]; sn[4 + e] = s1[e]; }
            } else {
#pragma unroll
                for (int e = 0; e < 8; ++e) { cs[e] = 1.f; sn[e] = 0.f; }
            }
            float x1[8], x2[8], o1[8], o2[8];
            unpack8(q1, x1); unpack8(q2, x2);
#pragma unroll
            for (int e = 0; e < 8; ++e) { o1[e] = x1[e] * cs[e] - x2[e] * sn[e]; o2[e] = x1[e] * sn[e] + x2[e] * cs[e]; }
            *(u32x4*)(Qs + r * 136 + d1) = pack8(o1); *(u32x4*)(Qs + r * 136 + d2) = pack8(o2);
            unpack8(k1, x1); unpack8(k2, x2);
            const float ksc = 0.08838834764831845f;
#pragma unroll
            for (int e = 0; e < 8; ++e) { o1[e] = (x1[e] * cs[e] - x2[e] * sn[e]) * ksc; o2[e] = (x1[e] * sn[e] + x2[e] * cs[e]) * ksc; }
            const u32x4 ko1 = pack8(o1), ko2 = pack8(o2);
            *(u32x4*)(Ks + r * 136 + d1) = ko1; *(u32x4*)(Ks + r * 136 + d2) = ko2;
            {
                const unsigned kw1[4] = {ko1.x, ko1.y, ko1.z, ko1.w}, kw2[4] = {ko2.x, ko2.y, ko2.z, ko2.w};
#pragma unroll
                for (int e = 0; e < 4; ++e) {
                    KT[(d1 + 2 * e) * 72 + r] = (bf16_t)(kw1[e] & 0xffffu); KT[(d1 + 2 * e + 1) * 72 + r] = (bf16_t)(kw1[e] >> 16);
                    KT[(d2 + 2 * e) * 72 + r] = (bf16_t)(kw2[e] & 0xffffu); KT[(d2 + 2 * e + 1) * 72 + r] = (bf16_t)(kw2[e] >> 16);
                }
                const unsigned vw1[4] = {v1.x, v1.y, v1.z, v1.w}, vw2[4] = {v2.x, v2.y, v2.z, v2.w};
#pragma unroll
                for (int e = 0; e < 4; ++e) {
                    VT[(seg * 16 + 2 * e) * 72 + r] = (bf16_t)(vw1[e] & 0xffffu); VT[(seg * 16 + 2 * e + 1) * 72 + r] = (bf16_t)(vw1[e] >> 16);
                    VT[(seg * 16 + 8 + 2 * e) * 72 + r] = (bf16_t)(vw2[e] & 0xffffu); VT[(seg * 16 + 8 + 2 * e + 1) * 72 + r] = (bf16_t)(vw2[e] >> 16);
                }
            }
            if (tid < 64) {
                const int rr = tid, tl2 = dir ? 63 - rr : rr;
                const float* g = GATES + (size_t)(rowbase + tl2) * 16;
                const float ig = g[dir * 8 + h] + gate_b[dir * 8 + h];
                const float fg = g[dir * 8 + 4 + h] + gate_b[dir * 8 + 4 + h];
                igs[rr] = ig; lfs[rr] = fminf(fg, 0.f) - __logf(1.f + __expf(-fabsf(fg)));
            }
        }
        __syncthreads();
        if (w == 0) {
            float bcs = lfs[lane];
#pragma unroll
            for (int o = 1; o < 64; o <<= 1) { const float t = __shfl_up(bcs, o); if (lane >= o) bcs += t; }
            const float a = igs[lane] - bcs;
            float pm = a;
#pragma unroll
            for (int o = 1; o < 64; o <<= 1) { const float t = __shfl_up(pm, o); if (lane >= o) pm = fmaxf(pm, t); }
            const float Mx = fmaxf(m, pm);
            a_s[lane] = a; Mt[lane] = Mx; scs[lane] = __expf(m - Mx); emt[lane] = __expf(-bcs - Mx);
            if (lane == 63) { scal[0] = bcs; scal[1] = Mx; }
        }
        {
            const int st = w & 3, tt0 = (w >> 2) * 2;
            f32x4 sacc[2];
#pragma unroll
            for (int u = 0; u < 2; ++u) {
                sacc[u] = (f32x4){0.f, 0.f, 0.f, 0.f};
#pragma unroll
                for (int kk = 0; kk < 4; ++kk) {
                    const bf16x8 Ak = *(const bf16x8*)(Ks + (st * 16 + fr) * 136 + kk * 32 + fq * 8);
                    const bf16x8 Bq = *(const bf16x8*)(Qs + ((tt0 + u) * 16 + fr) * 136 + kk * 32 + fq * 8);
                    sacc[u] = mfma16(Ak, Bq, sacc[u]);
                }
            }
            __syncthreads();
#pragma unroll
            for (int u = 0; u < 2; ++u) {
                const int t = (tt0 + u) * 16 + fr, sb = st * 16 + fq * 4;
                const float Mv = Mt[t];
                float pv[4];
#pragma unroll
                for (int j = 0; j < 4; ++j) { const int s = sb + j; pv[j] = (s <= t) ? sacc[u][j] * __expf(a_s[s] - Mv) : 0.f; }
                u32x2 o; o.x = pk2(pv[0], pv[1]); o.y = pk2(pv[2], pv[3]);
                *(u32x2*)(Ps + t * 72 + sb) = o;
            }
        }
        __syncthreads();
        {
            const int tt = w & 3, up = w >> 2, vt0 = up ? 5 : 0, nvt = up ? 4 : 5;
            bf16x8 qf[4], pf[2];
#pragma unroll
            for (int kk = 0; kk < 4; ++kk) qf[kk] = *(const bf16x8*)(Qs + (tt * 16 + fr) * 136 + kk * 32 + fq * 8);
#pragma unroll
            for (int kk = 0; kk < 2; ++kk) pf[kk] = *(const bf16x8*)(Ps + (tt * 16 + fr) * 72 + kk * 32 + fq * 8);
            const float sct = scs[tt * 16 + fr];
            f32x4 hacc[5];
#pragma unroll
            for (int vi = 0; vi < 5; ++vi) {
                hacc[vi] = (f32x4){0.f, 0.f, 0.f, 0.f};
                if (vi < nvt) {
                    const int v0 = (vt0 + vi) * 16;
                    f32x4 ac = (f32x4){0.f, 0.f, 0.f, 0.f};
#pragma unroll
                    for (int kk = 0; kk < 4; ++kk) ac = mfma16(*(const bf16x8*)(Cb + (v0 + fr) * 136 + kk * 32 + fq * 8), qf[kk], ac);
                    ac = ac * sct;
#pragma unroll
                    for (int kk = 0; kk < 2; ++kk) ac = mfma16(*(const bf16x8*)(VT + (v0 + fr) * 72 + kk * 32 + fq * 8), pf[kk], ac);
                    hacc[vi] = ac;
                }
            }
            if (up && fq == 0) den[tt * 16 + fr] = hacc[3][0];
            __syncthreads();
            const int t = tt * 16 + fr, tl = dir ? 63 - t : t;
            const float dn = den[t];
            const float inv = 1.f / fmaxf(fabsf(dn), emt[t]);
            bf16_t* orow = HFB + (size_t)(rowbase + tl) * 512 + h * 128;
#pragma unroll
            for (int vi = 0; vi < 5; ++vi) {
                if (vi < nvt && (vt0 + vi) < 8) {
                    const int v0 = (vt0 + vi) * 16 + fq * 4;
                    u32x2 o; o.x = pk2(hacc[vi][0] * inv, hacc[vi][1] * inv); o.y = pk2(hacc[vi][2] * inv, hacc[vi][3] * inv);
                    *(u32x2*)(orow + v0) = o;
                }
            }
        }
        {
            const float bl = scal[0], M63 = scal[1];
            const float decay = __expf(m - M63);
            bf16x8 ka[2];
#pragma unroll
            for (int kk = 0; kk < 2; ++kk) {
                const u32x4 raw = *(const u32x4*)(KT + (w * 16 + fr) * 72 + kk * 32 + fq * 8);
                float f[8]; unpack8(raw, f);
#pragma unroll
                for (int j = 0; j < 8; ++j) f[j] *= __expf(a_s[kk * 32 + fq * 8 + j] - M63);
                ka[kk] = as_bf8(pack8(f));
            }
#pragma unroll
            for (int vt = 0; vt < 9; ++vt) {
                f32x4 ac = cacc[vt] * decay;
#pragma unroll
                for (int kk = 0; kk < 2; ++kk) ac = mfma16(ka[kk], *(const bf16x8*)(VT + (vt * 16 + fr) * 72 + kk * 32 + fq * 8), ac);
                cacc[vt] = ac;
                u32x2 o; o.x = pk2(ac[0], ac[1]); o.y = pk2(ac[2], ac[3]);
                *(u32x2*)(Cb + (vt * 16 + fr) * 136 + w * 16 + fq * 4) = o;
            }
            m = bl + M63;
        }
        __syncthreads();
    }
}

__device__ __forceinline__ void combine_phase(const Params& p, int li) {
    const int tid = tid_l(), lane = tid & 63, gw = blockIdx.x * 8 + (tid >> 6), ngw = gridDim.x * 8;
    const bf16_t* HF = (const bf16_t*)(p.ws + WS_HFB); const bf16_t* HB = HF + (size_t)MTOT * 512;
    const bf16_t* QKVO = (const bf16_t*)(p.ws + WS_BIG);
    bf16_t* MIX = (bf16_t*)(p.ws + WS_ACT);
    const float* hn = p.in[10] + li * 512 + lane * 8;
    float g[8];
#pragma unroll
    for (int e = 0; e < 8; ++e) g[e] = hn[e];
    for (int row = gw; row < MTOT; row += ngw) {
        float a[8], bq[8], og[8], y[8];
        unpack8(*(const u32x4*)(HF + (size_t)row * 512 + lane * 8), a);
        unpack8(*(const u32x4*)(HB + (size_t)row * 512 + lane * 8), bq);
        unpack8(*(const u32x4*)(QKVO + (size_t)row * 2048 + 1536 + lane * 8), og);
        float ss = 0.f;
#pragma unroll
        for (int e = 0; e < 8; ++e) { a[e] += bq[e]; ss += a[e] * a[e]; }
        ss += __shfl_xor(ss, 1); ss += __shfl_xor(ss, 2); ss += __shfl_xor(ss, 4); ss += __shfl_xor(ss, 8);
        const float rstd = rsqrtf(ss * (1.f / 128.f) + EPS);
#pragma unroll
        for (int e = 0; e < 8; ++e) y[e] = a[e] * rstd * g[e] / (1.f + __expf(-og[e]));
        *(u32x4*)(MIX + (size_t)row * 1024 + lane * 8) = pack8(y);
    }
}

template <int L>
__device__ __forceinline__ void hyena_item(const Params& p, int li, int c) {
    constexpr int ZS = L + 8, NI = L / 128, NS = L / 32;
    const int tid = tid_l(), w = tid >> 6, lane = tid & 63, fr = lane & 15, fq = lane >> 4;
    bf16_t* ZA = (bf16_t*)dyn_lds; bf16_t* ZB = ZA + 16 * ZS; bf16_t* HFl = ZB + 16 * ZS;
    const bf16_t* zpad = HFl + 2 * L;
    if (tid < 8) HFl[2 * L + tid] = 0;
    const int segbase = (L == 2048) ? 0 : NLAT;
    const bf16_t* HYT = (const bf16_t*)(p.ws + WS_P2);
    bf16_t* MIX = (bf16_t*)(p.ws + WS_ACT);
    const float* cw = p.in[11] + (size_t)li * 3 * 1536; const float* cb = p.in[12] + (size_t)li * 1536; const float* hd = p.in[19] + (size_t)li * 2 * 512;
    const bf16_t* FIL = (L == 2048) ? (const bf16_t*)(p.ws + WS_FLAT) : (const bf16_t*)(p.ws + WS_FCTX);
    {
        const float w0 = cw[c], w1 = cw[1536 + c], w2 = cw[2 * 1536 + c], bb = cb[c];
        const bf16_t* src = HYT + (size_t)c * MTOT + segbase;
        for (int ch = tid; ch < 16 * L / 8; ch += NT) {
            const int b = ch / (L / 8), t0 = (ch % (L / 8)) * 8;
            const bf16_t* s = src + b * L + t0;
            float x[10], y[8];
            x[0] = t0 > 0 ? b2f(s[-1]) : 0.f;
            unpack8(*(const u32x4*)s, x + 1);
            x[9] = (t0 + 8 < L) ? b2f(s[8]) : 0.f;
#pragma unroll
            for (int e = 0; e < 8; ++e) y[e] = bb + w0 * x[e] + w1 * x[e + 1] + w2 * x[e + 2];
            *(u32x4*)(ZA + b * ZS + t0) = pack8(y);
        }
    }
#pragma unroll 1
    for (int o = 0; o < 2; ++o) {
        for (int i = tid; i < 2 * L / 8; i += NT) *(u32x4*)(HFl + i * 8) = *(const u32x4*)(FIL + ((size_t)o * 512 + c) * 2 * L + i * 8);
        __syncthreads();
        const bf16_t* Zin = o ? ZB : ZA;
        const int gc = (o + 1) * 512 + c;
        const float gw0 = cw[gc], gw1 = cw[1536 + gc], gw2 = cw[2 * 1536 + gc], gb = cb[gc], dsk = hd[o * 512 + c];
        const bf16_t* gs = HYT + (size_t)gc * MTOT + segbase + fr * L;
        constexpr int NIB = NI < 8 ? NI : 8;
#pragma unroll 1
        for (int hp = 0; hp < NI; hp += NIB) {
            f32x4 acc[NIB];
#pragma unroll
            for (int i = 0; i < NIB; ++i) acc[i] = (f32x4){0.f, 0.f, 0.f, 0.f};
#pragma unroll 2
            for (int e = 4 * hp - (NS - 1); e <= 4 * (hp + NIB - 1); ++e) {
                const int base = L + 16 * w + 32 * e + fr - fq * 8;
                bf16x8 Af;
#pragma unroll
                for (int j = 0; j < 8; ++j) Af[j] = (short)HFl[base - j];
                const bf16_t* zb = Zin + fr * ZS + (4 * hp - e) * 32 + fq * 8;
#pragma unroll
                for (int i = 0; i < NIB; ++i) {
                    const int sj = 4 * (hp + i) - e;
                    const bf16_t* bp = (sj >= 0 && sj < NS) ? (zb + i * 128) : zpad;
                    acc[i] = mfma16(Af, *(const bf16x8*)bp, acc[i]);
                }
            }
#pragma unroll
            for (int i = 0; i < NIB; ++i) {
                const int t0 = 16 * (w + 8 * (hp + i)) + fq * 4;
                float x[6];
                x[0] = t0 > 0 ? b2f(gs[t0 - 1]) : 0.f;
                const u32x2 gv = *(const u32x2*)(gs + t0);
                x[1] = blo(gv.x); x[2] = bhi(gv.x); x[3] = blo(gv.y); x[4] = bhi(gv.y);
                x[5] = (t0 + 4 < L) ? b2f(gs[t0 + 4]) : 0.f;
                const u32x2 zv = *(const u32x2*)(Zin + fr * ZS + t0);
                const float z[4] = {blo(zv.x), bhi(zv.x), blo(zv.y), bhi(zv.y)};
                float val[4];
#pragma unroll
                for (int j = 0; j < 4; ++j) val[j] = (gb + gw0 * x[j] + gw1 * x[j + 1] + gw2 * x[j + 2]) * (acc[i][j] + dsk * z[j]);
                { u32x2 ov; ov.x = pk2(val[0], val[1]); ov.y = pk2(val[2], val[3]); *(u32x2*)((o == 0 ? ZB : ZA) + fr * ZS + t0) = ov; }
            }
        }
        __syncthreads();
    }
    {
        bf16_t* dstp = (bf16_t*)(p.ws + WS_P2) + (size_t)c * MTOT + segbase;
        for (int ch = tid; ch < 16 * L / 8; ch += NT) {
            const int b = ch / (L / 8), t0 = (ch % (L / 8)) * 8;
            *(u32x4*)(dstp + b * L + t0) = *(const u32x4*)(ZA + b * ZS + t0);
        }
        __syncthreads();
    }
}

__device__ __forceinline__ void hy_transpose(const Params& p) {
    const int tid = tid_l();
    bf16_t* T = (bf16_t*)dyn_lds;
    const bf16_t* HYO = (const bf16_t*)(p.ws + WS_P2);
    bf16_t* MIX = (bf16_t*)(p.ws + WS_ACT);
    for (int it = blockIdx.x; it < (MTOT / 64) * 8; it += gridDim.x) {
        const int tt = it >> 3, cg_ = it & 7, tok0 = tt * 64, c0 = cg_ * 64;
        {
            const int ch = tid >> 3, t8 = (tid & 7) * 8;
            const u32x4 v = *(const u32x4*)(HYO + (size_t)(c0 + ch) * MTOT + tok0 + t8);
            const unsigned wv[4] = {v.x, v.y, v.z, v.w};
#pragma unroll
            for (int e = 0; e < 4; ++e) { T[(t8 + 2 * e) * 72 + ch] = (bf16_t)(wv[e] & 0xffffu); T[(t8 + 2 * e + 1) * 72 + ch] = (bf16_t)(wv[e] >> 16); }
        }
        __syncthreads();
        {
            const int tk = tid >> 3, c8 = (tid & 7) * 8;
            *(u32x4*)(MIX + (size_t)(tok0 + tk) * 1024 + 512 + c0 + c8) = *(const u32x4*)(T + tk * 72 + c8);
        }
        __syncthreads();
    }
}

__device__ __forceinline__ void qknorm_phase(const Params& p, int li) {
    const int tid = tid_l(), lane = tid & 63, gw = blockIdx.x * 8 + (tid >> 6), ngw = gridDim.x * 8;
    bf16_t* QK = (bf16_t*)(p.ws + WS_BIG);
    float gq[8], gk[8];
#pragma unroll
    for (int e = 0; e < 8; ++e) { gq[e] = p.in[22][li * 64 + (lane & 7) * 8 + e] * 0.125f; gk[e] = p.in[23][li * 64 + (lane & 7) * 8 + e]; }
    for (int row = gw; row < MTOT; row += ngw) {
        bf16_t* rp = QK + (size_t)row * 2048 + lane * 8;
        u32x4 v[4];
#pragma unroll
        for (int j = 0; j < 4; ++j) v[j] = *(const u32x4*)(rp + j * 512);
#pragma unroll
        for (int j = 0; j < 4; ++j) {
            float f[8]; unpack8(v[j], f);
            float ss = 0.f;
#pragma unroll
            for (int e = 0; e < 8; ++e) ss += f[e] * f[e];
            ss += __shfl_xor(ss, 1); ss += __shfl_xor(ss, 2); ss += __shfl_xor(ss, 4);
            const float rstd = rsqrtf(ss * (1.f / 64.f) + EPS);
#pragma unroll
            for (int e = 0; e < 8; ++e) f[e] *= rstd * (j < 2 ? gq[e] : gk[e]);
            *(u32x4*)(rp + j * 512) = pack8(f);
        }
    }
}

template <bool LAT>
__device__ __forceinline__ void attn_item(const Params& p, int li, int b, int h, int sub) {
    const int tid = tid_l(), w = tid >> 6, lane = tid & 63, fr = lane & 15, fq = lane >> 4;
    bf16_t* Pw = (bf16_t*)dyn_lds + w * (16 * 520);
    float* rpbs = (float*)(dyn_lds + 8 * 16 * 520 * 2);
    const bf16_t* QK = (const bf16_t*)(p.ws + WS_BIG);
    const bf16_t* VTg = (const bf16_t*)(p.ws + WS_P2);
    bf16_t* MIX = (bf16_t*)(p.ws + WS_ACT);
    if (LAT) { const float* rp = p.in[24] + ((size_t)li * 16 + h) * 465; for (int i = tid; i < 465; i += NT) rpbs[i] = rp[i]; }
    __syncthreads();
    int r = 0, c0 = 0, rs = 0, cw0 = 0, qtok0;
    if (LAT) { r = sub * 2 + (w >> 2); const int qt = w & 3; c0 = qt * 16; qtok0 = b * 2048 + r * 64 + c0; rs = min(max(r - 4, 0), 24); cw0 = (qt == 0) ? 0 : (qt == 1) ? 8 : (qt == 2) ? 24 : 32; }
    else { qtok0 = NLAT + b * 256 + (sub * 8 + w) * 16; }
    bf16x8 qf[2];
    {
        const bf16_t* qp = QK + (size_t)(qtok0 + fr) * 2048 + h * 64 + fq * 8;
        qf[0] = *(const bf16x8*)qp; qf[1] = *(const bf16x8*)(qp + 32);
    }
    f32x4 sreg[32];
#define KTILE(KT_, KTOK0_) do { \
        const bf16_t* kp = QK + (size_t)((KTOK0_) + fr) * 2048 + 1024 + h * 64 + fq * 8; \
        f32x4 sa = (f32x4){0.f, 0.f, 0.f, 0.f}; \
        sa = mfma16(*(const bf16x8*)kp, qf[0], sa); sa = mfma16(*(const bf16x8*)(kp + 32), qf[1], sa); \
        sreg[KT_] = sa; } while (0)
    if (LAT) {
        const int qc = c0 + fr; const int cstart = min(max(qc - 8, 0), 48);
#pragma unroll
        for (int kt = 0; kt < 16; ++kt) {
            const int kr = kt >> 1, kcb = cw0 + (kt & 1) * 16;
            KTILE(kt, b * 2048 + (rs + kr) * 64 + kcb);
            const int dri = (rs + kr - r + 7) * 31;
#pragma unroll
            for (int j = 0; j < 4; ++j) {
                const int kc = kcb + fq * 4 + j;
                const bool valid = (kc >= cstart) && (kc < cstart + 16);
                const int dci = min(max(kc - qc + 15, 0), 30);
                sreg[kt][j] = valid ? sreg[kt][j] + rpbs[dri + dci] : -1e30f;
            }
            if ((kt & 7) == 7) __builtin_amdgcn_sched_barrier(0);
        }
    }
    constexpr int KT0 = LAT ? 0 : 16;
#pragma unroll
    for (int kt = 16; kt < 32; ++kt) { KTILE(kt, NLAT + b * 256 + (kt - 16) * 16); if ((kt & 7) == 7) __builtin_amdgcn_sched_barrier(0); }
    float mx = -1e30f;
#pragma unroll
    for (int kt = KT0; kt < 32; ++kt)
#pragma unroll
        for (int j = 0; j < 4; ++j) mx = fmaxf(mx, sreg[kt][j]);
    mx = fmaxf(mx, __shfl_xor(mx, 16)); mx = fmaxf(mx, __shfl_xor(mx, 32));
    float lsum = 0.f;
#pragma unroll
    for (int kt = KT0; kt < 32; ++kt) {
        float pj[4];
#pragma unroll
        for (int j = 0; j < 4; ++j) { pj[j] = __expf(sreg[kt][j] - mx); lsum += pj[j]; }
        u32x2 o; o.x = pk2(pj[0], pj[1]); o.y = pk2(pj[2], pj[3]);
        *(u32x2*)(Pw + fr * 520 + kt * 16 + fq * 4) = o;
    }
    lsum += __shfl_xor(lsum, 16); lsum += __shfl_xor(lsum, 32);
    __syncthreads();
    f32x4 oacc[4];
#pragma unroll
    for (int dt = 0; dt < 4; ++dt) oacc[dt] = (f32x4){0.f, 0.f, 0.f, 0.f};
#pragma unroll
    for (int kb = (LAT ? 0 : 8); kb < 16; kb += 4) {
        bf16x8 vf[4][4], pf[4];
#pragma unroll
        for (int u = 0; u < 4; ++u) {
            const int ks = kb + u;
            const int vtok0 = ks < 8 ? b * 2048 + (rs + ks) * 64 + cw0 : NLAT + b * 256 + (ks - 8) * 32;
#pragma unroll
            for (int dt = 0; dt < 4; ++dt) vf[u][dt] = *(const bf16x8*)(VTg + (size_t)(h * 64 + dt * 16 + fr) * MTOT + vtok0 + fq * 8);
            pf[u] = *(const bf16x8*)(Pw + fr * 520 + ks * 32 + fq * 8);
        }
#pragma unroll
        for (int u = 0; u < 4; ++u)
#pragma unroll
            for (int dt = 0; dt < 4; ++dt) oacc[dt] = mfma16(vf[u][dt], pf[u], oacc[dt]);
        __builtin_amdgcn_sched_barrier(0);
    }
    const float inv = 1.f / lsum;
#pragma unroll
    for (int dt = 0; dt < 4; ++dt) {
        u32x2 o; o.x = pk2(oacc[dt][0] * inv, oacc[dt][1] * inv); o.y = pk2(oacc[dt][2] * inv, oacc[dt][3] * inv);
        *(u32x2*)(MIX + (size_t)(qtok0 + fr) * 1024 + h * 64 + dt * 16 + fq * 4) = o;
    }
    __syncthreads();
#undef KTILE
}


#ifdef DBG_NAN
__device__ __forceinline__ bool bad16(bf16_t v) { return ((v >> 7) & 0xFF) >= 227; }
__device__ __forceinline__ bool bad32(float f) { return !(fabsf(f) < 1e30f); }
__device__ __forceinline__ void scan16(const bf16_t* p, size_t n, unsigned* flags, unsigned bit) {
    bool bad = false;
    for (size_t i = (size_t)blockIdx.x * NT + threadIdx.x; i < n; i += (size_t)gridDim.x * NT) bad |= bad16(p[i]);
    if (bad) atomicOr(flags, bit);
}
__device__ __forceinline__ void scan32(const float* p, size_t n, unsigned* flags, unsigned bit) {
    bool bad = false;
    for (size_t i = (size_t)blockIdx.x * NT + threadIdx.x; i < n; i += (size_t)gridDim.x * NT) bad |= bad32(p[i]);
    if (bad) atomicOr(flags, bit);
}
#endif
#define GSYNC() do { asm volatile("s_waitcnt vmcnt(0) lgkmcnt(0)" ::: "memory"); grid.sync(); } while (0)
__global__ void __launch_bounds__(NT) fwd_megakernel(Params p) {
    cg::grid_group grid = cg::this_grid();
    const int blk = blockIdx.x, G = gridDim.x;
    bf16_t* WIN = (bf16_t*)(p.ws + WS_WIN); bf16_t* WOUT = (bf16_t*)(p.ws + WS_WOUT); bf16_t* WM1 = (bf16_t*)(p.ws + WS_WM1); bf16_t* WM2 = (bf16_t*)(p.ws + WS_WM2);
    bf16_t* ACT = (bf16_t*)(p.ws + WS_ACT); bf16_t* BIG = (bf16_t*)(p.ws + WS_BIG);
    float* XC = (float*)(p.ws + WS_XC);
    const float* MOD = (const float*)(p.ws + WS_MOD);
    REP(64) if (PHMASK & 1) phase0(p);
#ifdef DBG_NAN
    unsigned* dflags = (unsigned*)(p.ws + WS_END);
    if (blk == 0 && threadIdx.x < 64) dflags[threadIdx.x] = 0u;
#endif
    GSYNC();
#pragma unroll 1
    for (int l = 0; l < 4; ++l) {
        const bool even = !(l & 1), last = (l == 3); const int li = l >> 1;
        const float* xlat = (l == 0) ? p.in[0] : p.out; const float* xctx = (l == 0) ? p.in[2] : XC;
        const int Mtail = last ? NLAT : MTOT;
        REP(1) {
        if (PHMASK & 2) convert_weights(p, l);
        if (PHMASK & 4) norm_phase(p, l, xlat, xctx, 0, 1024, MTOT);
        if ((PHMASK & 8) && even) filter_gen(p, li);
        }
        GSYNC();
        {
            EpiArgs ea{}; ea.o_rm = BIG; ea.ld_rm = 2048; ea.o_cm = (bf16_t*)(p.ws + WS_P2); ea.gates = (float*)(p.ws + WS_GATES); ea.gate_pn = even ? 14 : -1; ea.o_dbg = (bf16_t*)(p.ws + WS_HFB);
            REP(2) if (PHMASK & 16) gemm_phase<EPI_INPROJ>(ACT, WIN, MTOT, even ? 3840 : 3072, 1024, ea);
        }
        GSYNC();
#ifdef DBG_NAN
        if (l == DBG_LAYER) {
            {
                const unsigned gid = blk * NT + threadIdx.x;
                unsigned hsh = gid * 2654435761u + 12345u; hsh ^= hsh >> 13; hsh *= 2246822519u; hsh ^= hsh >> 16;
                const int row = hsh % MTOT; const int col = (hsh >> 8) % 2048; const int ch = (hsh >> 4) % 1536;
                const bf16_t* ar = ACT + (size_t)row * 1024; const bf16_t* wq = WIN + (size_t)col * 1024; const bf16_t* wh = WIN + (size_t)(2048 + ch) * 1024;
                float sq = 0.f, sh_ = 0.f;
                for (int k = 0; k < 1024; ++k) { const float av = b2f(ar[k]); sq += av * b2f(wq[k]); sh_ += av * b2f(wh[k]); }
                const float gq = b2f(BIG[(size_t)row * 2048 + col]);
                const float gh = b2f(((const bf16_t*)(p.ws + WS_P2))[(size_t)ch * MTOT + row]);
                (void)gq; (void)sq;

                { const int cls = DBG_CLS; atomicAdd(dflags + 16 + cls, 1u);
                  if (!(fabsf(gh - sh_) <= 0.05f + 0.02f * fabsf(sh_))) { atomicAdd(dflags + 2, 1u); atomicAdd(dflags + 32 + cls, 1u); } }
            }
            GSYNC();
            if (blk == 0 && threadIdx.x == 0) {
                const float fQ = (float)__hip_atomic_load(dflags + 1, __ATOMIC_RELAXED, __HIP_MEMORY_SCOPE_AGENT) / (float)(G * NT);
                const float fH = (float)__hip_atomic_load(dflags + 2, __ATOMIC_RELAXED, __HIP_MEMORY_SCOPE_AGENT) / (float)(G * NT);
                unsigned mask = 0;
                for (int q_ = 0; q_ < 8; ++q_) { const unsigned tot = __hip_atomic_load(dflags + 16 + q_, __ATOMIC_RELAXED, __HIP_MEMORY_SCOPE_AGENT), bad = __hip_atomic_load(dflags + 32 + q_, __ATOMIC_RELAXED, __HIP_MEMORY_SCOPE_AGENT); if (bad * 4 > tot) mask |= 1u << q_; }
                float code = 1e5f; for (unsigned q_ = 0; q_ < (mask >> 4); ++q_) code *= 10.f;
                const unsigned n3 = __hip_atomic_load(dflags + 3, __ATOMIC_RELAXED, __HIP_MEMORY_SCOPE_AGENT), b1 = __hip_atomic_load(dflags + 1, __ATOMIC_RELAXED, __HIP_MEMORY_SCOPE_AGENT), b4 = __hip_atomic_load(dflags + 4, __ATOMIC_RELAXED, __HIP_MEMORY_SCOPE_AGENT);
                p.out[0] = code * (1.f + 0.5f * (float)(mask & 15)) + 0.f * (fQ + fH + (float)(n3 + b1 + b4));
            }
            return;
        }
#endif
        if (!even) { qknorm_phase(p, li); GSYNC(); }
        if (even) {
            REP(4) if (G >= 256) {
                if (blk < 128) { REP(512) if (PHMASK & 32) mlstm_item(p, li, blk);
                    if (PHMASK & 64) { hyena_item<2048>(p, li, 384 + blk); hyena_item<256>(p, li, 384 + blk); } }
                else { const int hb = blk - 128;
                    if (PHMASK & 64) for (int it = hb; it < 384; it += 128) { hyena_item<2048>(p, li, it); hyena_item<256>(p, li, it); } }
            } else {
            }
            GSYNC();
            if (PHMASK & 128) { combine_phase(p, li); hy_transpose(p); }
        } else {
            const int x = blk & 7, y = blk >> 3, ny = (G + 7) >> 3;
            REP(256) for (int i = 0; ; ++i) {
                const int slot = i * ny + y;
                if (slot >= 512) break;
                const int bh = x * 32 + (slot >> 4), rp = slot & 15;
                if (PHMASK & 256) attn_item<true>(p, li, bh >> 4, bh & 15, rp);
            }
            if ((PHMASK & 512) && !last) for (int it = blk; it < 512; it += G) attn_item<false>(p, li, it >> 5, (it >> 1) & 15, it & 1);
        }
        GSYNC();
        {
            EpiArgs ea{}; ea.res_lat = xlat; ea.res_ctx = xctx; ea.out_lat = p.out; ea.out_ctx = XC; ea.modg = MOD + (size_t)l * 17 * 6144 + 2048;
            if (DUPMASK & 32) gemm_phase<EPI_DRY>(ACT, WOUT, Mtail, 1024, 1024, ea);
            if (PHMASK & 1024) gemm_phase<EPI_RESID>(ACT, WOUT, Mtail, 1024, 1024, ea);
        }
        GSYNC();
        REP(8) norm_phase(p, l, p.out, XC, 3072, 4096, Mtail);
        GSYNC();
        { EpiArgs ea{}; ea.o_rm = BIG; ea.ld_rm = 4096; ea.gate_pn = -1; REP(16) if (PHMASK & 2048) gemm_phase<EPI_RELU2>(ACT, WM1, Mtail, 4096, 1024, ea); }
        GSYNC();
        {
            EpiArgs ea{}; ea.res_lat = p.out; ea.res_ctx = XC; ea.out_lat = p.out; ea.out_ctx = XC; ea.modg = MOD + (size_t)l * 17 * 6144 + 5120;
            if (DUPMASK & 32) gemm_phase<EPI_DRY>(BIG, WM2, Mtail, 1024, 4096, ea);
            if (PHMASK & 4096) gemm_phase<EPI_RESID>(BIG, WM2, Mtail, 1024, 4096, ea);
        }
        GSYNC();
    }
}

extern "C" void kernel_launch(void* const* d_in, const int* in_sizes, int n_in, void* d_out, int out_size, void* d_ws, size_t ws_size, hipStream_t stream) {
    static int grid_blocks = 0;
    if (grid_blocks == 0) {
        if (n_in != 26 || ws_size < WS_END + 256) { fprintf(stderr, "kernel_launch: unexpected n_in %d or ws_size %zu (< %zu)\n", n_in, ws_size, (size_t)WS_END); grid_blocks = -1; return; }
        int dev = 0, cus = 0, per_cu = 0;
        hipGetDevice(&dev);
        hipDeviceGetAttribute(&cus, hipDeviceAttributeMultiprocessorCount, dev);
        if (hipFuncSetAttribute((const void*)fwd_megakernel, hipFuncAttributeMaxDynamicSharedMemorySize, LDS_BYTES) != hipSuccess) fprintf(stderr, "kernel_launch: hipFuncSetAttribute failed\n");
        if (hipOccupancyMaxActiveBlocksPerMultiprocessor(&per_cu, (const void*)fwd_megakernel, NT, LDS_BYTES) != hipSuccess || per_cu < 1) { fprintf(stderr, "kernel_launch: occupancy query gave %d\n", per_cu); per_cu = 1; }
        (void)hipGetLastError();
        grid_blocks = cus * 1;
        fprintf(stderr, "kernel_launch: cus %d per_cu %d grid %d\n", cus, per_cu, grid_blocks);
    }
    if (grid_blocks < 0) return;
    Params p{};
    for (int i = 0; i < 26; ++i) p.in[i] = (const float*)d_in[i];
    p.out = (float*)d_out; p.ws = (unsigned char*)d_ws;
    void* args[] = {&p};
    hipError_t e = hipLaunchCooperativeKernel((void*)fwd_megakernel, dim3(grid_blocks), dim3(NT), args, LDS_BYTES, stream);
    if (e != hipSuccess) fprintf(stderr, "cooperative launch failed: %s (grid %d)\n", hipGetErrorString(e), grid_blocks);
}
```

```cpp
#include <hip/hip_runtime.h>
#include <hip/hip_cooperative_groups.h>
#include <cstdio>
#include <cstdint>
namespace cg = cooperative_groups;

typedef unsigned short bf16_t;
typedef short bf16x8 __attribute__((ext_vector_type(8)));
typedef float f32x4 __attribute__((ext_vector_type(4)));
typedef unsigned u32x4 __attribute__((ext_vector_type(4)));
typedef unsigned u32x2 __attribute__((ext_vector_type(2)));

#define NT 512
#define DBG_LAYER 0
#define DBG_CLS ((((row % 64) / 16) * 2) + ((ch % 32) / 16))
#ifndef PHMASK
#define PHMASK 0xFFFF
#endif
#ifndef DUPMASK
#define DUPMASK 0
#endif
#define REP(bit) for (int rep_ = 0; rep_ < (((DUPMASK) & (bit)) ? 2 : 1); ++rep_)
constexpr int BATCH = 16, SEQ = 2048, DM = 1024, CTXL = 256;
constexpr int NLAT = BATCH * SEQ, NCTX = BATCH * CTXL, MTOT = NLAT + NCTX;
constexpr int DFF = 4096;
constexpr float EPS = 1e-6f;
constexpr int LDS_BYTES = 147456;

constexpr size_t al256(size_t x) { return (x + 255) & ~(size_t)255; }
constexpr size_t WS_WIN = 0;
constexpr size_t WS_WOUT = al256(WS_WIN + (size_t)3840 * 1024 * 2);
constexpr size_t WS_WM1 = al256(WS_WOUT + (size_t)1024 * 1024 * 2);
constexpr size_t WS_WM2 = al256(WS_WM1 + (size_t)4096 * 1024 * 2);
constexpr size_t WS_MOD = al256(WS_WM2 + (size_t)4096 * 1024 * 2);
constexpr size_t WS_XC = al256(WS_MOD + (size_t)4 * 17 * 6144 * 4);
constexpr size_t WS_ACT = al256(WS_XC + (size_t)NCTX * 1024 * 4);
constexpr size_t WS_BIG = al256(WS_ACT + (size_t)MTOT * 1024 * 2);
constexpr size_t WS_P2 = WS_BIG + (size_t)MTOT * 2048 * 2;
constexpr int QK_LD = 2048 + 64;
constexpr int VT_LD = MTOT + 64;
constexpr size_t WS_P2ODD = WS_BIG + (size_t)MTOT * QK_LD * 2;
constexpr size_t WS_GATES = WS_P2 + (size_t)1536 * MTOT * 2;
constexpr size_t WS_HFB = al256(WS_BIG + (size_t)MTOT * 4096 * 2);
constexpr size_t WS_FLAT = al256(WS_HFB + (size_t)2 * MTOT * 512 * 2);
constexpr size_t WS_FCTX = al256(WS_FLAT + (size_t)2 * 512 * 4096 * 2);
constexpr size_t WS_H2 = al256(WS_FCTX + (size_t)2 * 512 * 512 * 2);
constexpr size_t WS_ROPE = al256(WS_H2 + (size_t)2 * 2304 * 64 * 4);
constexpr size_t WS_END = al256(WS_ROPE + (size_t)2 * 64 * 32 * 4);
static_assert(WS_GATES + (size_t)MTOT * 16 * 4 <= WS_HFB, "projection overlay too large");
static_assert(WS_P2ODD + (size_t)1024 * VT_LD * 2 <= WS_HFB, "odd projection overlay too large");

struct Params { const float* in[26]; float* out; unsigned char* ws; };

typedef float f32x2_ __attribute__((ext_vector_type(2)));
typedef __bf16 bf16x2_ __attribute__((ext_vector_type(2)));
__device__ __forceinline__ unsigned pk2(float lo, float hi) { f32x2_ v = {lo, hi}; bf16x2_ b = __builtin_convertvector(v, bf16x2_); return __builtin_bit_cast(unsigned, b); }
__device__ __forceinline__ bf16_t f2b(float x) { return (bf16_t)(pk2(x, 0.f) & 0xffffu); }
__device__ __forceinline__ float b2f(bf16_t b) { return __uint_as_float(((unsigned)b) << 16); }
__device__ __forceinline__ float blo(unsigned w) { return __uint_as_float(w << 16); }
__device__ __forceinline__ float bhi(unsigned w) { return __uint_as_float(w & 0xffff0000u); }
__device__ __forceinline__ void unpack8(u32x4 v, float* f) {
    f[0] = blo(v.x); f[1] = bhi(v.x); f[2] = blo(v.y); f[3] = bhi(v.y); f[4] = blo(v.z); f[5] = bhi(v.z); f[6] = blo(v.w); f[7] = bhi(v.w);
}
__device__ __forceinline__ u32x4 pack8(const float* f) { u32x4 r; r.x = pk2(f[0], f[1]); r.y = pk2(f[2], f[3]); r.z = pk2(f[4], f[5]); r.w = pk2(f[6], f[7]); return r; }
__device__ __forceinline__ float fsin_(float x) { float r = x * 0.15915494309189535f; r -= floorf(r); return __builtin_amdgcn_sinf(r); }
__device__ __forceinline__ float fcos_(float x) { float r = x * 0.15915494309189535f; r -= floorf(r); return __builtin_amdgcn_cosf(r); }
__device__ __forceinline__ float wave_sum(float v) {
#pragma unroll
    for (int o = 1; o < 64; o <<= 1) v += __shfl_xor(v, o);
    return v;
}
__device__ __forceinline__ f32x4 mfma16(bf16x8 a, bf16x8 b, f32x4 c) { return __builtin_amdgcn_mfma_f32_16x16x32_bf16(a, b, c, 0, 0, 0); }
__device__ __forceinline__ bf16x8 as_bf8(u32x4 v) { return __builtin_bit_cast(bf16x8, v); }

extern __shared__ __attribute__((aligned(16))) unsigned char dyn_lds[];
__device__ __forceinline__ int tid_l() { int t = threadIdx.x; asm volatile("" : "+v"(t)); return t; }

constexpr int G_BM = 256, G_BK = 64, G_HALF = 128, G_HT = G_HALF * G_BK;
__device__ __forceinline__ int lds_byte(int r, int c) {
    int st = (r >> 4) * 2 + (c >> 5), rr = r & 15, cc = c & 31, ob = rr * 64 + cc * 2;
    return st * 1024 + (ob ^ (((ob >> 9) & 1) << 5));
}
__device__ __forceinline__ void stage_rc(int b, int& R, int& C) {
    int st = b / 1024, sb = b % 1024, swz = sb ^ (((sb >> 9) & 1) << 5);
    R = (st >> 1) * 16 + swz / 64; C = (st & 1) * 32 + (swz % 64) / 2;
}

enum { EPI_INPROJ = 0, EPI_RESID = 1, EPI_RELU2 = 2, EPI_DRY = 3 };
struct EpiArgs {
    bf16_t* o_rm; int ld_rm;
    bf16_t* o_dbg;
    int ld_cm;
    bf16_t* o_cm;
    float* gates; int gate_pn;
    const float* res_lat; const float* res_ctx; float* out_lat; float* out_ctx; const float* modg;
};

#define WAIT_V_(n) asm volatile("s_waitcnt vmcnt(" #n ")" ::: "memory")
#define WAIT_V(n) WAIT_V_(n)
#ifndef GEMM_SGB
#define GEMM_SGB 0
#endif
#ifndef GEMM_VM
#define GEMM_VM 8
#endif
#define WAIT_L(n) asm volatile("s_waitcnt lgkmcnt(" #n ")" ::: "memory")
#define BAR __builtin_amdgcn_s_barrier()
#define CFENCE asm volatile("" ::: "memory")

template <bool TR, int NAI>
__device__ __forceinline__ void gemm_kloop(const bf16_t* __restrict__ A, const bf16_t* __restrict__ Bt, int K, int brow, int bcol, f32x4 (&acc)[NAI][2][4][2], int kt0, int nt) {
    bf16_t* shm = (bf16_t*)dyn_lds;
#define SA(b, h) (shm + ((b) * 2 + (h)) * G_HT)
#define SB(b, h) (shm + (4 + (b) * 2 + (h)) * G_HT)
    const int tidx = tid_l();
    const int wid = tidx >> 6, lane = tidx & 63, wr = wid >> 2, wc = wid & 3, fr = lane & 15, fq = lane >> 4;
    int goff[2];
#pragma unroll
    for (int i = 0; i < 2; ++i) { int r_, c_; stage_rc(tidx * 16 + i * 8192, r_, c_); goff[i] = r_ * K + c_; }
    const bf16_t* Ab = A + (long)brow * K + kt0 * G_BK; const bf16_t* Bb = Bt + (long)bcol * K + kt0 * G_BK;
#define STAGE2(P, BASEP, kt) do { _Pragma("unroll") for (int _i = 0; _i < 2; ++_i) \
      __builtin_amdgcn_global_load_lds((const unsigned*)((BASEP) + (kt) * G_BK + goff[_i]), (unsigned*)((char*)(P) + tidx * 16 + _i * 8192), 16, 0, 0); } while (0)
    STAGE2(SA(0, 0), Ab, 0); if (NAI == 2) STAGE2(SA(0, 1), Ab + (long)G_HALF * K, 0); STAGE2(SB(0, 0), Bb, 0); STAGE2(SB(0, 1), Bb + (long)G_HALF * K, 0);
    for (int kt = 0; kt < nt; ++kt) {
        const int cur = kt & 1, nxt = cur ^ 1;
        WAIT_V(0); WAIT_L(0);
        BAR; CFENCE;
#define LDBF(dst, k) _Pragma("unroll") for (int bj = 0; bj < 2; ++bj) _Pragma("unroll") for (int n = 0; n < 2; ++n) \
            dst[bj][n] = *reinterpret_cast<const bf16x8*>((char*)SB(cur, bj) + lds_byte(wc * 32 + n * 16 + fr, (k) * 32 + fq * 8))
#define LDAF(dst, ai, k) _Pragma("unroll") for (int m = 0; m < 4; ++m) \
            dst[m] = *reinterpret_cast<const bf16x8*>((char*)SA(cur, ai) + lds_byte(wr * 64 + m * 16 + fr, (k) * 32 + fq * 8))
#define MMAG(ai, Af_, Bf_) _Pragma("unroll") for (int m = 0; m < 4; ++m) _Pragma("unroll") for (int bj = 0; bj < 2; ++bj) _Pragma("unroll") for (int n = 0; n < 2; ++n) \
            acc[ai][bj][m][n] = TR ? mfma16(Bf_[bj][n], Af_[m], acc[ai][bj][m][n]) : mfma16(Af_[m], Bf_[bj][n], acc[ai][bj][m][n])
        bf16x8 B0[2][2], B1[2][2], A0[4], A1[4];
        LDBF(B0, 0); LDAF(A0, 0, 0); if (NAI == 2) { LDAF(A1, 1, 0); }
        if (kt + 1 < nt) {
            STAGE2(SA(nxt, 0), Ab, kt + 1); if (NAI == 2) STAGE2(SA(nxt, 1), Ab + (long)G_HALF * K, kt + 1);
            STAGE2(SB(nxt, 0), Bb, kt + 1); STAGE2(SB(nxt, 1), Bb + (long)G_HALF * K, kt + 1);
        }
        MMAG(0, A0, B0);
        LDBF(B1, 1); LDAF(A0, 0, 1);
        if (NAI == 2) { MMAG(NAI - 1, A1, B0); LDAF(A1, 1, 1); }
        MMAG(0, A0, B1);
        if (NAI == 2) { MMAG(NAI - 1, A1, B1); }
#if GEMM_SGB
        __builtin_amdgcn_sched_group_barrier(0x100, 12, 0);
        __builtin_amdgcn_sched_group_barrier(0x020, 8, 0);
        __builtin_amdgcn_sched_group_barrier(0x008, 16, 0);
        __builtin_amdgcn_sched_group_barrier(0x100, 8, 0);
        __builtin_amdgcn_sched_group_barrier(0x008, 16, 0);
        __builtin_amdgcn_sched_group_barrier(0x100, 4, 0);
        __builtin_amdgcn_sched_group_barrier(0x008, 32, 0);
#endif
    }
    WAIT_L(0); BAR; CFENCE;
}

template <int EPI, int NAI>
__device__ __forceinline__ void gemm_tile(const bf16_t* A, const bf16_t* Bt, int K, int brow, int bcol, int pn, const EpiArgs& ea, int wr, int wc, int fr, int fq) {
        constexpr bool SPLITTAIL = false; const int kq = -1, kt0 = 0, ntl = K / G_BK; (void)kq;
        f32x4 acc[NAI][2][4][2];
#pragma unroll
        for (int a = 0; a < NAI; ++a)
#pragma unroll
            for (int b = 0; b < 2; ++b)
#pragma unroll
                for (int m = 0; m < 4; ++m)
#pragma unroll
                    for (int n = 0; n < 2; ++n) acc[a][b][m][n] = (f32x4){0.f, 0.f, 0.f, 0.f};
        const bool colmajor = (EPI == EPI_INPROJ) && pn >= 8 && pn != ea.gate_pn;
        if (colmajor) {
            gemm_kloop<true, NAI>(A, Bt, K, brow, bcol, acc, kt0, ntl);
#pragma unroll
            for (int ai = 0; ai < NAI; ++ai)
#pragma unroll
                for (int bj = 0; bj < 2; ++bj)
#pragma unroll
                    for (int m = 0; m < 4; ++m)
#pragma unroll
                        for (int n = 0; n < 2; ++n) {
                            const int row = brow + ai * 128 + wr * 64 + m * 16 + fr, col = bcol + bj * 128 + wc * 32 + n * 16 + fq * 4;
                            const f32x4 v = acc[ai][bj][m][n];
#pragma unroll
                            for (int j = 0; j < 4; ++j) ea.o_cm[(size_t)(col + j - 2048) * ea.ld_cm + row] = f2b(v[j]);
                        }
        } else if (EPI == EPI_RESID) {
            gemm_kloop<true, NAI>(A, Bt, K, brow, bcol, acc, kt0, ntl);
            const bool lat = brow < NLAT;
            const int mrow = lat ? brow >> 11 : 16;
            const float* rbase = lat ? ea.res_lat + (size_t)brow * 1024 : ea.res_ctx + (size_t)(brow - NLAT) * 1024;
            float* obase = lat ? ea.out_lat + (size_t)brow * 1024 : ea.out_ctx + (size_t)(brow - NLAT) * 1024;
            f32x4 g[2][2];
#pragma unroll
            for (int bj = 0; bj < 2; ++bj)
#pragma unroll
                for (int n = 0; n < 2; ++n) g[bj][n] = *(const f32x4*)(ea.modg + (size_t)mrow * 6144 + bcol + bj * 128 + wc * 32 + n * 16 + fq * 4);
            if (SPLITTAIL && kq >= 0) {
#pragma unroll
                for (int ai = 0; ai < NAI; ++ai)
#pragma unroll
                    for (int m = 0; m < 4; ++m)
#pragma unroll
                        for (int bj = 0; bj < 2; ++bj)
#pragma unroll
                            for (int n = 0; n < 2; ++n) {
                                float* op = obase + (size_t)(ai * 128 + wr * 64 + m * 16 + fr) * 1024 + bcol + bj * 128 + wc * 32 + n * 16 + fq * 4;
                                const f32x4 dv = g[bj][n] * acc[ai][bj][m][n];
#pragma unroll
                                for (int j = 0; j < 4; ++j) unsafeAtomicAdd(op + j, dv[j]);
                            }
            } else
#pragma unroll
            for (int ai = 0; ai < NAI; ++ai) {
                f32x4 xv[4][2][2];
#pragma unroll
                for (int m = 0; m < 4; ++m)
#pragma unroll
                    for (int bj = 0; bj < 2; ++bj)
#pragma unroll
                        for (int n = 0; n < 2; ++n)
                            xv[m][bj][n] = *(const f32x4*)(rbase + (size_t)(ai * 128 + wr * 64 + m * 16 + fr) * 1024 + bcol + bj * 128 + wc * 32 + n * 16 + fq * 4);
#pragma unroll
                for (int m = 0; m < 4; ++m)
#pragma unroll
                    for (int bj = 0; bj < 2; ++bj)
#pragma unroll
                        for (int n = 0; n < 2; ++n)
                            *(f32x4*)(obase + (size_t)(ai * 128 + wr * 64 + m * 16 + fr) * 1024 + bcol + bj * 128 + wc * 32 + n * 16 + fq * 4) = xv[m][bj][n] + g[bj][n] * acc[ai][bj][m][n];
            }
        } else {
            gemm_kloop<true, NAI>(A, Bt, K, brow, bcol, acc, kt0, ntl);
#pragma unroll
            for (int ai = 0; ai < NAI; ++ai)
#pragma unroll
                for (int m = 0; m < 4; ++m) {
                    const int row = brow + ai * 128 + wr * 64 + m * 16 + fr;
#pragma unroll
                    for (int bj = 0; bj < 2; ++bj)
#pragma unroll
                        for (int n = 0; n < 2; ++n) {
                            const int col = bcol + bj * 128 + wc * 32 + n * 16 + fq * 4;
                            const f32x4 v = acc[ai][bj][m][n];
                            if (EPI == EPI_INPROJ) {
                                if (pn == ea.gate_pn) {
                                    if (bj == 0 && wc == 0 && n == 0) *(f32x4*)(ea.gates + (size_t)row * 16 + fq * 4) = v;
                                } else {
                                    u32x2 o; o.x = pk2(v[0], v[1]); o.y = pk2(v[2], v[3]);
                                    *(u32x2*)(ea.o_rm + (size_t)row * ea.ld_rm + col) = o;
                                }
                            } else if (EPI == EPI_DRY) {
                                if (v[0] == 123456.789f && v[1] == 3.25f) *(f32x4*)(ea.out_lat + (size_t)row * 1024 + (col & 1023)) = v;
                            } else if (EPI == EPI_RELU2) {
                                float r0 = fmaxf(v[0], 0.f), r1 = fmaxf(v[1], 0.f), r2 = fmaxf(v[2], 0.f), r3 = fmaxf(v[3], 0.f);
                                u32x2 o; o.x = pk2(r0 * r0, r1 * r1); o.y = pk2(r2 * r2, r3 * r3);
                                *(u32x2*)(ea.o_rm + (size_t)row * ea.ld_rm + col) = o;
                            } else {
                                const float* rp; float* op; int mrow;
                                if (row < NLAT) { rp = ea.res_lat + (size_t)row * 1024 + col; op = ea.out_lat + (size_t)row * 1024 + col; mrow = row >> 11; }
                                else { rp = ea.res_ctx + (size_t)(row - NLAT) * 1024 + col; op = ea.out_ctx + (size_t)(row - NLAT) * 1024 + col; mrow = 16; }
                                const f32x4 g = *(const f32x4*)(ea.modg + (size_t)mrow * 6144 + col);
                                const f32x4 x = *(const f32x4*)rp;
                                f32x4 rr = x + g * v;
#ifdef SANITIZE
#pragma unroll
                                for (int q_ = 0; q_ < 4; ++q_) if (!(fabsf(rr[q_]) < 1e30f)) rr[q_] = 0.f;
#endif
                                *(f32x4*)op = rr;
                            }
                        }
                }
        }
        asm volatile("s_waitcnt vmcnt(0)" ::: "memory");
        __syncthreads();
}

template <int EPI, bool HALFTAIL = true>
__device__ __forceinline__ void gemm_phase(const bf16_t* A, const bf16_t* Bt, int M, int N, int K, const EpiArgs& ea) {
    const int nM = M / G_BM, nN = N / G_BM, nwg = nM * nN, G_ = gridDim.x;
    const int tidx = tid_l(); const int wid = tidx >> 6, lane = tidx & 63, wr = wid >> 2, wc = wid & 3, fr = lane & 15, fq = lane >> 4;
    int nfull = nwg;
    if (HALFTAIL) { const int rem = nwg % G_; if (rem > 0 && rem * 2 <= G_) nfull = nwg - rem; }
    const int nunits = nfull + (nwg - nfull) * 2;
    for (int U = blockIdx.x; U < nunits; U += G_) {
        const int L = U < nfull ? U : nfull + ((U - nfull) >> 1);
        const int half = U < nfull ? -1 : ((U - nfull) & 1);
        int wgid = L;
        { int q = nwg / 8, r = nwg % 8, xcd = wgid % 8, off = wgid / 8; wgid = (xcd < r ? xcd * (q + 1) : r * (q + 1) + (xcd - r) * q) + off; }
        const int nig = 8 * nN, gid = wgid / nig, fm = gid * 8, gsz = min(nM - fm, 8);
        const int pm = fm + ((wgid % nig) % gsz), pn = (wgid % nig) / gsz, bcol = pn * G_BM;
        if (half < 0) gemm_tile<EPI, 2>(A, Bt, K, pm * G_BM, bcol, pn, ea, wr, wc, fr, fq);
        else gemm_tile<EPI, 1>(A, Bt, K, pm * G_BM + half * 128, bcol, pn, ea, wr, wc, fr, fq);
    }
}

__device__ __forceinline__ void phase0(const Params& p) {
    const int tid = tid_l(), blk = blockIdx.x, nb = gridDim.x;
    float* MOD = (float*)(p.ws + WS_MOD);
    for (int it = blk; it < 193; it += nb) {
        if (it < 192) {
            float* sl = (float*)dyn_lds;
            float* red = sl + 17 * 1024;
            for (int i = tid; i < 17 * 1024; i += NT) { float v = (i < 16 * 1024) ? p.in[1][i] : p.in[3][i - 16 * 1024]; sl[i] = v / (1.f + __expf(-v)); }
            __syncthreads();
            const int l = it / 48, nc = it % 48, kp = tid >> 7, col = tid & 127;
            const float* W = p.in[4] + (size_t)l * 1024 * 6144 + nc * 128 + col;
            float acc[17];
#pragma unroll
            for (int r = 0; r < 17; ++r) acc[r] = 0.f;
            for (int k = kp * 256; k < kp * 256 + 256; ++k) {
                const float wv = W[(size_t)k * 6144];
#pragma unroll
                for (int r = 0; r < 17; ++r) acc[r] += sl[r * 1024 + k] * wv;
            }
#pragma unroll
            for (int r = 0; r < 17; ++r) red[(kp * 17 + r) * 128 + col] = acc[r];
            __syncthreads();
            for (int i = tid; i < 17 * 128; i += NT) {
                const int r = i >> 7, cc = i & 127;
                const float s = red[(0 * 17 + r) * 128 + cc] + red[(1 * 17 + r) * 128 + cc] + red[(2 * 17 + r) * 128 + cc] + red[(3 * 17 + r) * 128 + cc];
                MOD[((size_t)l * 17 + r) * 6144 + nc * 128 + cc] = s + p.in[5][l * 6144 + nc * 128 + cc];
            }
            __syncthreads();
        } else {
            float* ROPE = (float*)(p.ws + WS_ROPE);
            for (int i = tid; i < 2048; i += NT) {
                const int pos = i >> 5, j = i & 31;
                const float inv = exp2f(-(float)j * (13.287712379549449f / 32.f));
                const float ang = (float)pos * inv;
                ROPE[i] = fcos_(ang); ROPE[2048 + i] = fsin_(ang);
            }
        }
    }
    float* H2 = (float*)(p.ws + WS_H2);
    const int gw = blk * 8 + (tid >> 6), lane = tid & 63;
    for (int it = gw; it < 2 * 2304; it += nb * 8) {
        const int i = it / 2304, row = it % 2304;
        const int L = row < 2048 ? 2048 : 256, t = row < 2048 ? row : row - 2048;
        const float tn = (float)t / (float)(L - 1);
        const float wpos = 6.283185307179586f * (float)t / (float)L;
        float ev = 0.f;
        if (lane == 0) ev = tn;
        else if (lane <= 16) { const float fr = 1e-4f + (float)(lane - 1) * ((15.f - 1e-4f) / 15.f); ev = fcos_(wpos * fr); }
        else if (lane <= 32) { const float fr = 1e-4f + (float)(lane - 17) * ((15.f - 1e-4f) / 15.f); ev = -fsin_(wpos * fr); }
        const float* w1 = p.in[13] + i * 33 * 64; const float* b1 = p.in[14] + i * 64;
        const float* w2 = p.in[15] + i * 64 * 64; const float* b2 = p.in[16] + i * 64; const float* fq = p.in[18] + i * 64;
        float a = b1[lane];
        for (int e = 0; e < 33; ++e) a += __shfl(ev, e) * w1[e * 64 + lane];
        const float h1 = fsin_(fq[lane] * a);
        float a2 = b2[lane];
        for (int e = 0; e < 64; ++e) a2 += __shfl(h1, e) * w2[e * 64 + lane];
        H2[((size_t)i * 2304 + row) * 64 + lane] = fsin_(fq[lane] * a2);
    }
}

__device__ __forceinline__ void cvt_tile(const float* W, int N, int K, bf16_t* WT, int n0, int k0, int mapmode) {
    float* tl = (float*)dyn_lds;
    const int tid = tid_l(), nl = tid & 63, kb = tid >> 6;
    const int n = n0 + nl; int sc = n;
    if (mapmode == 1) sc = n < 2048 ? n : (n < 3584 ? n + 16 : (n < 3600 ? n - 3584 + 2048 : -1));
#pragma unroll
    for (int i = 0; i < 8; ++i) { const int kl = kb + 8 * i; tl[kl * 65 + nl] = sc >= 0 ? W[(size_t)(k0 + kl) * N + sc] : 0.f; }
    __syncthreads();
    const int nn = tid >> 3, kc = tid & 7;
    float f[8];
#pragma unroll
    for (int j = 0; j < 8; ++j) f[j] = tl[(kc * 8 + j) * 65 + nn];
    *(u32x4*)(WT + (size_t)(n0 + nn) * K + k0 + kc * 8) = pack8(f);
    __syncthreads();
}

__device__ __forceinline__ void convert_weights(const Params& p, int l, bool first_part, bool second_part, int bstart, int bcount) {
    const int blk = (int)blockIdx.x - bstart, nb = bcount, li = l >> 1; const bool even = !(l & 1);
    if (blk < 0 || blk >= bcount) return;
    const int nin = even ? 60 : 48;
    const int t_in = nin * 16, t_out = 256, t_m1 = 1024, t_m2 = 1024;
    const int it0 = first_part ? 0 : t_in + t_out + t_m1, it1 = second_part ? t_in + t_out + t_m1 + t_m2 : t_in + t_out + t_m1;
    for (int it = it0 + blk; it < it1; it += nb) {
        int r = it;
        if (r < t_in) {
            const int nt = r / 16, kt = r % 16;
            if (even) cvt_tile(p.in[8] + (size_t)li * 1024 * 3600, 3600, 1024, (bf16_t*)(p.ws + WS_WIN), nt * 64, kt * 64, 1);
            else cvt_tile(p.in[21] + (size_t)li * 1024 * 3072, 3072, 1024, (bf16_t*)(p.ws + WS_WIN), nt * 64, kt * 64, 0);
            continue;
        }
        r -= t_in;
        if (r < t_out) {
            const int nt = r / 16, kt = r % 16;
            cvt_tile((even ? p.in[20] : p.in[25]) + (size_t)li * 1024 * 1024, 1024, 1024, (bf16_t*)(p.ws + WS_WOUT), nt * 64, kt * 64, 0);
            continue;
        }
        r -= t_out;
        if (r < t_m1) {
            const int nt = r / 16, kt = r % 16;
            cvt_tile(p.in[6] + (size_t)l * 1024 * 4096, 4096, 1024, (bf16_t*)(p.ws + WS_WM1), nt * 64, kt * 64, 0);
            continue;
        }
        r -= t_m1;
        { const int nt = r / 64, kt = r % 64;
          cvt_tile(p.in[7] + (size_t)l * 4096 * 1024, 1024, 4096, (bf16_t*)(p.ws + WS_WM2), nt * 64, kt * 64, 0); }
    }
}

__device__ __forceinline__ void norm_phase(const Params& p, int l, const float* xlat, const float* xctx, int shoff, int scoff, int M) {
    const int tid = tid_l(), lane = tid & 63, gw = blockIdx.x * 8 + (tid >> 6), ngw = gridDim.x * 8;
    const float* MOD = (const float*)(p.ws + WS_MOD) + (size_t)l * 17 * 6144;
    bf16_t* ACT = (bf16_t*)(p.ws + WS_ACT);
    for (int row = gw; row < M; row += ngw) {
        const float* xr = row < NLAT ? xlat + (size_t)row * 1024 : xctx + (size_t)(row - NLAT) * 1024;
        const int mrow = row < NLAT ? row >> 11 : 16;
        const float* mod = MOD + (size_t)mrow * 6144;
        f32x4 v[4]; float ss = 0.f;
#pragma unroll
        for (int j = 0; j < 4; ++j) { v[j] = *(const f32x4*)(xr + 4 * lane + 256 * j); ss += v[j][0] * v[j][0] + v[j][1] * v[j][1] + v[j][2] * v[j][2] + v[j][3] * v[j][3]; }
        ss = wave_sum(ss);
        const float rstd = rsqrtf(ss * (1.f / 1024.f) + EPS);
#pragma unroll
        for (int j = 0; j < 4; ++j) {
            const int col = 4 * lane + 256 * j;
            const f32x4 sh = *(const f32x4*)(mod + shoff + col), sc = *(const f32x4*)(mod + scoff + col);
            const f32x4 y = v[j] * rstd * (sc + 1.f) + sh;
            u32x2 o; o.x = pk2(y[0], y[1]); o.y = pk2(y[2], y[3]);
            *(u32x2*)(ACT + (size_t)row * 1024 + col) = o;
        }
    }
}

__device__ __forceinline__ void filter_gen(const Params& p, int li) {
    const int tid = tid_l(), lane = tid & 63, w = tid >> 6;
    float* wf = (float*)dyn_lds; float* wb = wf + 64; float* red = wb + 64;
    const float* H2 = (const float*)(p.ws + WS_H2);
    for (int it = blockIdx.x; it < 2048; it += gridDim.x) {
        const int ltype = it >> 10, o = (it >> 9) & 1, c = it & 511;
        const int L = ltype ? 256 : 2048;
        const float* H2r = H2 + ((size_t)li * 2304 + (ltype ? 2048 : 0)) * 64;
        const float* w3 = p.in[17] + (size_t)li * 64 * 2048;
        if (tid < 64) wf[tid] = w3[tid * 2048 + (o * 2 + 0) * 512 + c];
        else if (tid < 128) wb[tid - 64] = w3[(tid - 64) * 2048 + (o * 2 + 1) * 512 + c];
        __syncthreads();
        const float lo = -4.605170185988091f / 1.5f, hi = -4.605170185988091f / 0.3f;
        const float delta = fabsf(lo + (hi - lo) * (float)c / 511.f);
        float vf[4], vb[4]; float ssf = 0.f, ssb = 0.f;
#pragma unroll
        for (int q = 0; q < 4; ++q) {
            const int t = tid + 512 * q; vf[q] = 0.f; vb[q] = 0.f;
            if (t < L) {
                float df = 0.f, db = 0.f;
                const f32x4* hr = (const f32x4*)(H2r + (size_t)t * 64);
#pragma unroll
                for (int j = 0; j < 16; ++j) { const f32x4 hv = hr[j];
                    df += hv[0] * wf[4 * j] + hv[1] * wf[4 * j + 1] + hv[2] * wf[4 * j + 2] + hv[3] * wf[4 * j + 3];
                    db += hv[0] * wb[4 * j] + hv[1] * wb[4 * j + 1] + hv[2] * wb[4 * j + 2] + hv[3] * wb[4 * j + 3]; }
                const float dec = __expf(-((float)t / (float)(L - 1)) * delta);
                vf[q] = df * dec; vb[q] = db * dec; ssf += vf[q] * vf[q]; ssb += vb[q] * vb[q];
            }
        }
        ssf = wave_sum(ssf); ssb = wave_sum(ssb);
        if (lane == 0) { red[w] = ssf; red[8 + w] = ssb; }
        __syncthreads();
        float tf = 0.f, tb = 0.f;
#pragma unroll
        for (int i = 0; i < 8; ++i) { tf += red[i]; tb += red[8 + i]; }
        const float nf = rsqrtf(tf + EPS), nbk = rsqrtf(tb + EPS);
        bf16_t* dst = ltype ? (bf16_t*)(p.ws + WS_FCTX) + ((size_t)o * 512 + c) * 512 : (bf16_t*)(p.ws + WS_FLAT) + ((size_t)o * 512 + c) * 4096;
#pragma unroll
        for (int q = 0; q < 4; ++q) {
            const int t = tid + 512 * q;
            if (t < L) {
                if (t == 0) { dst[L] = f2b(vf[q] * nf + vb[q] * nbk); dst[0] = 0; }
                else { dst[L + t] = f2b(vf[q] * nf); dst[L - t] = f2b(vb[q] * nbk); }
            }
        }
        __syncthreads();
    }
}

__device__ __forceinline__ void mlstm_item(const Params& p, int li, int it) {
    const int tid = tid_l(), w = tid >> 6, lane = tid & 63, fr = lane & 15, fq = lane >> 4;
    const int b = it >> 3, h = (it >> 1) & 3, dir = it & 1;
    bf16_t* Qs = (bf16_t*)dyn_lds;
    bf16_t* Ks = Qs + 64 * 136;
    bf16_t* KT = Ks + 64 * 136;
    bf16_t* VT = KT + 128 * 72;
    bf16_t* Cb = VT + 144 * 72;
    bf16_t* Ps = Cb + 144 * 136;
    float* fl = (float*)(Ps + 64 * 72);
    float* a_s = fl; float* Mt = fl + 64; float* scs = fl + 128; float* emt = fl + 192; float* den = fl + 256; float* lfs = fl + 320; float* igs = fl + 384; float* scal = fl + 448;
    const bf16_t* QKVO = (const bf16_t*)(p.ws + WS_BIG);
    const float* GATES = (const float*)(p.ws + WS_GATES);
    bf16_t* HFB = (bf16_t*)(p.ws + WS_HFB) + (size_t)dir * MTOT * 512;
    const float* ROPE = (const float*)(p.ws + WS_ROPE);
    const float* gate_b = p.in[9] + li * 16;
    for (int i = tid; i < 144 * 136 / 2; i += NT) ((unsigned*)Cb)[i] = 0u;
    for (int i = tid; i < 16 * 72; i += NT) { const int r = i / 72, ci = i % 72; VT[(128 + r) * 72 + ci] = (r == 0 && ci < 64) ? (bf16_t)0x3F80 : (bf16_t)0; }
    f32x4 cacc[9];
#pragma unroll
    for (int i = 0; i < 9; ++i) cacc[i] = (f32x4){0.f, 0.f, 0.f, 0.f};
    float m = 0.f;
    __syncthreads();
    for (int step = 0; step < 36; ++step) {
        const bool isctx = step < 4;
        const int cj = isctx ? (dir ? 3 - step : step) : (dir ? 35 - step : step - 4);
        const int rowbase = isctx ? NLAT + b * 256 + cj * 64 : b * 2048 + cj * 64;
        {
            const int r = tid >> 3, seg = tid & 7; const int tl = dir ? 63 - r : r;
            const bf16_t* src = QKVO + (size_t)(rowbase + tl) * 2048 + h * 128;
            const int hb = seg >> 2, jb = (seg & 3) * 8, d1 = hb * 64 + jb, d2 = d1 + 32;
            const u32x4 q1 = *(const u32x4*)(src + d1), q2 = *(const u32x4*)(src + d2);
            const u32x4 k1 = *(const u32x4*)(src + 512 + d1), k2 = *(const u32x4*)(src + 512 + d2);
            const u32x4 v1 = *(const u32x4*)(src + 1024 + seg * 16), v2 = *(const u32x4*)(src + 1024 + seg * 16 + 8);
            float cs[8], sn[8];
            if (!isctx) {
                const int pos = hb ? tl : cj;
                const f32x4 c0 = *(const f32x4*)(ROPE + pos * 32 + jb), c1 = *(const f32x4*)(ROPE + pos * 32 + jb + 4);
                const f32x4 s0 = *(const f32x4*)(ROPE + 2048 + pos * 32 + jb), s1 = *(const f32x4*)(ROPE + 2048 + pos * 32 + jb + 4);
#pragma unroll
                for (int e = 0; e < 4; ++e) { cs[e] = c0[e]; cs[4 + e] = c1[e]; sn[e] = s0[e]; sn[4 + e] = s1[e]; }
            } else {
#pragma unroll
                for (int e = 0; e < 8; ++e) { cs[e] = 1.f; sn[e] = 0.f; }
            }
            float x1[8], x2[8], o1[8], o2[8];
            unpack8(q1, x1); unpack8(q2, x2);
#pragma unroll
            for (int e = 0; e < 8; ++e) { o1[e] = x1[e] * cs[e] - x2[e] * sn[e]; o2[e] = x1[e] * sn[e] + x2[e] * cs[e]; }
            *(u32x4*)(Qs + r * 136 + d1) = pack8(o1); *(u32x4*)(Qs + r * 136 + d2) = pack8(o2);
            unpack8(k1, x1); unpack8(k2, x2);
            const float ksc = 0.08838834764831845f;
#pragma unroll
            for (int e = 0; e < 8; ++e) { o1[e] = (x1[e] * cs[e] - x2[e] * sn[e]) * ksc; o2[e] = (x1[e] * sn[e] + x2[e] * cs[e]) * ksc; }
            const u32x4 ko1 = pack8(o1), ko2 = pack8(o2);
            *(u32x4*)(Ks + r * 136 + d1) = ko1; *(u32x4*)(Ks + r * 136 + d2) = ko2;
            {
                const unsigned kw1[4] = {ko1.x, ko1.y, ko1.z, ko1.w}, kw2[4] = {ko2.x, ko2.y, ko2.z, ko2.w};
#pragma unroll
                for (int e = 0; e < 4; ++e) {
                    KT[(d1 + 2 * e) * 72 + r] = (bf16_t)(kw1[e] & 0xffffu); KT[(d1 + 2 * e + 1) * 72 + r] = (bf16_t)(kw1[e] >> 16);
                    KT[(d2 + 2 * e) * 72 + r] = (bf16_t)(kw2[e] & 0xffffu); KT[(d2 + 2 * e + 1) * 72 + r] = (bf16_t)(kw2[e] >> 16);
                }
                const unsigned vw1[4] = {v1.x, v1.y, v1.z, v1.w}, vw2[4] = {v2.x, v2.y, v2.z, v2.w};
#pragma unroll
                for (int e = 0; e < 4; ++e) {
                    VT[(seg * 16 + 2 * e) * 72 + r] = (bf16_t)(vw1[e] & 0xffffu); VT[(seg * 16 + 2 * e + 1) * 72 + r] = (bf16_t)(vw1[e] >> 16);
                    VT[(seg * 16 + 8 + 2 * e) * 72 + r] = (bf16_t)(vw2[e] & 0xffffu); VT[(seg * 16 + 8 + 2 * e + 1) * 72 + r] = (bf16_t)(vw2[e] >> 16);
                }
            }
            if (tid < 64) {
                const int rr = tid, tl2 = dir ? 63 - rr : rr;
                const float* g = GATES + (size_t)(rowbase + tl2) * 16;
                const float ig = g[dir * 8 + h] + gate_b[dir * 8 + h];
                const float fg = g[dir * 8 + 4 + h] + gate_b[dir * 8 + 4 + h];
                igs[rr] = ig; lfs[rr] = fminf(fg, 0.f) - __logf(1.f + __expf(-fabsf(fg)));
            }
        }
        __syncthreads();
        if (w == 0) {
            float bcs = lfs[lane];
#pragma unroll
            for (int o = 1; o < 64; o <<= 1) { const float t = __shfl_up(bcs, o); if (lane >= o) bcs += t; }
            const float a = igs[lane] - bcs;
            float pm = a;
#pragma unroll
            for (int o = 1; o < 64; o <<= 1) { const float t = __shfl_up(pm, o); if (lane >= o) pm = fmaxf(pm, t); }
            const float Mx = fmaxf(m, pm);
            a_s[lane] = a; Mt[lane] = Mx; scs[lane] = __expf(m - Mx); emt[lane] = __expf(-bcs - Mx);
            if (lane == 63) { scal[0] = bcs; scal[1] = Mx; }
        }
        {
            const int st = w & 3, tt0 = (w >> 2) * 2;
            f32x4 sacc[2];
#pragma unroll
            for (int u = 0; u < 2; ++u) {
                sacc[u] = (f32x4){0.f, 0.f, 0.f, 0.f};
#pragma unroll
                for (int kk = 0; kk < 4; ++kk) {
                    const bf16x8 Ak = *(const bf16x8*)(Ks + (st * 16 + fr) * 136 + kk * 32 + fq * 8);
                    const bf16x8 Bq = *(const bf16x8*)(Qs + ((tt0 + u) * 16 + fr) * 136 + kk * 32 + fq * 8);
                    sacc[u] = mfma16(Ak, Bq, sacc[u]);
                }
            }
            __syncthreads();
#pragma unroll
            for (int u = 0; u < 2; ++u) {
                const int t = (tt0 + u) * 16 + fr, sb = st * 16 + fq * 4;
                const float Mv = Mt[t];
                float pv[4];
#pragma unroll
                for (int j = 0; j < 4; ++j) { const int s = sb + j; pv[j] = (s <= t) ? sacc[u][j] * __expf(a_s[s] - Mv) : 0.f; }
                u32x2 o; o.x = pk2(pv[0], pv[1]); o.y = pk2(pv[2], pv[3]);
                *(u32x2*)(Ps + t * 72 + sb) = o;
            }
        }
        __syncthreads();
        {
            const int tt = w & 3, up = w >> 2, vt0 = up ? 5 : 0, nvt = up ? 4 : 5;
            bf16x8 qf[4], pf[2];
#pragma unroll
            for (int kk = 0; kk < 4; ++kk) qf[kk] = *(const bf16x8*)(Qs + (tt * 16 + fr) * 136 + kk * 32 + fq * 8);
#pragma unroll
            for (int kk = 0; kk < 2; ++kk) pf[kk] = *(const bf16x8*)(Ps + (tt * 16 + fr) * 72 + kk * 32 + fq * 8);
            const float sct = scs[tt * 16 + fr];
            f32x4 hacc[5];
#pragma unroll
            for (int vi = 0; vi < 5; ++vi) {
                hacc[vi] = (f32x4){0.f, 0.f, 0.f, 0.f};
                if (vi < nvt) {
                    const int v0 = (vt0 + vi) * 16;
                    f32x4 ac = (f32x4){0.f, 0.f, 0.f, 0.f};
#pragma unroll
                    for (int kk = 0; kk < 4; ++kk) ac = mfma16(*(const bf16x8*)(Cb + (v0 + fr) * 136 + kk * 32 + fq * 8), qf[kk], ac);
                    ac = ac * sct;
#pragma unroll
                    for (int kk = 0; kk < 2; ++kk) ac = mfma16(*(const bf16x8*)(VT + (v0 + fr) * 72 + kk * 32 + fq * 8), pf[kk], ac);
                    hacc[vi] = ac;
                }
            }
            if (up && fq == 0) den[tt * 16 + fr] = hacc[3][0];
            __syncthreads();
            const int t = tt * 16 + fr, tl = dir ? 63 - t : t;
            const float dn = den[t];
            const float inv = 1.f / fmaxf(fabsf(dn), emt[t]);
            bf16_t* orow = HFB + (size_t)(rowbase + tl) * 512 + h * 128;
#pragma unroll
            for (int vi = 0; vi < 5; ++vi) {
                if (vi < nvt && (vt0 + vi) < 8) {
                    const int v0 = (vt0 + vi) * 16 + fq * 4;
                    u32x2 o; o.x = pk2(hacc[vi][0] * inv, hacc[vi][1] * inv); o.y = pk2(hacc[vi][2] * inv, hacc[vi][3] * inv);
                    *(u32x2*)(orow + v0) = o;
                }
            }
        }
        {
            const float bl = scal[0], M63 = scal[1];
            const float decay = __expf(m - M63);
            bf16x8 ka[2];
#pragma unroll
            for (int kk = 0; kk < 2; ++kk) {
                const u32x4 raw = *(const u32x4*)(KT + (w * 16 + fr) * 72 + kk * 32 + fq * 8);
                float f[8]; unpack8(raw, f);
#pragma unroll
                for (int j = 0; j < 8; ++j) f[j] *= __expf(a_s[kk * 32 + fq * 8 + j] - M63);
                ka[kk] = as_bf8(pack8(f));
            }
#pragma unroll
            for (int vt = 0; vt < 9; ++vt) {
                f32x4 ac = cacc[vt] * decay;
#pragma unroll
                for (int kk = 0; kk < 2; ++kk) ac = mfma16(ka[kk], *(const bf16x8*)(VT + (vt * 16 + fr) * 72 + kk * 32 + fq * 8), ac);
                cacc[vt] = ac;
                u32x2 o; o.x = pk2(ac[0], ac[1]); o.y = pk2(ac[2], ac[3]);
                *(u32x2*)(Cb + (vt * 16 + fr) * 136 + w * 16 + fq * 4) = o;
            }
            m = bl + M63;
        }
        __syncthreads();
    }
}

__device__ __forceinline__ void combine_phase(const Params& p, int li) {
    const int tid = tid_l(), lane = tid & 63, gw = blockIdx.x * 8 + (tid >> 6), ngw = gridDim.x * 8;
    const bf16_t* HF = (const bf16_t*)(p.ws + WS_HFB); const bf16_t* HB = HF + (size_t)MTOT * 512;
    const bf16_t* QKVO = (const bf16_t*)(p.ws + WS_BIG);
    bf16_t* MIX = (bf16_t*)(p.ws + WS_ACT);
    const float* hn = p.in[10] + li * 512 + lane * 8;
    float g[8];
#pragma unroll
    for (int e = 0; e < 8; ++e) g[e] = hn[e];
    for (int row = gw; row < MTOT; row += ngw) {
        float a[8], bq[8], og[8], y[8];
        unpack8(*(const u32x4*)(HF + (size_t)row * 512 + lane * 8), a);
        unpack8(*(const u32x4*)(HB + (size_t)row * 512 + lane * 8), bq);
        unpack8(*(const u32x4*)(QKVO + (size_t)row * 2048 + 1536 + lane * 8), og);
        float ss = 0.f;
#pragma unroll
        for (int e = 0; e < 8; ++e) { a[e] += bq[e]; ss += a[e] * a[e]; }
        ss += __shfl_xor(ss, 1); ss += __shfl_xor(ss, 2); ss += __shfl_xor(ss, 4); ss += __shfl_xor(ss, 8);
        const float rstd = rsqrtf(ss * (1.f / 128.f) + EPS);
#pragma unroll
        for (int e = 0; e < 8; ++e) y[e] = a[e] * rstd * g[e] / (1.f + __expf(-og[e]));
        *(u32x4*)(MIX + (size_t)row * 1024 + lane * 8) = pack8(y);
    }
}

template <int L>
__device__ __forceinline__ void hyena_item(const Params& p, int li, int c, bool dry = false) {
    constexpr int ZS = L + 8, NI = L / 128, NS = L / 32;
    const int tid = tid_l(), w = tid >> 6, lane = tid & 63, fr = lane & 15, fq = lane >> 4;
    bf16_t* ZA = (bf16_t*)dyn_lds; bf16_t* ZB = ZA + 16 * ZS; bf16_t* HFl = ZB + 16 * ZS;
    const bf16_t* zpad = HFl + 2 * L;
    if (tid < 8) HFl[2 * L + tid] = 0;
    const int segbase = (L == 2048) ? 0 : NLAT;
    const bf16_t* HYT = (const bf16_t*)(p.ws + WS_P2);
    bf16_t* MIX = (bf16_t*)(p.ws + WS_ACT);
    const float* cw = p.in[11] + (size_t)li * 3 * 1536; const float* cb = p.in[12] + (size_t)li * 1536; const float* hd = p.in[19] + (size_t)li * 2 * 512;
    const bf16_t* FIL = (L == 2048) ? (const bf16_t*)(p.ws + WS_FLAT) : (const bf16_t*)(p.ws + WS_FCTX);
    {
        const float w0 = cw[c], w1 = cw[1536 + c], w2 = cw[2 * 1536 + c], bb = cb[c];
        const bf16_t* src = HYT + (size_t)c * MTOT + segbase;
#pragma unroll
        for (int ci = 0; ci < (16 * L / 8 + NT - 1) / NT; ++ci) {
            const int ch = tid + ci * NT; if (ch >= 16 * L / 8) break;
            const int b = ch / (L / 8), t0 = (ch % (L / 8)) * 8;
            const bf16_t* s = src + b * L + t0;
            float x[10], y[8];
            const float xl = b2f(s[t0 > 0 ? -1 : 0]), xr = b2f(s[(t0 + 8 < L) ? 8 : 7]);
            unpack8(*(const u32x4*)s, x + 1);
            x[0] = t0 > 0 ? xl : 0.f; x[9] = (t0 + 8 < L) ? xr : 0.f;
#pragma unroll
            for (int e = 0; e < 8; ++e) y[e] = bb + w0 * x[e] + w1 * x[e + 1] + w2 * x[e + 2];
            *(u32x4*)(ZA + b * ZS + t0) = pack8(y);
        }
    }
#pragma unroll 1
    for (int o = 0; o < 2; ++o) {
        for (int i = tid; i < 2 * L / 8; i += NT) *(u32x4*)(HFl + i * 8) = *(const u32x4*)(FIL + ((size_t)o * 512 + c) * 2 * L + i * 8);
        __syncthreads();
        const bf16_t* Zin = o ? ZB : ZA;
        const int gc = (o + 1) * 512 + c;
        const float gw0 = cw[gc], gw1 = cw[1536 + gc], gw2 = cw[2 * 1536 + gc], gb = cb[gc], dsk = hd[o * 512 + c];
        const bf16_t* gs = HYT + (size_t)gc * MTOT + segbase + fr * L;
        constexpr int NIB = NI < 8 ? NI : 8;
#pragma unroll 1
        for (int hp = 0; hp < NI; hp += NIB) {
            f32x4 acc[NIB];
#pragma unroll
            for (int i = 0; i < NIB; ++i) acc[i] = (f32x4){0.f, 0.f, 0.f, 0.f};
            constexpr int NQ = NS / 4;
#pragma unroll 1
            for (int r = 0; r < 4; ++r) {
                bf16x8 Aw[NIB];
#pragma unroll
                for (int i = 0; i < NIB; ++i) {
                    const int base = L + 16 * w + 32 * (4 * (hp + i) - r) + fr - fq * 8;
#pragma unroll
                    for (int j = 0; j < 8; ++j) Aw[i][j] = (short)HFl[base - j];
                }
#pragma unroll 1
                for (int qc = 0; qc < NQ; qc += NIB) {
#pragma unroll
                    for (int qq = 0; qq < NIB; ++qq) {
                        const int q = qc + qq;
                        const bf16x8 Bz = *(const bf16x8*)(Zin + fr * ZS + (4 * q + r) * 32 + fq * 8);
#pragma unroll
                        for (int i = 0; i < NIB; ++i) acc[i] = mfma16(Aw[(i - qq + NIB) % NIB], Bz, acc[i]);
                        if (q + 1 < NQ) {
                            const int base = L + 16 * w + 32 * (4 * (hp - q - 1) - r) + fr - fq * 8;
#pragma unroll
                            for (int j = 0; j < 8; ++j) Aw[(NIB - 1 - qq) % NIB][j] = (short)HFl[base - j];
                        }
                    }
                }
            }
#pragma unroll
            for (int i = 0; i < NIB; ++i) {
                const int t0 = 16 * (w + 8 * (hp + i)) + fq * 4;
                float x[6];
                const float xl = b2f(gs[t0 > 0 ? t0 - 1 : 0]), xr = b2f(gs[(t0 + 4 < L) ? t0 + 4 : L - 1]);
                const u32x2 gv = *(const u32x2*)(gs + t0);
                x[0] = t0 > 0 ? xl : 0.f;
                x[1] = blo(gv.x); x[2] = bhi(gv.x); x[3] = blo(gv.y); x[4] = bhi(gv.y);
                x[5] = (t0 + 4 < L) ? xr : 0.f;
                const u32x2 zv = *(const u32x2*)(Zin + fr * ZS + t0);
                const float z[4] = {blo(zv.x), bhi(zv.x), blo(zv.y), bhi(zv.y)};
                float val[4];
#pragma unroll
                for (int j = 0; j < 4; ++j) val[j] = (gb + gw0 * x[j] + gw1 * x[j + 1] + gw2 * x[j + 2]) * (acc[i][j] + dsk * z[j]);
                { u32x2 ov; ov.x = pk2(val[0], val[1]); ov.y = pk2(val[2], val[3]); *(u32x2*)((o == 0 ? ZB : ZA) + fr * ZS + t0) = ov; }
            }
        }
        __syncthreads();
    }
    if (!dry) {
        bf16_t* dstp = (bf16_t*)(p.ws + WS_P2) + (size_t)c * MTOT + segbase;
#pragma unroll
        for (int ci = 0; ci < (16 * L / 8 + NT - 1) / NT; ++ci) {
            const int ch = tid + ci * NT; if (ch >= 16 * L / 8) break;
            const int b = ch / (L / 8), t0 = (ch % (L / 8)) * 8;
            *(u32x4*)(dstp + b * L + t0) = *(const u32x4*)(ZA + b * ZS + t0);
        }
        __syncthreads();
    }
}

__device__ __forceinline__ void hy_transpose(const Params& p) {
    const int tid = tid_l();
    bf16_t* T = (bf16_t*)dyn_lds;
    const bf16_t* HYO = (const bf16_t*)(p.ws + WS_P2);
    bf16_t* MIX = (bf16_t*)(p.ws + WS_ACT);
    for (int it = blockIdx.x; it < (MTOT / 64) * 8; it += gridDim.x) {
        const int tt = it >> 3, cg_ = it & 7, tok0 = tt * 64, c0 = cg_ * 64;
        {
            const int ch = tid >> 3, t8 = (tid & 7) * 8;
            const u32x4 v = *(const u32x4*)(HYO + (size_t)(c0 + ch) * MTOT + tok0 + t8);
            const unsigned wv[4] = {v.x, v.y, v.z, v.w};
#pragma unroll
            for (int e = 0; e < 4; ++e) { T[(t8 + 2 * e) * 72 + ch] = (bf16_t)(wv[e] & 0xffffu); T[(t8 + 2 * e + 1) * 72 + ch] = (bf16_t)(wv[e] >> 16); }
        }
        __syncthreads();
        {
            const int tk = tid >> 3, c8 = (tid & 7) * 8;
            *(u32x4*)(MIX + (size_t)(tok0 + tk) * 1024 + 512 + c0 + c8) = *(const u32x4*)(T + tk * 72 + c8);
        }
        __syncthreads();
    }
}

__device__ __forceinline__ void qknorm_phase(const Params& p, int li) {
    const int tid = tid_l(), lane = tid & 63, gw = blockIdx.x * 8 + (tid >> 6), ngw = gridDim.x * 8;
    bf16_t* QK = (bf16_t*)(p.ws + WS_BIG);
    float gq[8], gk[8];
#pragma unroll
    for (int e = 0; e < 8; ++e) { gq[e] = p.in[22][li * 64 + (lane & 7) * 8 + e] * 0.125f; gk[e] = p.in[23][li * 64 + (lane & 7) * 8 + e]; }
    for (int row = gw; row < MTOT; row += ngw) {
        bf16_t* rp = QK + (size_t)row * QK_LD + lane * 8;
        u32x4 v[4];
#pragma unroll
        for (int j = 0; j < 4; ++j) v[j] = *(const u32x4*)(rp + j * 512);
#pragma unroll
        for (int j = 0; j < 4; ++j) {
            float f[8]; unpack8(v[j], f);
            float ss = 0.f;
#pragma unroll
            for (int e = 0; e < 8; ++e) ss += f[e] * f[e];
            ss += __shfl_xor(ss, 1); ss += __shfl_xor(ss, 2); ss += __shfl_xor(ss, 4);
            const float rstd = rsqrtf(ss * (1.f / 64.f) + EPS);
#pragma unroll
            for (int e = 0; e < 8; ++e) f[e] *= rstd * (j < 2 ? gq[e] : gk[e]);
            *(u32x4*)(rp + j * 512) = pack8(f);
        }
    }
}

template <bool LAT>
__device__ __forceinline__ void attn_item(const Params& p, int li, int b, int h, int sub, bool stage = true) {
    const int tid = tid_l(), w = tid >> 6, lane = tid & 63, fr = lane & 15, fq = lane >> 4;
    bf16_t* Pw = (bf16_t*)dyn_lds + w * (16 * 264);
    bf16_t* KC = (bf16_t*)(dyn_lds + 67584);
    bf16_t* VC = (bf16_t*)(dyn_lds + 67584 + 36864);
    float* rpbs = (float*)(dyn_lds + 67584 + 36864 + 33792);
    const bf16_t* QK = (const bf16_t*)(p.ws + WS_BIG);
    const bf16_t* VTg = (const bf16_t*)(p.ws + WS_P2ODD);
    bf16_t* MIX = (bf16_t*)(p.ws + WS_ACT);
    if (stage) {
    if (LAT) { const float* rp = p.in[24] + ((size_t)li * 16 + h) * 465; for (int i = tid; i < 465; i += NT) rpbs[i] = rp[i]; }
    {
        u32x4 kv[4], vv[4];
#pragma unroll
        for (int i = 0; i < 4; ++i) {
            const int c = tid + i * NT;
            kv[i] = *(const u32x4*)(QK + (size_t)(NLAT + b * 256 + (c >> 3)) * QK_LD + 1024 + h * 64 + (c & 7) * 8);
            vv[i] = *(const u32x4*)(VTg + (size_t)(h * 64 + (c >> 5)) * VT_LD + NLAT + b * 256 + (c & 31) * 8);
        }
#pragma unroll
        for (int i = 0; i < 4; ++i) {
            const int c = tid + i * NT;
            *(u32x4*)(KC + (c >> 3) * 72 + (c & 7) * 8) = kv[i];
            *(u32x4*)(VC + (c >> 5) * 264 + (c & 31) * 8) = vv[i];
        }
    }
    __syncthreads();
    }
    int r = 0, c0 = 0, rs = 0, cw0 = 0, qtok0;
    if (LAT) { r = sub * 2 + (w >> 2); const int qt = w & 3; c0 = qt * 16; qtok0 = b * 2048 + r * 64 + c0; rs = min(max(r - 4, 0), 24); cw0 = (qt == 0) ? 0 : (qt == 1) ? 8 : (qt == 2) ? 24 : 32; }
    else { qtok0 = NLAT + b * 256 + (sub * 8 + w) * 16; }
    bf16x8 qf[2];
    {
        const bf16_t* qp = QK + (size_t)(qtok0 + fr) * QK_LD + h * 64 + fq * 8;
        qf[0] = *(const bf16x8*)qp; qf[1] = *(const bf16x8*)(qp + 32);
    }
    f32x4 o1[4], o2[4];
    float m1 = -1e30f, l1 = 0.f, m2, l2 = 0.f;
#pragma unroll
    for (int dt = 0; dt < 4; ++dt) { o1[dt] = (f32x4){0.f, 0.f, 0.f, 0.f}; o2[dt] = (f32x4){0.f, 0.f, 0.f, 0.f}; }
    if (LAT) {
        f32x4 sreg[16];
        const int qc = c0 + fr; const int cstart = min(max(qc - 8, 0), 48);
#pragma unroll
        for (int kt = 0; kt < 16; ++kt) {
            const int kr = kt >> 1, kcb = cw0 + (kt & 1) * 16;
            const bf16_t* kp = QK + (size_t)(b * 2048 + (rs + kr) * 64 + kcb + fr) * QK_LD + 1024 + h * 64 + fq * 8;
            f32x4 sa = (f32x4){0.f, 0.f, 0.f, 0.f};
            sa = mfma16(*(const bf16x8*)kp, qf[0], sa); sa = mfma16(*(const bf16x8*)(kp + 32), qf[1], sa);
            const int dri = (rs + kr - r + 7) * 31;
#pragma unroll
            for (int j = 0; j < 4; ++j) {
                const int kc = kcb + fq * 4 + j;
                const bool valid = (kc >= cstart) && (kc < cstart + 16);
                const int dci = min(max(kc - qc + 15, 0), 30);
                sa[j] = valid ? sa[j] + rpbs[dri + dci] : -1e30f;
            }
            sreg[kt] = sa;
            if ((kt & 7) == 7) __builtin_amdgcn_sched_barrier(0);
        }
#pragma unroll
        for (int kt = 0; kt < 16; ++kt)
#pragma unroll
            for (int j = 0; j < 4; ++j) m1 = fmaxf(m1, sreg[kt][j]);
        m1 = fmaxf(m1, __shfl_xor(m1, 16)); m1 = fmaxf(m1, __shfl_xor(m1, 32));
#pragma unroll
        for (int kt = 0; kt < 16; ++kt) {
            float pj[4];
#pragma unroll
            for (int j = 0; j < 4; ++j) { pj[j] = __expf(sreg[kt][j] - m1); l1 += pj[j]; }
            u32x2 o; o.x = pk2(pj[0], pj[1]); o.y = pk2(pj[2], pj[3]);
            *(u32x2*)(Pw + fr * 264 + kt * 16 + fq * 4) = o;
        }
        l1 += __shfl_xor(l1, 16); l1 += __shfl_xor(l1, 32);
#pragma unroll
        for (int kb = 0; kb < 8; kb += 4) {
            bf16x8 vf[4][4], pf[4];
#pragma unroll
            for (int u = 0; u < 4; ++u) {
                const int ks = kb + u;
                const int vtok0 = b * 2048 + (rs + ks) * 64 + cw0;
#pragma unroll
                for (int dt = 0; dt < 4; ++dt) vf[u][dt] = *(const bf16x8*)(VTg + (size_t)(h * 64 + dt * 16 + fr) * VT_LD + vtok0 + fq * 8);
                pf[u] = *(const bf16x8*)(Pw + fr * 264 + ks * 32 + fq * 8);
            }
#pragma unroll
            for (int u = 0; u < 4; ++u)
#pragma unroll
                for (int dt = 0; dt < 4; ++dt) o1[dt] = mfma16(vf[u][dt], pf[u], o1[dt]);
            __builtin_amdgcn_sched_barrier(0);
        }
    }
    {
        f32x4 sreg[16];
#pragma unroll
        for (int kt = 0; kt < 16; ++kt) {
            const bf16_t* kp = KC + (kt * 16 + fr) * 72 + fq * 8;
            f32x4 sa = (f32x4){0.f, 0.f, 0.f, 0.f};
            sa = mfma16(*(const bf16x8*)kp, qf[0], sa); sa = mfma16(*(const bf16x8*)(kp + 32), qf[1], sa);
            sreg[kt] = sa;
        }
        m2 = -1e30f;
#pragma unroll
        for (int kt = 0; kt < 16; ++kt)
#pragma unroll
            for (int j = 0; j < 4; ++j) m2 = fmaxf(m2, sreg[kt][j]);
        m2 = fmaxf(m2, __shfl_xor(m2, 16)); m2 = fmaxf(m2, __shfl_xor(m2, 32));
#pragma unroll
        for (int kt = 0; kt < 16; ++kt) {
            float pj[4];
#pragma unroll
            for (int j = 0; j < 4; ++j) { pj[j] = __expf(sreg[kt][j] - m2); l2 += pj[j]; }
            u32x2 o; o.x = pk2(pj[0], pj[1]); o.y = pk2(pj[2], pj[3]);
            *(u32x2*)(Pw + fr * 264 + kt * 16 + fq * 4) = o;
        }
        l2 += __shfl_xor(l2, 16); l2 += __shfl_xor(l2, 32);
#pragma unroll
        for (int ks = 0; ks < 8; ++ks) {
            const bf16x8 pf = *(const bf16x8*)(Pw + fr * 264 + ks * 32 + fq * 8);
#pragma unroll
            for (int dt = 0; dt < 4; ++dt) o2[dt] = mfma16(*(const bf16x8*)(VC + (dt * 16 + fr) * 264 + ks * 32 + fq * 8), pf, o2[dt]);
        }
    }
    const float mm = fmaxf(m1, m2);
    const float a1 = LAT ? __expf(m1 - mm) : 0.f, a2 = __expf(m2 - mm);
    const float inv = 1.f / (l1 * a1 + l2 * a2);
    const float s1 = a1 * inv, s2 = a2 * inv;
#pragma unroll
    for (int dt = 0; dt < 4; ++dt) {
        const f32x4 ov = o1[dt] * s1 + o2[dt] * s2;
        u32x2 o; o.x = pk2(ov[0], ov[1]); o.y = pk2(ov[2], ov[3]);
        *(u32x2*)(MIX + (size_t)(qtok0 + fr) * 1024 + h * 64 + dt * 16 + fq * 4) = o;
    }
    __syncthreads();
}


#ifdef DBG_NAN
__device__ __forceinline__ bool bad16(bf16_t v) { return ((v >> 7) & 0xFF) >= 227; }
__device__ __forceinline__ bool bad32(float f) { return !(fabsf(f) < 1e30f); }
__device__ __forceinline__ void scan16(const bf16_t* p, size_t n, unsigned* flags, unsigned bit) {
    bool bad = false;
    for (size_t i = (size_t)blockIdx.x * NT + threadIdx.x; i < n; i += (size_t)gridDim.x * NT) bad |= bad16(p[i]);
    if (bad) atomicOr(flags, bit);
}
__device__ __forceinline__ void scan32(const float* p, size_t n, unsigned* flags, unsigned bit) {
    bool bad = false;
    for (size_t i = (size_t)blockIdx.x * NT + threadIdx.x; i < n; i += (size_t)gridDim.x * NT) bad |= bad32(p[i]);
    if (bad) atomicOr(flags, bit);
}
#endif

#define XB_TMO      128
#define XB_XCNT(j)  (256  + 64 * (j))
#define XB_XSUB(j)  (1280 + 64 * (j))
#define XB_XGEN(j)  (2304 + 64 * (j))
#define XB_TOP      3328
#define XB_TOPGEN   3392
#define XCD_BAR_WORDS 3456
#define XB_SPIN_CAP (1u << 20)
#define LAS __attribute__((address_space(3)))
__device__ __forceinline__ unsigned xb_ld(unsigned* p)              { return __hip_atomic_load(p, __ATOMIC_RELAXED, __HIP_MEMORY_SCOPE_AGENT); }
__device__ __forceinline__ unsigned xb_add(unsigned* p, unsigned v) { return __hip_atomic_fetch_add(p, v, __ATOMIC_RELAXED, __HIP_MEMORY_SCOPE_AGENT); }
__device__ __forceinline__ unsigned xb_xcc_id() { return (unsigned)__builtin_amdgcn_s_getreg((3 << 11) | 20) & 0xFu; }
#define XB_SPIN(cond, bar) do { unsigned _sp = 0; while (cond) { __builtin_amdgcn_s_sleep(1); \
    if ((++_sp & 255u) == 0u) { if (xb_ld(&(bar)[XB_TMO])) break; if (_sp > XB_SPIN_CAP) { atomicAdd(&(bar)[XB_TMO], 1u); break; } } } } while (0)
struct XcdBarrier { unsigned* bar; unsigned x; volatile LAS unsigned* st; };
__device__ __forceinline__ XcdBarrier xcd_barrier_post(unsigned* bar, volatile LAS unsigned* st) {
    XcdBarrier b; b.bar = bar; b.x = xb_xcc_id(); b.st = st;
    if (threadIdx.x == 0) (void)xb_add(&bar[XB_XCNT(b.x)], 1u);
    return b;
}
__device__ __forceinline__ void xcd_barrier_complete(unsigned* bar, unsigned x, unsigned& nloc, unsigned& nx) {
    const unsigned G = gridDim.x * gridDim.y * gridDim.z;
    unsigned sum, cnt, mine, sp = 0u;
    for (;;) {
        sum = 0u; cnt = 0u; mine = 0u;
#pragma unroll
        for (unsigned j = 0; j < 16; ++j) { const unsigned c = xb_ld(&bar[XB_XCNT(j)]); sum += c; cnt += (c > 0u) ? 1u : 0u; mine = (j == x) ? c : mine; }
        if (sum == G) break;
        __builtin_amdgcn_s_sleep(1);
        if ((++sp & 255u) == 0u) { if (xb_ld(&bar[XB_TMO])) break; if (sp > XB_SPIN_CAP) { atomicAdd(&bar[XB_TMO], 1u); break; } }
    }
    nloc = mine > 0u ? mine : 1u; nx = cnt > 0u ? cnt : 1u;
}
__device__ __forceinline__ void xcd_barrier(const XcdBarrier& b) {
    asm volatile("s_waitcnt vmcnt(0)" ::: "memory");
    __syncthreads();
    if (threadIdx.x == 0) {
        unsigned* bar = b.bar;
        __builtin_amdgcn_s_waitcnt(0);
        unsigned nloc = b.st[0], nx = b.st[1];
        if (nloc == 0u) { xcd_barrier_complete(bar, b.x, nloc, nx); b.st[0] = nloc; b.st[1] = nx; }
        const unsigned old = xb_add(&bar[XB_XSUB(b.x)], 1u);
        const unsigned gen = old / nloc;
        if (old + 1u == (gen + 1u) * nloc) {
            __builtin_amdgcn_fence(__ATOMIC_RELEASE, "agent");
            asm volatile("s_waitcnt vmcnt(0)" ::: "memory");
            const unsigned og = xb_add(&bar[XB_TOP], 1u);
            const unsigned tg = og / nx;
            if (og + 1u == (tg + 1u) * nx) xb_add(&bar[XB_TOPGEN], 1u);
            else XB_SPIN(xb_ld(&bar[XB_TOPGEN]) == tg, bar);
            __builtin_amdgcn_fence(__ATOMIC_ACQUIRE, "agent");
            xb_add(&bar[XB_XGEN(b.x)], 1u);
            asm volatile("s_waitcnt vmcnt(0)" ::: "memory");
        } else {
            XB_SPIN(xb_ld(&bar[XB_XGEN(b.x)]) == gen, bar);
            __builtin_amdgcn_fence(__ATOMIC_ACQUIRE, "agent");
            asm volatile("s_waitcnt vmcnt(0)" ::: "memory");
        }
    }
    __syncthreads();
}
constexpr size_t WS_BAR = WS_END + 32768;

#ifdef TPROBE_A
#define GSYNC() do { asm volatile("s_waitcnt vmcnt(0) lgkmcnt(0)" ::: "memory"); grid.sync(); ++nsync_; if (nsync_ == TPROBE_A) t0_ = wall_clock64(); if (nsync_ == TPROBE_B) t1_ = wall_clock64(); } while (0)
#else
#define GSYNC() xcd_barrier(xbar_)
#endif
#define GSYNC_CG() do { asm volatile("s_waitcnt vmcnt(0) lgkmcnt(0)" ::: "memory"); grid.sync(); } while (0)
__global__ void __launch_bounds__(NT) fwd_megakernel(Params p) {
    cg::grid_group grid = cg::this_grid();
#ifdef TPROBE_A
    int nsync_ = 0; long long t0_ = 0, t1_ = 0;
#endif
    const int blk = blockIdx.x, G = gridDim.x;
    bf16_t* WIN = (bf16_t*)(p.ws + WS_WIN); bf16_t* WOUT = (bf16_t*)(p.ws + WS_WOUT); bf16_t* WM1 = (bf16_t*)(p.ws + WS_WM1); bf16_t* WM2 = (bf16_t*)(p.ws + WS_WM2);
    bf16_t* ACT = (bf16_t*)(p.ws + WS_ACT); bf16_t* BIG = (bf16_t*)(p.ws + WS_BIG);
    float* XC = (float*)(p.ws + WS_XC);
    const float* MOD = (const float*)(p.ws + WS_MOD);
    volatile LAS unsigned* xst_ = (volatile LAS unsigned*)(dyn_lds + LDS_BYTES - 16);
    if (threadIdx.x == 0) { xst_[0] = 0u; xst_[1] = 0u; }
    __syncthreads();
    const XcdBarrier xbar_ = xcd_barrier_post((unsigned*)(p.ws + WS_BAR), xst_);
    REP(64) if (PHMASK & 1) phase0(p);
#ifdef DBG_NAN
    unsigned* dflags = (unsigned*)(p.ws + WS_END);
    if (blk == 0 && threadIdx.x < 64) dflags[threadIdx.x] = 0u;
#endif
    GSYNC_CG();
#pragma unroll 1
    for (int l = 0; l < 4; ++l) {
        const bool even = !(l & 1), last = (l == 3); const int li = l >> 1;
        const float* xlat = (l == 0) ? p.in[0] : p.out; const float* xctx = (l == 0) ? p.in[2] : XC;
        const int Mtail = last ? NLAT : MTOT;
        REP(1) {
        if (PHMASK & 2) convert_weights(p, l, l == 0 || G < 256, true, 0, G);
        if (PHMASK & 4) norm_phase(p, l, xlat, xctx, 0, 1024, MTOT);
        if ((PHMASK & 8) && even) filter_gen(p, li);
        }
        GSYNC();
        {
            EpiArgs ea{}; ea.o_rm = BIG; ea.ld_rm = even ? 2048 : QK_LD; ea.o_cm = (bf16_t*)(p.ws + (even ? WS_P2 : WS_P2ODD)); ea.ld_cm = even ? MTOT : VT_LD; ea.gates = (float*)(p.ws + WS_GATES); ea.gate_pn = even ? 14 : -1; ea.o_dbg = (bf16_t*)(p.ws + WS_HFB);
            REP(2) if (PHMASK & 16) gemm_phase<EPI_INPROJ>(ACT, WIN, MTOT, even ? 3840 : 3072, 1024, ea);
        }
        GSYNC();
#ifdef DBG_NAN
        if (l == DBG_LAYER) {
            {
                const unsigned gid = blk * NT + threadIdx.x;
                unsigned hsh = gid * 2654435761u + 12345u; hsh ^= hsh >> 13; hsh *= 2246822519u; hsh ^= hsh >> 16;
                const int row = hsh % MTOT; const int col = (hsh >> 8) % 2048; const int ch = (hsh >> 4) % 1536;
                const bf16_t* ar = ACT + (size_t)row * 1024; const bf16_t* wq = WIN + (size_t)col * 1024; const bf16_t* wh = WIN + (size_t)(2048 + ch) * 1024;
                float sq = 0.f, sh_ = 0.f;
                for (int k = 0; k < 1024; ++k) { const float av = b2f(ar[k]); sq += av * b2f(wq[k]); sh_ += av * b2f(wh[k]); }
                const float gq = b2f(BIG[(size_t)row * 2048 + col]);
                const float gh = b2f(((const bf16_t*)(p.ws + WS_P2))[(size_t)ch * MTOT + row]);
                (void)gq; (void)sq;

                { const int cls = DBG_CLS; atomicAdd(dflags + 16 + cls, 1u);
                  if (!(fabsf(gh - sh_) <= 0.05f + 0.02f * fabsf(sh_))) { atomicAdd(dflags + 2, 1u); atomicAdd(dflags + 32 + cls, 1u); } }
            }
            GSYNC();
            if (blk == 0 && threadIdx.x == 0) {
                const float fQ = (float)__hip_atomic_load(dflags + 1, __ATOMIC_RELAXED, __HIP_MEMORY_SCOPE_AGENT) / (float)(G * NT);
                const float fH = (float)__hip_atomic_load(dflags + 2, __ATOMIC_RELAXED, __HIP_MEMORY_SCOPE_AGENT) / (float)(G * NT);
                unsigned mask = 0;
                for (int q_ = 0; q_ < 8; ++q_) { const unsigned tot = __hip_atomic_load(dflags + 16 + q_, __ATOMIC_RELAXED, __HIP_MEMORY_SCOPE_AGENT), bad = __hip_atomic_load(dflags + 32 + q_, __ATOMIC_RELAXED, __HIP_MEMORY_SCOPE_AGENT); if (bad * 4 > tot) mask |= 1u << q_; }
                float code = 1e5f; for (unsigned q_ = 0; q_ < (mask >> 4); ++q_) code *= 10.f;
                const unsigned n3 = __hip_atomic_load(dflags + 3, __ATOMIC_RELAXED, __HIP_MEMORY_SCOPE_AGENT), b1 = __hip_atomic_load(dflags + 1, __ATOMIC_RELAXED, __HIP_MEMORY_SCOPE_AGENT), b4 = __hip_atomic_load(dflags + 4, __ATOMIC_RELAXED, __HIP_MEMORY_SCOPE_AGENT);
                p.out[0] = code * (1.f + 0.5f * (float)(mask & 15)) + 0.f * (fQ + fH + (float)(n3 + b1 + b4));
            }
            return;
        }
#endif
        if (!even) { qknorm_phase(p, li); GSYNC(); }
        if (even) {
            REP(4) if (G >= 256) {
                if (blk < 128) { REP(512) if (PHMASK & 32) mlstm_item(p, li, blk);
                    if (DUPMASK & 1024) { hyena_item<2048>(p, li, 384 + blk, true); hyena_item<256>(p, li, 384 + blk, true); }
                    if (PHMASK & 64) { hyena_item<2048>(p, li, 384 + blk); hyena_item<256>(p, li, 384 + blk); } }
                else { const int hb = blk - 128;
                    if (DUPMASK & 1024) for (int it = hb; it < 384; it += 128) { hyena_item<2048>(p, li, it, true); hyena_item<256>(p, li, it, true); }
                    if (PHMASK & 64) for (int it = hb; it < 384; it += 128) { hyena_item<2048>(p, li, it); hyena_item<256>(p, li, it); } }
            } else {
            }
            GSYNC();
            if (PHMASK & 128) { combine_phase(p, li); hy_transpose(p); }
        } else {
            const int x = blk & 7, y = blk >> 3, ny = (G + 7) >> 3;
            REP(256) for (int i = 0; ; ++i) {
                const int slot = i * ny + y;
                if (slot >= 512) break;
                const int bh = x * 32 + 8 * (i >> 2) + (y >> 2), rp = (y & 3) * 4 + (i & 3);
                if (PHMASK & 256) attn_item<true>(p, li, bh >> 4, bh & 15, rp, (i & 3) == 0 || ny != 32);
            }
            if ((PHMASK & 512) && !last) for (int it = blk; it < 512; it += G) attn_item<false>(p, li, it >> 5, (it >> 1) & 15, it & 1);
        }
        GSYNC();
        {
            EpiArgs ea{}; ea.res_lat = xlat; ea.res_ctx = xctx; ea.out_lat = p.out; ea.out_ctx = XC; ea.modg = MOD + (size_t)l * 17 * 6144 + 2048;
            if (DUPMASK & 32) gemm_phase<EPI_DRY>(ACT, WOUT, Mtail, 1024, 1024, ea);
            if (PHMASK & 1024) gemm_phase<EPI_RESID>(ACT, WOUT, Mtail, 1024, 1024, ea);
        }
        GSYNC();
        REP(8) norm_phase(p, l, p.out, XC, 3072, 4096, Mtail);
        GSYNC();
        { EpiArgs ea{}; ea.o_rm = BIG; ea.ld_rm = 4096; ea.gate_pn = -1; REP(16) if (PHMASK & 2048) gemm_phase<EPI_RELU2>(ACT, WM1, Mtail, 4096, 1024, ea); }
        GSYNC();
        {
            EpiArgs ea{}; ea.res_lat = p.out; ea.res_ctx = XC; ea.out_lat = p.out; ea.out_ctx = XC; ea.modg = MOD + (size_t)l * 17 * 6144 + 5120;
            if (DUPMASK & 32) gemm_phase<EPI_DRY>(BIG, WM2, Mtail, 1024, 4096, ea);
            if (PHMASK & 4096) gemm_phase<EPI_RESID>(BIG, WM2, Mtail, 1024, 4096, ea);
            if (!last && G >= 256) convert_weights(p, l + 1, true, false, 128, G - 128);
        }
        GSYNC();
    }
#ifdef TPROBE_A
    if (blk == 0 && threadIdx.x == 0) p.out[0] = (float)(t1_ - t0_) * 10.f;
#endif
}

extern "C" void kernel_launch(void* const* d_in, const int* in_sizes, int n_in, void* d_out, int out_size, void* d_ws, size_t ws_size, hipStream_t stream) {
    static int grid_blocks = 0;
    if (grid_blocks == 0) {
        if (n_in != 26 || ws_size < WS_BAR + XCD_BAR_WORDS * 4) { fprintf(stderr, "kernel_launch: unexpected n_in %d or ws_size %zu (< %zu)\n", n_in, ws_size, (size_t)WS_END); grid_blocks = -1; return; }
        int dev = 0, cus = 0, per_cu = 0;
        hipGetDevice(&dev);
        hipDeviceGetAttribute(&cus, hipDeviceAttributeMultiprocessorCount, dev);
        if (hipFuncSetAttribute((const void*)fwd_megakernel, hipFuncAttributeMaxDynamicSharedMemorySize, LDS_BYTES) != hipSuccess) fprintf(stderr, "kernel_launch: hipFuncSetAttribute failed\n");
        if (hipOccupancyMaxActiveBlocksPerMultiprocessor(&per_cu, (const void*)fwd_megakernel, NT, LDS_BYTES) != hipSuccess || per_cu < 1) { fprintf(stderr, "kernel_launch: occupancy query gave %d\n", per_cu); per_cu = 1; }
        (void)hipGetLastError();
        grid_blocks = cus * 1;
        fprintf(stderr, "kernel_launch: cus %d per_cu %d grid %d\n", cus, per_cu, grid_blocks);
    }
    if (grid_blocks < 0) return;
    if (hipMemsetAsync((char*)d_ws + WS_BAR, 0, XCD_BAR_WORDS * 4, stream) != hipSuccess) { fprintf(stderr, "kernel_launch: memset of barrier words failed\n"); return; }
    Params p{};
    for (int i = 0; i < 26; ++i) p.in[i] = (const float*)d_in[i];
    p.out = (float*)d_out; p.ws = (unsigned char*)d_ws;
    void* args[] = {&p};
    hipError_t e = hipLaunchCooperativeKernel((void*)fwd_megakernel, dim3(grid_blocks), dim3(NT), args, LDS_BYTES, stream);
    if (e != hipSuccess) fprintf(stderr, "cooperative launch failed: %s (grid %d)\n", hipGetErrorString(e), grid_blocks);
}
```

```cpp
#include <hip/hip_runtime.h>
#include <hip/hip_cooperative_groups.h>
#include <cstdio>
#include <cstdint>
namespace cg = cooperative_groups;

typedef unsigned short bf16_t;
typedef short bf16x8 __attribute__((ext_vector_type(8)));
typedef float f32x4 __attribute__((ext_vector_type(4)));
typedef unsigned u32x4 __attribute__((ext_vector_type(4)));
typedef unsigned u32x2 __attribute__((ext_vector_type(2)));

#define NT 512
#define DBG_LAYER 0
#define DBG_CLS ((((row % 64) / 16) * 2) + ((ch % 32) / 16))
#ifndef PHMASK
#define PHMASK 0xFFFF
#endif
#ifndef DUPMASK
#define DUPMASK 0
#endif
#define REP(bit) for (int rep_ = 0; rep_ < (((DUPMASK) & (bit)) ? 2 : 1); ++rep_)
constexpr int BATCH = 16, SEQ = 2048, DM = 1024, CTXL = 256;
constexpr int NLAT = BATCH * SEQ, NCTX = BATCH * CTXL, MTOT = NLAT + NCTX;
constexpr int DFF = 4096;
constexpr float EPS = 1e-6f;
constexpr int LDS_BYTES = 147456;

constexpr size_t al256(size_t x) { return (x + 255) & ~(size_t)255; }
constexpr size_t WS_WIN = 0;
constexpr size_t WS_WOUT = al256(WS_WIN + (size_t)3840 * 1024 * 2);
constexpr size_t WS_WM1 = al256(WS_WOUT + (size_t)1024 * 1024 * 2);
constexpr size_t WS_WM2 = al256(WS_WM1 + (size_t)4096 * 1024 * 2);
constexpr size_t WS_MOD = al256(WS_WM2 + (size_t)4096 * 1024 * 2);
constexpr size_t WS_XC = al256(WS_MOD + (size_t)4 * 17 * 6144 * 4);
constexpr size_t WS_ACT = al256(WS_XC + (size_t)NCTX * 1024 * 4);
constexpr size_t WS_BIG = al256(WS_ACT + (size_t)MTOT * 1024 * 2);
constexpr size_t WS_P2 = WS_BIG + (size_t)MTOT * 2048 * 2;
constexpr int QK_LD = 2048 + 64;
constexpr int VT_LD = MTOT + 64;
constexpr size_t WS_P2ODD = WS_BIG + (size_t)MTOT * QK_LD * 2;
constexpr size_t WS_GATES = WS_P2 + (size_t)1536 * MTOT * 2;
constexpr size_t WS_HFB = al256(WS_BIG + (size_t)MTOT * 4096 * 2);
constexpr size_t WS_FLAT = al256(WS_HFB + (size_t)2 * MTOT * 512 * 2);
constexpr size_t WS_FCTX = al256(WS_FLAT + (size_t)2 * 512 * 4096 * 2);
constexpr size_t WS_H2 = al256(WS_FCTX + (size_t)2 * 512 * 512 * 2);
constexpr size_t WS_ROPE = al256(WS_H2 + (size_t)2 * 2304 * 64 * 4);
constexpr size_t WS_END = al256(WS_ROPE + (size_t)2 * 64 * 32 * 4);
static_assert(WS_GATES + (size_t)MTOT * 16 * 4 <= WS_HFB, "projection overlay too large");
static_assert(WS_P2ODD + (size_t)1024 * VT_LD * 2 <= WS_HFB, "odd projection overlay too large");

struct Params { const float* in[26]; float* out; unsigned char* ws; };

typedef float f32x2_ __attribute__((ext_vector_type(2)));
typedef __bf16 bf16x2_ __attribute__((ext_vector_type(2)));
__device__ __forceinline__ unsigned pk2(float lo, float hi) { f32x2_ v = {lo, hi}; bf16x2_ b = __builtin_convertvector(v, bf16x2_); return __builtin_bit_cast(unsigned, b); }
__device__ __forceinline__ bf16_t f2b(float x) { return (bf16_t)(pk2(x, 0.f) & 0xffffu); }
__device__ __forceinline__ float b2f(bf16_t b) { return __uint_as_float(((unsigned)b) << 16); }
__device__ __forceinline__ float blo(unsigned w) { return __uint_as_float(w << 16); }
__device__ __forceinline__ float bhi(unsigned w) { return __uint_as_float(w & 0xffff0000u); }
__device__ __forceinline__ void unpack8(u32x4 v, float* f) {
    f[0] = blo(v.x); f[1] = bhi(v.x); f[2] = blo(v.y); f[3] = bhi(v.y); f[4] = blo(v.z); f[5] = bhi(v.z); f[6] = blo(v.w); f[7] = bhi(v.w);
}
__device__ __forceinline__ u32x4 pack8(const float* f) { u32x4 r; r.x = pk2(f[0], f[1]); r.y = pk2(f[2], f[3]); r.z = pk2(f[4], f[5]); r.w = pk2(f[6], f[7]); return r; }
__device__ __forceinline__ float fsin_(float x) { float r = x * 0.15915494309189535f; r -= floorf(r); return __builtin_amdgcn_sinf(r); }
__device__ __forceinline__ float fcos_(float x) { float r = x * 0.15915494309189535f; r -= floorf(r); return __builtin_amdgcn_cosf(r); }
__device__ __forceinline__ float wave_sum(float v) {
#pragma unroll
    for (int o = 1; o < 64; o <<= 1) v += __shfl_xor(v, o);
    return v;
}
__device__ __forceinline__ f32x4 mfma16(bf16x8 a, bf16x8 b, f32x4 c) { return __builtin_amdgcn_mfma_f32_16x16x32_bf16(a, b, c, 0, 0, 0); }
__device__ __forceinline__ bf16x8 as_bf8(u32x4 v) { return __builtin_bit_cast(bf16x8, v); }

extern __shared__ __attribute__((aligned(16))) unsigned char dyn_lds[];
__device__ __forceinline__ int tid_l() { int t = threadIdx.x; asm volatile("" : "+v"(t)); return t; }

constexpr int G_BM = 256, G_BK = 64, G_HALF = 128, G_HT = G_HALF * G_BK;
__device__ __forceinline__ int lds_byte(int r, int c) {
    int st = (r >> 4) * 2 + (c >> 5), rr = r & 15, cc = c & 31, ob = rr * 64 + cc * 2;
    return st * 1024 + (ob ^ (((ob >> 9) & 1) << 5));
}
__device__ __forceinline__ void stage_rc(int b, int& R, int& C) {
    int st = b / 1024, sb = b % 1024, swz = sb ^ (((sb >> 9) & 1) << 5);
    R = (st >> 1) * 16 + swz / 64; C = (st & 1) * 32 + (swz % 64) / 2;
}

enum { EPI_INPROJ = 0, EPI_RESID = 1, EPI_RELU2 = 2, EPI_DRY = 3 };
struct EpiArgs {
    bf16_t* o_rm; int ld_rm;
    bf16_t* o_dbg;
    int ld_cm;
    bf16_t* o_cm;
    float* gates; int gate_pn;
    const float* res_lat; const float* res_ctx; float* out_lat; float* out_ctx; const float* modg;
};

#define WAIT_V_(n) asm volatile("s_waitcnt vmcnt(" #n ")" ::: "memory")
#define WAIT_V(n) WAIT_V_(n)
#ifndef GEMM_SGB
#define GEMM_SGB 0
#endif
#ifndef GEMM_VM
#define GEMM_VM 8
#endif
#define WAIT_L(n) asm volatile("s_waitcnt lgkmcnt(" #n ")" ::: "memory")
#define BAR __builtin_amdgcn_s_barrier()
#define CFENCE asm volatile("" ::: "memory")

template <bool TR, int NAI>
__device__ __forceinline__ void gemm_kloop(const bf16_t* __restrict__ A, const bf16_t* __restrict__ Bt, int K, int brow, int bcol, f32x4 (&acc)[NAI][2][4][2], int kt0, int nt) {
    bf16_t* shm = (bf16_t*)dyn_lds;
#define SA(b, h) (shm + ((b) * 2 + (h)) * G_HT)
#define SB(b, h) (shm + (4 + (b) * 2 + (h)) * G_HT)
    const int tidx = tid_l();
    const int wid = tidx >> 6, lane = tidx & 63, wr = wid >> 2, wc = wid & 3, fr = lane & 15, fq = lane >> 4;
    int goff[2];
#pragma unroll
    for (int i = 0; i < 2; ++i) { int r_, c_; stage_rc(tidx * 16 + i * 8192, r_, c_); goff[i] = r_ * K + c_; }
    const bf16_t* Ab = A + (long)brow * K + kt0 * G_BK; const bf16_t* Bb = Bt + (long)bcol * K + kt0 * G_BK;
#define STAGE2(P, BASEP, kt) do { _Pragma("unroll") for (int _i = 0; _i < 2; ++_i) \
      __builtin_amdgcn_global_load_lds((const unsigned*)((BASEP) + (kt) * G_BK + goff[_i]), (unsigned*)((char*)(P) + tidx * 16 + _i * 8192), 16, 0, 0); } while (0)
    STAGE2(SA(0, 0), Ab, 0); if (NAI == 2) STAGE2(SA(0, 1), Ab + (long)G_HALF * K, 0); STAGE2(SB(0, 0), Bb, 0); STAGE2(SB(0, 1), Bb + (long)G_HALF * K, 0);
    for (int kt = 0; kt < nt; ++kt) {
        const int cur = kt & 1, nxt = cur ^ 1;
        WAIT_V(0); WAIT_L(0);
        BAR; CFENCE;
#define LDBF(dst, k) _Pragma("unroll") for (int bj = 0; bj < 2; ++bj) _Pragma("unroll") for (int n = 0; n < 2; ++n) \
            dst[bj][n] = *reinterpret_cast<const bf16x8*>((char*)SB(cur, bj) + lds_byte(wc * 32 + n * 16 + fr, (k) * 32 + fq * 8))
#define LDAF(dst, ai, k) _Pragma("unroll") for (int m = 0; m < 4; ++m) \
            dst[m] = *reinterpret_cast<const bf16x8*>((char*)SA(cur, ai) + lds_byte(wr * 64 + m * 16 + fr, (k) * 32 + fq * 8))
#define MMAG(ai, Af_, Bf_) _Pragma("unroll") for (int m = 0; m < 4; ++m) _Pragma("unroll") for (int bj = 0; bj < 2; ++bj) _Pragma("unroll") for (int n = 0; n < 2; ++n) \
            acc[ai][bj][m][n] = TR ? mfma16(Bf_[bj][n], Af_[m], acc[ai][bj][m][n]) : mfma16(Af_[m], Bf_[bj][n], acc[ai][bj][m][n])
        bf16x8 B0[2][2], B1[2][2], A0[4], A1[4];
        LDBF(B0, 0); LDAF(A0, 0, 0); if (NAI == 2) { LDAF(A1, 1, 0); }
        if (kt + 1 < nt) {
            STAGE2(SA(nxt, 0), Ab, kt + 1); if (NAI == 2) STAGE2(SA(nxt, 1), Ab + (long)G_HALF * K, kt + 1);
            STAGE2(SB(nxt, 0), Bb, kt + 1); STAGE2(SB(nxt, 1), Bb + (long)G_HALF * K, kt + 1);
        }
        MMAG(0, A0, B0);
        LDBF(B1, 1); LDAF(A0, 0, 1);
        if (NAI == 2) { MMAG(NAI - 1, A1, B0); LDAF(A1, 1, 1); }
        MMAG(0, A0, B1);
        if (NAI == 2) { MMAG(NAI - 1, A1, B1); }
#if GEMM_SGB
        __builtin_amdgcn_sched_group_barrier(0x100, 12, 0);
        __builtin_amdgcn_sched_group_barrier(0x020, 8, 0);
        __builtin_amdgcn_sched_group_barrier(0x008, 16, 0);
        __builtin_amdgcn_sched_group_barrier(0x100, 8, 0);
        __builtin_amdgcn_sched_group_barrier(0x008, 16, 0);
        __builtin_amdgcn_sched_group_barrier(0x100, 4, 0);
        __builtin_amdgcn_sched_group_barrier(0x008, 32, 0);
#endif
    }
    WAIT_L(0); BAR; CFENCE;
}

template <int EPI, int NAI>
__device__ __forceinline__ void gemm_tile(const bf16_t* A, const bf16_t* Bt, int K, int brow, int bcol, int pn, const EpiArgs& ea, int wr, int wc, int fr, int fq) {
        constexpr bool SPLITTAIL = false; const int kq = -1, kt0 = 0, ntl = K / G_BK; (void)kq;
        f32x4 acc[NAI][2][4][2];
#pragma unroll
        for (int a = 0; a < NAI; ++a)
#pragma unroll
            for (int b = 0; b < 2; ++b)
#pragma unroll
                for (int m = 0; m < 4; ++m)
#pragma unroll
                    for (int n = 0; n < 2; ++n) acc[a][b][m][n] = (f32x4){0.f, 0.f, 0.f, 0.f};
        const bool colmajor = (EPI == EPI_INPROJ) && pn >= 8 && pn != ea.gate_pn;
        if (colmajor) {
            gemm_kloop<true, NAI>(A, Bt, K, brow, bcol, acc, kt0, ntl);
#pragma unroll
            for (int ai = 0; ai < NAI; ++ai)
#pragma unroll
                for (int bj = 0; bj < 2; ++bj)
#pragma unroll
                    for (int m = 0; m < 4; ++m)
#pragma unroll
                        for (int n = 0; n < 2; ++n) {
                            const int row = brow + ai * 128 + wr * 64 + m * 16 + fr, col = bcol + bj * 128 + wc * 32 + n * 16 + fq * 4;
                            const f32x4 v = acc[ai][bj][m][n];
#pragma unroll
                            for (int j = 0; j < 4; ++j) ea.o_cm[(size_t)(col + j - 2048) * ea.ld_cm + row] = f2b(v[j]);
                        }
        } else if (EPI == EPI_RESID) {
            gemm_kloop<true, NAI>(A, Bt, K, brow, bcol, acc, kt0, ntl);
            const bool lat = brow < NLAT;
            const int mrow = lat ? brow >> 11 : 16;
            const float* rbase = lat ? ea.res_lat + (size_t)brow * 1024 : ea.res_ctx + (size_t)(brow - NLAT) * 1024;
            float* obase = lat ? ea.out_lat + (size_t)brow * 1024 : ea.out_ctx + (size_t)(brow - NLAT) * 1024;
            f32x4 g[2][2];
#pragma unroll
            for (int bj = 0; bj < 2; ++bj)
#pragma unroll
                for (int n = 0; n < 2; ++n) g[bj][n] = *(const f32x4*)(ea.modg + (size_t)mrow * 6144 + bcol + bj * 128 + wc * 32 + n * 16 + fq * 4);
            if (SPLITTAIL && kq >= 0) {
#pragma unroll
                for (int ai = 0; ai < NAI; ++ai)
#pragma unroll
                    for (int m = 0; m < 4; ++m)
#pragma unroll
                        for (int bj = 0; bj < 2; ++bj)
#pragma unroll
                            for (int n = 0; n < 2; ++n) {
                                float* op = obase + (size_t)(ai * 128 + wr * 64 + m * 16 + fr) * 1024 + bcol + bj * 128 + wc * 32 + n * 16 + fq * 4;
                                const f32x4 dv = g[bj][n] * acc[ai][bj][m][n];
#pragma unroll
                                for (int j = 0; j < 4; ++j) unsafeAtomicAdd(op + j, dv[j]);
                            }
            } else
#pragma unroll
            for (int ai = 0; ai < NAI; ++ai) {
                f32x4 xv[4][2][2];
#pragma unroll
                for (int m = 0; m < 4; ++m)
#pragma unroll
                    for (int bj = 0; bj < 2; ++bj)
#pragma unroll
                        for (int n = 0; n < 2; ++n)
                            xv[m][bj][n] = *(const f32x4*)(rbase + (size_t)(ai * 128 + wr * 64 + m * 16 + fr) * 1024 + bcol + bj * 128 + wc * 32 + n * 16 + fq * 4);
#pragma unroll
                for (int m = 0; m < 4; ++m)
#pragma unroll
                    for (int bj = 0; bj < 2; ++bj)
#pragma unroll
                        for (int n = 0; n < 2; ++n)
                            *(f32x4*)(obase + (size_t)(ai * 128 + wr * 64 + m * 16 + fr) * 1024 + bcol + bj * 128 + wc * 32 + n * 16 + fq * 4) = xv[m][bj][n] + g[bj][n] * acc[ai][bj][m][n];
            }
        } else {
            gemm_kloop<true, NAI>(A, Bt, K, brow, bcol, acc, kt0, ntl);
#pragma unroll
            for (int ai = 0; ai < NAI; ++ai)
#pragma unroll
                for (int m = 0; m < 4; ++m) {
                    const int row = brow + ai * 128 + wr * 64 + m * 16 + fr;
#pragma unroll
                    for (int bj = 0; bj < 2; ++bj)
#pragma unroll
                        for (int n = 0; n < 2; ++n) {
                            const int col = bcol + bj * 128 + wc * 32 + n * 16 + fq * 4;
                            const f32x4 v = acc[ai][bj][m][n];
                            if (EPI == EPI_INPROJ) {
                                if (pn == ea.gate_pn) {
                                    if (bj == 0 && wc == 0 && n == 0) *(f32x4*)(ea.gates + (size_t)row * 16 + fq * 4) = v;
                                } else {
                                    u32x2 o; o.x = pk2(v[0], v[1]); o.y = pk2(v[2], v[3]);
                                    *(u32x2*)(ea.o_rm + (size_t)row * ea.ld_rm + col) = o;
                                }
                            } else if (EPI == EPI_DRY) {
                                if (v[0] == 123456.789f && v[1] == 3.25f) *(f32x4*)(ea.out_lat + (size_t)row * 1024 + (col & 1023)) = v;
                            } else if (EPI == EPI_RELU2) {
                                float r0 = fmaxf(v[0], 0.f), r1 = fmaxf(v[1], 0.f), r2 = fmaxf(v[2], 0.f), r3 = fmaxf(v[3], 0.f);
                                u32x2 o; o.x = pk2(r0 * r0, r1 * r1); o.y = pk2(r2 * r2, r3 * r3);
                                *(u32x2*)(ea.o_rm + (size_t)row * ea.ld_rm + col) = o;
                            } else {
                                const float* rp; float* op; int mrow;
                                if (row < NLAT) { rp = ea.res_lat + (size_t)row * 1024 + col; op = ea.out_lat + (size_t)row * 1024 + col; mrow = row >> 11; }
                                else { rp = ea.res_ctx + (size_t)(row - NLAT) * 1024 + col; op = ea.out_ctx + (size_t)(row - NLAT) * 1024 + col; mrow = 16; }
                                const f32x4 g = *(const f32x4*)(ea.modg + (size_t)mrow * 6144 + col);
                                const f32x4 x = *(const f32x4*)rp;
                                f32x4 rr = x + g * v;
#ifdef SANITIZE
#pragma unroll
                                for (int q_ = 0; q_ < 4; ++q_) if (!(fabsf(rr[q_]) < 1e30f)) rr[q_] = 0.f;
#endif
                                *(f32x4*)op = rr;
                            }
                        }
                }
        }
        asm volatile("s_waitcnt vmcnt(0)" ::: "memory");
        __syncthreads();
}

template <int EPI, bool HALFTAIL = true>
__device__ __forceinline__ void gemm_phase(const bf16_t* A, const bf16_t* Bt, int M, int N, int K, const EpiArgs& ea) {
    const int nM = M / G_BM, nN = N / G_BM, nwg = nM * nN, G_ = gridDim.x;
    const int tidx = tid_l(); const int wid = tidx >> 6, lane = tidx & 63, wr = wid >> 2, wc = wid & 3, fr = lane & 15, fq = lane >> 4;
    int nfull = nwg;
    if (HALFTAIL) { const int rem = nwg % G_; if (rem > 0 && rem * 2 <= G_) nfull = nwg - rem; }
    const int nunits = nfull + (nwg - nfull) * 2;
    for (int U = blockIdx.x; U < nunits; U += G_) {
        const int L = U < nfull ? U : nfull + ((U - nfull) >> 1);
        const int half = U < nfull ? -1 : ((U - nfull) & 1);
        int wgid = L;
        { int q = nwg / 8, r = nwg % 8, xcd = wgid % 8, off = wgid / 8; wgid = (xcd < r ? xcd * (q + 1) : r * (q + 1) + (xcd - r) * q) + off; }
        const int nig = 8 * nN, gid = wgid / nig, fm = gid * 8, gsz = min(nM - fm, 8);
        const int pm = fm + ((wgid % nig) % gsz), pn = (wgid % nig) / gsz, bcol = pn * G_BM;
        if (half < 0) gemm_tile<EPI, 2>(A, Bt, K, pm * G_BM, bcol, pn, ea, wr, wc, fr, fq);
        else gemm_tile<EPI, 1>(A, Bt, K, pm * G_BM + half * 128, bcol, pn, ea, wr, wc, fr, fq);
    }
}

__device__ __forceinline__ void phase0(const Params& p) {
    const int tid = tid_l(), blk = blockIdx.x, nb = gridDim.x;
    float* MOD = (float*)(p.ws + WS_MOD);
    for (int it = blk; it < 193; it += nb) {
        if (it < 192) {
            float* sl = (float*)dyn_lds;
            float* red = sl + 17 * 1024;
            for (int i = tid; i < 17 * 1024; i += NT) { float v = (i < 16 * 1024) ? p.in[1][i] : p.in[3][i - 16 * 1024]; sl[i] = v / (1.f + __expf(-v)); }
            __syncthreads();
            const int l = it / 48, nc = it % 48, kp = tid >> 7, col = tid & 127;
            const float* W = p.in[4] + (size_t)l * 1024 * 6144 + nc * 128 + col;
            float acc[17];
#pragma unroll
            for (int r = 0; r < 17; ++r) acc[r] = 0.f;
            for (int k = kp * 256; k < kp * 256 + 256; ++k) {
                const float wv = W[(size_t)k * 6144];
#pragma unroll
                for (int r = 0; r < 17; ++r) acc[r] += sl[r * 1024 + k] * wv;
            }
#pragma unroll
            for (int r = 0; r < 17; ++r) red[(kp * 17 + r) * 128 + col] = acc[r];
            __syncthreads();
            for (int i = tid; i < 17 * 128; i += NT) {
                const int r = i >> 7, cc = i & 127;
                const float s = red[(0 * 17 + r) * 128 + cc] + red[(1 * 17 + r) * 128 + cc] + red[(2 * 17 + r) * 128 + cc] + red[(3 * 17 + r) * 128 + cc];
                MOD[((size_t)l * 17 + r) * 6144 + nc * 128 + cc] = s + p.in[5][l * 6144 + nc * 128 + cc];
            }
            __syncthreads();
        } else {
            float* ROPE = (float*)(p.ws + WS_ROPE);
            for (int i = tid; i < 2048; i += NT) {
                const int pos = i >> 5, j = i & 31;
                const float inv = exp2f(-(float)j * (13.287712379549449f / 32.f));
                const float ang = (float)pos * inv;
                ROPE[i] = fcos_(ang); ROPE[2048 + i] = fsin_(ang);
            }
        }
    }
    float* H2 = (float*)(p.ws + WS_H2);
    const int gw = blk * 8 + (tid >> 6), lane = tid & 63;
    for (int it = gw; it < 2 * 2304; it += nb * 8) {
        const int i = it / 2304, row = it % 2304;
        const int L = row < 2048 ? 2048 : 256, t = row < 2048 ? row : row - 2048;
        const float tn = (float)t / (float)(L - 1);
        const float wpos = 6.283185307179586f * (float)t / (float)L;
        float ev = 0.f;
        if (lane == 0) ev = tn;
        else if (lane <= 16) { const float fr = 1e-4f + (float)(lane - 1) * ((15.f - 1e-4f) / 15.f); ev = fcos_(wpos * fr); }
        else if (lane <= 32) { const float fr = 1e-4f + (float)(lane - 17) * ((15.f - 1e-4f) / 15.f); ev = -fsin_(wpos * fr); }
        const float* w1 = p.in[13] + i * 33 * 64; const float* b1 = p.in[14] + i * 64;
        const float* w2 = p.in[15] + i * 64 * 64; const float* b2 = p.in[16] + i * 64; const float* fq = p.in[18] + i * 64;
        float a = b1[lane];
        for (int e = 0; e < 33; ++e) a += __shfl(ev, e) * w1[e * 64 + lane];
        const float h1 = fsin_(fq[lane] * a);
        float a2 = b2[lane];
        for (int e = 0; e < 64; ++e) a2 += __shfl(h1, e) * w2[e * 64 + lane];
        H2[((size_t)i * 2304 + row) * 64 + lane] = fsin_(fq[lane] * a2);
    }
}

__device__ __forceinline__ void cvt_tile(const float* W, int N, int K, bf16_t* WT, int n0, int k0, int mapmode) {
    float* tl = (float*)dyn_lds;
    const int tid = tid_l(), nl = tid & 63, kb = tid >> 6;
    const int n = n0 + nl; int sc = n;
    if (mapmode == 1) sc = n < 2048 ? n : (n < 3584 ? n + 16 : (n < 3600 ? n - 3584 + 2048 : -1));
#pragma unroll
    for (int i = 0; i < 8; ++i) { const int kl = kb + 8 * i; tl[kl * 65 + nl] = sc >= 0 ? W[(size_t)(k0 + kl) * N + sc] : 0.f; }
    __syncthreads();
    const int nn = tid >> 3, kc = tid & 7;
    float f[8];
#pragma unroll
    for (int j = 0; j < 8; ++j) f[j] = tl[(kc * 8 + j) * 65 + nn];
    *(u32x4*)(WT + (size_t)(n0 + nn) * K + k0 + kc * 8) = pack8(f);
    __syncthreads();
}

__device__ __forceinline__ void convert_weights(const Params& p, int l, bool first_part, bool second_part, int bstart, int bcount) {
    const int blk = (int)blockIdx.x - bstart, nb = bcount, li = l >> 1; const bool even = !(l & 1);
    if (blk < 0 || blk >= bcount) return;
    const int nin = even ? 60 : 48;
    const int t_in = nin * 16, t_out = 256, t_m1 = 1024, t_m2 = 1024;
    const int it0 = first_part ? 0 : t_in + t_out + t_m1, it1 = second_part ? t_in + t_out + t_m1 + t_m2 : t_in + t_out + t_m1;
    for (int it = it0 + blk; it < it1; it += nb) {
        int r = it;
        if (r < t_in) {
            const int nt = r / 16, kt = r % 16;
            if (even) cvt_tile(p.in[8] + (size_t)li * 1024 * 3600, 3600, 1024, (bf16_t*)(p.ws + WS_WIN), nt * 64, kt * 64, 1);
            else cvt_tile(p.in[21] + (size_t)li * 1024 * 3072, 3072, 1024, (bf16_t*)(p.ws + WS_WIN), nt * 64, kt * 64, 0);
            continue;
        }
        r -= t_in;
        if (r < t_out) {
            const int nt = r / 16, kt = r % 16;
            cvt_tile((even ? p.in[20] : p.in[25]) + (size_t)li * 1024 * 1024, 1024, 1024, (bf16_t*)(p.ws + WS_WOUT), nt * 64, kt * 64, 0);
            continue;
        }
        r -= t_out;
        if (r < t_m1) {
            const int nt = r / 16, kt = r % 16;
            cvt_tile(p.in[6] + (size_t)l * 1024 * 4096, 4096, 1024, (bf16_t*)(p.ws + WS_WM1), nt * 64, kt * 64, 0);
            continue;
        }
        r -= t_m1;
        { const int nt = r / 64, kt = r % 64;
          cvt_tile(p.in[7] + (size_t)l * 4096 * 1024, 1024, 4096, (bf16_t*)(p.ws + WS_WM2), nt * 64, kt * 64, 0); }
    }
}

__device__ __forceinline__ void norm_phase(const Params& p, int l, const float* xlat, const float* xctx, int shoff, int scoff, int M) {
    const int tid = tid_l(), lane = tid & 63, gw = blockIdx.x * 8 + (tid >> 6), ngw = gridDim.x * 8;
    const float* MOD = (const float*)(p.ws + WS_MOD) + (size_t)l * 17 * 6144;
    bf16_t* ACT = (bf16_t*)(p.ws + WS_ACT);
    for (int row = gw; row < M; row += ngw) {
        const float* xr = row < NLAT ? xlat + (size_t)row * 1024 : xctx + (size_t)(row - NLAT) * 1024;
        const int mrow = row < NLAT ? row >> 11 : 16;
        const float* mod = MOD + (size_t)mrow * 6144;
        f32x4 v[4]; float ss = 0.f;
#pragma unroll
        for (int j = 0; j < 4; ++j) { v[j] = *(const f32x4*)(xr + 4 * lane + 256 * j); ss += v[j][0] * v[j][0] + v[j][1] * v[j][1] + v[j][2] * v[j][2] + v[j][3] * v[j][3]; }
        ss = wave_sum(ss);
        const float rstd = rsqrtf(ss * (1.f / 1024.f) + EPS);
#pragma unroll
        for (int j = 0; j < 4; ++j) {
            const int col = 4 * lane + 256 * j;
            const f32x4 sh = *(const f32x4*)(mod + shoff + col), sc = *(const f32x4*)(mod + scoff + col);
            const f32x4 y = v[j] * rstd * (sc + 1.f) + sh;
            u32x2 o; o.x = pk2(y[0], y[1]); o.y = pk2(y[2], y[3]);
            *(u32x2*)(ACT + (size_t)row * 1024 + col) = o;
        }
    }
}

__device__ __forceinline__ void filter_gen(const Params& p, int li) {
    const int tid = tid_l(), lane = tid & 63, w = tid >> 6;
    float* wf = (float*)dyn_lds; float* wb = wf + 64; float* red = wb + 64;
    const float* H2 = (const float*)(p.ws + WS_H2);
    for (int it = blockIdx.x; it < 2048; it += gridDim.x) {
        const int ltype = it >> 10, o = (it >> 9) & 1, c = it & 511;
        const int L = ltype ? 256 : 2048;
        const float* H2r = H2 + ((size_t)li * 2304 + (ltype ? 2048 : 0)) * 64;
        const float* w3 = p.in[17] + (size_t)li * 64 * 2048;
        if (tid < 64) wf[tid] = w3[tid * 2048 + (o * 2 + 0) * 512 + c];
        else if (tid < 128) wb[tid - 64] = w3[(tid - 64) * 2048 + (o * 2 + 1) * 512 + c];
        __syncthreads();
        const float lo = -4.605170185988091f / 1.5f, hi = -4.605170185988091f / 0.3f;
        const float delta = fabsf(lo + (hi - lo) * (float)c / 511.f);
        float vf[4], vb[4]; float ssf = 0.f, ssb = 0.f;
#pragma unroll
        for (int q = 0; q < 4; ++q) {
            const int t = tid + 512 * q; vf[q] = 0.f; vb[q] = 0.f;
            if (t < L) {
                float df = 0.f, db = 0.f;
                const f32x4* hr = (const f32x4*)(H2r + (size_t)t * 64);
#pragma unroll
                for (int j = 0; j < 16; ++j) { const f32x4 hv = hr[j];
                    df += hv[0] * wf[4 * j] + hv[1] * wf[4 * j + 1] + hv[2] * wf[4 * j + 2] + hv[3] * wf[4 * j + 3];
                    db += hv[0] * wb[4 * j] + hv[1] * wb[4 * j + 1] + hv[2] * wb[4 * j + 2] + hv[3] * wb[4 * j + 3]; }
                const float dec = __expf(-((float)t / (float)(L - 1)) * delta);
                vf[q] = df * dec; vb[q] = db * dec; ssf += vf[q] * vf[q]; ssb += vb[q] * vb[q];
            }
        }
        ssf = wave_sum(ssf); ssb = wave_sum(ssb);
        if (lane == 0) { red[w] = ssf; red[8 + w] = ssb; }
        __syncthreads();
        float tf = 0.f, tb = 0.f;
#pragma unroll
        for (int i = 0; i < 8; ++i) { tf += red[i]; tb += red[8 + i]; }
        const float nf = rsqrtf(tf + EPS), nbk = rsqrtf(tb + EPS);
        bf16_t* dst = ltype ? (bf16_t*)(p.ws + WS_FCTX) + ((size_t)o * 512 + c) * 512 : (bf16_t*)(p.ws + WS_FLAT) + ((size_t)o * 512 + c) * 4096;
#pragma unroll
        for (int q = 0; q < 4; ++q) {
            const int t = tid + 512 * q;
            if (t < L) {
                if (t == 0) { dst[L] = f2b(vf[q] * nf + vb[q] * nbk); dst[0] = 0; }
                else { dst[L + t] = f2b(vf[q] * nf); dst[L - t] = f2b(vb[q] * nbk); }
            }
        }
        __syncthreads();
    }
}

__device__ __forceinline__ void mlstm_item(const Params& p, int li, int it) {
    const int tid = tid_l(), w = tid >> 6, lane = tid & 63, fr = lane & 15, fq = lane >> 4;
    const int b = it >> 3, h = (it >> 1) & 3, dir = it & 1;
    bf16_t* Qs = (bf16_t*)dyn_lds;
    bf16_t* Ks = Qs + 64 * 136;
    bf16_t* KT = Ks + 64 * 136;
    bf16_t* VT = KT + 128 * 72;
    bf16_t* Cb = VT + 144 * 72;
    bf16_t* Ps = Cb + 144 * 136;
    float* fl = (float*)(Ps + 64 * 72);
    float* a_s = fl; float* Mt = fl + 64; float* scs = fl + 128; float* emt = fl + 192; float* den = fl + 256; float* lfs = fl + 320; float* igs = fl + 384; float* scal = fl + 448;
    const bf16_t* QKVO = (const bf16_t*)(p.ws + WS_BIG);
    const float* GATES = (const float*)(p.ws + WS_GATES);
    bf16_t* HFB = (bf16_t*)(p.ws + WS_HFB) + (size_t)dir * MTOT * 512;
    const float* ROPE = (const float*)(p.ws + WS_ROPE);
    const float* gate_b = p.in[9] + li * 16;
    for (int i = tid; i < 144 * 136 / 2; i += NT) ((unsigned*)Cb)[i] = 0u;
    for (int i = tid; i < 16 * 72; i += NT) { const int r = i / 72, ci = i % 72; VT[(128 + r) * 72 + ci] = (r == 0 && ci < 64) ? (bf16_t)0x3F80 : (bf16_t)0; }
    f32x4 cacc[9];
#pragma unroll
    for (int i = 0; i < 9; ++i) cacc[i] = (f32x4){0.f, 0.f, 0.f, 0.f};
    float m = 0.f;
    __syncthreads();
    for (int step = 0; step < 36; ++step) {
        const bool isctx = step < 4;
        const int cj = isctx ? (dir ? 3 - step : step) : (dir ? 35 - step : step - 4);
        const int rowbase = isctx ? NLAT + b * 256 + cj * 64 : b * 2048 + cj * 64;
        {
            const int r = tid >> 3, seg = tid & 7; const int tl = dir ? 63 - r : r;
            const bf16_t* src = QKVO + (size_t)(rowbase + tl) * 2048 + h * 128;
            const int hb = seg >> 2, jb = (seg & 3) * 8, d1 = hb * 64 + jb, d2 = d1 + 32;
            const u32x4 q1 = *(const u32x4*)(src + d1), q2 = *(const u32x4*)(src + d2);
            const u32x4 k1 = *(const u32x4*)(src + 512 + d1), k2 = *(const u32x4*)(src + 512 + d2);
            const u32x4 v1 = *(const u32x4*)(src + 1024 + seg * 16), v2 = *(const u32x4*)(src + 1024 + seg * 16 + 8);
            float cs[8], sn[8];
            if (!isctx) {
                const int pos = hb ? tl : cj;
                const f32x4 c0 = *(const f32x4*)(ROPE + pos * 32 + jb), c1 = *(const f32x4*)(ROPE + pos * 32 + jb + 4);
                const f32x4 s0 = *(const f32x4*)(ROPE + 2048 + pos * 32 + jb), s1 = *(const f32x4*)(ROPE + 2048 + pos * 32 + jb + 4);
#pragma unroll
                for (int e = 0; e < 4; ++e) { cs[e] = c0[e]; cs[4 + e] = c1[e]; sn[e] = s0[e]; sn[4 + e] = s1[e]; }
            } else {
#pragma unroll
                for (int e = 0; e < 8; ++e) { cs[e] = 1.f; sn[e] = 0.f; }
            }
            float x1[8], x2[8], o1[8], o2[8];
            unpack8(q1, x1); unpack8(q2, x2);
#pragma unroll
            for (int e = 0; e < 8; ++e) { o1[e] = x1[e] * cs[e] - x2[e] * sn[e]; o2[e] = x1[e] * sn[e] + x2[e] * cs[e]; }
            *(u32x4*)(Qs + r * 136 + d1) = pack8(o1); *(u32x4*)(Qs + r * 136 + d2) = pack8(o2);
            unpack8(k1, x1); unpack8(k2, x2);
            const float ksc = 0.08838834764831845f;
#pragma unroll
            for (int e = 0; e < 8; ++e) { o1[e] = (x1[e] * cs[e] - x2[e] * sn[e]) * ksc; o2[e] = (x1[e] * sn[e] + x2[e] * cs[e]) * ksc; }
            const u32x4 ko1 = pack8(o1), ko2 = pack8(o2);
            *(u32x4*)(Ks + r * 136 + d1) = ko1; *(u32x4*)(Ks + r * 136 + d2) = ko2;
            {
                const unsigned kw1[4] = {ko1.x, ko1.y, ko1.z, ko1.w}, kw2[4] = {ko2.x, ko2.y, ko2.z, ko2.w};
#pragma unroll
                for (int e = 0; e < 4; ++e) {
                    KT[(d1 + 2 * e) * 72 + r] = (bf16_t)(kw1[e] & 0xffffu); KT[(d1 + 2 * e + 1) * 72 + r] = (bf16_t)(kw1[e] >> 16);
                    KT[(d2 + 2 * e) * 72 + r] = (bf16_t)(kw2[e] & 0xffffu); KT[(d2 + 2 * e + 1) * 72 + r] = (bf16_t)(kw2[e] >> 16);
                }
                const unsigned vw1[4] = {v1.x, v1.y, v1.z, v1.w}, vw2[4] = {v2.x, v2.y, v2.z, v2.w};
#pragma unroll
                for (int e = 0; e < 4; ++e) {
                    VT[(seg * 16 + 2 * e) * 72 + r] = (bf16_t)(vw1[e] & 0xffffu); VT[(seg * 16 + 2 * e + 1) * 72 + r] = (bf16_t)(vw1[e] >> 16);
                    VT[(seg * 16 + 8 + 2 * e) * 72 + r] = (bf16_t)(vw2[e] & 0xffffu); VT[(seg * 16 + 8 + 2 * e + 1) * 72 + r] = (bf16_t)(vw2[e] >> 16);
                }
            }
            if (tid < 64) {
                const int rr = tid, tl2 = dir ? 63 - rr : rr;
                const float* g = GATES + (size_t)(rowbase + tl2) * 16;
                const float ig = g[dir * 8 + h] + gate_b[dir * 8 + h];
                const float fg = g[dir * 8 + 4 + h] + gate_b[dir * 8 + 4 + h];
                igs[rr] = ig; lfs[rr] = fminf(fg, 0.f) - __logf(1.f + __expf(-fabsf(fg)));
            }
        }
        __syncthreads();
        if (w == 0) {
            float bcs = lfs[lane];
#pragma unroll
            for (int o = 1; o < 64; o <<= 1) { const float t = __shfl_up(bcs, o); if (lane >= o) bcs += t; }
            const float a = igs[lane] - bcs;
            float pm = a;
#pragma unroll
            for (int o = 1; o < 64; o <<= 1) { const float t = __shfl_up(pm, o); if (lane >= o) pm = fmaxf(pm, t); }
            const float Mx = fmaxf(m, pm);
            a_s[lane] = a; Mt[lane] = Mx; scs[lane] = __expf(m - Mx); emt[lane] = __expf(-bcs - Mx);
            if (lane == 63) { scal[0] = bcs; scal[1] = Mx; }
        }
        {
            const int st = w & 3, tt0 = (w >> 2) * 2;
            f32x4 sacc[2];
#pragma unroll
            for (int u = 0; u < 2; ++u) {
                sacc[u] = (f32x4){0.f, 0.f, 0.f, 0.f};
#pragma unroll
                for (int kk = 0; kk < 4; ++kk) {
                    const bf16x8 Ak = *(const bf16x8*)(Ks + (st * 16 + fr) * 136 + kk * 32 + fq * 8);
                    const bf16x8 Bq = *(const bf16x8*)(Qs + ((tt0 + u) * 16 + fr) * 136 + kk * 32 + fq * 8);
                    sacc[u] = mfma16(Ak, Bq, sacc[u]);
                }
            }
            __syncthreads();
#pragma unroll
            for (int u = 0; u < 2; ++u) {
                const int t = (tt0 + u) * 16 + fr, sb = st * 16 + fq * 4;
                const float Mv = Mt[t];
                float pv[4];
#pragma unroll
                for (int j = 0; j < 4; ++j) { const int s = sb + j; pv[j] = (s <= t) ? sacc[u][j] * __expf(a_s[s] - Mv) : 0.f; }
                u32x2 o; o.x = pk2(pv[0], pv[1]); o.y = pk2(pv[2], pv[3]);
                *(u32x2*)(Ps + t * 72 + sb) = o;
            }
        }
        __syncthreads();
        {
            const int tt = w & 3, up = w >> 2, vt0 = up ? 5 : 0, nvt = up ? 4 : 5;
            bf16x8 qf[4], pf[2];
#pragma unroll
            for (int kk = 0; kk < 4; ++kk) qf[kk] = *(const bf16x8*)(Qs + (tt * 16 + fr) * 136 + kk * 32 + fq * 8);
#pragma unroll
            for (int kk = 0; kk < 2; ++kk) pf[kk] = *(const bf16x8*)(Ps + (tt * 16 + fr) * 72 + kk * 32 + fq * 8);
            const float sct = scs[tt * 16 + fr];
            f32x4 hacc[5];
#pragma unroll
            for (int vi = 0; vi < 5; ++vi) {
                hacc[vi] = (f32x4){0.f, 0.f, 0.f, 0.f};
                if (vi < nvt) {
                    const int v0 = (vt0 + vi) * 16;
                    f32x4 ac = (f32x4){0.f, 0.f, 0.f, 0.f};
#pragma unroll
                    for (int kk = 0; kk < 4; ++kk) ac = mfma16(*(const bf16x8*)(Cb + (v0 + fr) * 136 + kk * 32 + fq * 8), qf[kk], ac);
                    ac = ac * sct;
#pragma unroll
                    for (int kk = 0; kk < 2; ++kk) ac = mfma16(*(const bf16x8*)(VT + (v0 + fr) * 72 + kk * 32 + fq * 8), pf[kk], ac);
                    hacc[vi] = ac;
                }
            }
            if (up && fq == 0) den[tt * 16 + fr] = hacc[3][0];
            __syncthreads();
            const int t = tt * 16 + fr, tl = dir ? 63 - t : t;
            const float dn = den[t];
            const float inv = 1.f / fmaxf(fabsf(dn), emt[t]);
            bf16_t* orow = HFB + (size_t)(rowbase + tl) * 512 + h * 128;
#pragma unroll
            for (int vi = 0; vi < 5; ++vi) {
                if (vi < nvt && (vt0 + vi) < 8) {
                    const int v0 = (vt0 + vi) * 16 + fq * 4;
                    u32x2 o; o.x = pk2(hacc[vi][0] * inv, hacc[vi][1] * inv); o.y = pk2(hacc[vi][2] * inv, hacc[vi][3] * inv);
                    *(u32x2*)(orow + v0) = o;
                }
            }
        }
        {
            const float bl = scal[0], M63 = scal[1];
            const float decay = __expf(m - M63);
            bf16x8 ka[2];
#pragma unroll
            for (int kk = 0; kk < 2; ++kk) {
                const u32x4 raw = *(const u32x4*)(KT + (w * 16 + fr) * 72 + kk * 32 + fq * 8);
                float f[8]; unpack8(raw, f);
#pragma unroll
                for (int j = 0; j < 8; ++j) f[j] *= __expf(a_s[kk * 32 + fq * 8 + j] - M63);
                ka[kk] = as_bf8(pack8(f));
            }
#pragma unroll
            for (int vt = 0; vt < 9; ++vt) {
                f32x4 ac = cacc[vt] * decay;
#pragma unroll
                for (int kk = 0; kk < 2; ++kk) ac = mfma16(ka[kk], *(const bf16x8*)(VT + (vt * 16 + fr) * 72 + kk * 32 + fq * 8), ac);
                cacc[vt] = ac;
                u32x2 o; o.x = pk2(ac[0], ac[1]); o.y = pk2(ac[2], ac[3]);
                *(u32x2*)(Cb + (vt * 16 + fr) * 136 + w * 16 + fq * 4) = o;
            }
            m = bl + M63;
        }
        __syncthreads();
    }
}

__device__ __forceinline__ void combine_phase(const Params& p, int li) {
    const int tid = tid_l(), lane = tid & 63, gw = blockIdx.x * 8 + (tid >> 6), ngw = gridDim.x * 8;
    const bf16_t* HF = (const bf16_t*)(p.ws + WS_HFB); const bf16_t* HB = HF + (size_t)MTOT * 512;
    const bf16_t* QKVO = (const bf16_t*)(p.ws + WS_BIG);
    bf16_t* MIX = (bf16_t*)(p.ws + WS_ACT);
    const float* hn = p.in[10] + li * 512 + lane * 8;
    float g[8];
#pragma unroll
    for (int e = 0; e < 8; ++e) g[e] = hn[e];
    for (int row = gw; row < MTOT; row += ngw) {
        float a[8], bq[8], og[8], y[8];
        unpack8(*(const u32x4*)(HF + (size_t)row * 512 + lane * 8), a);
        unpack8(*(const u32x4*)(HB + (size_t)row * 512 + lane * 8), bq);
        unpack8(*(const u32x4*)(QKVO + (size_t)row * 2048 + 1536 + lane * 8), og);
        float ss = 0.f;
#pragma unroll
        for (int e = 0; e < 8; ++e) { a[e] += bq[e]; ss += a[e] * a[e]; }
        ss += __shfl_xor(ss, 1); ss += __shfl_xor(ss, 2); ss += __shfl_xor(ss, 4); ss += __shfl_xor(ss, 8);
        const float rstd = rsqrtf(ss * (1.f / 128.f) + EPS);
#pragma unroll
        for (int e = 0; e < 8; ++e) y[e] = a[e] * rstd * g[e] / (1.f + __expf(-og[e]));
        *(u32x4*)(MIX + (size_t)row * 1024 + lane * 8) = pack8(y);
    }
}

__device__ __forceinline__ bf16x8 hy_afrag(const bf16_t* HRp, int q, int m, int o4, int hsh) {
    const bf16_t* ap = HRp + (q + 8 - m);
    const u32x4 lo = *(const u32x4*)ap, hi = *(const u32x4*)(ap + 8);
    const bool b0 = (o4 & 1) != 0, b1 = (o4 & 2) != 0;
#define HYSEL(A_, B_, C_, D_) (b1 ? (b0 ? (D_) : (C_)) : (b0 ? (B_) : (A_)))
    const unsigned w0 = HYSEL(lo.x, lo.y, lo.z, lo.w), w1 = HYSEL(lo.y, lo.z, lo.w, hi.x), w2 = HYSEL(lo.z, lo.w, hi.x, hi.y),
                   w3 = HYSEL(lo.w, hi.x, hi.y, hi.z), w4 = HYSEL(hi.x, hi.y, hi.z, hi.w);
#undef HYSEL
    u32x4 o;
    o.x = __builtin_amdgcn_alignbit(w1, w0, hsh); o.y = __builtin_amdgcn_alignbit(w2, w1, hsh);
    o.z = __builtin_amdgcn_alignbit(w3, w2, hsh); o.w = __builtin_amdgcn_alignbit(w4, w3, hsh);
    return as_bf8(o);
}

template <int L>
__device__ __forceinline__ void hyena_item(const Params& p, int li, int c, bool dry = false) {
    constexpr int ZS = L + 8, NI = L / 128, NS = L / 32;
    const int tid = tid_l(), w = tid >> 6, lane = tid & 63, fr = lane & 15, fq = lane >> 4;
    bf16_t* ZA = (bf16_t*)dyn_lds; bf16_t* ZB = ZA + 16 * ZS; bf16_t* HFl = ZB + 16 * ZS;
    const int segbase = (L == 2048) ? 0 : NLAT;
    const bf16_t* HYT = (const bf16_t*)(p.ws + WS_P2);
    bf16_t* MIX = (bf16_t*)(p.ws + WS_ACT);
    const float* cw = p.in[11] + (size_t)li * 3 * 1536; const float* cb = p.in[12] + (size_t)li * 1536; const float* hd = p.in[19] + (size_t)li * 2 * 512;
    const bf16_t* FIL = (L == 2048) ? (const bf16_t*)(p.ws + WS_FLAT) : (const bf16_t*)(p.ws + WS_FCTX);
    {
        const float w0 = cw[c], w1 = cw[1536 + c], w2 = cw[2 * 1536 + c], bb = cb[c];
        const bf16_t* src = HYT + (size_t)c * MTOT + segbase;
#pragma unroll
        for (int ci = 0; ci < (16 * L / 8 + NT - 1) / NT; ++ci) {
            const int ch = tid + ci * NT; if (ch >= 16 * L / 8) break;
            const int b = ch / (L / 8), t0 = (ch % (L / 8)) * 8;
            const bf16_t* s = src + b * L + t0;
            float x[10], y[8];
            const float xl = b2f(s[t0 > 0 ? -1 : 0]), xr = b2f(s[(t0 + 8 < L) ? 8 : 7]);
            unpack8(*(const u32x4*)s, x + 1);
            x[0] = t0 > 0 ? xl : 0.f; x[9] = (t0 + 8 < L) ? xr : 0.f;
#pragma unroll
            for (int e = 0; e < 8; ++e) y[e] = bb + w0 * x[e] + w1 * x[e + 1] + w2 * x[e + 2];
            *(u32x4*)(ZA + b * ZS + t0) = pack8(y);
        }
    }
#pragma unroll 1
    for (int o = 0; o < 2; ++o) {
        for (int i = tid; i < 2 * L / 8; i += NT) {
            const u32x4 v = *(const u32x4*)(FIL + ((size_t)o * 512 + c) * 2 * L + i * 8);
            u32x4 rv; rv.x = (v.w >> 16) | (v.w << 16); rv.y = (v.z >> 16) | (v.z << 16); rv.z = (v.y >> 16) | (v.y << 16); rv.w = (v.x >> 16) | (v.x << 16);
            *(u32x4*)(HFl + 8 + 2 * L - 8 - 8 * i) = rv;
        }
        if (tid < 8) HFl[tid] = 0; else if (tid < 24) HFl[2 * L + tid] = 0;
        __syncthreads();
        const bf16_t* Zin = o ? ZB : ZA;
        const int gc = (o + 1) * 512 + c;
        const float gw0 = cw[gc], gw1 = cw[1536 + gc], gw2 = cw[2 * 1536 + gc], gb = cb[gc], dsk = hd[o * 512 + c];
        const bf16_t* gs = HYT + (size_t)gc * MTOT + segbase + fr * L;
        constexpr int NIB = NI < 8 ? NI : 8;
#pragma unroll 1
        for (int hp = 0; hp < NI; hp += NIB) {
            f32x4 acc[NIB];
#pragma unroll
            for (int i = 0; i < NIB; ++i) acc[i] = (f32x4){0.f, 0.f, 0.f, 0.f};
            constexpr int NQ = NS / 4;
            const int am = (7 - fr) & 7, ao4 = am >> 1, ahs = (am & 1) * 16;
#pragma unroll 1
            for (int r = 0; r < 4; ++r) {
                bf16x8 Aw[NIB];
#pragma unroll
                for (int i = 0; i < NIB; ++i) {
                    Aw[i] = hy_afrag(HFl, (L - 1) - 16 * w - 32 * (4 * (hp + i) - r) - fr + fq * 8, am, ao4, ahs);
                }
#pragma unroll 1
                for (int qc = 0; qc < NQ; qc += NIB) {
#pragma unroll
                    for (int qq = 0; qq < NIB; ++qq) {
                        const int q = qc + qq;
                        const bf16x8 Bz = *(const bf16x8*)(Zin + fr * ZS + (4 * q + r) * 32 + fq * 8);
#pragma unroll
                        for (int i = 0; i < NIB; ++i) acc[i] = mfma16(Aw[(i - qq + NIB) % NIB], Bz, acc[i]);
                        if (q + 1 < NQ) {
                            Aw[(NIB - 1 - qq) % NIB] = hy_afrag(HFl, (L - 1) - 16 * w - 32 * (4 * (hp - q - 1) - r) - fr + fq * 8, am, ao4, ahs);
                        }
                    }
                }
            }
#pragma unroll
            for (int i = 0; i < NIB; ++i) {
                const int t0 = 16 * (w + 8 * (hp + i)) + fq * 4;
                float x[6];
                const float xl = b2f(gs[t0 > 0 ? t0 - 1 : 0]), xr = b2f(gs[(t0 + 4 < L) ? t0 + 4 : L - 1]);
                const u32x2 gv = *(const u32x2*)(gs + t0);
                x[0] = t0 > 0 ? xl : 0.f;
                x[1] = blo(gv.x); x[2] = bhi(gv.x); x[3] = blo(gv.y); x[4] = bhi(gv.y);
                x[5] = (t0 + 4 < L) ? xr : 0.f;
                const u32x2 zv = *(const u32x2*)(Zin + fr * ZS + t0);
                const float z[4] = {blo(zv.x), bhi(zv.x), blo(zv.y), bhi(zv.y)};
                float val[4];
#pragma unroll
                for (int j = 0; j < 4; ++j) val[j] = (gb + gw0 * x[j] + gw1 * x[j + 1] + gw2 * x[j + 2]) * (acc[i][j] + dsk * z[j]);
                { u32x2 ov; ov.x = pk2(val[0], val[1]); ov.y = pk2(val[2], val[3]); *(u32x2*)((o == 0 ? ZB : ZA) + fr * ZS + t0) = ov; }
            }
        }
        __syncthreads();
    }
    if (!dry) {
        bf16_t* dstp = (bf16_t*)(p.ws + WS_P2) + (size_t)c * MTOT + segbase;
#pragma unroll
        for (int ci = 0; ci < (16 * L / 8 + NT - 1) / NT; ++ci) {
            const int ch = tid + ci * NT; if (ch >= 16 * L / 8) break;
            const int b = ch / (L / 8), t0 = (ch % (L / 8)) * 8;
            *(u32x4*)(dstp + b * L + t0) = *(const u32x4*)(ZA + b * ZS + t0);
        }
        __syncthreads();
    }
}

__device__ __forceinline__ void hy_transpose(const Params& p) {
    const int tid = tid_l();
    bf16_t* T = (bf16_t*)dyn_lds;
    const bf16_t* HYO = (const bf16_t*)(p.ws + WS_P2);
    bf16_t* MIX = (bf16_t*)(p.ws + WS_ACT);
    for (int it = blockIdx.x; it < (MTOT / 64) * 8; it += gridDim.x) {
        const int tt = it >> 3, cg_ = it & 7, tok0 = tt * 64, c0 = cg_ * 64;
        {
            const int ch = tid >> 3, t8 = (tid & 7) * 8;
            const u32x4 v = *(const u32x4*)(HYO + (size_t)(c0 + ch) * MTOT + tok0 + t8);
            const unsigned wv[4] = {v.x, v.y, v.z, v.w};
#pragma unroll
            for (int e = 0; e < 4; ++e) { T[(t8 + 2 * e) * 72 + ch] = (bf16_t)(wv[e] & 0xffffu); T[(t8 + 2 * e + 1) * 72 + ch] = (bf16_t)(wv[e] >> 16); }
        }
        __syncthreads();
        {
            const int tk = tid >> 3, c8 = (tid & 7) * 8;
            *(u32x4*)(MIX + (size_t)(tok0 + tk) * 1024 + 512 + c0 + c8) = *(const u32x4*)(T + tk * 72 + c8);
        }
        __syncthreads();
    }
}

__device__ __forceinline__ void qknorm_phase(const Params& p, int li) {
    const int tid = tid_l(), lane = tid & 63, gw = blockIdx.x * 8 + (tid >> 6), ngw = gridDim.x * 8;
    bf16_t* QK = (bf16_t*)(p.ws + WS_BIG);
    float gq[8], gk[8];
#pragma unroll
    for (int e = 0; e < 8; ++e) { gq[e] = p.in[22][li * 64 + (lane & 7) * 8 + e] * 0.125f; gk[e] = p.in[23][li * 64 + (lane & 7) * 8 + e]; }
    for (int row = gw; row < MTOT; row += ngw) {
        bf16_t* rp = QK + (size_t)row * QK_LD + lane * 8;
        u32x4 v[4];
#pragma unroll
        for (int j = 0; j < 4; ++j) v[j] = *(const u32x4*)(rp + j * 512);
#pragma unroll
        for (int j = 0; j < 4; ++j) {
            float f[8]; unpack8(v[j], f);
            float ss = 0.f;
#pragma unroll
            for (int e = 0; e < 8; ++e) ss += f[e] * f[e];
            ss += __shfl_xor(ss, 1); ss += __shfl_xor(ss, 2); ss += __shfl_xor(ss, 4);
            const float rstd = rsqrtf(ss * (1.f / 64.f) + EPS);
#pragma unroll
            for (int e = 0; e < 8; ++e) f[e] *= rstd * (j < 2 ? gq[e] : gk[e]);
            *(u32x4*)(rp + j * 512) = pack8(f);
        }
    }
}

template <bool LAT>
__device__ __forceinline__ void attn_item(const Params& p, int li, int b, int h, int sub, bool stage = true) {
    const int tid = tid_l(), w = tid >> 6, lane = tid & 63, fr = lane & 15, fq = lane >> 4;
    bf16_t* Pw = (bf16_t*)dyn_lds + w * (16 * 264);
    bf16_t* KC = (bf16_t*)(dyn_lds + 67584);
    bf16_t* VC = (bf16_t*)(dyn_lds + 67584 + 36864);
    float* rpbs = (float*)(dyn_lds + 67584 + 36864 + 33792);
    const bf16_t* QK = (const bf16_t*)(p.ws + WS_BIG);
    const bf16_t* VTg = (const bf16_t*)(p.ws + WS_P2ODD);
    bf16_t* MIX = (bf16_t*)(p.ws + WS_ACT);
    if (stage) {
    if (LAT) { const float* rp = p.in[24] + ((size_t)li * 16 + h) * 465; for (int i = tid; i < 465; i += NT) rpbs[i] = rp[i]; }
    {
        u32x4 kv[4], vv[4];
#pragma unroll
        for (int i = 0; i < 4; ++i) {
            const int c = tid + i * NT;
            kv[i] = *(const u32x4*)(QK + (size_t)(NLAT + b * 256 + (c >> 3)) * QK_LD + 1024 + h * 64 + (c & 7) * 8);
            vv[i] = *(const u32x4*)(VTg + (size_t)(h * 64 + (c >> 5)) * VT_LD + NLAT + b * 256 + (c & 31) * 8);
        }
#pragma unroll
        for (int i = 0; i < 4; ++i) {
            const int c = tid + i * NT;
            *(u32x4*)(KC + (c >> 3) * 72 + (c & 7) * 8) = kv[i];
            *(u32x4*)(VC + (c >> 5) * 264 + (c & 31) * 8) = vv[i];
        }
    }
    __syncthreads();
    }
    int r = 0, c0 = 0, rs = 0, cw0 = 0, qtok0;
    if (LAT) { r = sub * 2 + (w >> 2); const int qt = w & 3; c0 = qt * 16; qtok0 = b * 2048 + r * 64 + c0; rs = min(max(r - 4, 0), 24); cw0 = (qt == 0) ? 0 : (qt == 1) ? 8 : (qt == 2) ? 24 : 32; }
    else { qtok0 = NLAT + b * 256 + (sub * 8 + w) * 16; }
    bf16x8 qf[2];
    {
        const bf16_t* qp = QK + (size_t)(qtok0 + fr) * QK_LD + h * 64 + fq * 8;
        qf[0] = *(const bf16x8*)qp; qf[1] = *(const bf16x8*)(qp + 32);
    }
    f32x4 o1[4], o2[4];
    float m1 = -1e30f, l1 = 0.f, m2, l2 = 0.f;
#pragma unroll
    for (int dt = 0; dt < 4; ++dt) { o1[dt] = (f32x4){0.f, 0.f, 0.f, 0.f}; o2[dt] = (f32x4){0.f, 0.f, 0.f, 0.f}; }
    if (LAT) {
        f32x4 sreg[16];
        const int qc = c0 + fr; const int cstart = min(max(qc - 8, 0), 48);
#pragma unroll
        for (int kt = 0; kt < 16; ++kt) {
            const int kr = kt >> 1, kcb = cw0 + (kt & 1) * 16;
            const bf16_t* kp = QK + (size_t)(b * 2048 + (rs + kr) * 64 + kcb + fr) * QK_LD + 1024 + h * 64 + fq * 8;
            f32x4 sa = (f32x4){0.f, 0.f, 0.f, 0.f};
            sa = mfma16(*(const bf16x8*)kp, qf[0], sa); sa = mfma16(*(const bf16x8*)(kp + 32), qf[1], sa);
            const int dri = (rs + kr - r + 7) * 31;
#pragma unroll
            for (int j = 0; j < 4; ++j) {
                const int kc = kcb + fq * 4 + j;
                const bool valid = (kc >= cstart) && (kc < cstart + 16);
                const int dci = min(max(kc - qc + 15, 0), 30);
                sa[j] = valid ? sa[j] + rpbs[dri + dci] : -1e30f;
            }
            sreg[kt] = sa;
            if ((kt & 7) == 7) __builtin_amdgcn_sched_barrier(0);
        }
#pragma unroll
        for (int kt = 0; kt < 16; ++kt)
#pragma unroll
            for (int j = 0; j < 4; ++j) m1 = fmaxf(m1, sreg[kt][j]);
        m1 = fmaxf(m1, __shfl_xor(m1, 16)); m1 = fmaxf(m1, __shfl_xor(m1, 32));
#pragma unroll
        for (int kt = 0; kt < 16; ++kt) {
            float pj[4];
#pragma unroll
            for (int j = 0; j < 4; ++j) { pj[j] = __expf(sreg[kt][j] - m1); l1 += pj[j]; }
            u32x2 o; o.x = pk2(pj[0], pj[1]); o.y = pk2(pj[2], pj[3]);
            *(u32x2*)(Pw + fr * 264 + kt * 16 + fq * 4) = o;
        }
        l1 += __shfl_xor(l1, 16); l1 += __shfl_xor(l1, 32);
#pragma unroll
        for (int kb = 0; kb < 8; kb += 4) {
            bf16x8 vf[4][4], pf[4];
#pragma unroll
            for (int u = 0; u < 4; ++u) {
                const int ks = kb + u;
                const int vtok0 = b * 2048 + (rs + ks) * 64 + cw0;
#pragma unroll
                for (int dt = 0; dt < 4; ++dt) vf[u][dt] = *(const bf16x8*)(VTg + (size_t)(h * 64 + dt * 16 + fr) * VT_LD + vtok0 + fq * 8);
                pf[u] = *(const bf16x8*)(Pw + fr * 264 + ks * 32 + fq * 8);
            }
#pragma unroll
            for (int u = 0; u < 4; ++u)
#pragma unroll
                for (int dt = 0; dt < 4; ++dt) o1[dt] = mfma16(vf[u][dt], pf[u], o1[dt]);
            __builtin_amdgcn_sched_barrier(0);
        }
    }
    {
        f32x4 sreg[16];
#pragma unroll
        for (int kt = 0; kt < 16; ++kt) {
            const bf16_t* kp = KC + (kt * 16 + fr) * 72 + fq * 8;
            f32x4 sa = (f32x4){0.f, 0.f, 0.f, 0.f};
            sa = mfma16(*(const bf16x8*)kp, qf[0], sa); sa = mfma16(*(const bf16x8*)(kp + 32), qf[1], sa);
            sreg[kt] = sa;
        }
        m2 = -1e30f;
#pragma unroll
        for (int kt = 0; kt < 16; ++kt)
#pragma unroll
            for (int j = 0; j < 4; ++j) m2 = fmaxf(m2, sreg[kt][j]);
        m2 = fmaxf(m2, __shfl_xor(m2, 16)); m2 = fmaxf(m2, __shfl_xor(m2, 32));
#pragma unroll
        for (int kt = 0; kt < 16; ++kt) {
            float pj[4];
#pragma unroll
            for (int j = 0; j < 4; ++j) { pj[j] = __expf(sreg[kt][j] - m2); l2 += pj[j]; }
            u32x2 o; o.x = pk2(pj[0], pj[1]); o.y = pk2(pj[2], pj[3]);
            *(u32x2*)(Pw + fr * 264 + kt * 16 + fq * 4) = o;
        }
        l2 += __shfl_xor(l2, 16); l2 += __shfl_xor(l2, 32);
#pragma unroll
        for (int ks = 0; ks < 8; ++ks) {
            const bf16x8 pf = *(const bf16x8*)(Pw + fr * 264 + ks * 32 + fq * 8);
#pragma unroll
            for (int dt = 0; dt < 4; ++dt) o2[dt] = mfma16(*(const bf16x8*)(VC + (dt * 16 + fr) * 264 + ks * 32 + fq * 8), pf, o2[dt]);
        }
    }
    const float mm = fmaxf(m1, m2);
    const float a1 = LAT ? __expf(m1 - mm) : 0.f, a2 = __expf(m2 - mm);
    const float inv = 1.f / (l1 * a1 + l2 * a2);
    const float s1 = a1 * inv, s2 = a2 * inv;
#pragma unroll
    for (int dt = 0; dt < 4; ++dt) {
        const f32x4 ov = o1[dt] * s1 + o2[dt] * s2;
        u32x2 o; o.x = pk2(ov[0], ov[1]); o.y = pk2(ov[2], ov[3]);
        *(u32x2*)(MIX + (size_t)(qtok0 + fr) * 1024 + h * 64 + dt * 16 + fq * 4) = o;
    }
    __syncthreads();
}


#ifdef DBG_NAN
__device__ __forceinline__ bool bad16(bf16_t v) { return ((v >> 7) & 0xFF) >= 227; }
__device__ __forceinline__ bool bad32(float f) { return !(fabsf(f) < 1e30f); }
__device__ __forceinline__ void scan16(const bf16_t* p, size_t n, unsigned* flags, unsigned bit) {
    bool bad = false;
    for (size_t i = (size_t)blockIdx.x * NT + threadIdx.x; i < n; i += (size_t)gridDim.x * NT) bad |= bad16(p[i]);
    if (bad) atomicOr(flags, bit);
}
__device__ __forceinline__ void scan32(const float* p, size_t n, unsigned* flags, unsigned bit) {
    bool bad = false;
    for (size_t i = (size_t)blockIdx.x * NT + threadIdx.x; i < n; i += (size_t)gridDim.x * NT) bad |= bad32(p[i]);
    if (bad) atomicOr(flags, bit);
}
#endif

#define XB_TMO      128
#define XB_XCNT(j)  (256  + 64 * (j))
#define XB_XSUB(j)  (1280 + 64 * (j))
#define XB_XGEN(j)  (2304 + 64 * (j))
#define XB_TOP      3328
#define XB_TOPGEN   3392
#define XCD_BAR_WORDS 3456
#define XB_SPIN_CAP (1u << 20)
#define LAS __attribute__((address_space(3)))
__device__ __forceinline__ unsigned xb_ld(unsigned* p)              { return __hip_atomic_load(p, __ATOMIC_RELAXED, __HIP_MEMORY_SCOPE_AGENT); }
__device__ __forceinline__ unsigned xb_add(unsigned* p, unsigned v) { return __hip_atomic_fetch_add(p, v, __ATOMIC_RELAXED, __HIP_MEMORY_SCOPE_AGENT); }
__device__ __forceinline__ unsigned xb_xcc_id() { return (unsigned)__builtin_amdgcn_s_getreg((3 << 11) | 20) & 0xFu; }
#define XB_SPIN(cond, bar) do { unsigned _sp = 0; while (cond) { __builtin_amdgcn_s_sleep(1); \
    if ((++_sp & 255u) == 0u) { if (xb_ld(&(bar)[XB_TMO])) break; if (_sp > XB_SPIN_CAP) { atomicAdd(&(bar)[XB_TMO], 1u); break; } } } } while (0)
struct XcdBarrier { unsigned* bar; unsigned x; volatile LAS unsigned* st; };
__device__ __forceinline__ XcdBarrier xcd_barrier_post(unsigned* bar, volatile LAS unsigned* st) {
    XcdBarrier b; b.bar = bar; b.x = xb_xcc_id(); b.st = st;
    if (threadIdx.x == 0) (void)xb_add(&bar[XB_XCNT(b.x)], 1u);
    return b;
}
__device__ __forceinline__ void xcd_barrier_complete(unsigned* bar, unsigned x, unsigned& nloc, unsigned& nx) {
    const unsigned G = gridDim.x * gridDim.y * gridDim.z;
    unsigned sum, cnt, mine, sp = 0u;
    for (;;) {
        sum = 0u; cnt = 0u; mine = 0u;
#pragma unroll
        for (unsigned j = 0; j < 16; ++j) { const unsigned c = xb_ld(&bar[XB_XCNT(j)]); sum += c; cnt += (c > 0u) ? 1u : 0u; mine = (j == x) ? c : mine; }
        if (sum == G) break;
        __builtin_amdgcn_s_sleep(1);
        if ((++sp & 255u) == 0u) { if (xb_ld(&bar[XB_TMO])) break; if (sp > XB_SPIN_CAP) { atomicAdd(&bar[XB_TMO], 1u); break; } }
    }
    nloc = mine > 0u ? mine : 1u; nx = cnt > 0u ? cnt : 1u;
}
__device__ __forceinline__ void xcd_barrier(const XcdBarrier& b) {
    asm volatile("s_waitcnt vmcnt(0)" ::: "memory");
    __syncthreads();
    if (threadIdx.x == 0) {
        unsigned* bar = b.bar;
        __builtin_amdgcn_s_waitcnt(0);
        unsigned nloc = b.st[0], nx = b.st[1];
        if (nloc == 0u) { xcd_barrier_complete(bar, b.x, nloc, nx); b.st[0] = nloc; b.st[1] = nx; }
        const unsigned old = xb_add(&bar[XB_XSUB(b.x)], 1u);
        const unsigned gen = old / nloc;
        if (old + 1u == (gen + 1u) * nloc) {
            __builtin_amdgcn_fence(__ATOMIC_RELEASE, "agent");
            asm volatile("s_waitcnt vmcnt(0)" ::: "memory");
            const unsigned og = xb_add(&bar[XB_TOP], 1u);
            const unsigned tg = og / nx;
            if (og + 1u == (tg + 1u) * nx) xb_add(&bar[XB_TOPGEN], 1u);
            else XB_SPIN(xb_ld(&bar[XB_TOPGEN]) == tg, bar);
            __builtin_amdgcn_fence(__ATOMIC_ACQUIRE, "agent");
            xb_add(&bar[XB_XGEN(b.x)], 1u);
            asm volatile("s_waitcnt vmcnt(0)" ::: "memory");
        } else {
            XB_SPIN(xb_ld(&bar[XB_XGEN(b.x)]) == gen, bar);
            __builtin_amdgcn_fence(__ATOMIC_ACQUIRE, "agent");
            asm volatile("s_waitcnt vmcnt(0)" ::: "memory");
        }
    }
    __syncthreads();
}
constexpr size_t WS_BAR = WS_END + 32768;

#ifdef TPROBE_A
#define GSYNC() do { asm volatile("s_waitcnt vmcnt(0) lgkmcnt(0)" ::: "memory"); grid.sync(); ++nsync_; if (nsync_ == TPROBE_A) t0_ = wall_clock64(); if (nsync_ == TPROBE_B) t1_ = wall_clock64(); } while (0)
#else
#define GSYNC() xcd_barrier(xbar_)
#endif
#define GSYNC_CG() do { asm volatile("s_waitcnt vmcnt(0) lgkmcnt(0)" ::: "memory"); grid.sync(); } while (0)
__global__ void __launch_bounds__(NT) fwd_megakernel(Params p) {
    cg::grid_group grid = cg::this_grid();
#ifdef TPROBE_A
    int nsync_ = 0; long long t0_ = 0, t1_ = 0;
#endif
    const int blk = blockIdx.x, G = gridDim.x;
    bf16_t* WIN = (bf16_t*)(p.ws + WS_WIN); bf16_t* WOUT = (bf16_t*)(p.ws + WS_WOUT); bf16_t* WM1 = (bf16_t*)(p.ws + WS_WM1); bf16_t* WM2 = (bf16_t*)(p.ws + WS_WM2);
    bf16_t* ACT = (bf16_t*)(p.ws + WS_ACT); bf16_t* BIG = (bf16_t*)(p.ws + WS_BIG);
    float* XC = (float*)(p.ws + WS_XC);
    const float* MOD = (const float*)(p.ws + WS_MOD);
    volatile LAS unsigned* xst_ = (volatile LAS unsigned*)(dyn_lds + LDS_BYTES - 16);
    if (threadIdx.x == 0) { xst_[0] = 0u; xst_[1] = 0u; }
    __syncthreads();
    const XcdBarrier xbar_ = xcd_barrier_post((unsigned*)(p.ws + WS_BAR), xst_);
    REP(64) if (PHMASK & 1) phase0(p);
#ifdef DBG_NAN
    unsigned* dflags = (unsigned*)(p.ws + WS_END);
    if (blk == 0 && threadIdx.x < 64) dflags[threadIdx.x] = 0u;
#endif
    GSYNC_CG();
#pragma unroll 1
    for (int l = 0; l < 4; ++l) {
        const bool even = !(l & 1), last = (l == 3); const int li = l >> 1;
        const float* xlat = (l == 0) ? p.in[0] : p.out; const float* xctx = (l == 0) ? p.in[2] : XC;
        const int Mtail = last ? NLAT : MTOT;
        REP(1) {
        if (PHMASK & 2) convert_weights(p, l, l == 0 || G < 256, true, 0, G);
        if (PHMASK & 4) norm_phase(p, l, xlat, xctx, 0, 1024, MTOT);
        if ((PHMASK & 8) && even) filter_gen(p, li);
        }
        GSYNC();
        {
            EpiArgs ea{}; ea.o_rm = BIG; ea.ld_rm = even ? 2048 : QK_LD; ea.o_cm = (bf16_t*)(p.ws + (even ? WS_P2 : WS_P2ODD)); ea.ld_cm = even ? MTOT : VT_LD; ea.gates = (float*)(p.ws + WS_GATES); ea.gate_pn = even ? 14 : -1; ea.o_dbg = (bf16_t*)(p.ws + WS_HFB);
            REP(2) if (PHMASK & 16) gemm_phase<EPI_INPROJ>(ACT, WIN, MTOT, even ? 3840 : 3072, 1024, ea);
        }
        GSYNC();
#ifdef DBG_NAN
        if (l == DBG_LAYER) {
            {
                const unsigned gid = blk * NT + threadIdx.x;
                unsigned hsh = gid * 2654435761u + 12345u; hsh ^= hsh >> 13; hsh *= 2246822519u; hsh ^= hsh >> 16;
                const int row = hsh % MTOT; const int col = (hsh >> 8) % 2048; const int ch = (hsh >> 4) % 1536;
                const bf16_t* ar = ACT + (size_t)row * 1024; const bf16_t* wq = WIN + (size_t)col * 1024; const bf16_t* wh = WIN + (size_t)(2048 + ch) * 1024;
                float sq = 0.f, sh_ = 0.f;
                for (int k = 0; k < 1024; ++k) { const float av = b2f(ar[k]); sq += av * b2f(wq[k]); sh_ += av * b2f(wh[k]); }
                const float gq = b2f(BIG[(size_t)row * 2048 + col]);
                const float gh = b2f(((const bf16_t*)(p.ws + WS_P2))[(size_t)ch * MTOT + row]);
                (void)gq; (void)sq;

                { const int cls = DBG_CLS; atomicAdd(dflags + 16 + cls, 1u);
                  if (!(fabsf(gh - sh_) <= 0.05f + 0.02f * fabsf(sh_))) { atomicAdd(dflags + 2, 1u); atomicAdd(dflags + 32 + cls, 1u); } }
            }
            GSYNC();
            if (blk == 0 && threadIdx.x == 0) {
                const float fQ = (float)__hip_atomic_load(dflags + 1, __ATOMIC_RELAXED, __HIP_MEMORY_SCOPE_AGENT) / (float)(G * NT);
                const float fH = (float)__hip_atomic_load(dflags + 2, __ATOMIC_RELAXED, __HIP_MEMORY_SCOPE_AGENT) / (float)(G * NT);
                unsigned mask = 0;
                for (int q_ = 0; q_ < 8; ++q_) { const unsigned tot = __hip_atomic_load(dflags + 16 + q_, __ATOMIC_RELAXED, __HIP_MEMORY_SCOPE_AGENT), bad = __hip_atomic_load(dflags + 32 + q_, __ATOMIC_RELAXED, __HIP_MEMORY_SCOPE_AGENT); if (bad * 4 > tot) mask |= 1u << q_; }
                float code = 1e5f; for (unsigned q_ = 0; q_ < (mask >> 4); ++q_) code *= 10.f;
                const unsigned n3 = __hip_atomic_load(dflags + 3, __ATOMIC_RELAXED, __HIP_MEMORY_SCOPE_AGENT), b1 = __hip_atomic_load(dflags + 1, __ATOMIC_RELAXED, __HIP_MEMORY_SCOPE_AGENT), b4 = __hip_atomic_load(dflags + 4, __ATOMIC_RELAXED, __HIP_MEMORY_SCOPE_AGENT);
                p.out[0] = code * (1.f + 0.5f * (float)(mask & 15)) + 0.f * (fQ + fH + (float)(n3 + b1 + b4));
            }
            return;
        }
#endif
        if (!even) { qknorm_phase(p, li); GSYNC(); }
        if (even) {
            REP(4) if (G >= 256) {
                if (blk < 128) { REP(512) if (PHMASK & 32) mlstm_item(p, li, blk);
                    if (DUPMASK & 1024) { hyena_item<2048>(p, li, 384 + blk, true); hyena_item<256>(p, li, 384 + blk, true); }
                    if (PHMASK & 64) { hyena_item<2048>(p, li, 384 + blk); hyena_item<256>(p, li, 384 + blk); } }
                else { const int hb = blk - 128;
                    if (DUPMASK & 1024) for (int it = hb; it < 384; it += 128) { hyena_item<2048>(p, li, it, true); hyena_item<256>(p, li, it, true); }
                    if (PHMASK & 64) for (int it = hb; it < 384; it += 128) { hyena_item<2048>(p, li, it); hyena_item<256>(p, li, it); } }
            } else {
            }
            GSYNC();
            if (PHMASK & 128) { combine_phase(p, li); hy_transpose(p); }
        } else {
            const int x = blk & 7, y = blk >> 3, ny = (G + 7) >> 3;
            REP(256) for (int i = 0; ; ++i) {
                const int slot = i * ny + y;
                if (slot >= 512) break;
                const int bh = x * 32 + 4 * (i >> 1) + (y >> 3), rp = (y & 7) * 2 + (i & 1);
                if (PHMASK & 256) attn_item<true>(p, li, bh >> 4, bh & 15, rp, (i & 1) == 0 || ny != 32);
            }
            if ((PHMASK & 512) && !last) for (int it = blk; it < 512; it += G) attn_item<false>(p, li, it >> 5, (it >> 1) & 15, it & 1);
        }
        GSYNC();
        {
            EpiArgs ea{}; ea.res_lat = xlat; ea.res_ctx = xctx; ea.out_lat = p.out; ea.out_ctx = XC; ea.modg = MOD + (size_t)l * 17 * 6144 + 2048;
            if (DUPMASK & 32) gemm_phase<EPI_DRY>(ACT, WOUT, Mtail, 1024, 1024, ea);
            if (PHMASK & 1024) gemm_phase<EPI_RESID>(ACT, WOUT, Mtail, 1024, 1024, ea);
        }
        GSYNC();
        REP(8) norm_phase(p, l, p.out, XC, 3072, 4096, Mtail);
        GSYNC();
        { EpiArgs ea{}; ea.o_rm = BIG; ea.ld_rm = 4096; ea.gate_pn = -1; REP(16) if (PHMASK & 2048) gemm_phase<EPI_RELU2>(ACT, WM1, Mtail, 4096, 1024, ea); }
        GSYNC();
        {
            EpiArgs ea{}; ea.res_lat = p.out; ea.res_ctx = XC; ea.out_lat = p.out; ea.out_ctx = XC; ea.modg = MOD + (size_t)l * 17 * 6144 + 5120;
            if (DUPMASK & 32) gemm_phase<EPI_DRY>(BIG, WM2, Mtail, 1024, 4096, ea);
            if (PHMASK & 4096) gemm_phase<EPI_RESID>(BIG, WM2, Mtail, 1024, 4096, ea);
            if (!last && G >= 256) convert_weights(p, l + 1, true, false, 128, G - 128);
        }
        GSYNC();
    }
#ifdef TPROBE_A
    if (blk == 0 && threadIdx.x == 0) p.out[0] = (float)(t1_ - t0_) * 10.f;
#endif
}

extern "C" void kernel_launch(void* const* d_in, const int* in_sizes, int n_in, void* d_out, int out_size, void* d_ws, size_t ws_size, hipStream_t stream) {
    static int grid_blocks = 0;
    if (grid_blocks == 0) {
        if (n_in != 26 || ws_size < WS_BAR + XCD_BAR_WORDS * 4) { fprintf(stderr, "kernel_launch: unexpected n_in %d or ws_size %zu (< %zu)\n", n_in, ws_size, (size_t)WS_END); grid_blocks = -1; return; }
        int dev = 0, cus = 0, per_cu = 0;
        hipGetDevice(&dev);
        hipDeviceGetAttribute(&cus, hipDeviceAttributeMultiprocessorCount, dev);
        if (hipFuncSetAttribute((const void*)fwd_megakernel, hipFuncAttributeMaxDynamicSharedMemorySize, LDS_BYTES) != hipSuccess) fprintf(stderr, "kernel_launch: hipFuncSetAttribute failed\n");
        if (hipOccupancyMaxActiveBlocksPerMultiprocessor(&per_cu, (const void*)fwd_megakernel, NT, LDS_BYTES) != hipSuccess || per_cu < 1) { fprintf(stderr, "kernel_launch: occupancy query gave %d\n", per_cu); per_cu = 1; }
        (void)hipGetLastError();
        grid_blocks = cus * 1;
        fprintf(stderr, "kernel_launch: cus %d per_cu %d grid %d\n", cus, per_cu, grid_blocks);
    }
    if (grid_blocks < 0) return;
    if (hipMemsetAsync((char*)d_ws + WS_BAR, 0, XCD_BAR_WORDS * 4, stream) != hipSuccess) { fprintf(stderr, "kernel_launch: memset of barrier words failed\n"); return; }
    Params p{};
    for (int i = 0; i < 26; ++i) p.in[i] = (const float*)d_in[i];
    p.out = (float*)d_out; p.ws = (unsigned char*)d_ws;
    void* args[] = {&p};
    hipError_t e = hipLaunchCooperativeKernel((void*)fwd_megakernel, dim3(grid_blocks), dim3(NT), args, LDS_BYTES, stream);
    if (e != hipSuccess) fprintf(stderr, "cooperative launch failed: %s (grid %d)\n", hipGetErrorString(e), grid_blocks);
}
```

```cpp
#include <hip/hip_runtime.h>
#include <hip/hip_cooperative_groups.h>
#include <cstdio>
#include <cstdint>
namespace cg = cooperative_groups;

typedef unsigned short bf16_t;
typedef short bf16x8 __attribute__((ext_vector_type(8)));
typedef float f32x4 __attribute__((ext_vector_type(4)));
typedef unsigned u32x4 __attribute__((ext_vector_type(4)));
typedef unsigned u32x2 __attribute__((ext_vector_type(2)));

#define NT 512
#define DBG_LAYER 0
#define DBG_CLS ((((row % 64) / 16) * 2) + ((ch % 32) / 16))
#ifndef PHMASK
#define PHMASK 0xFFFF
#endif
#ifndef DUPMASK
#define DUPMASK 0
#endif
#define REP(bit) for (int rep_ = 0; rep_ < (((DUPMASK) & (bit)) ? 2 : 1); ++rep_)
constexpr int BATCH = 16, SEQ = 2048, DM = 1024, CTXL = 256;
constexpr int NLAT = BATCH * SEQ, NCTX = BATCH * CTXL, MTOT = NLAT + NCTX;
constexpr int DFF = 4096;
constexpr float EPS = 1e-6f;
constexpr int LDS_BYTES = 147456;

constexpr size_t al256(size_t x) { return (x + 255) & ~(size_t)255; }
constexpr size_t WS_WIN = 0;
constexpr size_t WS_WOUT = al256(WS_WIN + (size_t)3840 * 1024 * 2);
constexpr size_t WS_WM1 = al256(WS_WOUT + (size_t)1024 * 1024 * 2);
constexpr size_t WS_WM2 = al256(WS_WM1 + (size_t)4096 * 1024 * 2);
constexpr size_t WS_MOD = al256(WS_WM2 + (size_t)4096 * 1024 * 2);
constexpr size_t WS_XC = al256(WS_MOD + (size_t)4 * 17 * 6144 * 4);
constexpr size_t WS_ACT = al256(WS_XC + (size_t)NCTX * 1024 * 4);
constexpr size_t WS_BIG = al256(WS_ACT + (size_t)MTOT * 1024 * 2);
constexpr size_t WS_P2 = WS_BIG + (size_t)MTOT * 2048 * 2;
constexpr int QK_LD = 2048 + 64;
constexpr int VT_LD = MTOT + 64;
constexpr size_t WS_P2ODD = WS_BIG + (size_t)MTOT * QK_LD * 2;
constexpr size_t WS_GATES = WS_P2 + (size_t)1536 * MTOT * 2;
constexpr size_t WS_HFB = al256(WS_BIG + (size_t)MTOT * 4096 * 2);
constexpr size_t WS_FLAT = al256(WS_HFB + (size_t)2 * MTOT * 512 * 2);
constexpr size_t WS_FCTX = al256(WS_FLAT + (size_t)2 * 512 * 4096 * 2);
constexpr size_t WS_H2 = al256(WS_FCTX + (size_t)2 * 512 * 512 * 2);
constexpr size_t WS_ROPE = al256(WS_H2 + (size_t)2 * 2304 * 64 * 4);
constexpr size_t WS_END = al256(WS_ROPE + (size_t)2 * 64 * 32 * 4);
static_assert(WS_GATES + (size_t)MTOT * 16 * 4 <= WS_HFB, "projection overlay too large");
static_assert(WS_P2ODD + (size_t)1024 * VT_LD * 2 <= WS_HFB, "odd projection overlay too large");

struct Params { const float* in[26]; float* out; unsigned char* ws; };

typedef float f32x2_ __attribute__((ext_vector_type(2)));
typedef __bf16 bf16x2_ __attribute__((ext_vector_type(2)));
__device__ __forceinline__ unsigned pk2(float lo, float hi) { f32x2_ v = {lo, hi}; bf16x2_ b = __builtin_convertvector(v, bf16x2_); return __builtin_bit_cast(unsigned, b); }
__device__ __forceinline__ bf16_t f2b(float x) { return (bf16_t)(pk2(x, 0.f) & 0xffffu); }
__device__ __forceinline__ float b2f(bf16_t b) { return __uint_as_float(((unsigned)b) << 16); }
__device__ __forceinline__ float blo(unsigned w) { return __uint_as_float(w << 16); }
__device__ __forceinline__ float bhi(unsigned w) { return __uint_as_float(w & 0xffff0000u); }
__device__ __forceinline__ void unpack8(u32x4 v, float* f) {
    f[0] = blo(v.x); f[1] = bhi(v.x); f[2] = blo(v.y); f[3] = bhi(v.y); f[4] = blo(v.z); f[5] = bhi(v.z); f[6] = blo(v.w); f[7] = bhi(v.w);
}
__device__ __forceinline__ u32x4 pack8(const float* f) { u32x4 r; r.x = pk2(f[0], f[1]); r.y = pk2(f[2], f[3]); r.z = pk2(f[4], f[5]); r.w = pk2(f[6], f[7]); return r; }
__device__ __forceinline__ float fsin_(float x) { float r = x * 0.15915494309189535f; r -= floorf(r); return __builtin_amdgcn_sinf(r); }
__device__ __forceinline__ float fcos_(float x) { float r = x * 0.15915494309189535f; r -= floorf(r); return __builtin_amdgcn_cosf(r); }
__device__ __forceinline__ float wave_sum(float v) {
#pragma unroll
    for (int o = 1; o < 64; o <<= 1) v += __shfl_xor(v, o);
    return v;
}
__device__ __forceinline__ f32x4 mfma16(bf16x8 a, bf16x8 b, f32x4 c) { return __builtin_amdgcn_mfma_f32_16x16x32_bf16(a, b, c, 0, 0, 0); }
__device__ __forceinline__ bf16x8 as_bf8(u32x4 v) { return __builtin_bit_cast(bf16x8, v); }

extern __shared__ __attribute__((aligned(16))) unsigned char dyn_lds[];
__device__ __forceinline__ int tid_l() { int t = threadIdx.x; asm volatile("" : "+v"(t)); return t; }

constexpr int G_BM = 256, G_BK = 64, G_HALF = 128, G_HT = G_HALF * G_BK;
__device__ __forceinline__ int lds_byte(int r, int c) {
    int st = (r >> 4) * 2 + (c >> 5), rr = r & 15, cc = c & 31, ob = rr * 64 + cc * 2;
    return st * 1024 + (ob ^ (((ob >> 9) & 1) << 5));
}
__device__ __forceinline__ void stage_rc(int b, int& R, int& C) {
    int st = b / 1024, sb = b % 1024, swz = sb ^ (((sb >> 9) & 1) << 5);
    R = (st >> 1) * 16 + swz / 64; C = (st & 1) * 32 + (swz % 64) / 2;
}

enum { EPI_INPROJ = 0, EPI_RESID = 1, EPI_RELU2 = 2, EPI_DRY = 3 };
struct EpiArgs {
    bf16_t* o_rm; int ld_rm;
    bf16_t* o_dbg;
    int ld_cm;
    bf16_t* o_cm;
    float* gates; int gate_pn;
    const float* res_lat; const float* res_ctx; float* out_lat; float* out_ctx; const float* modg;
};

#define WAIT_V_(n) asm volatile("s_waitcnt vmcnt(" #n ")" ::: "memory")
#define WAIT_V(n) WAIT_V_(n)
#ifndef GEMM_SGB
#define GEMM_SGB 0
#endif
#ifndef GEMM_VM
#define GEMM_VM 8
#endif
#define WAIT_L(n) asm volatile("s_waitcnt lgkmcnt(" #n ")" ::: "memory")
#define BAR __builtin_amdgcn_s_barrier()
#define CFENCE asm volatile("" ::: "memory")

template <bool TR, int NAI>
__device__ __forceinline__ void gemm_kloop(const bf16_t* __restrict__ A, const bf16_t* __restrict__ Bt, int K, int brow, int bcol, f32x4 (&acc)[NAI][2][4][2], int kt0, int nt) {
    bf16_t* shm = (bf16_t*)dyn_lds;
#define SA(b, h) (shm + ((b) * 2 + (h)) * G_HT)
#define SB(b, h) (shm + (4 + (b) * 2 + (h)) * G_HT)
    const int tidx = tid_l();
    const int wid = tidx >> 6, lane = tidx & 63, wr = wid >> 2, wc = wid & 3, fr = lane & 15, fq = lane >> 4;
    int goff[2];
#pragma unroll
    for (int i = 0; i < 2; ++i) { int r_, c_; stage_rc(tidx * 16 + i * 8192, r_, c_); goff[i] = r_ * K + c_; }
    const bf16_t* Ab = A + (long)brow * K + kt0 * G_BK; const bf16_t* Bb = Bt + (long)bcol * K + kt0 * G_BK;
#define STAGE2(P, BASEP, kt) do { _Pragma("unroll") for (int _i = 0; _i < 2; ++_i) \
      __builtin_amdgcn_global_load_lds((const unsigned*)((BASEP) + (kt) * G_BK + goff[_i]), (unsigned*)((char*)(P) + tidx * 16 + _i * 8192), 16, 0, 0); } while (0)
    STAGE2(SA(0, 0), Ab, 0); if (NAI == 2) STAGE2(SA(0, 1), Ab + (long)G_HALF * K, 0); STAGE2(SB(0, 0), Bb, 0); STAGE2(SB(0, 1), Bb + (long)G_HALF * K, 0);
    for (int kt = 0; kt < nt; ++kt) {
        const int cur = kt & 1, nxt = cur ^ 1;
        WAIT_V(0); WAIT_L(0);
        BAR; CFENCE;
#define LDBF(dst, k) _Pragma("unroll") for (int bj = 0; bj < 2; ++bj) _Pragma("unroll") for (int n = 0; n < 2; ++n) \
            dst[bj][n] = *reinterpret_cast<const bf16x8*>((char*)SB(cur, bj) + lds_byte(wc * 32 + n * 16 + fr, (k) * 32 + fq * 8))
#define LDAF(dst, ai, k) _Pragma("unroll") for (int m = 0; m < 4; ++m) \
            dst[m] = *reinterpret_cast<const bf16x8*>((char*)SA(cur, ai) + lds_byte(wr * 64 + m * 16 + fr, (k) * 32 + fq * 8))
#define MMAG(ai, Af_, Bf_) _Pragma("unroll") for (int m = 0; m < 4; ++m) _Pragma("unroll") for (int bj = 0; bj < 2; ++bj) _Pragma("unroll") for (int n = 0; n < 2; ++n) \
            acc[ai][bj][m][n] = TR ? mfma16(Bf_[bj][n], Af_[m], acc[ai][bj][m][n]) : mfma16(Af_[m], Bf_[bj][n], acc[ai][bj][m][n])
        bf16x8 B0[2][2], B1[2][2], A0[4], A1[4];
        LDBF(B0, 0); LDAF(A0, 0, 0); if (NAI == 2) { LDAF(A1, 1, 0); }
        if (kt + 1 < nt) {
            STAGE2(SA(nxt, 0), Ab, kt + 1); if (NAI == 2) STAGE2(SA(nxt, 1), Ab + (long)G_HALF * K, kt + 1);
            STAGE2(SB(nxt, 0), Bb, kt + 1); STAGE2(SB(nxt, 1), Bb + (long)G_HALF * K, kt + 1);
        }
        MMAG(0, A0, B0);
        LDBF(B1, 1); LDAF(A0, 0, 1);
        if (NAI == 2) { MMAG(NAI - 1, A1, B0); LDAF(A1, 1, 1); }
        MMAG(0, A0, B1);
        if (NAI == 2) { MMAG(NAI - 1, A1, B1); }
#if GEMM_SGB
        __builtin_amdgcn_sched_group_barrier(0x100, 12, 0);
        __builtin_amdgcn_sched_group_barrier(0x020, 8, 0);
        __builtin_amdgcn_sched_group_barrier(0x008, 16, 0);
        __builtin_amdgcn_sched_group_barrier(0x100, 8, 0);
        __builtin_amdgcn_sched_group_barrier(0x008, 16, 0);
        __builtin_amdgcn_sched_group_barrier(0x100, 4, 0);
        __builtin_amdgcn_sched_group_barrier(0x008, 32, 0);
#endif
    }
    WAIT_L(0); BAR; CFENCE;
}

template <int EPI, int NAI>
__device__ __forceinline__ void gemm_tile(const bf16_t* A, const bf16_t* Bt, int K, int brow, int bcol, int pn, const EpiArgs& ea, int wr, int wc, int fr, int fq) {
        constexpr bool SPLITTAIL = false; const int kq = -1, kt0 = 0, ntl = K / G_BK; (void)kq;
        f32x4 acc[NAI][2][4][2];
#pragma unroll
        for (int a = 0; a < NAI; ++a)
#pragma unroll
            for (int b = 0; b < 2; ++b)
#pragma unroll
                for (int m = 0; m < 4; ++m)
#pragma unroll
                    for (int n = 0; n < 2; ++n) acc[a][b][m][n] = (f32x4){0.f, 0.f, 0.f, 0.f};
        const bool colmajor = (EPI == EPI_INPROJ) && pn >= 8 && pn != ea.gate_pn;
        if (colmajor) {
            gemm_kloop<true, NAI>(A, Bt, K, brow, bcol, acc, kt0, ntl);
#pragma unroll
            for (int ai = 0; ai < NAI; ++ai)
#pragma unroll
                for (int bj = 0; bj < 2; ++bj)
#pragma unroll
                    for (int m = 0; m < 4; ++m)
#pragma unroll
                        for (int n = 0; n < 2; ++n) {
                            const int row = brow + ai * 128 + wr * 64 + m * 16 + fr, col = bcol + bj * 128 + wc * 32 + n * 16 + fq * 4;
                            const f32x4 v = acc[ai][bj][m][n];
#pragma unroll
                            for (int j = 0; j < 4; ++j) ea.o_cm[(size_t)(col + j - 2048) * ea.ld_cm + row] = f2b(v[j]);
                        }
        } else if (EPI == EPI_RESID) {
            gemm_kloop<true, NAI>(A, Bt, K, brow, bcol, acc, kt0, ntl);
            const bool lat = brow < NLAT;
            const int mrow = lat ? brow >> 11 : 16;
            const float* rbase = lat ? ea.res_lat + (size_t)brow * 1024 : ea.res_ctx + (size_t)(brow - NLAT) * 1024;
            float* obase = lat ? ea.out_lat + (size_t)brow * 1024 : ea.out_ctx + (size_t)(brow - NLAT) * 1024;
            f32x4 g[2][2];
#pragma unroll
            for (int bj = 0; bj < 2; ++bj)
#pragma unroll
                for (int n = 0; n < 2; ++n) g[bj][n] = *(const f32x4*)(ea.modg + (size_t)mrow * 6144 + bcol + bj * 128 + wc * 32 + n * 16 + fq * 4);
            if (SPLITTAIL && kq >= 0) {
#pragma unroll
                for (int ai = 0; ai < NAI; ++ai)
#pragma unroll
                    for (int m = 0; m < 4; ++m)
#pragma unroll
                        for (int bj = 0; bj < 2; ++bj)
#pragma unroll
                            for (int n = 0; n < 2; ++n) {
                                float* op = obase + (size_t)(ai * 128 + wr * 64 + m * 16 + fr) * 1024 + bcol + bj * 128 + wc * 32 + n * 16 + fq * 4;
                                const f32x4 dv = g[bj][n] * acc[ai][bj][m][n];
#pragma unroll
                                for (int j = 0; j < 4; ++j) unsafeAtomicAdd(op + j, dv[j]);
                            }
            } else
#pragma unroll
            for (int ai = 0; ai < NAI; ++ai) {
                f32x4 xv[4][2][2];
#pragma unroll
                for (int m = 0; m < 4; ++m)
#pragma unroll
                    for (int bj = 0; bj < 2; ++bj)
#pragma unroll
                        for (int n = 0; n < 2; ++n)
                            xv[m][bj][n] = *(const f32x4*)(rbase + (size_t)(ai * 128 + wr * 64 + m * 16 + fr) * 1024 + bcol + bj * 128 + wc * 32 + n * 16 + fq * 4);
#pragma unroll
                for (int m = 0; m < 4; ++m)
#pragma unroll
                    for (int bj = 0; bj < 2; ++bj)
#pragma unroll
                        for (int n = 0; n < 2; ++n)
                            *(f32x4*)(obase + (size_t)(ai * 128 + wr * 64 + m * 16 + fr) * 1024 + bcol + bj * 128 + wc * 32 + n * 16 + fq * 4) = xv[m][bj][n] + g[bj][n] * acc[ai][bj][m][n];
            }
        } else {
            gemm_kloop<true, NAI>(A, Bt, K, brow, bcol, acc, kt0, ntl);
#pragma unroll
            for (int ai = 0; ai < NAI; ++ai)
#pragma unroll
                for (int m = 0; m < 4; ++m) {
                    const int row = brow + ai * 128 + wr * 64 + m * 16 + fr;
#pragma unroll
                    for (int bj = 0; bj < 2; ++bj)
#pragma unroll
                        for (int n = 0; n < 2; ++n) {
                            const int col = bcol + bj * 128 + wc * 32 + n * 16 + fq * 4;
                            const f32x4 v = acc[ai][bj][m][n];
                            if (EPI == EPI_INPROJ) {
                                if (pn == ea.gate_pn) {
                                    if (bj == 0 && wc == 0 && n == 0) *(f32x4*)(ea.gates + (size_t)row * 16 + fq * 4) = v;
                                } else {
                                    u32x2 o; o.x = pk2(v[0], v[1]); o.y = pk2(v[2], v[3]);
                                    *(u32x2*)(ea.o_rm + (size_t)row * ea.ld_rm + col) = o;
                                }
                            } else if (EPI == EPI_DRY) {
                                if (v[0] == 123456.789f && v[1] == 3.25f) *(f32x4*)(ea.out_lat + (size_t)row * 1024 + (col & 1023)) = v;
                            } else if (EPI == EPI_RELU2) {
                                float r0 = fmaxf(v[0], 0.f), r1 = fmaxf(v[1], 0.f), r2 = fmaxf(v[2], 0.f), r3 = fmaxf(v[3], 0.f);
                                u32x2 o; o.x = pk2(r0 * r0, r1 * r1); o.y = pk2(r2 * r2, r3 * r3);
                                *(u32x2*)(ea.o_rm + (size_t)row * ea.ld_rm + col) = o;
                            } else {
                                const float* rp; float* op; int mrow;
                                if (row < NLAT) { rp = ea.res_lat + (size_t)row * 1024 + col; op = ea.out_lat + (size_t)row * 1024 + col; mrow = row >> 11; }
                                else { rp = ea.res_ctx + (size_t)(row - NLAT) * 1024 + col; op = ea.out_ctx + (size_t)(row - NLAT) * 1024 + col; mrow = 16; }
                                const f32x4 g = *(const f32x4*)(ea.modg + (size_t)mrow * 6144 + col);
                                const f32x4 x = *(const f32x4*)rp;
                                f32x4 rr = x + g * v;
#ifdef SANITIZE
#pragma unroll
                                for (int q_ = 0; q_ < 4; ++q_) if (!(fabsf(rr[q_]) < 1e30f)) rr[q_] = 0.f;
#endif
                                *(f32x4*)op = rr;
                            }
                        }
                }
        }
        asm volatile("s_waitcnt vmcnt(0)" ::: "memory");
        __syncthreads();
}

template <int EPI, bool HALFTAIL = true>
__device__ __forceinline__ void gemm_phase(const bf16_t* A, const bf16_t* Bt, int M, int N, int K, const EpiArgs& ea) {
    const int nM = M / G_BM, nN = N / G_BM, nwg = nM * nN, G_ = gridDim.x;
    const int tidx = tid_l(); const int wid = tidx >> 6, lane = tidx & 63, wr = wid >> 2, wc = wid & 3, fr = lane & 15, fq = lane >> 4;
    int nfull = nwg;
    if (HALFTAIL) { const int rem = nwg % G_; if (rem > 0 && rem * 2 <= G_) nfull = nwg - rem; }
    const int nunits = nfull + (nwg - nfull) * 2;
    for (int U = blockIdx.x; U < nunits; U += G_) {
        const int L = U < nfull ? U : nfull + ((U - nfull) >> 1);
        const int half = U < nfull ? -1 : ((U - nfull) & 1);
        int wgid = L;
        { int q = nwg / 8, r = nwg % 8, xcd = wgid % 8, off = wgid / 8; wgid = (xcd < r ? xcd * (q + 1) : r * (q + 1) + (xcd - r) * q) + off; }
        const int nig = 8 * nN, gid = wgid / nig, fm = gid * 8, gsz = min(nM - fm, 8);
        const int pm = fm + ((wgid % nig) % gsz), pn = (wgid % nig) / gsz, bcol = pn * G_BM;
        if (half < 0) gemm_tile<EPI, 2>(A, Bt, K, pm * G_BM, bcol, pn, ea, wr, wc, fr, fq);
        else gemm_tile<EPI, 1>(A, Bt, K, pm * G_BM + half * 128, bcol, pn, ea, wr, wc, fr, fq);
    }
}

__device__ __forceinline__ void phase0(const Params& p) {
    const int tid = tid_l(), blk = blockIdx.x, nb = gridDim.x;
    float* MOD = (float*)(p.ws + WS_MOD);
    for (int it = blk; it < 193; it += nb) {
        if (it < 192) {
            float* sl = (float*)dyn_lds;
            float* red = sl + 17 * 1024;
            for (int i = tid; i < 17 * 1024; i += NT) { float v = (i < 16 * 1024) ? p.in[1][i] : p.in[3][i - 16 * 1024]; sl[i] = v / (1.f + __expf(-v)); }
            __syncthreads();
            const int l = it / 48, nc = it % 48, kp = tid >> 7, col = tid & 127;
            const float* W = p.in[4] + (size_t)l * 1024 * 6144 + nc * 128 + col;
            float acc[17];
#pragma unroll
            for (int r = 0; r < 17; ++r) acc[r] = 0.f;
            for (int k = kp * 256; k < kp * 256 + 256; ++k) {
                const float wv = W[(size_t)k * 6144];
#pragma unroll
                for (int r = 0; r < 17; ++r) acc[r] += sl[r * 1024 + k] * wv;
            }
#pragma unroll
            for (int r = 0; r < 17; ++r) red[(kp * 17 + r) * 128 + col] = acc[r];
            __syncthreads();
            for (int i = tid; i < 17 * 128; i += NT) {
                const int r = i >> 7, cc = i & 127;
                const float s = red[(0 * 17 + r) * 128 + cc] + red[(1 * 17 + r) * 128 + cc] + red[(2 * 17 + r) * 128 + cc] + red[(3 * 17 + r) * 128 + cc];
                MOD[((size_t)l * 17 + r) * 6144 + nc * 128 + cc] = s + p.in[5][l * 6144 + nc * 128 + cc];
            }
            __syncthreads();
        } else {
            float* ROPE = (float*)(p.ws + WS_ROPE);
            for (int i = tid; i < 2048; i += NT) {
                const int pos = i >> 5, j = i & 31;
                const float inv = exp2f(-(float)j * (13.287712379549449f / 32.f));
                const float ang = (float)pos * inv;
                ROPE[i] = fcos_(ang); ROPE[2048 + i] = fsin_(ang);
            }
        }
    }
    float* H2 = (float*)(p.ws + WS_H2);
    const int gw = blk * 8 + (tid >> 6), lane = tid & 63;
    for (int it = gw; it < 2 * 2304; it += nb * 8) {
        const int i = it / 2304, row = it % 2304;
        const int L = row < 2048 ? 2048 : 256, t = row < 2048 ? row : row - 2048;
        const float tn = (float)t / (float)(L - 1);
        const float wpos = 6.283185307179586f * (float)t / (float)L;
        float ev = 0.f;
        if (lane == 0) ev = tn;
        else if (lane <= 16) { const float fr = 1e-4f + (float)(lane - 1) * ((15.f - 1e-4f) / 15.f); ev = fcos_(wpos * fr); }
        else if (lane <= 32) { const float fr = 1e-4f + (float)(lane - 17) * ((15.f - 1e-4f) / 15.f); ev = -fsin_(wpos * fr); }
        const float* w1 = p.in[13] + i * 33 * 64; const float* b1 = p.in[14] + i * 64;
        const float* w2 = p.in[15] + i * 64 * 64; const float* b2 = p.in[16] + i * 64; const float* fq = p.in[18] + i * 64;
        float a = b1[lane];
        for (int e = 0; e < 33; ++e) a += __shfl(ev, e) * w1[e * 64 + lane];
        const float h1 = fsin_(fq[lane] * a);
        float a2 = b2[lane];
        for (int e = 0; e < 64; ++e) a2 += __shfl(h1, e) * w2[e * 64 + lane];
        H2[((size_t)i * 2304 + row) * 64 + lane] = fsin_(fq[lane] * a2);
    }
}

__device__ __forceinline__ void cvt_tile(const float* W, int N, int K, bf16_t* WT, int n0, int k0, int mapmode) {
    float* tl = (float*)dyn_lds;
    const int tid = tid_l(), nl = tid & 63, kb = tid >> 6;
    const int n = n0 + nl; int sc = n;
    if (mapmode == 1) sc = n < 2048 ? n : (n < 3584 ? n + 16 : (n < 3600 ? n - 3584 + 2048 : -1));
#pragma unroll
    for (int i = 0; i < 8; ++i) { const int kl = kb + 8 * i; tl[kl * 65 + nl] = sc >= 0 ? W[(size_t)(k0 + kl) * N + sc] : 0.f; }
    __syncthreads();
    const int nn = tid >> 3, kc = tid & 7;
    float f[8];
#pragma unroll
    for (int j = 0; j < 8; ++j) f[j] = tl[(kc * 8 + j) * 65 + nn];
    *(u32x4*)(WT + (size_t)(n0 + nn) * K + k0 + kc * 8) = pack8(f);
    __syncthreads();
}

__device__ __forceinline__ void convert_weights(const Params& p, int l, bool first_part, bool second_part, int bstart, int bcount) {
    const int blk = (int)blockIdx.x - bstart, nb = bcount, li = l >> 1; const bool even = !(l & 1);
    if (blk < 0 || blk >= bcount) return;
    const int nin = even ? 60 : 48;
    const int t_in = nin * 16, t_out = 256, t_m1 = 1024, t_m2 = 1024;
    const int it0 = first_part ? 0 : t_in + t_out + t_m1, it1 = second_part ? t_in + t_out + t_m1 + t_m2 : t_in + t_out + t_m1;
    for (int it = it0 + blk; it < it1; it += nb) {
        int r = it;
        if (r < t_in) {
            const int nt = r / 16, kt = r % 16;
            if (even) cvt_tile(p.in[8] + (size_t)li * 1024 * 3600, 3600, 1024, (bf16_t*)(p.ws + WS_WIN), nt * 64, kt * 64, 1);
            else cvt_tile(p.in[21] + (size_t)li * 1024 * 3072, 3072, 1024, (bf16_t*)(p.ws + WS_WIN), nt * 64, kt * 64, 0);
            continue;
        }
        r -= t_in;
        if (r < t_out) {
            const int nt = r / 16, kt = r % 16;
            cvt_tile((even ? p.in[20] : p.in[25]) + (size_t)li * 1024 * 1024, 1024, 1024, (bf16_t*)(p.ws + WS_WOUT), nt * 64, kt * 64, 0);
            continue;
        }
        r -= t_out;
        if (r < t_m1) {
            const int nt = r / 16, kt = r % 16;
            cvt_tile(p.in[6] + (size_t)l * 1024 * 4096, 4096, 1024, (bf16_t*)(p.ws + WS_WM1), nt * 64, kt * 64, 0);
            continue;
        }
        r -= t_m1;
        { const int nt = r / 64, kt = r % 64;
          cvt_tile(p.in[7] + (size_t)l * 4096 * 1024, 1024, 4096, (bf16_t*)(p.ws + WS_WM2), nt * 64, kt * 64, 0); }
    }
}

__device__ __forceinline__ void norm_phase(const Params& p, int l, const float* xlat, const float* xctx, int shoff, int scoff, int M) {
    const int tid = tid_l(), lane = tid & 63, gw = blockIdx.x * 8 + (tid >> 6), ngw = gridDim.x * 8;
    const float* MOD = (const float*)(p.ws + WS_MOD) + (size_t)l * 17 * 6144;
    bf16_t* ACT = (bf16_t*)(p.ws + WS_ACT);
    for (int row = gw; row < M; row += ngw) {
        const float* xr = row < NLAT ? xlat + (size_t)row * 1024 : xctx + (size_t)(row - NLAT) * 1024;
        const int mrow = row < NLAT ? row >> 11 : 16;
        const float* mod = MOD + (size_t)mrow * 6144;
        f32x4 v[4]; float ss = 0.f;
#pragma unroll
        for (int j = 0; j < 4; ++j) { v[j] = *(const f32x4*)(xr + 4 * lane + 256 * j); ss += v[j][0] * v[j][0] + v[j][1] * v[j][1] + v[j][2] * v[j][2] + v[j][3] * v[j][3]; }
        ss = wave_sum(ss);
        const float rstd = rsqrtf(ss * (1.f / 1024.f) + EPS);
#pragma unroll
        for (int j = 0; j < 4; ++j) {
            const int col = 4 * lane + 256 * j;
            const f32x4 sh = *(const f32x4*)(mod + shoff + col), sc = *(const f32x4*)(mod + scoff + col);
            const f32x4 y = v[j] * rstd * (sc + 1.f) + sh;
            u32x2 o; o.x = pk2(y[0], y[1]); o.y = pk2(y[2], y[3]);
            *(u32x2*)(ACT + (size_t)row * 1024 + col) = o;
        }
    }
}

__device__ __forceinline__ void filter_gen(const Params& p, int li) {
    const int tid = tid_l(), lane = tid & 63, w = tid >> 6;
    float* wf = (float*)dyn_lds; float* wb = wf + 64; float* red = wb + 64;
    const float* H2 = (const float*)(p.ws + WS_H2);
    for (int it = blockIdx.x; it < 2048; it += gridDim.x) {
        const int ltype = it >> 10, o = (it >> 9) & 1, c = it & 511;
        const int L = ltype ? 256 : 2048;
        const float* H2r = H2 + ((size_t)li * 2304 + (ltype ? 2048 : 0)) * 64;
        const float* w3 = p.in[17] + (size_t)li * 64 * 2048;
        if (tid < 64) wf[tid] = w3[tid * 2048 + (o * 2 + 0) * 512 + c];
        else if (tid < 128) wb[tid - 64] = w3[(tid - 64) * 2048 + (o * 2 + 1) * 512 + c];
        __syncthreads();
        const float lo = -4.605170185988091f / 1.5f, hi = -4.605170185988091f / 0.3f;
        const float delta = fabsf(lo + (hi - lo) * (float)c / 511.f);
        float vf[4], vb[4]; float ssf = 0.f, ssb = 0.f;
#pragma unroll
        for (int q = 0; q < 4; ++q) {
            const int t = tid + 512 * q; vf[q] = 0.f; vb[q] = 0.f;
            if (t < L) {
                float df = 0.f, db = 0.f;
                const f32x4* hr = (const f32x4*)(H2r + (size_t)t * 64);
#pragma unroll
                for (int j = 0; j < 16; ++j) { const f32x4 hv = hr[j];
                    df += hv[0] * wf[4 * j] + hv[1] * wf[4 * j + 1] + hv[2] * wf[4 * j + 2] + hv[3] * wf[4 * j + 3];
                    db += hv[0] * wb[4 * j] + hv[1] * wb[4 * j + 1] + hv[2] * wb[4 * j + 2] + hv[3] * wb[4 * j + 3]; }
                const float dec = __expf(-((float)t / (float)(L - 1)) * delta);
                vf[q] = df * dec; vb[q] = db * dec; ssf += vf[q] * vf[q]; ssb += vb[q] * vb[q];
            }
        }
        ssf = wave_sum(ssf); ssb = wave_sum(ssb);
        if (lane == 0) { red[w] = ssf; red[8 + w] = ssb; }
        __syncthreads();
        float tf = 0.f, tb = 0.f;
#pragma unroll
        for (int i = 0; i < 8; ++i) { tf += red[i]; tb += red[8 + i]; }
        const float nf = rsqrtf(tf + EPS), nbk = rsqrtf(tb + EPS);
        bf16_t* dst = ltype ? (bf16_t*)(p.ws + WS_FCTX) + ((size_t)o * 512 + c) * 512 : (bf16_t*)(p.ws + WS_FLAT) + ((size_t)o * 512 + c) * 4096;
#pragma unroll
        for (int q = 0; q < 4; ++q) {
            const int t = tid + 512 * q;
            if (t < L) {
                if (t == 0) { dst[L] = f2b(vf[q] * nf + vb[q] * nbk); dst[0] = 0; }
                else { dst[L + t] = f2b(vf[q] * nf); dst[L - t] = f2b(vb[q] * nbk); }
            }
        }
        __syncthreads();
    }
}

__device__ __forceinline__ void mlstm_item(const Params& p, int li, int it) {
    const int tid = tid_l(), w = tid >> 6, lane = tid & 63, fr = lane & 15, fq = lane >> 4;
    const int b = it >> 3, h = (it >> 1) & 3, dir = it & 1;
    bf16_t* Qs = (bf16_t*)dyn_lds;
    bf16_t* Ks = Qs + 64 * 136;
    bf16_t* KT = Ks + 64 * 136;
    bf16_t* VT = KT + 128 * 72;
    bf16_t* Cb = VT + 144 * 72;
    bf16_t* Ps = Cb + 144 * 136;
    float* fl = (float*)(Ps + 64 * 72);
    float* a_s = fl; float* Mt = fl + 64; float* scs = fl + 128; float* emt = fl + 192; float* den = fl + 256; float* lfs = fl + 320; float* igs = fl + 384; float* scal = fl + 448;
    const bf16_t* QKVO = (const bf16_t*)(p.ws + WS_BIG);
    const float* GATES = (const float*)(p.ws + WS_GATES);
    bf16_t* HFB = (bf16_t*)(p.ws + WS_HFB) + (size_t)dir * MTOT * 512;
    const float* ROPE = (const float*)(p.ws + WS_ROPE);
    const float* gate_b = p.in[9] + li * 16;
    for (int i = tid; i < 144 * 136 / 2; i += NT) ((unsigned*)Cb)[i] = 0u;
    for (int i = tid; i < 16 * 72; i += NT) { const int r = i / 72, ci = i % 72; VT[(128 + r) * 72 + ci] = (r == 0 && ci < 64) ? (bf16_t)0x3F80 : (bf16_t)0; }
    f32x4 cacc[9];
#pragma unroll
    for (int i = 0; i < 9; ++i) cacc[i] = (f32x4){0.f, 0.f, 0.f, 0.f};
    float m = 0.f;
    __syncthreads();
    for (int step = 0; step < 36; ++step) {
        const bool isctx = step < 4;
        const int cj = isctx ? (dir ? 3 - step : step) : (dir ? 35 - step : step - 4);
        const int rowbase = isctx ? NLAT + b * 256 + cj * 64 : b * 2048 + cj * 64;
        {
            const int r = tid >> 3, seg = tid & 7; const int tl = dir ? 63 - r : r;
            const bf16_t* src = QKVO + (size_t)(rowbase + tl) * 2048 + h * 128;
            const int hb = seg >> 2, jb = (seg & 3) * 8, d1 = hb * 64 + jb, d2 = d1 + 32;
            const u32x4 q1 = *(const u32x4*)(src + d1), q2 = *(const u32x4*)(src + d2);
            const u32x4 k1 = *(const u32x4*)(src + 512 + d1), k2 = *(const u32x4*)(src + 512 + d2);
            const u32x4 v1 = *(const u32x4*)(src + 1024 + seg * 16), v2 = *(const u32x4*)(src + 1024 + seg * 16 + 8);
            float cs[8], sn[8];
            if (!isctx) {
                const int pos = hb ? tl : cj;
                const f32x4 c0 = *(const f32x4*)(ROPE + pos * 32 + jb), c1 = *(const f32x4*)(ROPE + pos * 32 + jb + 4);
                const f32x4 s0 = *(const f32x4*)(ROPE + 2048 + pos * 32 + jb), s1 = *(const f32x4*)(ROPE + 2048 + pos * 32 + jb + 4);
#pragma unroll
                for (int e = 0; e < 4; ++e) { cs[e] = c0[e]; cs[4 + e] = c1[e]; sn[e] = s0[e]; sn[4 + e] = s1[e]; }
            } else {
#pragma unroll
                for (int e = 0; e < 8; ++e) { cs[e] = 1.f; sn[e] = 0.f; }
            }
            float x1[8], x2[8], o1[8], o2[8];
            unpack8(q1, x1); unpack8(q2, x2);
#pragma unroll
            for (int e = 0; e < 8; ++e) { o1[e] = x1[e] * cs[e] - x2[e] * sn[e]; o2[e] = x1[e] * sn[e] + x2[e] * cs[e]; }
            *(u32x4*)(Qs + r * 136 + d1) = pack8(o1); *(u32x4*)(Qs + r * 136 + d2) = pack8(o2);
            unpack8(k1, x1); unpack8(k2, x2);
            const float ksc = 0.08838834764831845f;
#pragma unroll
            for (int e = 0; e < 8; ++e) { o1[e] = (x1[e] * cs[e] - x2[e] * sn[e]) * ksc; o2[e] = (x1[e] * sn[e] + x2[e] * cs[e]) * ksc; }
            const u32x4 ko1 = pack8(o1), ko2 = pack8(o2);
            *(u32x4*)(Ks + r * 136 + d1) = ko1; *(u32x4*)(Ks + r * 136 + d2) = ko2;
            {
                const unsigned kw1[4] = {ko1.x, ko1.y, ko1.z, ko1.w}, kw2[4] = {ko2.x, ko2.y, ko2.z, ko2.w};
#pragma unroll
                for (int e = 0; e < 4; ++e) {
                    KT[(d1 + 2 * e) * 72 + r] = (bf16_t)(kw1[e] & 0xffffu); KT[(d1 + 2 * e + 1) * 72 + r] = (bf16_t)(kw1[e] >> 16);
                    KT[(d2 + 2 * e) * 72 + r] = (bf16_t)(kw2[e] & 0xffffu); KT[(d2 + 2 * e + 1) * 72 + r] = (bf16_t)(kw2[e] >> 16);
                }
                const unsigned vw1[4] = {v1.x, v1.y, v1.z, v1.w}, vw2[4] = {v2.x, v2.y, v2.z, v2.w};
#pragma unroll
                for (int e = 0; e < 4; ++e) {
                    VT[(seg * 16 + 2 * e) * 72 + r] = (bf16_t)(vw1[e] & 0xffffu); VT[(seg * 16 + 2 * e + 1) * 72 + r] = (bf16_t)(vw1[e] >> 16);
                    VT[(seg * 16 + 8 + 2 * e) * 72 + r] = (bf16_t)(vw2[e] & 0xffffu); VT[(seg * 16 + 8 + 2 * e + 1) * 72 + r] = (bf16_t)(vw2[e] >> 16);
                }
            }
            if (tid < 64) {
                const int rr = tid, tl2 = dir ? 63 - rr : rr;
                const float* g = GATES + (size_t)(rowbase + tl2) * 16;
                const float ig = g[dir * 8 + h] + gate_b[dir * 8 + h];
                const float fg = g[dir * 8 + 4 + h] + gate_b[dir * 8 + 4 + h];
                igs[rr] = ig; lfs[rr] = fminf(fg, 0.f) - __logf(1.f + __expf(-fabsf(fg)));
            }
        }
        __syncthreads();
        if (w == 0) {
            float bcs = lfs[lane];
#pragma unroll
            for (int o = 1; o < 64; o <<= 1) { const float t = __shfl_up(bcs, o); if (lane >= o) bcs += t; }
            const float a = igs[lane] - bcs;
            float pm = a;
#pragma unroll
            for (int o = 1; o < 64; o <<= 1) { const float t = __shfl_up(pm, o); if (lane >= o) pm = fmaxf(pm, t); }
            const float Mx = fmaxf(m, pm);
            a_s[lane] = a; Mt[lane] = Mx; scs[lane] = __expf(m - Mx); emt[lane] = __expf(-bcs - Mx);
            if (lane == 63) { scal[0] = bcs; scal[1] = Mx; }
        }
        {
            const int st = w & 3, tt0 = (w >> 2) * 2;
            f32x4 sacc[2];
#pragma unroll
            for (int u = 0; u < 2; ++u) {
                sacc[u] = (f32x4){0.f, 0.f, 0.f, 0.f};
#pragma unroll
                for (int kk = 0; kk < 4; ++kk) {
                    const bf16x8 Ak = *(const bf16x8*)(Ks + (st * 16 + fr) * 136 + kk * 32 + fq * 8);
                    const bf16x8 Bq = *(const bf16x8*)(Qs + ((tt0 + u) * 16 + fr) * 136 + kk * 32 + fq * 8);
                    sacc[u] = mfma16(Ak, Bq, sacc[u]);
                }
            }
            __syncthreads();
#pragma unroll
            for (int u = 0; u < 2; ++u) {
                const int t = (tt0 + u) * 16 + fr, sb = st * 16 + fq * 4;
                const float Mv = Mt[t];
                float pv[4];
#pragma unroll
                for (int j = 0; j < 4; ++j) { const int s = sb + j; pv[j] = (s <= t) ? sacc[u][j] * __expf(a_s[s] - Mv) : 0.f; }
                u32x2 o; o.x = pk2(pv[0], pv[1]); o.y = pk2(pv[2], pv[3]);
                *(u32x2*)(Ps + t * 72 + sb) = o;
            }
        }
        __syncthreads();
        {
            const int tt = w & 3, up = w >> 2, vt0 = up ? 5 : 0, nvt = up ? 4 : 5;
            bf16x8 qf[4], pf[2];
#pragma unroll
            for (int kk = 0; kk < 4; ++kk) qf[kk] = *(const bf16x8*)(Qs + (tt * 16 + fr) * 136 + kk * 32 + fq * 8);
#pragma unroll
            for (int kk = 0; kk < 2; ++kk) pf[kk] = *(const bf16x8*)(Ps + (tt * 16 + fr) * 72 + kk * 32 + fq * 8);
            const float sct = scs[tt * 16 + fr];
            f32x4 hacc[5];
#pragma unroll
            for (int vi = 0; vi < 5; ++vi) {
                hacc[vi] = (f32x4){0.f, 0.f, 0.f, 0.f};
                if (vi < nvt) {
                    const int v0 = (vt0 + vi) * 16;
                    f32x4 ac = (f32x4){0.f, 0.f, 0.f, 0.f};
#pragma unroll
                    for (int kk = 0; kk < 4; ++kk) ac = mfma16(*(const bf16x8*)(Cb + (v0 + fr) * 136 + kk * 32 + fq * 8), qf[kk], ac);
                    ac = ac * sct;
#pragma unroll
                    for (int kk = 0; kk < 2; ++kk) ac = mfma16(*(const bf16x8*)(VT + (v0 + fr) * 72 + kk * 32 + fq * 8), pf[kk], ac);
                    hacc[vi] = ac;
                }
            }
            if (up && fq == 0) den[tt * 16 + fr] = hacc[3][0];
            __syncthreads();
            const int t = tt * 16 + fr, tl = dir ? 63 - t : t;
            const float dn = den[t];
            const float inv = 1.f / fmaxf(fabsf(dn), emt[t]);
            bf16_t* orow = HFB + (size_t)(rowbase + tl) * 512 + h * 128;
#pragma unroll
            for (int vi = 0; vi < 5; ++vi) {
                if (vi < nvt && (vt0 + vi) < 8) {
                    const int v0 = (vt0 + vi) * 16 + fq * 4;
                    u32x2 o; o.x = pk2(hacc[vi][0] * inv, hacc[vi][1] * inv); o.y = pk2(hacc[vi][2] * inv, hacc[vi][3] * inv);
                    *(u32x2*)(orow + v0) = o;
                }
            }
        }
        {
            const float bl = scal[0], M63 = scal[1];
            const float decay = __expf(m - M63);
            bf16x8 ka[2];
#pragma unroll
            for (int kk = 0; kk < 2; ++kk) {
                const u32x4 raw = *(const u32x4*)(KT + (w * 16 + fr) * 72 + kk * 32 + fq * 8);
                float f[8]; unpack8(raw, f);
#pragma unroll
                for (int j = 0; j < 8; ++j) f[j] *= __expf(a_s[kk * 32 + fq * 8 + j] - M63);
                ka[kk] = as_bf8(pack8(f));
            }
#pragma unroll
            for (int vt = 0; vt < 9; ++vt) {
                f32x4 ac = cacc[vt] * decay;
#pragma unroll
                for (int kk = 0; kk < 2; ++kk) ac = mfma16(ka[kk], *(const bf16x8*)(VT + (vt * 16 + fr) * 72 + kk * 32 + fq * 8), ac);
                cacc[vt] = ac;
                u32x2 o; o.x = pk2(ac[0], ac[1]); o.y = pk2(ac[2], ac[3]);
                *(u32x2*)(Cb + (vt * 16 + fr) * 136 + w * 16 + fq * 4) = o;
            }
            m = bl + M63;
        }
        __syncthreads();
    }
}

__device__ __forceinline__ void combine_phase(const Params& p, int li) {
    const int tid = tid_l(), lane = tid & 63, gw = blockIdx.x * 8 + (tid >> 6), ngw = gridDim.x * 8;
    const bf16_t* HF = (const bf16_t*)(p.ws + WS_HFB); const bf16_t* HB = HF + (size_t)MTOT * 512;
    const bf16_t* QKVO = (const bf16_t*)(p.ws + WS_BIG);
    bf16_t* MIX = (bf16_t*)(p.ws + WS_ACT);
    const float* hn = p.in[10] + li * 512 + lane * 8;
    float g[8];
#pragma unroll
    for (int e = 0; e < 8; ++e) g[e] = hn[e];
    for (int row = gw; row < MTOT; row += ngw) {
        float a[8], bq[8], og[8], y[8];
        unpack8(*(const u32x4*)(HF + (size_t)row * 512 + lane * 8), a);
        unpack8(*(const u32x4*)(HB + (size_t)row * 512 + lane * 8), bq);
        unpack8(*(const u32x4*)(QKVO + (size_t)row * 2048 + 1536 + lane * 8), og);
        float ss = 0.f;
#pragma unroll
        for (int e = 0; e < 8; ++e) { a[e] += bq[e]; ss += a[e] * a[e]; }
        ss += __shfl_xor(ss, 1); ss += __shfl_xor(ss, 2); ss += __shfl_xor(ss, 4); ss += __shfl_xor(ss, 8);
        const float rstd = rsqrtf(ss * (1.f / 128.f) + EPS);
#pragma unroll
        for (int e = 0; e < 8; ++e) y[e] = a[e] * rstd * g[e] / (1.f + __expf(-og[e]));
        *(u32x4*)(MIX + (size_t)row * 1024 + lane * 8) = pack8(y);
    }
}

__device__ __forceinline__ bf16x8 hy_afrag(const bf16_t* HRp, int q, int m, int o4, int hsh) {
    const bf16_t* ap = HRp + (q + 8 - m);
    const u32x4 lo = *(const u32x4*)ap, hi = *(const u32x4*)(ap + 8);
    const bool b0 = (o4 & 1) != 0, b1 = (o4 & 2) != 0;
#define HYSEL(A_, B_, C_, D_) (b1 ? (b0 ? (D_) : (C_)) : (b0 ? (B_) : (A_)))
    const unsigned w0 = HYSEL(lo.x, lo.y, lo.z, lo.w), w1 = HYSEL(lo.y, lo.z, lo.w, hi.x), w2 = HYSEL(lo.z, lo.w, hi.x, hi.y),
                   w3 = HYSEL(lo.w, hi.x, hi.y, hi.z), w4 = HYSEL(hi.x, hi.y, hi.z, hi.w);
#undef HYSEL
    u32x4 o;
    o.x = __builtin_amdgcn_alignbit(w1, w0, hsh); o.y = __builtin_amdgcn_alignbit(w2, w1, hsh);
    o.z = __builtin_amdgcn_alignbit(w3, w2, hsh); o.w = __builtin_amdgcn_alignbit(w4, w3, hsh);
    return as_bf8(o);
}

template <int L>
__device__ __forceinline__ void hyena_item(const Params& p, int li, int c, bool dry = false) {
    constexpr int ZS = L + 8, NI = L / 128, NS = L / 32;
    const int tid = tid_l(), w = tid >> 6, lane = tid & 63, fr = lane & 15, fq = lane >> 4;
    bf16_t* ZA = (bf16_t*)dyn_lds; bf16_t* ZB = ZA + 16 * ZS; bf16_t* HFl = ZB + 16 * ZS;
    const int segbase = (L == 2048) ? 0 : NLAT;
    const bf16_t* HYT = (const bf16_t*)(p.ws + WS_P2);
    bf16_t* MIX = (bf16_t*)(p.ws + WS_ACT);
    const float* cw = p.in[11] + (size_t)li * 3 * 1536; const float* cb = p.in[12] + (size_t)li * 1536; const float* hd = p.in[19] + (size_t)li * 2 * 512;
    const bf16_t* FIL = (L == 2048) ? (const bf16_t*)(p.ws + WS_FLAT) : (const bf16_t*)(p.ws + WS_FCTX);
    {
        const float w0 = cw[c], w1 = cw[1536 + c], w2 = cw[2 * 1536 + c], bb = cb[c];
        const bf16_t* src = HYT + (size_t)c * MTOT + segbase;
#pragma unroll
        for (int ci = 0; ci < (16 * L / 8 + NT - 1) / NT; ++ci) {
            const int ch = tid + ci * NT; if (ch >= 16 * L / 8) break;
            const int b = ch / (L / 8), t0 = (ch % (L / 8)) * 8;
            const bf16_t* s = src + b * L + t0;
            float x[10], y[8];
            const float xl = b2f(s[t0 > 0 ? -1 : 0]), xr = b2f(s[(t0 + 8 < L) ? 8 : 7]);
            unpack8(*(const u32x4*)s, x + 1);
            x[0] = t0 > 0 ? xl : 0.f; x[9] = (t0 + 8 < L) ? xr : 0.f;
#pragma unroll
            for (int e = 0; e < 8; ++e) y[e] = bb + w0 * x[e] + w1 * x[e + 1] + w2 * x[e + 2];
            *(u32x4*)(ZA + b * ZS + t0) = pack8(y);
        }
    }
#pragma unroll 1
    for (int o = 0; o < 2; ++o) {
        for (int i = tid; i < 2 * L / 8; i += NT) {
            const u32x4 v = *(const u32x4*)(FIL + ((size_t)o * 512 + c) * 2 * L + i * 8);
            u32x4 rv; rv.x = (v.w >> 16) | (v.w << 16); rv.y = (v.z >> 16) | (v.z << 16); rv.z = (v.y >> 16) | (v.y << 16); rv.w = (v.x >> 16) | (v.x << 16);
            *(u32x4*)(HFl + 8 + 2 * L - 8 - 8 * i) = rv;
        }
        if (tid < 8) HFl[tid] = 0; else if (tid < 24) HFl[2 * L + tid] = 0;
        __syncthreads();
        const bf16_t* Zin = o ? ZB : ZA;
        const int gc = (o + 1) * 512 + c;
        const float gw0 = cw[gc], gw1 = cw[1536 + gc], gw2 = cw[2 * 1536 + gc], gb = cb[gc], dsk = hd[o * 512 + c];
        const bf16_t* gs = HYT + (size_t)gc * MTOT + segbase + fr * L;
        constexpr int NIB = NI < 8 ? NI : 8;
#pragma unroll 1
        for (int hp = 0; hp < NI; hp += NIB) {
            f32x4 acc[NIB];
#pragma unroll
            for (int i = 0; i < NIB; ++i) acc[i] = (f32x4){0.f, 0.f, 0.f, 0.f};
            constexpr int NQ = NS / 4;
            const int am = (7 - fr) & 7, ao4 = am >> 1, ahs = (am & 1) * 16;
            u32x2 pgv[NIB]; bf16_t pxl[NIB], pxr[NIB];
#pragma unroll
            for (int i = 0; i < NIB; ++i) {
                const int t0 = 16 * (w + 8 * (hp + i)) + fq * 4;
                pxl[i] = gs[t0 > 0 ? t0 - 1 : 0]; pxr[i] = gs[(t0 + 4 < L) ? t0 + 4 : L - 1];
                pgv[i] = *(const u32x2*)(gs + t0);
            }
#pragma unroll 1
            for (int r = 0; r < 4; ++r) {
                bf16x8 Aw[NIB];
#pragma unroll
                for (int i = 0; i < NIB; ++i) {
                    Aw[i] = hy_afrag(HFl, (L - 1) - 16 * w - 32 * (4 * (hp + i) - r) - fr + fq * 8, am, ao4, ahs);
                }
#pragma unroll 1
                for (int qc = 0; qc < NQ; qc += NIB) {
#pragma unroll
                    for (int qq = 0; qq < NIB; ++qq) {
                        const int q = qc + qq;
                        const bf16x8 Bz = *(const bf16x8*)(Zin + fr * ZS + (4 * q + r) * 32 + fq * 8);
#pragma unroll
                        for (int i = 0; i < NIB; ++i) acc[i] = mfma16(Aw[(i - qq + NIB) % NIB], Bz, acc[i]);
                        if (q + 1 < NQ) {
                            Aw[(NIB - 1 - qq) % NIB] = hy_afrag(HFl, (L - 1) - 16 * w - 32 * (4 * (hp - q - 1) - r) - fr + fq * 8, am, ao4, ahs);
                        }
                    }
                }
            }
#pragma unroll
            for (int i = 0; i < NIB; ++i) {
                const int t0 = 16 * (w + 8 * (hp + i)) + fq * 4;
                float x[6];
                const float xl = b2f(pxl[i]), xr = b2f(pxr[i]);
                const u32x2 gv = pgv[i];
                x[0] = t0 > 0 ? xl : 0.f;
                x[1] = blo(gv.x); x[2] = bhi(gv.x); x[3] = blo(gv.y); x[4] = bhi(gv.y);
                x[5] = (t0 + 4 < L) ? xr : 0.f;
                const u32x2 zv = *(const u32x2*)(Zin + fr * ZS + t0);
                const float z[4] = {blo(zv.x), bhi(zv.x), blo(zv.y), bhi(zv.y)};
                float val[4];
#pragma unroll
                for (int j = 0; j < 4; ++j) val[j] = (gb + gw0 * x[j] + gw1 * x[j + 1] + gw2 * x[j + 2]) * (acc[i][j] + dsk * z[j]);
                { u32x2 ov; ov.x = pk2(val[0], val[1]); ov.y = pk2(val[2], val[3]); *(u32x2*)((o == 0 ? ZB : ZA) + fr * ZS + t0) = ov; }
            }
        }
        __syncthreads();
    }
    if (!dry) {
        bf16_t* dstp = (bf16_t*)(p.ws + WS_P2) + (size_t)c * MTOT + segbase;
#pragma unroll
        for (int ci = 0; ci < (16 * L / 8 + NT - 1) / NT; ++ci) {
            const int ch = tid + ci * NT; if (ch >= 16 * L / 8) break;
            const int b = ch / (L / 8), t0 = (ch % (L / 8)) * 8;
            *(u32x4*)(dstp + b * L + t0) = *(const u32x4*)(ZA + b * ZS + t0);
        }
        __syncthreads();
    }
}

__device__ __forceinline__ void hy_transpose(const Params& p) {
    const int tid = tid_l();
    bf16_t* T = (bf16_t*)dyn_lds;
    const bf16_t* HYO = (const bf16_t*)(p.ws + WS_P2);
    bf16_t* MIX = (bf16_t*)(p.ws + WS_ACT);
    for (int it = blockIdx.x; it < (MTOT / 64) * 8; it += gridDim.x) {
        const int tt = it >> 3, cg_ = it & 7, tok0 = tt * 64, c0 = cg_ * 64;
        {
            const int ch = tid >> 3, t8 = (tid & 7) * 8;
            const u32x4 v = *(const u32x4*)(HYO + (size_t)(c0 + ch) * MTOT + tok0 + t8);
            const unsigned wv[4] = {v.x, v.y, v.z, v.w};
#pragma unroll
            for (int e = 0; e < 4; ++e) { T[(t8 + 2 * e) * 72 + ch] = (bf16_t)(wv[e] & 0xffffu); T[(t8 + 2 * e + 1) * 72 + ch] = (bf16_t)(wv[e] >> 16); }
        }
        __syncthreads();
        {
            const int tk = tid >> 3, c8 = (tid & 7) * 8;
            *(u32x4*)(MIX + (size_t)(tok0 + tk) * 1024 + 512 + c0 + c8) = *(const u32x4*)(T + tk * 72 + c8);
        }
        __syncthreads();
    }
}

__device__ __forceinline__ void qknorm_phase(const Params& p, int li) {
    const int tid = tid_l(), lane = tid & 63, gw = blockIdx.x * 8 + (tid >> 6), ngw = gridDim.x * 8;
    bf16_t* QK = (bf16_t*)(p.ws + WS_BIG);
    float gq[8], gk[8];
#pragma unroll
    for (int e = 0; e < 8; ++e) { gq[e] = p.in[22][li * 64 + (lane & 7) * 8 + e] * 0.125f; gk[e] = p.in[23][li * 64 + (lane & 7) * 8 + e]; }
    for (int row = gw; row < MTOT; row += ngw) {
        bf16_t* rp = QK + (size_t)row * QK_LD + lane * 8;
        u32x4 v[4];
#pragma unroll
        for (int j = 0; j < 4; ++j) v[j] = *(const u32x4*)(rp + j * 512);
#pragma unroll
        for (int j = 0; j < 4; ++j) {
            float f[8]; unpack8(v[j], f);
            float ss = 0.f;
#pragma unroll
            for (int e = 0; e < 8; ++e) ss += f[e] * f[e];
            ss += __shfl_xor(ss, 1); ss += __shfl_xor(ss, 2); ss += __shfl_xor(ss, 4);
            const float rstd = rsqrtf(ss * (1.f / 64.f) + EPS);
#pragma unroll
            for (int e = 0; e < 8; ++e) f[e] *= rstd * (j < 2 ? gq[e] : gk[e]);
            *(u32x4*)(rp + j * 512) = pack8(f);
        }
    }
}

template <bool LAT>
__device__ __forceinline__ void attn_item(const Params& p, int li, int b, int h, int sub, bool stage = true) {
    const int tid = tid_l(), w = tid >> 6, lane = tid & 63, fr = lane & 15, fq = lane >> 4;
    bf16_t* Pw = (bf16_t*)dyn_lds + w * (16 * 264);
    bf16_t* KC = (bf16_t*)(dyn_lds + 67584);
    bf16_t* VC = (bf16_t*)(dyn_lds + 67584 + 36864);
    float* rpbs = (float*)(dyn_lds + 67584 + 36864 + 33792);
    const bf16_t* QK = (const bf16_t*)(p.ws + WS_BIG);
    const bf16_t* VTg = (const bf16_t*)(p.ws + WS_P2ODD);
    bf16_t* MIX = (bf16_t*)(p.ws + WS_ACT);
    if (stage) {
    if (LAT) { const float* rp = p.in[24] + ((size_t)li * 16 + h) * 465; for (int i = tid; i < 465; i += NT) rpbs[i] = rp[i]; }
    {
        u32x4 kv[4], vv[4];
#pragma unroll
        for (int i = 0; i < 4; ++i) {
            const int c = tid + i * NT;
            kv[i] = *(const u32x4*)(QK + (size_t)(NLAT + b * 256 + (c >> 3)) * QK_LD + 1024 + h * 64 + (c & 7) * 8);
            vv[i] = *(const u32x4*)(VTg + (size_t)(h * 64 + (c >> 5)) * VT_LD + NLAT + b * 256 + (c & 31) * 8);
        }
#pragma unroll
        for (int i = 0; i < 4; ++i) {
            const int c = tid + i * NT;
            *(u32x4*)(KC + (c >> 3) * 72 + (c & 7) * 8) = kv[i];
            *(u32x4*)(VC + (c >> 5) * 264 + (c & 31) * 8) = vv[i];
        }
    }
    __syncthreads();
    }
    int r = 0, c0 = 0, rs = 0, cw0 = 0, qtok0;
    if (LAT) { r = sub * 2 + (w >> 2); const int qt = w & 3; c0 = qt * 16; qtok0 = b * 2048 + r * 64 + c0; rs = min(max(r - 4, 0), 24); cw0 = (qt == 0) ? 0 : (qt == 1) ? 8 : (qt == 2) ? 24 : 32; }
    else { qtok0 = NLAT + b * 256 + (sub * 8 + w) * 16; }
    bf16x8 qf[2];
    {
        const bf16_t* qp = QK + (size_t)(qtok0 + fr) * QK_LD + h * 64 + fq * 8;
        qf[0] = *(const bf16x8*)qp; qf[1] = *(const bf16x8*)(qp + 32);
    }
    f32x4 o1[4], o2[4];
    float m1 = -1e30f, l1 = 0.f, m2, l2 = 0.f;
#pragma unroll
    for (int dt = 0; dt < 4; ++dt) { o1[dt] = (f32x4){0.f, 0.f, 0.f, 0.f}; o2[dt] = (f32x4){0.f, 0.f, 0.f, 0.f}; }
    if (LAT) {
        f32x4 sreg[16];
        const int qc = c0 + fr; const int cstart = min(max(qc - 8, 0), 48);
#pragma unroll
        for (int kt = 0; kt < 16; ++kt) {
            const int kr = kt >> 1, kcb = cw0 + (kt & 1) * 16;
            const bf16_t* kp = QK + (size_t)(b * 2048 + (rs + kr) * 64 + kcb + fr) * QK_LD + 1024 + h * 64 + fq * 8;
            f32x4 sa = (f32x4){0.f, 0.f, 0.f, 0.f};
            sa = mfma16(*(const bf16x8*)kp, qf[0], sa); sa = mfma16(*(const bf16x8*)(kp + 32), qf[1], sa);
            const int dri = (rs + kr - r + 7) * 31;
#pragma unroll
            for (int j = 0; j < 4; ++j) {
                const int kc = kcb + fq * 4 + j;
                const bool valid = (kc >= cstart) && (kc < cstart + 16);
                const int dci = min(max(kc - qc + 15, 0), 30);
                sa[j] = valid ? sa[j] + rpbs[dri + dci] : -1e30f;
            }
            sreg[kt] = sa;
            if ((kt & 7) == 7) __builtin_amdgcn_sched_barrier(0);
        }
#pragma unroll
        for (int kt = 0; kt < 16; ++kt)
#pragma unroll
            for (int j = 0; j < 4; ++j) m1 = fmaxf(m1, sreg[kt][j]);
        m1 = fmaxf(m1, __shfl_xor(m1, 16)); m1 = fmaxf(m1, __shfl_xor(m1, 32));
#pragma unroll
        for (int kt = 0; kt < 16; ++kt) {
            float pj[4];
#pragma unroll
            for (int j = 0; j < 4; ++j) { pj[j] = __expf(sreg[kt][j] - m1); l1 += pj[j]; }
            u32x2 o; o.x = pk2(pj[0], pj[1]); o.y = pk2(pj[2], pj[3]);
            *(u32x2*)(Pw + fr * 264 + kt * 16 + fq * 4) = o;
        }
        l1 += __shfl_xor(l1, 16); l1 += __shfl_xor(l1, 32);
#pragma unroll
        for (int kb = 0; kb < 8; kb += 4) {
            bf16x8 vf[4][4], pf[4];
#pragma unroll
            for (int u = 0; u < 4; ++u) {
                const int ks = kb + u;
                const int vtok0 = b * 2048 + (rs + ks) * 64 + cw0;
#pragma unroll
                for (int dt = 0; dt < 4; ++dt) vf[u][dt] = *(const bf16x8*)(VTg + (size_t)(h * 64 + dt * 16 + fr) * VT_LD + vtok0 + fq * 8);
                pf[u] = *(const bf16x8*)(Pw + fr * 264 + ks * 32 + fq * 8);
            }
#pragma unroll
            for (int u = 0; u < 4; ++u)
#pragma unroll
                for (int dt = 0; dt < 4; ++dt) o1[dt] = mfma16(vf[u][dt], pf[u], o1[dt]);
            __builtin_amdgcn_sched_barrier(0);
        }
    }
    {
        f32x4 sreg[16];
#pragma unroll
        for (int kt = 0; kt < 16; ++kt) {
            const bf16_t* kp = KC + (kt * 16 + fr) * 72 + fq * 8;
            f32x4 sa = (f32x4){0.f, 0.f, 0.f, 0.f};
            sa = mfma16(*(const bf16x8*)kp, qf[0], sa); sa = mfma16(*(const bf16x8*)(kp + 32), qf[1], sa);
            sreg[kt] = sa;
        }
        m2 = -1e30f;
#pragma unroll
        for (int kt = 0; kt < 16; ++kt)
#pragma unroll
            for (int j = 0; j < 4; ++j) m2 = fmaxf(m2, sreg[kt][j]);
        m2 = fmaxf(m2, __shfl_xor(m2, 16)); m2 = fmaxf(m2, __shfl_xor(m2, 32));
#pragma unroll
        for (int kt = 0; kt < 16; ++kt) {
            float pj[4];
#pragma unroll
            for (int j = 0; j < 4; ++j) { pj[j] = __expf(sreg[kt][j] - m2); l2 += pj[j]; }
            u32x2 o; o.x = pk2(pj[0], pj[1]); o.y = pk2(pj[2], pj[3]);
            *(u32x2*)(Pw + fr * 264 + kt * 16 + fq * 4) = o;
        }
        l2 += __shfl_xor(l2, 16); l2 += __shfl_xor(l2, 32);
#pragma unroll
        for (int ks = 0; ks < 8; ++ks) {
            const bf16x8 pf = *(const bf16x8*)(Pw + fr * 264 + ks * 32 + fq * 8);
#pragma unroll
            for (int dt = 0; dt < 4; ++dt) o2[dt] = mfma16(*(const bf16x8*)(VC + (dt * 16 + fr) * 264 + ks * 32 + fq * 8), pf, o2[dt]);
        }
    }
    const float mm = fmaxf(m1, m2);
    const float a1 = LAT ? __expf(m1 - mm) : 0.f, a2 = __expf(m2 - mm);
    const float inv = 1.f / (l1 * a1 + l2 * a2);
    const float s1 = a1 * inv, s2 = a2 * inv;
#pragma unroll
    for (int dt = 0; dt < 4; ++dt) {
        const f32x4 ov = o1[dt] * s1 + o2[dt] * s2;
        u32x2 o; o.x = pk2(ov[0], ov[1]); o.y = pk2(ov[2], ov[3]);
        *(u32x2*)(MIX + (size_t)(qtok0 + fr) * 1024 + h * 64 + dt * 16 + fq * 4) = o;
    }
    __syncthreads();
}


#ifdef DBG_NAN
__device__ __forceinline__ bool bad16(bf16_t v) { return ((v >> 7) & 0xFF) >= 227; }
__device__ __forceinline__ bool bad32(float f) { return !(fabsf(f) < 1e30f); }
__device__ __forceinline__ void scan16(const bf16_t* p, size_t n, unsigned* flags, unsigned bit) {
    bool bad = false;
    for (size_t i = (size_t)blockIdx.x * NT + threadIdx.x; i < n; i += (size_t)gridDim.x * NT) bad |= bad16(p[i]);
    if (bad) atomicOr(flags, bit);
}
__device__ __forceinline__ void scan32(const float* p, size_t n, unsigned* flags, unsigned bit) {
    bool bad = false;
    for (size_t i = (size_t)blockIdx.x * NT + threadIdx.x; i < n; i += (size_t)gridDim.x * NT) bad |= bad32(p[i]);
    if (bad) atomicOr(flags, bit);
}
#endif

#define XB_TMO      128
#define XB_XCNT(j)  (256  + 64 * (j))
#define XB_XSUB(j)  (1280 + 64 * (j))
#define XB_XGEN(j)  (2304 + 64 * (j))
#define XB_TOP      3328
#define XB_TOPGEN   3392
#define XCD_BAR_WORDS 3456
#define XB_SPIN_CAP (1u << 20)
#define LAS __attribute__((address_space(3)))
__device__ __forceinline__ unsigned xb_ld(unsigned* p)              { return __hip_atomic_load(p, __ATOMIC_RELAXED, __HIP_MEMORY_SCOPE_AGENT); }
__device__ __forceinline__ unsigned xb_add(unsigned* p, unsigned v) { return __hip_atomic_fetch_add(p, v, __ATOMIC_RELAXED, __HIP_MEMORY_SCOPE_AGENT); }
__device__ __forceinline__ unsigned xb_xcc_id() { return (unsigned)__builtin_amdgcn_s_getreg((3 << 11) | 20) & 0xFu; }
#define XB_SPIN(cond, bar) do { unsigned _sp = 0; while (cond) { __builtin_amdgcn_s_sleep(1); \
    if ((++_sp & 255u) == 0u) { if (xb_ld(&(bar)[XB_TMO])) break; if (_sp > XB_SPIN_CAP) { atomicAdd(&(bar)[XB_TMO], 1u); break; } } } } while (0)
struct XcdBarrier { unsigned* bar; unsigned x; volatile LAS unsigned* st; };
__device__ __forceinline__ XcdBarrier xcd_barrier_post(unsigned* bar, volatile LAS unsigned* st) {
    XcdBarrier b; b.bar = bar; b.x = xb_xcc_id(); b.st = st;
    if (threadIdx.x == 0) (void)xb_add(&bar[XB_XCNT(b.x)], 1u);
    return b;
}
__device__ __forceinline__ void xcd_barrier_complete(unsigned* bar, unsigned x, unsigned& nloc, unsigned& nx) {
    const unsigned G = gridDim.x * gridDim.y * gridDim.z;
    unsigned sum, cnt, mine, sp = 0u;
    for (;;) {
        sum = 0u; cnt = 0u; mine = 0u;
#pragma unroll
        for (unsigned j = 0; j < 16; ++j) { const unsigned c = xb_ld(&bar[XB_XCNT(j)]); sum += c; cnt += (c > 0u) ? 1u : 0u; mine = (j == x) ? c : mine; }
        if (sum == G) break;
        __builtin_amdgcn_s_sleep(1);
        if ((++sp & 255u) == 0u) { if (xb_ld(&bar[XB_TMO])) break; if (sp > XB_SPIN_CAP) { atomicAdd(&bar[XB_TMO], 1u); break; } }
    }
    nloc = mine > 0u ? mine : 1u; nx = cnt > 0u ? cnt : 1u;
}
__device__ __forceinline__ void xcd_barrier(const XcdBarrier& b) {
    asm volatile("s_waitcnt vmcnt(0)" ::: "memory");
    __syncthreads();
    if (threadIdx.x == 0) {
        unsigned* bar = b.bar;
        __builtin_amdgcn_s_waitcnt(0);
        unsigned nloc = b.st[0], nx = b.st[1];
        if (nloc == 0u) { xcd_barrier_complete(bar, b.x, nloc, nx); b.st[0] = nloc; b.st[1] = nx; }
        const unsigned old = xb_add(&bar[XB_XSUB(b.x)], 1u);
        const unsigned gen = old / nloc;
        if (old + 1u == (gen + 1u) * nloc) {
            __builtin_amdgcn_fence(__ATOMIC_RELEASE, "agent");
            asm volatile("s_waitcnt vmcnt(0)" ::: "memory");
            const unsigned og = xb_add(&bar[XB_TOP], 1u);
            const unsigned tg = og / nx;
            if (og + 1u == (tg + 1u) * nx) xb_add(&bar[XB_TOPGEN], 1u);
            else XB_SPIN(xb_ld(&bar[XB_TOPGEN]) == tg, bar);
            __builtin_amdgcn_fence(__ATOMIC_ACQUIRE, "agent");
            xb_add(&bar[XB_XGEN(b.x)], 1u);
            asm volatile("s_waitcnt vmcnt(0)" ::: "memory");
        } else {
            XB_SPIN(xb_ld(&bar[XB_XGEN(b.x)]) == gen, bar);
            __builtin_amdgcn_fence(__ATOMIC_ACQUIRE, "agent");
            asm volatile("s_waitcnt vmcnt(0)" ::: "memory");
        }
    }
    __syncthreads();
}
constexpr size_t WS_BAR = WS_END + 32768;

#ifdef TPROBE_A
#define GSYNC() do { asm volatile("s_waitcnt vmcnt(0) lgkmcnt(0)" ::: "memory"); grid.sync(); ++nsync_; if (nsync_ == TPROBE_A) t0_ = wall_clock64(); if (nsync_ == TPROBE_B) t1_ = wall_clock64(); } while (0)
#else
#define GSYNC() xcd_barrier(xbar_)
#endif
#define GSYNC_CG() do { asm volatile("s_waitcnt vmcnt(0) lgkmcnt(0)" ::: "memory"); grid.sync(); } while (0)
__global__ void __launch_bounds__(NT) fwd_megakernel(Params p) {
    cg::grid_group grid = cg::this_grid();
#ifdef TPROBE_A
    int nsync_ = 0; long long t0_ = 0, t1_ = 0;
#endif
    const int blk = blockIdx.x, G = gridDim.x;
    bf16_t* WIN = (bf16_t*)(p.ws + WS_WIN); bf16_t* WOUT = (bf16_t*)(p.ws + WS_WOUT); bf16_t* WM1 = (bf16_t*)(p.ws + WS_WM1); bf16_t* WM2 = (bf16_t*)(p.ws + WS_WM2);
    bf16_t* ACT = (bf16_t*)(p.ws + WS_ACT); bf16_t* BIG = (bf16_t*)(p.ws + WS_BIG);
    float* XC = (float*)(p.ws + WS_XC);
    const float* MOD = (const float*)(p.ws + WS_MOD);
    volatile LAS unsigned* xst_ = (volatile LAS unsigned*)(dyn_lds + LDS_BYTES - 16);
    if (threadIdx.x == 0) { xst_[0] = 0u; xst_[1] = 0u; }
    __syncthreads();
    const XcdBarrier xbar_ = xcd_barrier_post((unsigned*)(p.ws + WS_BAR), xst_);
    REP(64) if (PHMASK & 1) phase0(p);
#ifdef DBG_NAN
    unsigned* dflags = (unsigned*)(p.ws + WS_END);
    if (blk == 0 && threadIdx.x < 64) dflags[threadIdx.x] = 0u;
#endif
    GSYNC_CG();
#pragma unroll 1
    for (int l = 0; l < 4; ++l) {
        const bool even = !(l & 1), last = (l == 3); const int li = l >> 1;
        const float* xlat = (l == 0) ? p.in[0] : p.out; const float* xctx = (l == 0) ? p.in[2] : XC;
        const int Mtail = last ? NLAT : MTOT;
        REP(1) {
        if (PHMASK & 2) convert_weights(p, l, l == 0 || G < 256, true, 0, G);
        if (PHMASK & 4) norm_phase(p, l, xlat, xctx, 0, 1024, MTOT);
        if ((PHMASK & 8) && even) filter_gen(p, li);
        }
        GSYNC();
        {
            EpiArgs ea{}; ea.o_rm = BIG; ea.ld_rm = even ? 2048 : QK_LD; ea.o_cm = (bf16_t*)(p.ws + (even ? WS_P2 : WS_P2ODD)); ea.ld_cm = even ? MTOT : VT_LD; ea.gates = (float*)(p.ws + WS_GATES); ea.gate_pn = even ? 14 : -1; ea.o_dbg = (bf16_t*)(p.ws + WS_HFB);
            REP(2) if (PHMASK & 16) gemm_phase<EPI_INPROJ>(ACT, WIN, MTOT, even ? 3840 : 3072, 1024, ea);
        }
        GSYNC();
#ifdef DBG_NAN
        if (l == DBG_LAYER) {
            {
                const unsigned gid = blk * NT + threadIdx.x;
                unsigned hsh = gid * 2654435761u + 12345u; hsh ^= hsh >> 13; hsh *= 2246822519u; hsh ^= hsh >> 16;
                const int row = hsh % MTOT; const int col = (hsh >> 8) % 2048; const int ch = (hsh >> 4) % 1536;
                const bf16_t* ar = ACT + (size_t)row * 1024; const bf16_t* wq = WIN + (size_t)col * 1024; const bf16_t* wh = WIN + (size_t)(2048 + ch) * 1024;
                float sq = 0.f, sh_ = 0.f;
                for (int k = 0; k < 1024; ++k) { const float av = b2f(ar[k]); sq += av * b2f(wq[k]); sh_ += av * b2f(wh[k]); }
                const float gq = b2f(BIG[(size_t)row * 2048 + col]);
                const float gh = b2f(((const bf16_t*)(p.ws + WS_P2))[(size_t)ch * MTOT + row]);
                (void)gq; (void)sq;

                { const int cls = DBG_CLS; atomicAdd(dflags + 16 + cls, 1u);
                  if (!(fabsf(gh - sh_) <= 0.05f + 0.02f * fabsf(sh_))) { atomicAdd(dflags + 2, 1u); atomicAdd(dflags + 32 + cls, 1u); } }
            }
            GSYNC();
            if (blk == 0 && threadIdx.x == 0) {
                const float fQ = (float)__hip_atomic_load(dflags + 1, __ATOMIC_RELAXED, __HIP_MEMORY_SCOPE_AGENT) / (float)(G * NT);
                const float fH = (float)__hip_atomic_load(dflags + 2, __ATOMIC_RELAXED, __HIP_MEMORY_SCOPE_AGENT) / (float)(G * NT);
                unsigned mask = 0;
                for (int q_ = 0; q_ < 8; ++q_) { const unsigned tot = __hip_atomic_load(dflags + 16 + q_, __ATOMIC_RELAXED, __HIP_MEMORY_SCOPE_AGENT), bad = __hip_atomic_load(dflags + 32 + q_, __ATOMIC_RELAXED, __HIP_MEMORY_SCOPE_AGENT); if (bad * 4 > tot) mask |= 1u << q_; }
                float code = 1e5f; for (unsigned q_ = 0; q_ < (mask >> 4); ++q_) code *= 10.f;
                const unsigned n3 = __hip_atomic_load(dflags + 3, __ATOMIC_RELAXED, __HIP_MEMORY_SCOPE_AGENT), b1 = __hip_atomic_load(dflags + 1, __ATOMIC_RELAXED, __HIP_MEMORY_SCOPE_AGENT), b4 = __hip_atomic_load(dflags + 4, __ATOMIC_RELAXED, __HIP_MEMORY_SCOPE_AGENT);
                p.out[0] = code * (1.f + 0.5f * (float)(mask & 15)) + 0.f * (fQ + fH + (float)(n3 + b1 + b4));
            }
            return;
        }
#endif
        if (!even) { qknorm_phase(p, li); GSYNC(); }
        if (even) {
            REP(4) if (G >= 256) {
                if (blk < 128) { REP(512) if (PHMASK & 32) mlstm_item(p, li, blk);
                    if (DUPMASK & 1024) { hyena_item<2048>(p, li, 384 + blk, true); hyena_item<256>(p, li, 384 + blk, true); }
                    if (PHMASK & 64) { hyena_item<2048>(p, li, 384 + blk); hyena_item<256>(p, li, 384 + blk); } }
                else { const int hb = blk - 128;
                    if (DUPMASK & 1024) for (int it = hb; it < 384; it += 128) { hyena_item<2048>(p, li, it, true); hyena_item<256>(p, li, it, true); }
                    if (PHMASK & 64) for (int it = hb; it < 384; it += 128) { hyena_item<2048>(p, li, it); hyena_item<256>(p, li, it); } }
            } else {
            }
            GSYNC();
            if (PHMASK & 128) { combine_phase(p, li); hy_transpose(p); }
        } else {
            const int x = blk & 7, y = blk >> 3, ny = (G + 7) >> 3;
            REP(256) for (int i = 0; ; ++i) {
                const int slot = i * ny + y;
                if (slot >= 512) break;
                const int bh = x * 32 + 4 * (i >> 1) + (y >> 3), rp = (y & 7) * 2 + (i & 1);
                if (PHMASK & 256) attn_item<true>(p, li, bh >> 4, bh & 15, rp, (i & 1) == 0 || ny != 32);
            }
            if ((PHMASK & 512) && !last) for (int it = blk; it < 512; it += G) attn_item<false>(p, li, it >> 5, (it >> 1) & 15, it & 1);
        }
        GSYNC();
        {
            EpiArgs ea{}; ea.res_lat = xlat; ea.res_ctx = xctx; ea.out_lat = p.out; ea.out_ctx = XC; ea.modg = MOD + (size_t)l * 17 * 6144 + 2048;
            if (DUPMASK & 32) gemm_phase<EPI_DRY>(ACT, WOUT, Mtail, 1024, 1024, ea);
            if (PHMASK & 1024) gemm_phase<EPI_RESID>(ACT, WOUT, Mtail, 1024, 1024, ea);
        }
        GSYNC();
        REP(8) norm_phase(p, l, p.out, XC, 3072, 4096, Mtail);
        GSYNC();
        { EpiArgs ea{}; ea.o_rm = BIG; ea.ld_rm = 4096; ea.gate_pn = -1; REP(16) if (PHMASK & 2048) gemm_phase<EPI_RELU2>(ACT, WM1, Mtail, 4096, 1024, ea); }
        GSYNC();
        {
            EpiArgs ea{}; ea.res_lat = p.out; ea.res_ctx = XC; ea.out_lat = p.out; ea.out_ctx = XC; ea.modg = MOD + (size_t)l * 17 * 6144 + 5120;
            if (DUPMASK & 32) gemm_phase<EPI_DRY>(BIG, WM2, Mtail, 1024, 4096, ea);
            if (PHMASK & 4096) gemm_phase<EPI_RESID>(BIG, WM2, Mtail, 1024, 4096, ea);
            if (!last && G >= 256) convert_weights(p, l + 1, true, false, 128, G - 128);
        }
        GSYNC();
    }
#ifdef TPROBE_A
    if (blk == 0 && threadIdx.x == 0) p.out[0] = (float)(t1_ - t0_) * 10.f;
#endif
}

extern "C" void kernel_launch(void* const* d_in, const int* in_sizes, int n_in, void* d_out, int out_size, void* d_ws, size_t ws_size, hipStream_t stream) {
    static int grid_blocks = 0;
    if (grid_blocks == 0) {
        if (n_in != 26 || ws_size < WS_BAR + XCD_BAR_WORDS * 4) { fprintf(stderr, "kernel_launch: unexpected n_in %d or ws_size %zu (< %zu)\n", n_in, ws_size, (size_t)WS_END); grid_blocks = -1; return; }
        int dev = 0, cus = 0, per_cu = 0;
        hipGetDevice(&dev);
        hipDeviceGetAttribute(&cus, hipDeviceAttributeMultiprocessorCount, dev);
        if (hipFuncSetAttribute((const void*)fwd_megakernel, hipFuncAttributeMaxDynamicSharedMemorySize, LDS_BYTES) != hipSuccess) fprintf(stderr, "kernel_launch: hipFuncSetAttribute failed\n");
        if (hipOccupancyMaxActiveBlocksPerMultiprocessor(&per_cu, (const void*)fwd_megakernel, NT, LDS_BYTES) != hipSuccess || per_cu < 1) { fprintf(stderr, "kernel_launch: occupancy query gave %d\n", per_cu); per_cu = 1; }
        (void)hipGetLastError();
        grid_blocks = cus * 1;
        fprintf(stderr, "kernel_launch: cus %d per_cu %d grid %d\n", cus, per_cu, grid_blocks);
    }
    if (grid_blocks < 0) return;
    if (hipMemsetAsync((char*)d_ws + WS_BAR, 0, XCD_BAR_WORDS * 4, stream) != hipSuccess) { fprintf(stderr, "kernel_launch: memset of barrier words failed\n"); return; }
    Params p{};
    for (int i = 0; i < 26; ++i) p.in[i] = (const float*)d_in[i];
    p.out = (float*)d_out; p.ws = (unsigned char*)d_ws;
    void* args[] = {&p};
    hipError_t e = hipLaunchCooperativeKernel((void*)fwd_megakernel, dim3(grid_blocks), dim3(NT), args, LDS_BYTES, stream);
    if (e != hipSuccess) fprintf(stderr, "cooperative launch failed: %s (grid %d)\n", hipGetErrorString(e), grid_blocks);
}
```

```cpp
#include <hip/hip_runtime.h>
#include <hip/hip_cooperative_groups.h>
#include <cstdio>
#include <cstdint>
namespace cg = cooperative_groups;

typedef unsigned short bf16_t;
typedef short bf16x8 __attribute__((ext_vector_type(8)));
typedef float f32x4 __attribute__((ext_vector_type(4)));
typedef unsigned u32x4 __attribute__((ext_vector_type(4)));
typedef unsigned u32x2 __attribute__((ext_vector_type(2)));

#define NT 512
#define DBG_LAYER 0
#define DBG_CLS ((((row % 64) / 16) * 2) + ((ch % 32) / 16))
#ifndef PHMASK
#define PHMASK 0xFFFF
#endif
#ifndef DUPMASK
#define DUPMASK 0
#endif
#define REP(bit) for (int rep_ = 0; rep_ < (((DUPMASK) & (bit)) ? 2 : 1); ++rep_)
constexpr int BATCH = 16, SEQ = 2048, DM = 1024, CTXL = 256;
constexpr int NLAT = BATCH * SEQ, NCTX = BATCH * CTXL, MTOT = NLAT + NCTX;
constexpr int DFF = 4096;
constexpr float EPS = 1e-6f;
constexpr int LDS_BYTES = 147456;

constexpr size_t al256(size_t x) { return (x + 255) & ~(size_t)255; }
constexpr size_t WS_WIN = 0;
constexpr size_t WS_WOUT = al256(WS_WIN + (size_t)3840 * 1024 * 2);
constexpr size_t WS_WM1 = al256(WS_WOUT + (size_t)1024 * 1024 * 2);
constexpr size_t WS_WM2 = al256(WS_WM1 + (size_t)4096 * 1024 * 2);
constexpr size_t WS_MOD = al256(WS_WM2 + (size_t)4096 * 1024 * 2);
constexpr size_t WS_XC = al256(WS_MOD + (size_t)4 * 17 * 6144 * 4);
constexpr size_t WS_ACT = al256(WS_XC + (size_t)NCTX * 1024 * 4);
constexpr size_t WS_BIG = al256(WS_ACT + (size_t)MTOT * 1024 * 2);
constexpr size_t WS_P2 = WS_BIG + (size_t)MTOT * 2048 * 2;
constexpr int QK_LD = 2048 + 64;
constexpr int VT_LD = MTOT + 64;
constexpr size_t WS_P2ODD = WS_BIG + (size_t)MTOT * QK_LD * 2;
constexpr size_t WS_GATES = WS_P2 + (size_t)1536 * MTOT * 2;
constexpr size_t WS_HFB = al256(WS_BIG + (size_t)MTOT * 4096 * 2);
constexpr size_t WS_FLAT = al256(WS_HFB + (size_t)2 * MTOT * 512 * 2);
constexpr size_t WS_FCTX = al256(WS_FLAT + (size_t)2 * 512 * 4096 * 2);
constexpr size_t WS_H2 = al256(WS_FCTX + (size_t)2 * 512 * 512 * 2);
constexpr size_t WS_ROPE = al256(WS_H2 + (size_t)2 * 2304 * 64 * 4);
constexpr size_t WS_END = al256(WS_ROPE + (size_t)2 * 64 * 32 * 4);
static_assert(WS_GATES + (size_t)MTOT * 16 * 4 <= WS_HFB, "projection overlay too large");
static_assert(WS_P2ODD + (size_t)1024 * VT_LD * 2 <= WS_HFB, "odd projection overlay too large");

struct Params { const float* in[26]; float* out; unsigned char* ws; };

typedef float f32x2_ __attribute__((ext_vector_type(2)));
typedef __bf16 bf16x2_ __attribute__((ext_vector_type(2)));
__device__ __forceinline__ unsigned pk2(float lo, float hi) { f32x2_ v = {lo, hi}; bf16x2_ b = __builtin_convertvector(v, bf16x2_); return __builtin_bit_cast(unsigned, b); }
__device__ __forceinline__ bf16_t f2b(float x) { return (bf16_t)(pk2(x, 0.f) & 0xffffu); }
__device__ __forceinline__ float b2f(bf16_t b) { return __uint_as_float(((unsigned)b) << 16); }
__device__ __forceinline__ float blo(unsigned w) { return __uint_as_float(w << 16); }
__device__ __forceinline__ float bhi(unsigned w) { return __uint_as_float(w & 0xffff0000u); }
__device__ __forceinline__ void unpack8(u32x4 v, float* f) {
    f[0] = blo(v.x); f[1] = bhi(v.x); f[2] = blo(v.y); f[3] = bhi(v.y); f[4] = blo(v.z); f[5] = bhi(v.z); f[6] = blo(v.w); f[7] = bhi(v.w);
}
__device__ __forceinline__ u32x4 pack8(const float* f) { u32x4 r; r.x = pk2(f[0], f[1]); r.y = pk2(f[2], f[3]); r.z = pk2(f[4], f[5]); r.w = pk2(f[6], f[7]); return r; }
__device__ __forceinline__ float fsin_(float x) { float r = x * 0.15915494309189535f; r -= floorf(r); return __builtin_amdgcn_sinf(r); }
__device__ __forceinline__ float fcos_(float x) { float r = x * 0.15915494309189535f; r -= floorf(r); return __builtin_amdgcn_cosf(r); }
__device__ __forceinline__ float wave_sum(float v) {
#pragma unroll
    for (int o = 1; o < 64; o <<= 1) v += __shfl_xor(v, o);
    return v;
}
__device__ __forceinline__ f32x4 mfma16(bf16x8 a, bf16x8 b, f32x4 c) { return __builtin_amdgcn_mfma_f32_16x16x32_bf16(a, b, c, 0, 0, 0); }
__device__ __forceinline__ bf16x8 as_bf8(u32x4 v) { return __builtin_bit_cast(bf16x8, v); }

extern __shared__ __attribute__((aligned(16))) unsigned char dyn_lds[];
__device__ __forceinline__ int tid_l() { int t = threadIdx.x; asm volatile("" : "+v"(t)); return t; }

constexpr int G_BM = 256, G_BK = 64, G_HALF = 128, G_HT = G_HALF * G_BK;
__device__ __forceinline__ int lds_byte(int r, int c) {
    int st = (r >> 4) * 2 + (c >> 5), rr = r & 15, cc = c & 31, ob = rr * 64 + cc * 2;
    return st * 1024 + (ob ^ (((ob >> 9) & 1) << 5));
}
__device__ __forceinline__ void stage_rc(int b, int& R, int& C) {
    int st = b / 1024, sb = b % 1024, swz = sb ^ (((sb >> 9) & 1) << 5);
    R = (st >> 1) * 16 + swz / 64; C = (st & 1) * 32 + (swz % 64) / 2;
}

enum { EPI_INPROJ = 0, EPI_RESID = 1, EPI_RELU2 = 2, EPI_DRY = 3 };
struct EpiArgs {
    bf16_t* o_rm; int ld_rm;
    bf16_t* o_dbg;
    int ld_cm;
    bf16_t* o_cm;
    float* gates; int gate_pn;
    const float* res_lat; const float* res_ctx; float* out_lat; float* out_ctx; const float* modg;
};

#define WAIT_V_(n) asm volatile("s_waitcnt vmcnt(" #n ")" ::: "memory")
#define WAIT_V(n) WAIT_V_(n)
#ifndef GEMM_SGB
#define GEMM_SGB 0
#endif
#ifndef GEMM_VM
#define GEMM_VM 8
#endif
#define WAIT_L(n) asm volatile("s_waitcnt lgkmcnt(" #n ")" ::: "memory")
#define BAR __builtin_amdgcn_s_barrier()
#define CFENCE asm volatile("" ::: "memory")

template <bool TR, int NAI>
__device__ __forceinline__ void gemm_kloop(const bf16_t* __restrict__ A, const bf16_t* __restrict__ Bt, int K, int brow, int bcol, f32x4 (&acc)[NAI][2][4][2], int kt0, int nt) {
    bf16_t* shm = (bf16_t*)dyn_lds;
#define SA(b, h) (shm + ((b) * 2 + (h)) * G_HT)
#define SB(b, h) (shm + (4 + (b) * 2 + (h)) * G_HT)
    const int tidx = tid_l();
    const int wid = tidx >> 6, lane = tidx & 63, wr = wid >> 2, wc = wid & 3, fr = lane & 15, fq = lane >> 4;
    int goff[2];
#pragma unroll
    for (int i = 0; i < 2; ++i) { int r_, c_; stage_rc(tidx * 16 + i * 8192, r_, c_); goff[i] = r_ * K + c_; }
    const bf16_t* Ab = A + (long)brow * K + kt0 * G_BK; const bf16_t* Bb = Bt + (long)bcol * K + kt0 * G_BK;
#define STAGE2(P, BASEP, kt) do { _Pragma("unroll") for (int _i = 0; _i < 2; ++_i) \
      __builtin_amdgcn_global_load_lds((const unsigned*)((BASEP) + (kt) * G_BK + goff[_i]), (unsigned*)((char*)(P) + tidx * 16 + _i * 8192), 16, 0, 0); } while (0)
    STAGE2(SA(0, 0), Ab, 0); if (NAI == 2) STAGE2(SA(0, 1), Ab + (long)G_HALF * K, 0); STAGE2(SB(0, 0), Bb, 0); STAGE2(SB(0, 1), Bb + (long)G_HALF * K, 0);
    for (int kt = 0; kt < nt; ++kt) {
        const int cur = kt & 1, nxt = cur ^ 1;
        WAIT_V(0); WAIT_L(0);
        BAR; CFENCE;
#define LDBF(dst, k) _Pragma("unroll") for (int bj = 0; bj < 2; ++bj) _Pragma("unroll") for (int n = 0; n < 2; ++n) \
            dst[bj][n] = *reinterpret_cast<const bf16x8*>((char*)SB(cur, bj) + lds_byte(wc * 32 + n * 16 + fr, (k) * 32 + fq * 8))
#define LDAF(dst, ai, k) _Pragma("unroll") for (int m = 0; m < 4; ++m) \
            dst[m] = *reinterpret_cast<const bf16x8*>((char*)SA(cur, ai) + lds_byte(wr * 64 + m * 16 + fr, (k) * 32 + fq * 8))
#define MMAG(ai, Af_, Bf_) _Pragma("unroll") for (int m = 0; m < 4; ++m) _Pragma("unroll") for (int bj = 0; bj < 2; ++bj) _Pragma("unroll") for (int n = 0; n < 2; ++n) \
            acc[ai][bj][m][n] = TR ? mfma16(Bf_[bj][n], Af_[m], acc[ai][bj][m][n]) : mfma16(Af_[m], Bf_[bj][n], acc[ai][bj][m][n])
        bf16x8 B0[2][2], B1[2][2], A0[4], A1[4];
        LDBF(B0, 0); LDAF(A0, 0, 0); if (NAI == 2) { LDAF(A1, 1, 0); }
        if (kt + 1 < nt) {
            STAGE2(SA(nxt, 0), Ab, kt + 1); if (NAI == 2) STAGE2(SA(nxt, 1), Ab + (long)G_HALF * K, kt + 1);
            STAGE2(SB(nxt, 0), Bb, kt + 1); STAGE2(SB(nxt, 1), Bb + (long)G_HALF * K, kt + 1);
        }
        MMAG(0, A0, B0);
        LDBF(B1, 1); LDAF(A0, 0, 1);
        if (NAI == 2) { MMAG(NAI - 1, A1, B0); LDAF(A1, 1, 1); }
        MMAG(0, A0, B1);
        if (NAI == 2) { MMAG(NAI - 1, A1, B1); }
#if GEMM_SGB
        __builtin_amdgcn_sched_group_barrier(0x100, 12, 0);
        __builtin_amdgcn_sched_group_barrier(0x020, 8, 0);
        __builtin_amdgcn_sched_group_barrier(0x008, 16, 0);
        __builtin_amdgcn_sched_group_barrier(0x100, 8, 0);
        __builtin_amdgcn_sched_group_barrier(0x008, 16, 0);
        __builtin_amdgcn_sched_group_barrier(0x100, 4, 0);
        __builtin_amdgcn_sched_group_barrier(0x008, 32, 0);
#endif
    }
    WAIT_L(0); BAR; CFENCE;
}

template <int EPI, int NAI>
__device__ __forceinline__ void gemm_tile(const bf16_t* A, const bf16_t* Bt, int K, int brow, int bcol, int pn, const EpiArgs& ea, int wr, int wc, int fr, int fq) {
        constexpr bool SPLITTAIL = false; const int kq = -1, kt0 = 0, ntl = K / G_BK; (void)kq;
        f32x4 acc[NAI][2][4][2];
#pragma unroll
        for (int a = 0; a < NAI; ++a)
#pragma unroll
            for (int b = 0; b < 2; ++b)
#pragma unroll
                for (int m = 0; m < 4; ++m)
#pragma unroll
                    for (int n = 0; n < 2; ++n) acc[a][b][m][n] = (f32x4){0.f, 0.f, 0.f, 0.f};
        const bool colmajor = (EPI == EPI_INPROJ) && pn >= 8 && pn != ea.gate_pn;
        if (colmajor) {
            gemm_kloop<true, NAI>(A, Bt, K, brow, bcol, acc, kt0, ntl);
#pragma unroll
            for (int ai = 0; ai < NAI; ++ai)
#pragma unroll
                for (int bj = 0; bj < 2; ++bj)
#pragma unroll
                    for (int m = 0; m < 4; ++m)
#pragma unroll
                        for (int n = 0; n < 2; ++n) {
                            const int row = brow + ai * 128 + wr * 64 + m * 16 + fr, col = bcol + bj * 128 + wc * 32 + n * 16 + fq * 4;
                            const f32x4 v = acc[ai][bj][m][n];
#pragma unroll
                            for (int j = 0; j < 4; ++j) ea.o_cm[(size_t)(col + j - 2048) * ea.ld_cm + row] = f2b(v[j]);
                        }
        } else if (EPI == EPI_RESID) {
            gemm_kloop<true, NAI>(A, Bt, K, brow, bcol, acc, kt0, ntl);
            const bool lat = brow < NLAT;
            const int mrow = lat ? brow >> 11 : 16;
            const float* rbase = lat ? ea.res_lat + (size_t)brow * 1024 : ea.res_ctx + (size_t)(brow - NLAT) * 1024;
            float* obase = lat ? ea.out_lat + (size_t)brow * 1024 : ea.out_ctx + (size_t)(brow - NLAT) * 1024;
            f32x4 g[2][2];
#pragma unroll
            for (int bj = 0; bj < 2; ++bj)
#pragma unroll
                for (int n = 0; n < 2; ++n) g[bj][n] = *(const f32x4*)(ea.modg + (size_t)mrow * 6144 + bcol + bj * 128 + wc * 32 + n * 16 + fq * 4);
            if (SPLITTAIL && kq >= 0) {
#pragma unroll
                for (int ai = 0; ai < NAI; ++ai)
#pragma unroll
                    for (int m = 0; m < 4; ++m)
#pragma unroll
                        for (int bj = 0; bj < 2; ++bj)
#pragma unroll
                            for (int n = 0; n < 2; ++n) {
                                float* op = obase + (size_t)(ai * 128 + wr * 64 + m * 16 + fr) * 1024 + bcol + bj * 128 + wc * 32 + n * 16 + fq * 4;
                                const f32x4 dv = g[bj][n] * acc[ai][bj][m][n];
#pragma unroll
                                for (int j = 0; j < 4; ++j) unsafeAtomicAdd(op + j, dv[j]);
                            }
            } else
#pragma unroll
            for (int ai = 0; ai < NAI; ++ai) {
                f32x4 xv[4][2][2];
#pragma unroll
                for (int m = 0; m < 4; ++m)
#pragma unroll
                    for (int bj = 0; bj < 2; ++bj)
#pragma unroll
                        for (int n = 0; n < 2; ++n)
                            xv[m][bj][n] = *(const f32x4*)(rbase + (size_t)(ai * 128 + wr * 64 + m * 16 + fr) * 1024 + bcol + bj * 128 + wc * 32 + n * 16 + fq * 4);
#pragma unroll
                for (int m = 0; m < 4; ++m)
#pragma unroll
                    for (int bj = 0; bj < 2; ++bj)
#pragma unroll
                        for (int n = 0; n < 2; ++n)
                            *(f32x4*)(obase + (size_t)(ai * 128 + wr * 64 + m * 16 + fr) * 1024 + bcol + bj * 128 + wc * 32 + n * 16 + fq * 4) = xv[m][bj][n] + g[bj][n] * acc[ai][bj][m][n];
            }
        } else {
            gemm_kloop<true, NAI>(A, Bt, K, brow, bcol, acc, kt0, ntl);
#pragma unroll
            for (int ai = 0; ai < NAI; ++ai)
#pragma unroll
                for (int m = 0; m < 4; ++m) {
                    const int row = brow + ai * 128 + wr * 64 + m * 16 + fr;
#pragma unroll
                    for (int bj = 0; bj < 2; ++bj)
#pragma unroll
                        for (int n = 0; n < 2; ++n) {
                            const int col = bcol + bj * 128 + wc * 32 + n * 16 + fq * 4;
                            const f32x4 v = acc[ai][bj][m][n];
                            if (EPI == EPI_INPROJ) {
                                if (pn == ea.gate_pn) {
                                    if (bj == 0 && wc == 0 && n == 0) *(f32x4*)(ea.gates + (size_t)row * 16 + fq * 4) = v;
                                } else {
                                    u32x2 o; o.x = pk2(v[0], v[1]); o.y = pk2(v[2], v[3]);
                                    *(u32x2*)(ea.o_rm + (size_t)row * ea.ld_rm + col) = o;
                                }
                            } else if (EPI == EPI_DRY) {
                                if (v[0] == 123456.789f && v[1] == 3.25f) *(f32x4*)(ea.out_lat + (size_t)row * 1024 + (col & 1023)) = v;
                            } else if (EPI == EPI_RELU2) {
                                float r0 = fmaxf(v[0], 0.f), r1 = fmaxf(v[1], 0.f), r2 = fmaxf(v[2], 0.f), r3 = fmaxf(v[3], 0.f);
                                u32x2 o; o.x = pk2(r0 * r0, r1 * r1); o.y = pk2(r2 * r2, r3 * r3);
                                *(u32x2*)(ea.o_rm + (size_t)row * ea.ld_rm + col) = o;
                            } else {
                                const float* rp; float* op; int mrow;
                                if (row < NLAT) { rp = ea.res_lat + (size_t)row * 1024 + col; op = ea.out_lat + (size_t)row * 1024 + col; mrow = row >> 11; }
                                else { rp = ea.res_ctx + (size_t)(row - NLAT) * 1024 + col; op = ea.out_ctx + (size_t)(row - NLAT) * 1024 + col; mrow = 16; }
                                const f32x4 g = *(const f32x4*)(ea.modg + (size_t)mrow * 6144 + col);
                                const f32x4 x = *(const f32x4*)rp;
                                f32x4 rr = x + g * v;
#ifdef SANITIZE
#pragma unroll
                                for (int q_ = 0; q_ < 4; ++q_) if (!(fabsf(rr[q_]) < 1e30f)) rr[q_] = 0.f;
#endif
                                *(f32x4*)op = rr;
                            }
                        }
                }
        }
        asm volatile("s_waitcnt vmcnt(0)" ::: "memory");
        __syncthreads();
}

template <int EPI, bool HALFTAIL = true>
__device__ __forceinline__ void gemm_phase(const bf16_t* A, const bf16_t* Bt, int M, int N, int K, const EpiArgs& ea) {
    const int nM = M / G_BM, nN = N / G_BM, nwg = nM * nN, G_ = gridDim.x;
    const int tidx = tid_l(); const int wid = tidx >> 6, lane = tidx & 63, wr = wid >> 2, wc = wid & 3, fr = lane & 15, fq = lane >> 4;
    int nfull = nwg;
    if (HALFTAIL) { const int rem = nwg % G_; if (rem > 0 && rem * 2 <= G_) nfull = nwg - rem; }
    const int nunits = nfull + (nwg - nfull) * 2;
    for (int U = blockIdx.x; U < nunits; U += G_) {
        const int L = U < nfull ? U : nfull + ((U - nfull) >> 1);
        const int half = U < nfull ? -1 : ((U - nfull) & 1);
        int wgid = L;
        { int q = nwg / 8, r = nwg % 8, xcd = wgid % 8, off = wgid / 8; wgid = (xcd < r ? xcd * (q + 1) : r * (q + 1) + (xcd - r) * q) + off; }
        const int nig = 8 * nN, gid = wgid / nig, fm = gid * 8, gsz = min(nM - fm, 8);
        const int pm = fm + ((wgid % nig) % gsz), pn = (wgid % nig) / gsz, bcol = pn * G_BM;
        if (half < 0) gemm_tile<EPI, 2>(A, Bt, K, pm * G_BM, bcol, pn, ea, wr, wc, fr, fq);
        else gemm_tile<EPI, 1>(A, Bt, K, pm * G_BM + half * 128, bcol, pn, ea, wr, wc, fr, fq);
    }
}

__device__ __forceinline__ void phase0(const Params& p) {
    const int tid = tid_l(), blk = blockIdx.x, nb = gridDim.x;
    float* MOD = (float*)(p.ws + WS_MOD);
    for (int it = blk; it < 193; it += nb) {
        if (it < 192) {
            float* sl = (float*)dyn_lds;
            float* red = sl + 17 * 1024;
            for (int i = tid; i < 17 * 1024; i += NT) { float v = (i < 16 * 1024) ? p.in[1][i] : p.in[3][i - 16 * 1024]; sl[i] = v / (1.f + __expf(-v)); }
            __syncthreads();
            const int l = it / 48, nc = it % 48, kp = tid >> 7, col = tid & 127;
            const float* W = p.in[4] + (size_t)l * 1024 * 6144 + nc * 128 + col;
            float acc[17];
#pragma unroll
            for (int r = 0; r < 17; ++r) acc[r] = 0.f;
            for (int k = kp * 256; k < kp * 256 + 256; ++k) {
                const float wv = W[(size_t)k * 6144];
#pragma unroll
                for (int r = 0; r < 17; ++r) acc[r] += sl[r * 1024 + k] * wv;
            }
#pragma unroll
            for (int r = 0; r < 17; ++r) red[(kp * 17 + r) * 128 + col] = acc[r];
            __syncthreads();
            for (int i = tid; i < 17 * 128; i += NT) {
                const int r = i >> 7, cc = i & 127;
                const float s = red[(0 * 17 + r) * 128 + cc] + red[(1 * 17 + r) * 128 + cc] + red[(2 * 17 + r) * 128 + cc] + red[(3 * 17 + r) * 128 + cc];
                MOD[((size_t)l * 17 + r) * 6144 + nc * 128 + cc] = s + p.in[5][l * 6144 + nc * 128 + cc];
            }
            __syncthreads();
        } else {
            float* ROPE = (float*)(p.ws + WS_ROPE);
            for (int i = tid; i < 2048; i += NT) {
                const int pos = i >> 5, j = i & 31;
                const float inv = exp2f(-(float)j * (13.287712379549449f / 32.f));
                const float ang = (float)pos * inv;
                ROPE[i] = fcos_(ang); ROPE[2048 + i] = fsin_(ang);
            }
        }
    }
    float* H2 = (float*)(p.ws + WS_H2);
    const int gw = blk * 8 + (tid >> 6), lane = tid & 63;
    for (int it = gw; it < 2 * 2304; it += nb * 8) {
        const int i = it / 2304, row = it % 2304;
        const int L = row < 2048 ? 2048 : 256, t = row < 2048 ? row : row - 2048;
        const float tn = (float)t / (float)(L - 1);
        const float wpos = 6.283185307179586f * (float)t / (float)L;
        float ev = 0.f;
        if (lane == 0) ev = tn;
        else if (lane <= 16) { const float fr = 1e-4f + (float)(lane - 1) * ((15.f - 1e-4f) / 15.f); ev = fcos_(wpos * fr); }
        else if (lane <= 32) { const float fr = 1e-4f + (float)(lane - 17) * ((15.f - 1e-4f) / 15.f); ev = -fsin_(wpos * fr); }
        const float* w1 = p.in[13] + i * 33 * 64; const float* b1 = p.in[14] + i * 64;
        const float* w2 = p.in[15] + i * 64 * 64; const float* b2 = p.in[16] + i * 64; const float* fq = p.in[18] + i * 64;
        float a = b1[lane];
        for (int e = 0; e < 33; ++e) a += __shfl(ev, e) * w1[e * 64 + lane];
        const float h1 = fsin_(fq[lane] * a);
        float a2 = b2[lane];
        for (int e = 0; e < 64; ++e) a2 += __shfl(h1, e) * w2[e * 64 + lane];
        H2[((size_t)i * 2304 + row) * 64 + lane] = fsin_(fq[lane] * a2);
    }
}

__device__ __forceinline__ void cvt_tile(const float* W, int N, int K, bf16_t* WT, int n0, int k0, int mapmode) {
    float* tl = (float*)dyn_lds;
    const int tid = tid_l(), nl = tid & 63, kb = tid >> 6;
    const int n = n0 + nl; int sc = n;
    if (mapmode == 1) sc = n < 2048 ? n : (n < 3584 ? n + 16 : (n < 3600 ? n - 3584 + 2048 : -1));
#pragma unroll
    for (int i = 0; i < 8; ++i) { const int kl = kb + 8 * i; tl[kl * 65 + nl] = sc >= 0 ? W[(size_t)(k0 + kl) * N + sc] : 0.f; }
    __syncthreads();
    const int nn = tid >> 3, kc = tid & 7;
    float f[8];
#pragma unroll
    for (int j = 0; j < 8; ++j) f[j] = tl[(kc * 8 + j) * 65 + nn];
    *(u32x4*)(WT + (size_t)(n0 + nn) * K + k0 + kc * 8) = pack8(f);
    __syncthreads();
}

__device__ __forceinline__ void convert_weights(const Params& p, int l, bool first_part, bool second_part, int bstart, int bcount) {
    const int blk = (int)blockIdx.x - bstart, nb = bcount, li = l >> 1; const bool even = !(l & 1);
    if (blk < 0 || blk >= bcount) return;
    const int nin = even ? 60 : 48;
    const int t_in = nin * 16, t_out = 256, t_m1 = 1024, t_m2 = 1024;
    const int it0 = first_part ? 0 : t_in + t_out + t_m1, it1 = second_part ? t_in + t_out + t_m1 + t_m2 : t_in + t_out + t_m1;
    for (int it = it0 + blk; it < it1; it += nb) {
        int r = it;
        if (r < t_in) {
            const int nt = r / 16, kt = r % 16;
            if (even) cvt_tile(p.in[8] + (size_t)li * 1024 * 3600, 3600, 1024, (bf16_t*)(p.ws + WS_WIN), nt * 64, kt * 64, 1);
            else cvt_tile(p.in[21] + (size_t)li * 1024 * 3072, 3072, 1024, (bf16_t*)(p.ws + WS_WIN), nt * 64, kt * 64, 0);
            continue;
        }
        r -= t_in;
        if (r < t_out) {
            const int nt = r / 16, kt = r % 16;
            cvt_tile((even ? p.in[20] : p.in[25]) + (size_t)li * 1024 * 1024, 1024, 1024, (bf16_t*)(p.ws + WS_WOUT), nt * 64, kt * 64, 0);
            continue;
        }
        r -= t_out;
        if (r < t_m1) {
            const int nt = r / 16, kt = r % 16;
            cvt_tile(p.in[6] + (size_t)l * 1024 * 4096, 4096, 1024, (bf16_t*)(p.ws + WS_WM1), nt * 64, kt * 64, 0);
            continue;
        }
        r -= t_m1;
        { const int nt = r / 64, kt = r % 64;
          cvt_tile(p.in[7] + (size_t)l * 4096 * 1024, 1024, 4096, (bf16_t*)(p.ws + WS_WM2), nt * 64, kt * 64, 0); }
    }
}

__device__ __forceinline__ void norm_phase(const Params& p, int l, const float* xlat, const float* xctx, int shoff, int scoff, int M) {
    const int tid = tid_l(), lane = tid & 63, gw = blockIdx.x * 8 + (tid >> 6), ngw = gridDim.x * 8;
    const float* MOD = (const float*)(p.ws + WS_MOD) + (size_t)l * 17 * 6144;
    bf16_t* ACT = (bf16_t*)(p.ws + WS_ACT);
    for (int row = gw; row < M; row += ngw) {
        const float* xr = row < NLAT ? xlat + (size_t)row * 1024 : xctx + (size_t)(row - NLAT) * 1024;
        const int mrow = row < NLAT ? row >> 11 : 16;
        const float* mod = MOD + (size_t)mrow * 6144;
        f32x4 v[4]; float ss = 0.f;
#pragma unroll
        for (int j = 0; j < 4; ++j) { v[j] = *(const f32x4*)(xr + 4 * lane + 256 * j); ss += v[j][0] * v[j][0] + v[j][1] * v[j][1] + v[j][2] * v[j][2] + v[j][3] * v[j][3]; }
        ss = wave_sum(ss);
        const float rstd = rsqrtf(ss * (1.f / 1024.f) + EPS);
#pragma unroll
        for (int j = 0; j < 4; ++j) {
            const int col = 4 * lane + 256 * j;
            const f32x4 sh = *(const f32x4*)(mod + shoff + col), sc = *(const f32x4*)(mod + scoff + col);
            const f32x4 y = v[j] * rstd * (sc + 1.f) + sh;
            u32x2 o; o.x = pk2(y[0], y[1]); o.y = pk2(y[2], y[3]);
            *(u32x2*)(ACT + (size_t)row * 1024 + col) = o;
        }
    }
}

__device__ __forceinline__ void filter_gen(const Params& p, int li) {
    const int tid = tid_l(), lane = tid & 63, w = tid >> 6;
    float* wf = (float*)dyn_lds; float* wb = wf + 64; float* red = wb + 64;
    const float* H2 = (const float*)(p.ws + WS_H2);
    for (int it = blockIdx.x; it < 2048; it += gridDim.x) {
        const int ltype = it >> 10, o = (it >> 9) & 1, c = it & 511;
        const int L = ltype ? 256 : 2048;
        const float* H2r = H2 + ((size_t)li * 2304 + (ltype ? 2048 : 0)) * 64;
        const float* w3 = p.in[17] + (size_t)li * 64 * 2048;
        if (tid < 64) wf[tid] = w3[tid * 2048 + (o * 2 + 0) * 512 + c];
        else if (tid < 128) wb[tid - 64] = w3[(tid - 64) * 2048 + (o * 2 + 1) * 512 + c];
        __syncthreads();
        const float lo = -4.605170185988091f / 1.5f, hi = -4.605170185988091f / 0.3f;
        const float delta = fabsf(lo + (hi - lo) * (float)c / 511.f);
        float vf[4], vb[4]; float ssf = 0.f, ssb = 0.f;
#pragma unroll
        for (int q = 0; q < 4; ++q) {
            const int t = tid + 512 * q; vf[q] = 0.f; vb[q] = 0.f;
            if (t < L) {
                float df = 0.f, db = 0.f;
                const f32x4* hr = (const f32x4*)(H2r + (size_t)t * 64);
#pragma unroll
                for (int j = 0; j < 16; ++j) { const f32x4 hv = hr[j];
                    df += hv[0] * wf[4 * j] + hv[1] * wf[4 * j + 1] + hv[2] * wf[4 * j + 2] + hv[3] * wf[4 * j + 3];
                    db += hv[0] * wb[4 * j] + hv[1] * wb[4 * j + 1] + hv[2] * wb[4 * j + 2] + hv[3] * wb[4 * j + 3]; }
                const float dec = __expf(-((float)t / (float)(L - 1)) * delta);
                vf[q] = df * dec; vb[q] = db * dec; ssf += vf[q] * vf[q]; ssb += vb[q] * vb[q];
            }
        }
        ssf = wave_sum(ssf); ssb = wave_sum(ssb);
        if (lane == 0) { red[w] = ssf; red[8 + w] = ssb; }
        __syncthreads();
        float tf = 0.f, tb = 0.f;
#pragma unroll
        for (int i = 0; i < 8; ++i) { tf += red[i]; tb += red[8 + i]; }
        const float nf = rsqrtf(tf + EPS), nbk = rsqrtf(tb + EPS);
        bf16_t* dst = ltype ? (bf16_t*)(p.ws + WS_FCTX) + ((size_t)o * 512 + c) * 512 : (bf16_t*)(p.ws + WS_FLAT) + ((size_t)o * 512 + c) * 4096;
#pragma unroll
        for (int q = 0; q < 4; ++q) {
            const int t = tid + 512 * q;
            if (t < L) {
                if (t == 0) { dst[L] = f2b(vf[q] * nf + vb[q] * nbk); dst[0] = 0; }
                else { dst[L + t] = f2b(vf[q] * nf); dst[L - t] = f2b(vb[q] * nbk); }
            }
        }
        __syncthreads();
    }
}

__device__ __forceinline__ void mlstm_item(const Params& p, int li, int it) {
    const int tid = tid_l(), w = tid >> 6, lane = tid & 63, fr = lane & 15, fq = lane >> 4;
    const int b = it >> 3, h = (it >> 1) & 3, dir = it & 1;
    bf16_t* Qs = (bf16_t*)dyn_lds;
    bf16_t* Ks = Qs + 64 * 136;
    bf16_t* KT = Ks + 64 * 136;
    bf16_t* VT = KT + 128 * 72;
    bf16_t* Cb = VT + 144 * 72;
    bf16_t* Ps = Cb + 144 * 136;
    float* fl = (float*)(Ps + 64 * 72);
    float* a_s = fl; float* Mt = fl + 64; float* scs = fl + 128; float* emt = fl + 192; float* den = fl + 256; float* lfs = fl + 320; float* igs = fl + 384; float* scal = fl + 448;
    const bf16_t* QKVO = (const bf16_t*)(p.ws + WS_BIG);
    const float* GATES = (const float*)(p.ws + WS_GATES);
    bf16_t* HFB = (bf16_t*)(p.ws + WS_HFB) + (size_t)dir * MTOT * 512;
    const float* ROPE = (const float*)(p.ws + WS_ROPE);
    const float* gate_b = p.in[9] + li * 16;
    for (int i = tid; i < 144 * 136 / 2; i += NT) ((unsigned*)Cb)[i] = 0u;
    for (int i = tid; i < 16 * 72; i += NT) { const int r = i / 72, ci = i % 72; VT[(128 + r) * 72 + ci] = (r == 0 && ci < 64) ? (bf16_t)0x3F80 : (bf16_t)0; }
    f32x4 cacc[9];
#pragma unroll
    for (int i = 0; i < 9; ++i) cacc[i] = (f32x4){0.f, 0.f, 0.f, 0.f};
    float m = 0.f;
    const int pr_r = tid >> 3, pr_seg = tid & 7, pr_tl = dir ? 63 - pr_r : pr_r, pr_tl2 = dir ? 63 - (tid & 63) : (tid & 63);
    const int pr_d1 = (pr_seg >> 2) * 64 + (pr_seg & 3) * 8;
    u32x4 pf_q1, pf_q2, pf_k1, pf_k2, pf_v1, pf_v2; float pgi = 0.f, pgf = 0.f;
#define MLSTM_ISSUE(ST_) do { const int st_ = (ST_); const bool ic_ = st_ < 4; const int cjn_ = ic_ ? (dir ? 3 - st_ : st_) : (dir ? 35 - st_ : st_ - 4); \
        const int rb_ = ic_ ? NLAT + b * 256 + cjn_ * 64 : b * 2048 + cjn_ * 64; \
        const bf16_t* sp_ = QKVO + (size_t)(rb_ + pr_tl) * 2048 + h * 128; \
        pf_q1 = *(const u32x4*)(sp_ + pr_d1); pf_q2 = *(const u32x4*)(sp_ + pr_d1 + 32); pf_k1 = *(const u32x4*)(sp_ + 512 + pr_d1); pf_k2 = *(const u32x4*)(sp_ + 512 + pr_d1 + 32); \
        pf_v1 = *(const u32x4*)(sp_ + 1024 + pr_seg * 16); pf_v2 = *(const u32x4*)(sp_ + 1024 + pr_seg * 16 + 8); \
        if (tid < 64) { const float* g_ = GATES + (size_t)(rb_ + pr_tl2) * 16; pgi = g_[dir * 8 + h]; pgf = g_[dir * 8 + 4 + h]; } } while (0)
    MLSTM_ISSUE(0);
    __syncthreads();
    for (int step = 0; step < 36; ++step) {
        const bool isctx = step < 4;
        const int cj = isctx ? (dir ? 3 - step : step) : (dir ? 35 - step : step - 4);
        const int rowbase = isctx ? NLAT + b * 256 + cj * 64 : b * 2048 + cj * 64;
        {
            const int r = tid >> 3, seg = tid & 7; const int tl = dir ? 63 - r : r;
            const int hb = seg >> 2, jb = (seg & 3) * 8, d1 = hb * 64 + jb, d2 = d1 + 32;
            const u32x4 q1 = pf_q1, q2 = pf_q2, k1 = pf_k1, k2 = pf_k2, v1 = pf_v1, v2 = pf_v2;
            const float cgi = pgi, cgf = pgf;
            if (step + 1 < 36) MLSTM_ISSUE(step + 1);
            float cs[8], sn[8];
            if (!isctx) {
                const int pos = hb ? tl : cj;
                const f32x4 c0 = *(const f32x4*)(ROPE + pos * 32 + jb), c1 = *(const f32x4*)(ROPE + pos * 32 + jb + 4);
                const f32x4 s0 = *(const f32x4*)(ROPE + 2048 + pos * 32 + jb), s1 = *(const f32x4*)(ROPE + 2048 + pos * 32 + jb + 4);
#pragma unroll
                for (int e = 0; e < 4; ++e) { cs[e] = c0[e]; cs[4 + e] = c1[e]; sn[e] = s0[e]; sn[4 + e] = s1[e]; }
            } else {
#pragma unroll
                for (int e = 0; e < 8; ++e) { cs[e] = 1.f; sn[e] = 0.f; }
            }
            float x1[8], x2[8], o1[8], o2[8];
            unpack8(q1, x1); unpack8(q2, x2);
#pragma unroll
            for (int e = 0; e < 8; ++e) { o1[e] = x1[e] * cs[e] - x2[e] * sn[e]; o2[e] = x1[e] * sn[e] + x2[e] * cs[e]; }
            *(u32x4*)(Qs + r * 136 + d1) = pack8(o1); *(u32x4*)(Qs + r * 136 + d2) = pack8(o2);
            unpack8(k1, x1); unpack8(k2, x2);
            const float ksc = 0.08838834764831845f;
#pragma unroll
            for (int e = 0; e < 8; ++e) { o1[e] = (x1[e] * cs[e] - x2[e] * sn[e]) * ksc; o2[e] = (x1[e] * sn[e] + x2[e] * cs[e]) * ksc; }
            const u32x4 ko1 = pack8(o1), ko2 = pack8(o2);
            *(u32x4*)(Ks + r * 136 + d1) = ko1; *(u32x4*)(Ks + r * 136 + d2) = ko2;
            {
                const unsigned kw1[4] = {ko1.x, ko1.y, ko1.z, ko1.w}, kw2[4] = {ko2.x, ko2.y, ko2.z, ko2.w};
#pragma unroll
                for (int e = 0; e < 4; ++e) {
                    KT[(d1 + 2 * e) * 72 + r] = (bf16_t)(kw1[e] & 0xffffu); KT[(d1 + 2 * e + 1) * 72 + r] = (bf16_t)(kw1[e] >> 16);
                    KT[(d2 + 2 * e) * 72 + r] = (bf16_t)(kw2[e] & 0xffffu); KT[(d2 + 2 * e + 1) * 72 + r] = (bf16_t)(kw2[e] >> 16);
                }
                const unsigned vw1[4] = {v1.x, v1.y, v1.z, v1.w}, vw2[4] = {v2.x, v2.y, v2.z, v2.w};
#pragma unroll
                for (int e = 0; e < 4; ++e) {
                    VT[(seg * 16 + 2 * e) * 72 + r] = (bf16_t)(vw1[e] & 0xffffu); VT[(seg * 16 + 2 * e + 1) * 72 + r] = (bf16_t)(vw1[e] >> 16);
                    VT[(seg * 16 + 8 + 2 * e) * 72 + r] = (bf16_t)(vw2[e] & 0xffffu); VT[(seg * 16 + 8 + 2 * e + 1) * 72 + r] = (bf16_t)(vw2[e] >> 16);
                }
            }
            if (tid < 64) {
                const int rr = tid;
                const float ig = cgi + gate_b[dir * 8 + h];
                const float fg = cgf + gate_b[dir * 8 + 4 + h];
                igs[rr] = ig; lfs[rr] = fminf(fg, 0.f) - __logf(1.f + __expf(-fabsf(fg)));
            }
        }
        __syncthreads();
        if (w == 0) {
            float bcs = lfs[lane];
#pragma unroll
            for (int o = 1; o < 64; o <<= 1) { const float t = __shfl_up(bcs, o); if (lane >= o) bcs += t; }
            const float a = igs[lane] - bcs;
            float pm = a;
#pragma unroll
            for (int o = 1; o < 64; o <<= 1) { const float t = __shfl_up(pm, o); if (lane >= o) pm = fmaxf(pm, t); }
            const float Mx = fmaxf(m, pm);
            a_s[lane] = a; Mt[lane] = Mx; scs[lane] = __expf(m - Mx); emt[lane] = __expf(-bcs - Mx);
            if (lane == 63) { scal[0] = bcs; scal[1] = Mx; }
        }
        {
            const int st = w & 3, tt0 = (w >> 2) * 2;
            f32x4 sacc[2];
#pragma unroll
            for (int u = 0; u < 2; ++u) {
                sacc[u] = (f32x4){0.f, 0.f, 0.f, 0.f};
#pragma unroll
                for (int kk = 0; kk < 4; ++kk) {
                    const bf16x8 Ak = *(const bf16x8*)(Ks + (st * 16 + fr) * 136 + kk * 32 + fq * 8);
                    const bf16x8 Bq = *(const bf16x8*)(Qs + ((tt0 + u) * 16 + fr) * 136 + kk * 32 + fq * 8);
                    sacc[u] = mfma16(Ak, Bq, sacc[u]);
                }
            }
            __syncthreads();
#pragma unroll
            for (int u = 0; u < 2; ++u) {
                const int t = (tt0 + u) * 16 + fr, sb = st * 16 + fq * 4;
                const float Mv = Mt[t];
                float pv[4];
#pragma unroll
                for (int j = 0; j < 4; ++j) { const int s = sb + j; pv[j] = (s <= t) ? sacc[u][j] * __expf(a_s[s] - Mv) : 0.f; }
                u32x2 o; o.x = pk2(pv[0], pv[1]); o.y = pk2(pv[2], pv[3]);
                *(u32x2*)(Ps + t * 72 + sb) = o;
            }
        }
        __syncthreads();
        {
            const int tt = w & 3, up = w >> 2, vt0 = up ? 5 : 0, nvt = up ? 4 : 5;
            bf16x8 qf[4], pf[2];
#pragma unroll
            for (int kk = 0; kk < 4; ++kk) qf[kk] = *(const bf16x8*)(Qs + (tt * 16 + fr) * 136 + kk * 32 + fq * 8);
#pragma unroll
            for (int kk = 0; kk < 2; ++kk) pf[kk] = *(const bf16x8*)(Ps + (tt * 16 + fr) * 72 + kk * 32 + fq * 8);
            const float sct = scs[tt * 16 + fr];
            f32x4 hacc[5];
#pragma unroll
            for (int vi = 0; vi < 5; ++vi) {
                hacc[vi] = (f32x4){0.f, 0.f, 0.f, 0.f};
                if (vi < nvt) {
                    const int v0 = (vt0 + vi) * 16;
                    f32x4 ac = (f32x4){0.f, 0.f, 0.f, 0.f};
#pragma unroll
                    for (int kk = 0; kk < 4; ++kk) ac = mfma16(*(const bf16x8*)(Cb + (v0 + fr) * 136 + kk * 32 + fq * 8), qf[kk], ac);
                    ac = ac * sct;
#pragma unroll
                    for (int kk = 0; kk < 2; ++kk) ac = mfma16(*(const bf16x8*)(VT + (v0 + fr) * 72 + kk * 32 + fq * 8), pf[kk], ac);
                    hacc[vi] = ac;
                }
            }
            if (up && fq == 0) den[tt * 16 + fr] = hacc[3][0];
            __syncthreads();
            const int t = tt * 16 + fr, tl = dir ? 63 - t : t;
            const float dn = den[t];
            const float inv = 1.f / fmaxf(fabsf(dn), emt[t]);
            bf16_t* orow = HFB + (size_t)(rowbase + tl) * 512 + h * 128;
#pragma unroll
            for (int vi = 0; vi < 5; ++vi) {
                if (vi < nvt && (vt0 + vi) < 8) {
                    const int v0 = (vt0 + vi) * 16 + fq * 4;
                    u32x2 o; o.x = pk2(hacc[vi][0] * inv, hacc[vi][1] * inv); o.y = pk2(hacc[vi][2] * inv, hacc[vi][3] * inv);
                    *(u32x2*)(orow + v0) = o;
                }
            }
        }
        {
            const float bl = scal[0], M63 = scal[1];
            const float decay = __expf(m - M63);
            bf16x8 ka[2];
#pragma unroll
            for (int kk = 0; kk < 2; ++kk) {
                const u32x4 raw = *(const u32x4*)(KT + (w * 16 + fr) * 72 + kk * 32 + fq * 8);
                float f[8]; unpack8(raw, f);
#pragma unroll
                for (int j = 0; j < 8; ++j) f[j] *= __expf(a_s[kk * 32 + fq * 8 + j] - M63);
                ka[kk] = as_bf8(pack8(f));
            }
#pragma unroll
            for (int vt = 0; vt < 9; ++vt) {
                f32x4 ac = cacc[vt] * decay;
#pragma unroll
                for (int kk = 0; kk < 2; ++kk) ac = mfma16(ka[kk], *(const bf16x8*)(VT + (vt * 16 + fr) * 72 + kk * 32 + fq * 8), ac);
                cacc[vt] = ac;
                u32x2 o; o.x = pk2(ac[0], ac[1]); o.y = pk2(ac[2], ac[3]);
                *(u32x2*)(Cb + (vt * 16 + fr) * 136 + w * 16 + fq * 4) = o;
            }
            m = bl + M63;
        }
        __syncthreads();
    }
}

__device__ __forceinline__ void combine_phase(const Params& p, int li) {
    const int tid = tid_l(), lane = tid & 63, gw = blockIdx.x * 8 + (tid >> 6), ngw = gridDim.x * 8;
    const bf16_t* HF = (const bf16_t*)(p.ws + WS_HFB); const bf16_t* HB = HF + (size_t)MTOT * 512;
    const bf16_t* QKVO = (const bf16_t*)(p.ws + WS_BIG);
    bf16_t* MIX = (bf16_t*)(p.ws + WS_ACT);
    const float* hn = p.in[10] + li * 512 + lane * 8;
    float g[8];
#pragma unroll
    for (int e = 0; e < 8; ++e) g[e] = hn[e];
    for (int row = gw; row < MTOT; row += ngw) {
        float a[8], bq[8], og[8], y[8];
        unpack8(*(const u32x4*)(HF + (size_t)row * 512 + lane * 8), a);
        unpack8(*(const u32x4*)(HB + (size_t)row * 512 + lane * 8), bq);
        unpack8(*(const u32x4*)(QKVO + (size_t)row * 2048 + 1536 + lane * 8), og);
        float ss = 0.f;
#pragma unroll
        for (int e = 0; e < 8; ++e) { a[e] += bq[e]; ss += a[e] * a[e]; }
        ss += __shfl_xor(ss, 1); ss += __shfl_xor(ss, 2); ss += __shfl_xor(ss, 4); ss += __shfl_xor(ss, 8);
        const float rstd = rsqrtf(ss * (1.f / 128.f) + EPS);
#pragma unroll
        for (int e = 0; e < 8; ++e) y[e] = a[e] * rstd * g[e] / (1.f + __expf(-og[e]));
        *(u32x4*)(MIX + (size_t)row * 1024 + lane * 8) = pack8(y);
    }
}

__device__ __forceinline__ bf16x8 hy_afrag(const bf16_t* HRp, int q, int m, int o4, int hsh) {
    const bf16_t* ap = HRp + (q + 8 - m);
    const u32x4 lo = *(const u32x4*)ap, hi = *(const u32x4*)(ap + 8);
    const bool b0 = (o4 & 1) != 0, b1 = (o4 & 2) != 0;
#define HYSEL(A_, B_, C_, D_) (b1 ? (b0 ? (D_) : (C_)) : (b0 ? (B_) : (A_)))
    const unsigned w0 = HYSEL(lo.x, lo.y, lo.z, lo.w), w1 = HYSEL(lo.y, lo.z, lo.w, hi.x), w2 = HYSEL(lo.z, lo.w, hi.x, hi.y),
                   w3 = HYSEL(lo.w, hi.x, hi.y, hi.z), w4 = HYSEL(hi.x, hi.y, hi.z, hi.w);
#undef HYSEL
    u32x4 o;
    o.x = __builtin_amdgcn_alignbit(w1, w0, hsh); o.y = __builtin_amdgcn_alignbit(w2, w1, hsh);
    o.z = __builtin_amdgcn_alignbit(w3, w2, hsh); o.w = __builtin_amdgcn_alignbit(w4, w3, hsh);
    return as_bf8(o);
}

template <int L>
__device__ __forceinline__ void hyena_item(const Params& p, int li, int c, bool dry = false) {
    constexpr int ZS = L + 8, NI = L / 128, NS = L / 32;
    const int tid = tid_l(), w = tid >> 6, lane = tid & 63, fr = lane & 15, fq = lane >> 4;
    bf16_t* ZA = (bf16_t*)dyn_lds; bf16_t* ZB = ZA + 16 * ZS; bf16_t* HFl = ZB + 16 * ZS;
    const int segbase = (L == 2048) ? 0 : NLAT;
    const bf16_t* HYT = (const bf16_t*)(p.ws + WS_P2);
    bf16_t* MIX = (bf16_t*)(p.ws + WS_ACT);
    const float* cw = p.in[11] + (size_t)li * 3 * 1536; const float* cb = p.in[12] + (size_t)li * 1536; const float* hd = p.in[19] + (size_t)li * 2 * 512;
    const bf16_t* FIL = (L == 2048) ? (const bf16_t*)(p.ws + WS_FLAT) : (const bf16_t*)(p.ws + WS_FCTX);
    {
        const float w0 = cw[c], w1 = cw[1536 + c], w2 = cw[2 * 1536 + c], bb = cb[c];
        const bf16_t* src = HYT + (size_t)c * MTOT + segbase;
#pragma unroll
        for (int ci = 0; ci < (16 * L / 8 + NT - 1) / NT; ++ci) {
            const int ch = tid + ci * NT; if (ch >= 16 * L / 8) break;
            const int b = ch / (L / 8), t0 = (ch % (L / 8)) * 8;
            const bf16_t* s = src + b * L + t0;
            float x[10], y[8];
            const float xl = b2f(s[t0 > 0 ? -1 : 0]), xr = b2f(s[(t0 + 8 < L) ? 8 : 7]);
            unpack8(*(const u32x4*)s, x + 1);
            x[0] = t0 > 0 ? xl : 0.f; x[9] = (t0 + 8 < L) ? xr : 0.f;
#pragma unroll
            for (int e = 0; e < 8; ++e) y[e] = bb + w0 * x[e] + w1 * x[e + 1] + w2 * x[e + 2];
            *(u32x4*)(ZA + b * ZS + t0) = pack8(y);
        }
    }
#pragma unroll 1
    for (int o = 0; o < 2; ++o) {
        for (int i = tid; i < 2 * L / 8; i += NT) {
            const u32x4 v = *(const u32x4*)(FIL + ((size_t)o * 512 + c) * 2 * L + i * 8);
            u32x4 rv; rv.x = (v.w >> 16) | (v.w << 16); rv.y = (v.z >> 16) | (v.z << 16); rv.z = (v.y >> 16) | (v.y << 16); rv.w = (v.x >> 16) | (v.x << 16);
            *(u32x4*)(HFl + 8 + 2 * L - 8 - 8 * i) = rv;
        }
        if (tid < 8) HFl[tid] = 0; else if (tid < 24) HFl[2 * L + tid] = 0;
        __syncthreads();
        const bf16_t* Zin = o ? ZB : ZA;
        const int gc = (o + 1) * 512 + c;
        const float gw0 = cw[gc], gw1 = cw[1536 + gc], gw2 = cw[2 * 1536 + gc], gb = cb[gc], dsk = hd[o * 512 + c];
        const bf16_t* gs = HYT + (size_t)gc * MTOT + segbase + fr * L;
        constexpr int NIB = NI < 8 ? NI : 8;
#pragma unroll 1
        for (int hp = 0; hp < NI; hp += NIB) {
            f32x4 acc[NIB];
#pragma unroll
            for (int i = 0; i < NIB; ++i) acc[i] = (f32x4){0.f, 0.f, 0.f, 0.f};
            constexpr int NQ = NS / 4;
            const int am = (7 - fr) & 7, ao4 = am >> 1, ahs = (am & 1) * 16;
            u32x2 pgv[NIB]; bf16_t pxl[NIB], pxr[NIB];
#pragma unroll
            for (int i = 0; i < NIB; ++i) {
                const int t0 = 16 * (w + 8 * (hp + i)) + fq * 4;
                pxl[i] = gs[t0 > 0 ? t0 - 1 : 0]; pxr[i] = gs[(t0 + 4 < L) ? t0 + 4 : L - 1];
                pgv[i] = *(const u32x2*)(gs + t0);
            }
#pragma unroll 1
            for (int r = 0; r < 4; ++r) {
                bf16x8 Aw[NIB];
#pragma unroll
                for (int i = 0; i < NIB; ++i) {
                    Aw[i] = hy_afrag(HFl, (L - 1) - 16 * w - 32 * (4 * (hp + i) - r) - fr + fq * 8, am, ao4, ahs);
                }
#pragma unroll 1
                for (int qc = 0; qc < NQ; qc += NIB) {
#pragma unroll
                    for (int qq = 0; qq < NIB; ++qq) {
                        const int q = qc + qq;
                        const bf16x8 Bz = *(const bf16x8*)(Zin + fr * ZS + (4 * q + r) * 32 + fq * 8);
#pragma unroll
                        for (int i = 0; i < NIB; ++i) acc[i] = mfma16(Aw[(i - qq + NIB) % NIB], Bz, acc[i]);
                        if (q + 1 < NQ) {
                            Aw[(NIB - 1 - qq) % NIB] = hy_afrag(HFl, (L - 1) - 16 * w - 32 * (4 * (hp - q - 1) - r) - fr + fq * 8, am, ao4, ahs);
                        }
                    }
                }
            }
#pragma unroll
            for (int i = 0; i < NIB; ++i) {
                const int t0 = 16 * (w + 8 * (hp + i)) + fq * 4;
                float x[6];
                const float xl = b2f(pxl[i]), xr = b2f(pxr[i]);
                const u32x2 gv = pgv[i];
                x[0] = t0 > 0 ? xl : 0.f;
                x[1] = blo(gv.x); x[2] = bhi(gv.x); x[3] = blo(gv.y); x[4] = bhi(gv.y);
                x[5] = (t0 + 4 < L) ? xr : 0.f;
                const u32x2 zv = *(const u32x2*)(Zin + fr * ZS + t0);
                const float z[4] = {blo(zv.x), bhi(zv.x), blo(zv.y), bhi(zv.y)};
                float val[4];
#pragma unroll
                for (int j = 0; j < 4; ++j) val[j] = (gb + gw0 * x[j] + gw1 * x[j + 1] + gw2 * x[j + 2]) * (acc[i][j] + dsk * z[j]);
                { u32x2 ov; ov.x = pk2(val[0], val[1]); ov.y = pk2(val[2], val[3]); *(u32x2*)((o == 0 ? ZB : ZA) + fr * ZS + t0) = ov; }
            }
        }
        __syncthreads();
    }
    if (!dry) {
        bf16_t* dstp = (bf16_t*)(p.ws + WS_P2) + (size_t)c * MTOT + segbase;
#pragma unroll
        for (int ci = 0; ci < (16 * L / 8 + NT - 1) / NT; ++ci) {
            const int ch = tid + ci * NT; if (ch >= 16 * L / 8) break;
            const int b = ch / (L / 8), t0 = (ch % (L / 8)) * 8;
            *(u32x4*)(dstp + b * L + t0) = *(const u32x4*)(ZA + b * ZS + t0);
        }
        __syncthreads();
    }
}

__device__ __forceinline__ void hy_transpose(const Params& p) {
    const int tid = tid_l();
    bf16_t* T = (bf16_t*)dyn_lds;
    const bf16_t* HYO = (const bf16_t*)(p.ws + WS_P2);
    bf16_t* MIX = (bf16_t*)(p.ws + WS_ACT);
    for (int it = blockIdx.x; it < (MTOT / 64) * 8; it += gridDim.x) {
        const int tt = it >> 3, cg_ = it & 7, tok0 = tt * 64, c0 = cg_ * 64;
        {
            const int ch = tid >> 3, t8 = (tid & 7) * 8;
            const u32x4 v = *(const u32x4*)(HYO + (size_t)(c0 + ch) * MTOT + tok0 + t8);
            const unsigned wv[4] = {v.x, v.y, v.z, v.w};
#pragma unroll
            for (int e = 0; e < 4; ++e) { T[(t8 + 2 * e) * 72 + ch] = (bf16_t)(wv[e] & 0xffffu); T[(t8 + 2 * e + 1) * 72 + ch] = (bf16_t)(wv[e] >> 16); }
        }
        __syncthreads();
        {
            const int tk = tid >> 3, c8 = (tid & 7) * 8;
            *(u32x4*)(MIX + (size_t)(tok0 + tk) * 1024 + 512 + c0 + c8) = *(const u32x4*)(T + tk * 72 + c8);
        }
        __syncthreads();
    }
}

__device__ __forceinline__ void qknorm_phase(const Params& p, int li) {
    const int tid = tid_l(), lane = tid & 63, gw = blockIdx.x * 8 + (tid >> 6), ngw = gridDim.x * 8;
    bf16_t* QK = (bf16_t*)(p.ws + WS_BIG);
    float gq[8], gk[8];
#pragma unroll
    for (int e = 0; e < 8; ++e) { gq[e] = p.in[22][li * 64 + (lane & 7) * 8 + e] * 0.125f; gk[e] = p.in[23][li * 64 + (lane & 7) * 8 + e]; }
    for (int row = gw; row < MTOT; row += ngw) {
        bf16_t* rp = QK + (size_t)row * QK_LD + lane * 8;
        u32x4 v[4];
#pragma unroll
        for (int j = 0; j < 4; ++j) v[j] = *(const u32x4*)(rp + j * 512);
#pragma unroll
        for (int j = 0; j < 4; ++j) {
            float f[8]; unpack8(v[j], f);
            float ss = 0.f;
#pragma unroll
            for (int e = 0; e < 8; ++e) ss += f[e] * f[e];
            ss += __shfl_xor(ss, 1); ss += __shfl_xor(ss, 2); ss += __shfl_xor(ss, 4);
            const float rstd = rsqrtf(ss * (1.f / 64.f) + EPS);
#pragma unroll
            for (int e = 0; e < 8; ++e) f[e] *= rstd * (j < 2 ? gq[e] : gk[e]);
            *(u32x4*)(rp + j * 512) = pack8(f);
        }
    }
}

template <bool LAT>
__device__ __forceinline__ void attn_item(const Params& p, int li, int b, int h, int sub, bool stage = true) {
    const int tid = tid_l(), w = tid >> 6, lane = tid & 63, fr = lane & 15, fq = lane >> 4;
    bf16_t* Pw = (bf16_t*)dyn_lds + w * (16 * 264);
    bf16_t* KC = (bf16_t*)(dyn_lds + 67584);
    bf16_t* VC = (bf16_t*)(dyn_lds + 67584 + 36864);
    float* rpbs = (float*)(dyn_lds + 67584 + 36864 + 33792);
    const bf16_t* QK = (const bf16_t*)(p.ws + WS_BIG);
    const bf16_t* VTg = (const bf16_t*)(p.ws + WS_P2ODD);
    bf16_t* MIX = (bf16_t*)(p.ws + WS_ACT);
    if (stage) {
    if (LAT) { const float* rp = p.in[24] + ((size_t)li * 16 + h) * 465; for (int i = tid; i < 465; i += NT) rpbs[i] = rp[i]; }
    {
        u32x4 kv[4], vv[4];
#pragma unroll
        for (int i = 0; i < 4; ++i) {
            const int c = tid + i * NT;
            kv[i] = *(const u32x4*)(QK + (size_t)(NLAT + b * 256 + (c >> 3)) * QK_LD + 1024 + h * 64 + (c & 7) * 8);
            vv[i] = *(const u32x4*)(VTg + (size_t)(h * 64 + (c >> 5)) * VT_LD + NLAT + b * 256 + (c & 31) * 8);
        }
#pragma unroll
        for (int i = 0; i < 4; ++i) {
            const int c = tid + i * NT;
            *(u32x4*)(KC + (c >> 3) * 72 + (c & 7) * 8) = kv[i];
            *(u32x4*)(VC + (c >> 5) * 264 + (c & 31) * 8) = vv[i];
        }
    }
    __syncthreads();
    }
    int r = 0, c0 = 0, rs = 0, cw0 = 0, qtok0;
    if (LAT) { r = sub * 2 + (w >> 2); const int qt = w & 3; c0 = qt * 16; qtok0 = b * 2048 + r * 64 + c0; rs = min(max(r - 4, 0), 24); cw0 = (qt == 0) ? 0 : (qt == 1) ? 8 : (qt == 2) ? 24 : 32; }
    else { qtok0 = NLAT + b * 256 + (sub * 8 + w) * 16; }
    bf16x8 qf[2];
    {
        const bf16_t* qp = QK + (size_t)(qtok0 + fr) * QK_LD + h * 64 + fq * 8;
        qf[0] = *(const bf16x8*)qp; qf[1] = *(const bf16x8*)(qp + 32);
    }
    f32x4 o1[4], o2[4];
    float m1 = -1e30f, l1 = 0.f, m2, l2 = 0.f;
#pragma unroll
    for (int dt = 0; dt < 4; ++dt) { o1[dt] = (f32x4){0.f, 0.f, 0.f, 0.f}; o2[dt] = (f32x4){0.f, 0.f, 0.f, 0.f}; }
    if (LAT) {
        f32x4 sreg[16];
        const int qc = c0 + fr; const int cstart = min(max(qc - 8, 0), 48);
#pragma unroll
        for (int kt = 0; kt < 16; ++kt) {
            const int kr = kt >> 1, kcb = cw0 + (kt & 1) * 16;
            const bf16_t* kp = QK + (size_t)(b * 2048 + (rs + kr) * 64 + kcb + fr) * QK_LD + 1024 + h * 64 + fq * 8;
            f32x4 sa = (f32x4){0.f, 0.f, 0.f, 0.f};
            sa = mfma16(*(const bf16x8*)kp, qf[0], sa); sa = mfma16(*(const bf16x8*)(kp + 32), qf[1], sa);
            const int dri = (rs + kr - r + 7) * 31;
#pragma unroll
            for (int j = 0; j < 4; ++j) {
                const int kc = kcb + fq * 4 + j;
                const bool valid = (kc >= cstart) && (kc < cstart + 16);
                const int dci = min(max(kc - qc + 15, 0), 30);
                sa[j] = valid ? sa[j] + rpbs[dri + dci] : -1e30f;
            }
            sreg[kt] = sa;
            if ((kt & 7) == 7) __builtin_amdgcn_sched_barrier(0);
        }
#pragma unroll
        for (int kt = 0; kt < 16; ++kt)
#pragma unroll
            for (int j = 0; j < 4; ++j) m1 = fmaxf(m1, sreg[kt][j]);
        m1 = fmaxf(m1, __shfl_xor(m1, 16)); m1 = fmaxf(m1, __shfl_xor(m1, 32));
#pragma unroll
        for (int kt = 0; kt < 16; ++kt) {
            float pj[4];
#pragma unroll
            for (int j = 0; j < 4; ++j) { pj[j] = __expf(sreg[kt][j] - m1); l1 += pj[j]; }
            u32x2 o; o.x = pk2(pj[0], pj[1]); o.y = pk2(pj[2], pj[3]);
            *(u32x2*)(Pw + fr * 264 + kt * 16 + fq * 4) = o;
        }
        l1 += __shfl_xor(l1, 16); l1 += __shfl_xor(l1, 32);
#pragma unroll
        for (int kb = 0; kb < 8; kb += 4) {
            bf16x8 vf[4][4], pf[4];
#pragma unroll
            for (int u = 0; u < 4; ++u) {
                const int ks = kb + u;
                const int vtok0 = b * 2048 + (rs + ks) * 64 + cw0;
#pragma unroll
                for (int dt = 0; dt < 4; ++dt) vf[u][dt] = *(const bf16x8*)(VTg + (size_t)(h * 64 + dt * 16 + fr) * VT_LD + vtok0 + fq * 8);
                pf[u] = *(const bf16x8*)(Pw + fr * 264 + ks * 32 + fq * 8);
            }
#pragma unroll
            for (int u = 0; u < 4; ++u)
#pragma unroll
                for (int dt = 0; dt < 4; ++dt) o1[dt] = mfma16(vf[u][dt], pf[u], o1[dt]);
            __builtin_amdgcn_sched_barrier(0);
        }
    }
    {
        f32x4 sreg[16];
#pragma unroll
        for (int kt = 0; kt < 16; ++kt) {
            const bf16_t* kp = KC + (kt * 16 + fr) * 72 + fq * 8;
            f32x4 sa = (f32x4){0.f, 0.f, 0.f, 0.f};
            sa = mfma16(*(const bf16x8*)kp, qf[0], sa); sa = mfma16(*(const bf16x8*)(kp + 32), qf[1], sa);
            sreg[kt] = sa;
        }
        m2 = -1e30f;
#pragma unroll
        for (int kt = 0; kt < 16; ++kt)
#pragma unroll
            for (int j = 0; j < 4; ++j) m2 = fmaxf(m2, sreg[kt][j]);
        m2 = fmaxf(m2, __shfl_xor(m2, 16)); m2 = fmaxf(m2, __shfl_xor(m2, 32));
#pragma unroll
        for (int kt = 0; kt < 16; ++kt) {
            float pj[4];
#pragma unroll
            for (int j = 0; j < 4; ++j) { pj[j] = __expf(sreg[kt][j] - m2); l2 += pj[j]; }
            u32x2 o; o.x = pk2(pj[0], pj[1]); o.y = pk2(pj[2], pj[3]);
            *(u32x2*)(Pw + fr * 264 + kt * 16 + fq * 4) = o;
        }
        l2 += __shfl_xor(l2, 16); l2 += __shfl_xor(l2, 32);
#pragma unroll
        for (int ks = 0; ks < 8; ++ks) {
            const bf16x8 pf = *(const bf16x8*)(Pw + fr * 264 + ks * 32 + fq * 8);
#pragma unroll
            for (int dt = 0; dt < 4; ++dt) o2[dt] = mfma16(*(const bf16x8*)(VC + (dt * 16 + fr) * 264 + ks * 32 + fq * 8), pf, o2[dt]);
        }
    }
    const float mm = fmaxf(m1, m2);
    const float a1 = LAT ? __expf(m1 - mm) : 0.f, a2 = __expf(m2 - mm);
    const float inv = 1.f / (l1 * a1 + l2 * a2);
    const float s1 = a1 * inv, s2 = a2 * inv;
#pragma unroll
    for (int dt = 0; dt < 4; ++dt) {
        const f32x4 ov = o1[dt] * s1 + o2[dt] * s2;
        u32x2 o; o.x = pk2(ov[0], ov[1]); o.y = pk2(ov[2], ov[3]);
        *(u32x2*)(MIX + (size_t)(qtok0 + fr) * 1024 + h * 64 + dt * 16 + fq * 4) = o;
    }
    __syncthreads();
}


#ifdef DBG_NAN
__device__ __forceinline__ bool bad16(bf16_t v) { return ((v >> 7) & 0xFF) >= 227; }
__device__ __forceinline__ bool bad32(float f) { return !(fabsf(f) < 1e30f); }
__device__ __forceinline__ void scan16(const bf16_t* p, size_t n, unsigned* flags, unsigned bit) {
    bool bad = false;
    for (size_t i = (size_t)blockIdx.x * NT + threadIdx.x; i < n; i += (size_t)gridDim.x * NT) bad |= bad16(p[i]);
    if (bad) atomicOr(flags, bit);
}
__device__ __forceinline__ void scan32(const float* p, size_t n, unsigned* flags, unsigned bit) {
    bool bad = false;
    for (size_t i = (size_t)blockIdx.x * NT + threadIdx.x; i < n; i += (size_t)gridDim.x * NT) bad |= bad32(p[i]);
    if (bad) atomicOr(flags, bit);
}
#endif

#define XB_TMO      128
#define XB_XCNT(j)  (256  + 64 * (j))
#define XB_XSUB(j)  (1280 + 64 * (j))
#define XB_XGEN(j)  (2304 + 64 * (j))
#define XB_TOP      3328
#define XB_TOPGEN   3392
#define XCD_BAR_WORDS 3456
#define XB_SPIN_CAP (1u << 20)
#define LAS __attribute__((address_space(3)))
__device__ __forceinline__ unsigned xb_ld(unsigned* p)              { return __hip_atomic_load(p, __ATOMIC_RELAXED, __HIP_MEMORY_SCOPE_AGENT); }
__device__ __forceinline__ unsigned xb_add(unsigned* p, unsigned v) { return __hip_atomic_fetch_add(p, v, __ATOMIC_RELAXED, __HIP_MEMORY_SCOPE_AGENT); }
__device__ __forceinline__ unsigned xb_xcc_id() { return (unsigned)__builtin_amdgcn_s_getreg((3 << 11) | 20) & 0xFu; }
#define XB_SPIN(cond, bar) do { unsigned _sp = 0; while (cond) { __builtin_amdgcn_s_sleep(1); \
    if ((++_sp & 255u) == 0u) { if (xb_ld(&(bar)[XB_TMO])) break; if (_sp > XB_SPIN_CAP) { atomicAdd(&(bar)[XB_TMO], 1u); break; } } } } while (0)
struct XcdBarrier { unsigned* bar; unsigned x; volatile LAS unsigned* st; };
__device__ __forceinline__ XcdBarrier xcd_barrier_post(unsigned* bar, volatile LAS unsigned* st) {
    XcdBarrier b; b.bar = bar; b.x = xb_xcc_id(); b.st = st;
    if (threadIdx.x == 0) (void)xb_add(&bar[XB_XCNT(b.x)], 1u);
    return b;
}
__device__ __forceinline__ void xcd_barrier_complete(unsigned* bar, unsigned x, unsigned& nloc, unsigned& nx) {
    const unsigned G = gridDim.x * gridDim.y * gridDim.z;
    unsigned sum, cnt, mine, sp = 0u;
    for (;;) {
        sum = 0u; cnt = 0u; mine = 0u;
#pragma unroll
        for (unsigned j = 0; j < 16; ++j) { const unsigned c = xb_ld(&bar[XB_XCNT(j)]); sum += c; cnt += (c > 0u) ? 1u : 0u; mine = (j == x) ? c : mine; }
        if (sum == G) break;
        __builtin_amdgcn_s_sleep(1);
        if ((++sp & 255u) == 0u) { if (xb_ld(&bar[XB_TMO])) break; if (sp > XB_SPIN_CAP) { atomicAdd(&bar[XB_TMO], 1u); break; } }
    }
    nloc = mine > 0u ? mine : 1u; nx = cnt > 0u ? cnt : 1u;
}
__device__ __forceinline__ void xcd_barrier(const XcdBarrier& b) {
    asm volatile("s_waitcnt vmcnt(0)" ::: "memory");
    __syncthreads();
    if (threadIdx.x == 0) {
        unsigned* bar = b.bar;
        __builtin_amdgcn_s_waitcnt(0);
        unsigned nloc = b.st[0], nx = b.st[1];
        if (nloc == 0u) { xcd_barrier_complete(bar, b.x, nloc, nx); b.st[0] = nloc; b.st[1] = nx; }
        const unsigned old = xb_add(&bar[XB_XSUB(b.x)], 1u);
        const unsigned gen = old / nloc;
        if (old + 1u == (gen + 1u) * nloc) {
            __builtin_amdgcn_fence(__ATOMIC_RELEASE, "agent");
            asm volatile("s_waitcnt vmcnt(0)" ::: "memory");
            const unsigned og = xb_add(&bar[XB_TOP], 1u);
            const unsigned tg = og / nx;
            if (og + 1u == (tg + 1u) * nx) xb_add(&bar[XB_TOPGEN], 1u);
            else XB_SPIN(xb_ld(&bar[XB_TOPGEN]) == tg, bar);
            __builtin_amdgcn_fence(__ATOMIC_ACQUIRE, "agent");
            xb_add(&bar[XB_XGEN(b.x)], 1u);
            asm volatile("s_waitcnt vmcnt(0)" ::: "memory");
        } else {
            XB_SPIN(xb_ld(&bar[XB_XGEN(b.x)]) == gen, bar);
            __builtin_amdgcn_fence(__ATOMIC_ACQUIRE, "agent");
            asm volatile("s_waitcnt vmcnt(0)" ::: "memory");
        }
    }
    __syncthreads();
}
constexpr size_t WS_BAR = WS_END + 32768;

#ifdef TPROBE_A
#define GSYNC() do { asm volatile("s_waitcnt vmcnt(0) lgkmcnt(0)" ::: "memory"); grid.sync(); ++nsync_; if (nsync_ == TPROBE_A) t0_ = wall_clock64(); if (nsync_ == TPROBE_B) t1_ = wall_clock64(); } while (0)
#else
#define GSYNC() xcd_barrier(xbar_)
#endif
#define GSYNC_CG() do { asm volatile("s_waitcnt vmcnt(0) lgkmcnt(0)" ::: "memory"); grid.sync(); } while (0)
__global__ void __launch_bounds__(NT) fwd_megakernel(Params p) {
    cg::grid_group grid = cg::this_grid();
#ifdef TPROBE_A
    int nsync_ = 0; long long t0_ = 0, t1_ = 0;
#endif
    const int blk = blockIdx.x, G = gridDim.x;
    bf16_t* WIN = (bf16_t*)(p.ws + WS_WIN); bf16_t* WOUT = (bf16_t*)(p.ws + WS_WOUT); bf16_t* WM1 = (bf16_t*)(p.ws + WS_WM1); bf16_t* WM2 = (bf16_t*)(p.ws + WS_WM2);
    bf16_t* ACT = (bf16_t*)(p.ws + WS_ACT); bf16_t* BIG = (bf16_t*)(p.ws + WS_BIG);
    float* XC = (float*)(p.ws + WS_XC);
    const float* MOD = (const float*)(p.ws + WS_MOD);
    volatile LAS unsigned* xst_ = (volatile LAS unsigned*)(dyn_lds + LDS_BYTES - 16);
    if (threadIdx.x == 0) { xst_[0] = 0u; xst_[1] = 0u; }
    __syncthreads();
    const XcdBarrier xbar_ = xcd_barrier_post((unsigned*)(p.ws + WS_BAR), xst_);
    REP(64) if (PHMASK & 1) phase0(p);
#ifdef DBG_NAN
    unsigned* dflags = (unsigned*)(p.ws + WS_END);
    if (blk == 0 && threadIdx.x < 64) dflags[threadIdx.x] = 0u;
#endif
    GSYNC_CG();
#pragma unroll 1
    for (int l = 0; l < 4; ++l) {
        const bool even = !(l & 1), last = (l == 3); const int li = l >> 1;
        const float* xlat = (l == 0) ? p.in[0] : p.out; const float* xctx = (l == 0) ? p.in[2] : XC;
        const int Mtail = last ? NLAT : MTOT;
        REP(1) {
        if (PHMASK & 2) convert_weights(p, l, l == 0 || G < 256, true, 0, G);
        if (PHMASK & 4) norm_phase(p, l, xlat, xctx, 0, 1024, MTOT);
        if ((PHMASK & 8) && even) filter_gen(p, li);
        }
        GSYNC();
        {
            EpiArgs ea{}; ea.o_rm = BIG; ea.ld_rm = even ? 2048 : QK_LD; ea.o_cm = (bf16_t*)(p.ws + (even ? WS_P2 : WS_P2ODD)); ea.ld_cm = even ? MTOT : VT_LD; ea.gates = (float*)(p.ws + WS_GATES); ea.gate_pn = even ? 14 : -1; ea.o_dbg = (bf16_t*)(p.ws + WS_HFB);
            REP(2) if (PHMASK & 16) gemm_phase<EPI_INPROJ>(ACT, WIN, MTOT, even ? 3840 : 3072, 1024, ea);
        }
        GSYNC();
#ifdef DBG_NAN
        if (l == DBG_LAYER) {
            {
                const unsigned gid = blk * NT + threadIdx.x;
                unsigned hsh = gid * 2654435761u + 12345u; hsh ^= hsh >> 13; hsh *= 2246822519u; hsh ^= hsh >> 16;
                const int row = hsh % MTOT; const int col = (hsh >> 8) % 2048; const int ch = (hsh >> 4) % 1536;
                const bf16_t* ar = ACT + (size_t)row * 1024; const bf16_t* wq = WIN + (size_t)col * 1024; const bf16_t* wh = WIN + (size_t)(2048 + ch) * 1024;
                float sq = 0.f, sh_ = 0.f;
                for (int k = 0; k < 1024; ++k) { const float av = b2f(ar[k]); sq += av * b2f(wq[k]); sh_ += av * b2f(wh[k]); }
                const float gq = b2f(BIG[(size_t)row * 2048 + col]);
                const float gh = b2f(((const bf16_t*)(p.ws + WS_P2))[(size_t)ch * MTOT + row]);
                (void)gq; (void)sq;

                { const int cls = DBG_CLS; atomicAdd(dflags + 16 + cls, 1u);
                  if (!(fabsf(gh - sh_) <= 0.05f + 0.02f * fabsf(sh_))) { atomicAdd(dflags + 2, 1u); atomicAdd(dflags + 32 + cls, 1u); } }
            }
            GSYNC();
            if (blk == 0 && threadIdx.x == 0) {
                const float fQ = (float)__hip_atomic_load(dflags + 1, __ATOMIC_RELAXED, __HIP_MEMORY_SCOPE_AGENT) / (float)(G * NT);
                const float fH = (float)__hip_atomic_load(dflags + 2, __ATOMIC_RELAXED, __HIP_MEMORY_SCOPE_AGENT) / (float)(G * NT);
                unsigned mask = 0;
                for (int q_ = 0; q_ < 8; ++q_) { const unsigned tot = __hip_atomic_load(dflags + 16 + q_, __ATOMIC_RELAXED, __HIP_MEMORY_SCOPE_AGENT), bad = __hip_atomic_load(dflags + 32 + q_, __ATOMIC_RELAXED, __HIP_MEMORY_SCOPE_AGENT); if (bad * 4 > tot) mask |= 1u << q_; }
                float code = 1e5f; for (unsigned q_ = 0; q_ < (mask >> 4); ++q_) code *= 10.f;
                const unsigned n3 = __hip_atomic_load(dflags + 3, __ATOMIC_RELAXED, __HIP_MEMORY_SCOPE_AGENT), b1 = __hip_atomic_load(dflags + 1, __ATOMIC_RELAXED, __HIP_MEMORY_SCOPE_AGENT), b4 = __hip_atomic_load(dflags + 4, __ATOMIC_RELAXED, __HIP_MEMORY_SCOPE_AGENT);
                p.out[0] = code * (1.f + 0.5f * (float)(mask & 15)) + 0.f * (fQ + fH + (float)(n3 + b1 + b4));
            }
            return;
        }
#endif
        if (!even) { qknorm_phase(p, li); GSYNC(); }
        if (even) {
            REP(4) if (G >= 256) {
                if (blk < 128) { REP(512) if (PHMASK & 32) mlstm_item(p, li, blk);
                    if (DUPMASK & 1024) { hyena_item<2048>(p, li, 384 + blk, true); hyena_item<256>(p, li, 384 + blk, true); }
                    if (PHMASK & 64) { hyena_item<2048>(p, li, 384 + blk); } }
                else { const int hb = blk - 128;
                    if (DUPMASK & 1024) for (int it = hb; it < 384; it += 128) { hyena_item<2048>(p, li, it, true); hyena_item<256>(p, li, it, true); }
                    if (PHMASK & 64) { for (int it = hb; it < 384; it += 128) { hyena_item<2048>(p, li, it); hyena_item<256>(p, li, it); } hyena_item<256>(p, li, 384 + hb); } }
            } else {
            }
            GSYNC();
            if (PHMASK & 128) { combine_phase(p, li); hy_transpose(p); }
        } else {
            const int x = blk & 7, y = blk >> 3, ny = (G + 7) >> 3;
            REP(256) for (int i = 0; ; ++i) {
                const int slot = i * ny + y;
                if (slot >= 512) break;
                const int bh = x * 32 + 4 * (i >> 1) + (y >> 3), rp = (y & 7) * 2 + (i & 1);
                if (PHMASK & 256) attn_item<true>(p, li, bh >> 4, bh & 15, rp, (i & 1) == 0 || ny != 32);
            }
            if ((PHMASK & 512) && !last) for (int it = blk; it < 512; it += G) attn_item<false>(p, li, it >> 5, (it >> 1) & 15, it & 1);
        }
        GSYNC();
        {
            EpiArgs ea{}; ea.res_lat = xlat; ea.res_ctx = xctx; ea.out_lat = p.out; ea.out_ctx = XC; ea.modg = MOD + (size_t)l * 17 * 6144 + 2048;
            if (DUPMASK & 32) gemm_phase<EPI_DRY>(ACT, WOUT, Mtail, 1024, 1024, ea);
            if (PHMASK & 1024) gemm_phase<EPI_RESID>(ACT, WOUT, Mtail, 1024, 1024, ea);
        }
        GSYNC();
        REP(8) norm_phase(p, l, p.out, XC, 3072, 4096, Mtail);
        GSYNC();
        { EpiArgs ea{}; ea.o_rm = BIG; ea.ld_rm = 4096; ea.gate_pn = -1; REP(16) if (PHMASK & 2048) gemm_phase<EPI_RELU2>(ACT, WM1, Mtail, 4096, 1024, ea); }
        GSYNC();
        {
            EpiArgs ea{}; ea.res_lat = p.out; ea.res_ctx = XC; ea.out_lat = p.out; ea.out_ctx = XC; ea.modg = MOD + (size_t)l * 17 * 6144 + 5120;
            if (DUPMASK & 32) gemm_phase<EPI_DRY>(BIG, WM2, Mtail, 1024, 4096, ea);
            if (PHMASK & 4096) gemm_phase<EPI_RESID>(BIG, WM2, Mtail, 1024, 4096, ea);
            if (!last && G >= 256) convert_weights(p, l + 1, true, false, 128, G - 128);
        }
        GSYNC();
    }
#ifdef TPROBE_A
    if (blk == 0 && threadIdx.x == 0) p.out[0] = (float)(t1_ - t0_) * 10.f;
#endif
}

extern "C" void kernel_launch(void* const* d_in, const int* in_sizes, int n_in, void* d_out, int out_size, void* d_ws, size_t ws_size, hipStream_t stream) {
    static int grid_blocks = 0;
    if (grid_blocks == 0) {
        if (n_in != 26 || ws_size < WS_BAR + XCD_BAR_WORDS * 4) { fprintf(stderr, "kernel_launch: unexpected n_in %d or ws_size %zu (< %zu)\n", n_in, ws_size, (size_t)WS_END); grid_blocks = -1; return; }
        int dev = 0, cus = 0, per_cu = 0;
        hipGetDevice(&dev);
        hipDeviceGetAttribute(&cus, hipDeviceAttributeMultiprocessorCount, dev);
        if (hipFuncSetAttribute((const void*)fwd_megakernel, hipFuncAttributeMaxDynamicSharedMemorySize, LDS_BYTES) != hipSuccess) fprintf(stderr, "kernel_launch: hipFuncSetAttribute failed\n");
        if (hipOccupancyMaxActiveBlocksPerMultiprocessor(&per_cu, (const void*)fwd_megakernel, NT, LDS_BYTES) != hipSuccess || per_cu < 1) { fprintf(stderr, "kernel_launch: occupancy query gave %d\n", per_cu); per_cu = 1; }
        (void)hipGetLastError();
        grid_blocks = cus * 1;
        fprintf(stderr, "kernel_launch: cus %d per_cu %d grid %d\n", cus, per_cu, grid_blocks);
    }
    if (grid_blocks < 0) return;
    if (hipMemsetAsync((char*)d_ws + WS_BAR, 0, XCD_BAR_WORDS * 4, stream) != hipSuccess) { fprintf(stderr, "kernel_launch: memset of barrier words failed\n"); return; }
    Params p{};
    for (int i = 0; i < 26; ++i) p.in[i] = (const float*)d_in[i];
    p.out = (float*)d_out; p.ws = (unsigned char*)d_ws;
    void* args[] = {&p};
    hipError_t e = hipLaunchCooperativeKernel((void*)fwd_megakernel, dim3(grid_blocks), dim3(NT), args, LDS_BYTES, stream);
    if (e != hipSuccess) fprintf(stderr, "cooperative launch failed: %s (grid %d)\n", hipGetErrorString(e), grid_blocks);
}
```

```cpp
#include <hip/hip_runtime.h>
#include <hip/hip_cooperative_groups.h>
#include <cstdio>
#include <cstdint>
namespace cg = cooperative_groups;

typedef unsigned short bf16_t;
typedef short bf16x8 __attribute__((ext_vector_type(8)));
typedef float f32x4 __attribute__((ext_vector_type(4)));
typedef unsigned u32x4 __attribute__((ext_vector_type(4)));
typedef unsigned u32x2 __attribute__((ext_vector_type(2)));

#define NT 512
#define DBG_LAYER 0
#define DBG_CLS ((((row % 64) / 16) * 2) + ((ch % 32) / 16))
#ifndef PHMASK
#define PHMASK 0xFFFF
#endif
#ifndef DUPMASK
#define DUPMASK 0
#endif
#define REP(bit) for (int rep_ = 0; rep_ < (((DUPMASK) & (bit)) ? 2 : 1); ++rep_)
constexpr int BATCH = 16, SEQ = 2048, DM = 1024, CTXL = 256;
constexpr int NLAT = BATCH * SEQ, NCTX = BATCH * CTXL, MTOT = NLAT + NCTX;
constexpr int DFF = 4096;
constexpr float EPS = 1e-6f;
constexpr int LDS_BYTES = 147456;

constexpr size_t al256(size_t x) { return (x + 255) & ~(size_t)255; }
constexpr size_t WS_WIN = 0;
constexpr size_t WS_WOUT = al256(WS_WIN + (size_t)3840 * 1024 * 2);
constexpr size_t WS_WM1 = al256(WS_WOUT + (size_t)1024 * 1024 * 2);
constexpr size_t WS_WM2 = al256(WS_WM1 + (size_t)4096 * 1024 * 2);
constexpr size_t WS_MOD = al256(WS_WM2 + (size_t)4096 * 1024 * 2);
constexpr size_t WS_XC = al256(WS_MOD + (size_t)4 * 17 * 6144 * 4);
constexpr size_t WS_ACT = al256(WS_XC + (size_t)NCTX * 1024 * 4);
constexpr size_t WS_BIG = al256(WS_ACT + (size_t)MTOT * 1024 * 2);
constexpr size_t WS_P2 = WS_BIG + (size_t)MTOT * 2048 * 2;
constexpr int QK_LD = 2048 + 64;
constexpr int VT_LD = MTOT + 64;
constexpr size_t WS_P2ODD = WS_BIG + (size_t)MTOT * QK_LD * 2;
constexpr size_t WS_GATES = WS_P2 + (size_t)1536 * MTOT * 2;
constexpr size_t WS_HFB = al256(WS_BIG + (size_t)MTOT * 4096 * 2);
constexpr size_t WS_FLAT = al256(WS_HFB + (size_t)2 * MTOT * 512 * 2);
constexpr size_t WS_FCTX = al256(WS_FLAT + (size_t)2 * 512 * 4096 * 2);
constexpr size_t WS_H2 = al256(WS_FCTX + (size_t)2 * 512 * 512 * 2);
constexpr size_t WS_ROPE = al256(WS_H2 + (size_t)2 * 2304 * 64 * 4);
constexpr size_t WS_END = al256(WS_ROPE + (size_t)2 * 64 * 32 * 4);
static_assert(WS_GATES + (size_t)MTOT * 16 * 4 <= WS_HFB, "projection overlay too large");
static_assert(WS_P2ODD + (size_t)1024 * VT_LD * 2 <= WS_HFB, "odd projection overlay too large");

struct Params { const float* in[26]; float* out; unsigned char* ws; };

typedef float f32x2_ __attribute__((ext_vector_type(2)));
typedef __bf16 bf16x2_ __attribute__((ext_vector_type(2)));
__device__ __forceinline__ unsigned pk2(float lo, float hi) { f32x2_ v = {lo, hi}; bf16x2_ b = __builtin_convertvector(v, bf16x2_); return __builtin_bit_cast(unsigned, b); }
__device__ __forceinline__ bf16_t f2b(float x) { return (bf16_t)(pk2(x, 0.f) & 0xffffu); }
__device__ __forceinline__ float b2f(bf16_t b) { return __uint_as_float(((unsigned)b) << 16); }
__device__ __forceinline__ float blo(unsigned w) { return __uint_as_float(w << 16); }
__device__ __forceinline__ float bhi(unsigned w) { return __uint_as_float(w & 0xffff0000u); }
__device__ __forceinline__ void unpack8(u32x4 v, float* f) {
    f[0] = blo(v.x); f[1] = bhi(v.x); f[2] = blo(v.y); f[3] = bhi(v.y); f[4] = blo(v.z); f[5] = bhi(v.z); f[6] = blo(v.w); f[7] = bhi(v.w);
}
__device__ __forceinline__ u32x4 pack8(const float* f) { u32x4 r; r.x = pk2(f[0], f[1]); r.y = pk2(f[2], f[3]); r.z = pk2(f[4], f[5]); r.w = pk2(f[6], f[7]); return r; }
__device__ __forceinline__ float fsin_(float x) { float r = x * 0.15915494309189535f; r -= floorf(r); return __builtin_amdgcn_sinf(r); }
__device__ __forceinline__ float fcos_(float x) { float r = x * 0.15915494309189535f; r -= floorf(r); return __builtin_amdgcn_cosf(r); }
__device__ __forceinline__ float wave_sum(float v) {
#pragma unroll
    for (int o = 1; o < 64; o <<= 1) v += __shfl_xor(v, o);
    return v;
}
__device__ __forceinline__ f32x4 mfma16(bf16x8 a, bf16x8 b, f32x4 c) { return __builtin_amdgcn_mfma_f32_16x16x32_bf16(a, b, c, 0, 0, 0); }
__device__ __forceinline__ bf16x8 as_bf8(u32x4 v) { return __builtin_bit_cast(bf16x8, v); }

extern __shared__ __attribute__((aligned(16))) unsigned char dyn_lds[];
__device__ __forceinline__ int tid_l() { int t = threadIdx.x; asm volatile("" : "+v"(t)); return t; }

constexpr int G_BM = 256, G_BK = 64, G_HALF = 128, G_HT = G_HALF * G_BK;
__device__ __forceinline__ int lds_byte(int r, int c) {
    int st = (r >> 4) * 2 + (c >> 5), rr = r & 15, cc = c & 31, ob = rr * 64 + cc * 2;
    return st * 1024 + (ob ^ (((ob >> 9) & 1) << 5));
}
__device__ __forceinline__ void stage_rc(int b, int& R, int& C) {
    int st = b / 1024, sb = b % 1024, swz = sb ^ (((sb >> 9) & 1) << 5);
    R = (st >> 1) * 16 + swz / 64; C = (st & 1) * 32 + (swz % 64) / 2;
}

enum { EPI_INPROJ = 0, EPI_RESID = 1, EPI_RELU2 = 2, EPI_DRY = 3 };
struct EpiArgs {
    bf16_t* o_rm; int ld_rm;
    bf16_t* o_dbg;
    int ld_cm;
    bf16_t* o_cm;
    float* gates; int gate_pn;
    const float* res_lat; const float* res_ctx; float* out_lat; float* out_ctx; const float* modg;
};

#define WAIT_V_(n) asm volatile("s_waitcnt vmcnt(" #n ")" ::: "memory")
#define WAIT_V(n) WAIT_V_(n)
#ifndef GEMM_SGB
#define GEMM_SGB 0
#endif
#ifndef GEMM_VM
#define GEMM_VM 8
#endif
#define WAIT_L(n) asm volatile("s_waitcnt lgkmcnt(" #n ")" ::: "memory")
#define BAR __builtin_amdgcn_s_barrier()
#define CFENCE asm volatile("" ::: "memory")

template <bool TR, int NAI>
__device__ __forceinline__ void gemm_kloop(const bf16_t* __restrict__ A, const bf16_t* __restrict__ Bt, int K, int brow, int bcol, f32x4 (&acc)[NAI][2][4][2], int kt0, int nt) {
    bf16_t* shm = (bf16_t*)dyn_lds;
#define SA(b, h) (shm + ((b) * 2 + (h)) * G_HT)
#define SB(b, h) (shm + (4 + (b) * 2 + (h)) * G_HT)
    const int tidx = tid_l();
    const int wid = tidx >> 6, lane = tidx & 63, wr = wid >> 2, wc = wid & 3, fr = lane & 15, fq = lane >> 4;
    int goff[2];
#pragma unroll
    for (int i = 0; i < 2; ++i) { int r_, c_; stage_rc(tidx * 16 + i * 8192, r_, c_); goff[i] = r_ * K + c_; }
    const bf16_t* Ab = A + (long)brow * K + kt0 * G_BK; const bf16_t* Bb = Bt + (long)bcol * K + kt0 * G_BK;
#define STAGE2(P, BASEP, kt) do { _Pragma("unroll") for (int _i = 0; _i < 2; ++_i) \
      __builtin_amdgcn_global_load_lds((const unsigned*)((BASEP) + (kt) * G_BK + goff[_i]), (unsigned*)((char*)(P) + tidx * 16 + _i * 8192), 16, 0, 0); } while (0)
    STAGE2(SA(0, 0), Ab, 0); if (NAI == 2) STAGE2(SA(0, 1), Ab + (long)G_HALF * K, 0); STAGE2(SB(0, 0), Bb, 0); STAGE2(SB(0, 1), Bb + (long)G_HALF * K, 0);
    for (int kt = 0; kt < nt; ++kt) {
        const int cur = kt & 1, nxt = cur ^ 1;
        WAIT_V(0); WAIT_L(0);
        BAR; CFENCE;
#define LDBF(dst, k) _Pragma("unroll") for (int bj = 0; bj < 2; ++bj) _Pragma("unroll") for (int n = 0; n < 2; ++n) \
            dst[bj][n] = *reinterpret_cast<const bf16x8*>((char*)SB(cur, bj) + lds_byte(wc * 32 + n * 16 + fr, (k) * 32 + fq * 8))
#define LDAF(dst, ai, k) _Pragma("unroll") for (int m = 0; m < 4; ++m) \
            dst[m] = *reinterpret_cast<const bf16x8*>((char*)SA(cur, ai) + lds_byte(wr * 64 + m * 16 + fr, (k) * 32 + fq * 8))
#define MMAG(ai, Af_, Bf_) _Pragma("unroll") for (int m = 0; m < 4; ++m) _Pragma("unroll") for (int bj = 0; bj < 2; ++bj) _Pragma("unroll") for (int n = 0; n < 2; ++n) \
            acc[ai][bj][m][n] = TR ? mfma16(Bf_[bj][n], Af_[m], acc[ai][bj][m][n]) : mfma16(Af_[m], Bf_[bj][n], acc[ai][bj][m][n])
        bf16x8 B0[2][2], B1[2][2], A0[4], A1[4];
        LDBF(B0, 0); LDAF(A0, 0, 0); if (NAI == 2) { LDAF(A1, 1, 0); }
        if (kt + 1 < nt) {
            STAGE2(SA(nxt, 0), Ab, kt + 1); if (NAI == 2) STAGE2(SA(nxt, 1), Ab + (long)G_HALF * K, kt + 1);
            STAGE2(SB(nxt, 0), Bb, kt + 1); STAGE2(SB(nxt, 1), Bb + (long)G_HALF * K, kt + 1);
        }
        MMAG(0, A0, B0);
        LDBF(B1, 1); LDAF(A0, 0, 1);
        if (NAI == 2) { MMAG(NAI - 1, A1, B0); LDAF(A1, 1, 1); }
        MMAG(0, A0, B1);
        if (NAI == 2) { MMAG(NAI - 1, A1, B1); }
#if GEMM_SGB
        __builtin_amdgcn_sched_group_barrier(0x100, 12, 0);
        __builtin_amdgcn_sched_group_barrier(0x020, 8, 0);
        __builtin_amdgcn_sched_group_barrier(0x008, 16, 0);
        __builtin_amdgcn_sched_group_barrier(0x100, 8, 0);
        __builtin_amdgcn_sched_group_barrier(0x008, 16, 0);
        __builtin_amdgcn_sched_group_barrier(0x100, 4, 0);
        __builtin_amdgcn_sched_group_barrier(0x008, 32, 0);
#endif
    }
    WAIT_L(0); BAR; CFENCE;
}

template <int EPI, int NAI>
__device__ __forceinline__ void gemm_tile(const bf16_t* A, const bf16_t* Bt, int K, int brow, int bcol, int pn, const EpiArgs& ea, int wr, int wc, int fr, int fq) {
        constexpr bool SPLITTAIL = false; const int kq = -1, kt0 = 0, ntl = K / G_BK; (void)kq;
        f32x4 acc[NAI][2][4][2];
#pragma unroll
        for (int a = 0; a < NAI; ++a)
#pragma unroll
            for (int b = 0; b < 2; ++b)
#pragma unroll
                for (int m = 0; m < 4; ++m)
#pragma unroll
                    for (int n = 0; n < 2; ++n) acc[a][b][m][n] = (f32x4){0.f, 0.f, 0.f, 0.f};
        const bool colmajor = (EPI == EPI_INPROJ) && pn >= 8 && pn != ea.gate_pn;
        if (colmajor) {
            gemm_kloop<true, NAI>(A, Bt, K, brow, bcol, acc, kt0, ntl);
#pragma unroll
            for (int ai = 0; ai < NAI; ++ai)
#pragma unroll
                for (int bj = 0; bj < 2; ++bj)
#pragma unroll
                    for (int m = 0; m < 4; ++m)
#pragma unroll
                        for (int n = 0; n < 2; ++n) {
                            const int row = brow + ai * 128 + wr * 64 + m * 16 + fr, col = bcol + bj * 128 + wc * 32 + n * 16 + fq * 4;
                            const f32x4 v = acc[ai][bj][m][n];
#pragma unroll
                            for (int j = 0; j < 4; ++j) ea.o_cm[(size_t)(col + j - 2048) * ea.ld_cm + row] = f2b(v[j]);
                        }
        } else if (EPI == EPI_RESID) {
            gemm_kloop<true, NAI>(A, Bt, K, brow, bcol, acc, kt0, ntl);
            const bool lat = brow < NLAT;
            const int mrow = lat ? brow >> 11 : 16;
            const float* rbase = lat ? ea.res_lat + (size_t)brow * 1024 : ea.res_ctx + (size_t)(brow - NLAT) * 1024;
            float* obase = lat ? ea.out_lat + (size_t)brow * 1024 : ea.out_ctx + (size_t)(brow - NLAT) * 1024;
            f32x4 g[2][2];
#pragma unroll
            for (int bj = 0; bj < 2; ++bj)
#pragma unroll
                for (int n = 0; n < 2; ++n) g[bj][n] = *(const f32x4*)(ea.modg + (size_t)mrow * 6144 + bcol + bj * 128 + wc * 32 + n * 16 + fq * 4);
            if (SPLITTAIL && kq >= 0) {
#pragma unroll
                for (int ai = 0; ai < NAI; ++ai)
#pragma unroll
                    for (int m = 0; m < 4; ++m)
#pragma unroll
                        for (int bj = 0; bj < 2; ++bj)
#pragma unroll
                            for (int n = 0; n < 2; ++n) {
                                float* op = obase + (size_t)(ai * 128 + wr * 64 + m * 16 + fr) * 1024 + bcol + bj * 128 + wc * 32 + n * 16 + fq * 4;
                                const f32x4 dv = g[bj][n] * acc[ai][bj][m][n];
#pragma unroll
                                for (int j = 0; j < 4; ++j) unsafeAtomicAdd(op + j, dv[j]);
                            }
            } else
#pragma unroll
            for (int ai = 0; ai < NAI; ++ai) {
                f32x4 xv[4][2][2];
#pragma unroll
                for (int m = 0; m < 4; ++m)
#pragma unroll
                    for (int bj = 0; bj < 2; ++bj)
#pragma unroll
                        for (int n = 0; n < 2; ++n)
                            xv[m][bj][n] = *(const f32x4*)(rbase + (size_t)(ai * 128 + wr * 64 + m * 16 + fr) * 1024 + bcol + bj * 128 + wc * 32 + n * 16 + fq * 4);
#pragma unroll
                for (int m = 0; m < 4; ++m)
#pragma unroll
                    for (int bj = 0; bj < 2; ++bj)
#pragma unroll
                        for (int n = 0; n < 2; ++n)
                            *(f32x4*)(obase + (size_t)(ai * 128 + wr * 64 + m * 16 + fr) * 1024 + bcol + bj * 128 + wc * 32 + n * 16 + fq * 4) = xv[m][bj][n] + g[bj][n] * acc[ai][bj][m][n];
            }
        } else {
            gemm_kloop<true, NAI>(A, Bt, K, brow, bcol, acc, kt0, ntl);
#pragma unroll
            for (int ai = 0; ai < NAI; ++ai)
#pragma unroll
                for (int m = 0; m < 4; ++m) {
                    const int row = brow + ai * 128 + wr * 64 + m * 16 + fr;
#pragma unroll
                    for (int bj = 0; bj < 2; ++bj)
#pragma unroll
                        for (int n = 0; n < 2; ++n) {
                            const int col = bcol + bj * 128 + wc * 32 + n * 16 + fq * 4;
                            const f32x4 v = acc[ai][bj][m][n];
                            if (EPI == EPI_INPROJ) {
                                if (pn == ea.gate_pn) {
                                    if (bj == 0 && wc == 0 && n == 0) *(f32x4*)(ea.gates + (size_t)row * 16 + fq * 4) = v;
                                } else {
                                    u32x2 o; o.x = pk2(v[0], v[1]); o.y = pk2(v[2], v[3]);
                                    *(u32x2*)(ea.o_rm + (size_t)row * ea.ld_rm + col) = o;
                                }
                            } else if (EPI == EPI_DRY) {
                                if (v[0] == 123456.789f && v[1] == 3.25f) *(f32x4*)(ea.out_lat + (size_t)row * 1024 + (col & 1023)) = v;
                            } else if (EPI == EPI_RELU2) {
                                float r0 = fmaxf(v[0], 0.f), r1 = fmaxf(v[1], 0.f), r2 = fmaxf(v[2], 0.f), r3 = fmaxf(v[3], 0.f);
                                u32x2 o; o.x = pk2(r0 * r0, r1 * r1); o.y = pk2(r2 * r2, r3 * r3);
                                *(u32x2*)(ea.o_rm + (size_t)row * ea.ld_rm + col) = o;
                            } else {
                                const float* rp; float* op; int mrow;
                                if (row < NLAT) { rp = ea.res_lat + (size_t)row * 1024 + col; op = ea.out_lat + (size_t)row * 1024 + col; mrow = row >> 11; }
                                else { rp = ea.res_ctx + (size_t)(row - NLAT) * 1024 + col; op = ea.out_ctx + (size_t)(row - NLAT) * 1024 + col; mrow = 16; }
                                const f32x4 g = *(const f32x4*)(ea.modg + (size_t)mrow * 6144 + col);
                                const f32x4 x = *(const f32x4*)rp;
                                f32x4 rr = x + g * v;
#ifdef SANITIZE
#pragma unroll
                                for (int q_ = 0; q_ < 4; ++q_) if (!(fabsf(rr[q_]) < 1e30f)) rr[q_] = 0.f;
#endif
                                *(f32x4*)op = rr;
                            }
                        }
                }
        }
        asm volatile("s_waitcnt vmcnt(0)" ::: "memory");
        __syncthreads();
}

template <int EPI, bool HALFTAIL = true>
__device__ __forceinline__ void gemm_phase(const bf16_t* A, const bf16_t* Bt, int M, int N, int K, const EpiArgs& ea) {
    const int nM = M / G_BM, nN = N / G_BM, nwg = nM * nN, G_ = gridDim.x;
    const int tidx = tid_l(); const int wid = tidx >> 6, lane = tidx & 63, wr = wid >> 2, wc = wid & 3, fr = lane & 15, fq = lane >> 4;
    int nfull = nwg;
    if (HALFTAIL) { const int rem = nwg % G_; if (rem > 0 && rem * 2 <= G_) nfull = nwg - rem; }
    const int nunits = nfull + (nwg - nfull) * 2;
    for (int U = blockIdx.x; U < nunits; U += G_) {
        const int L = U < nfull ? U : nfull + ((U - nfull) >> 1);
        const int half = U < nfull ? -1 : ((U - nfull) & 1);
        int wgid = L;
        { int q = nwg / 8, r = nwg % 8, xcd = wgid % 8, off = wgid / 8; wgid = (xcd < r ? xcd * (q + 1) : r * (q + 1) + (xcd - r) * q) + off; }
        const int nig = 4 * nN, gid = wgid / nig, fm = gid * 4, gsz = min(nM - fm, 4);
        const int pm = fm + ((wgid % nig) % gsz), pn = (wgid % nig) / gsz, bcol = pn * G_BM;
        if (half < 0) gemm_tile<EPI, 2>(A, Bt, K, pm * G_BM, bcol, pn, ea, wr, wc, fr, fq);
        else gemm_tile<EPI, 1>(A, Bt, K, pm * G_BM + half * 128, bcol, pn, ea, wr, wc, fr, fq);
    }
}

__device__ __forceinline__ void phase0(const Params& p) {
    const int tid = tid_l(), blk = blockIdx.x, nb = gridDim.x;
    float* MOD = (float*)(p.ws + WS_MOD);
    for (int it = blk; it < 193; it += nb) {
        if (it < 192) {
            float* sl = (float*)dyn_lds;
            float* red = sl + 17 * 1024;
            for (int i = tid; i < 17 * 1024; i += NT) { float v = (i < 16 * 1024) ? p.in[1][i] : p.in[3][i - 16 * 1024]; sl[i] = v / (1.f + __expf(-v)); }
            __syncthreads();
            const int l = it / 48, nc = it % 48, kp = tid >> 7, col = tid & 127;
            const float* W = p.in[4] + (size_t)l * 1024 * 6144 + nc * 128 + col;
            float acc[17];
#pragma unroll
            for (int r = 0; r < 17; ++r) acc[r] = 0.f;
            for (int k = kp * 256; k < kp * 256 + 256; ++k) {
                const float wv = W[(size_t)k * 6144];
#pragma unroll
                for (int r = 0; r < 17; ++r) acc[r] += sl[r * 1024 + k] * wv;
            }
#pragma unroll
            for (int r = 0; r < 17; ++r) red[(kp * 17 + r) * 128 + col] = acc[r];
            __syncthreads();
            for (int i = tid; i < 17 * 128; i += NT) {
                const int r = i >> 7, cc = i & 127;
                const float s = red[(0 * 17 + r) * 128 + cc] + red[(1 * 17 + r) * 128 + cc] + red[(2 * 17 + r) * 128 + cc] + red[(3 * 17 + r) * 128 + cc];
                MOD[((size_t)l * 17 + r) * 6144 + nc * 128 + cc] = s + p.in[5][l * 6144 + nc * 128 + cc];
            }
            __syncthreads();
        } else {
            float* ROPE = (float*)(p.ws + WS_ROPE);
            for (int i = tid; i < 2048; i += NT) {
                const int pos = i >> 5, j = i & 31;
                const float inv = exp2f(-(float)j * (13.287712379549449f / 32.f));
                const float ang = (float)pos * inv;
                ROPE[i] = fcos_(ang); ROPE[2048 + i] = fsin_(ang);
            }
        }
    }
    float* H2 = (float*)(p.ws + WS_H2);
    const int gw = blk * 8 + (tid >> 6), lane = tid & 63;
    for (int it = gw; it < 2 * 2304; it += nb * 8) {
        const int i = it / 2304, row = it % 2304;
        const int L = row < 2048 ? 2048 : 256, t = row < 2048 ? row : row - 2048;
        const float tn = (float)t / (float)(L - 1);
        const float wpos = 6.283185307179586f * (float)t / (float)L;
        float ev = 0.f;
        if (lane == 0) ev = tn;
        else if (lane <= 16) { const float fr = 1e-4f + (float)(lane - 1) * ((15.f - 1e-4f) / 15.f); ev = fcos_(wpos * fr); }
        else if (lane <= 32) { const float fr = 1e-4f + (float)(lane - 17) * ((15.f - 1e-4f) / 15.f); ev = -fsin_(wpos * fr); }
        const float* w1 = p.in[13] + i * 33 * 64; const float* b1 = p.in[14] + i * 64;
        const float* w2 = p.in[15] + i * 64 * 64; const float* b2 = p.in[16] + i * 64; const float* fq = p.in[18] + i * 64;
        float a = b1[lane];
        for (int e = 0; e < 33; ++e) a += __shfl(ev, e) * w1[e * 64 + lane];
        const float h1 = fsin_(fq[lane] * a);
        float a2 = b2[lane];
        for (int e = 0; e < 64; ++e) a2 += __shfl(h1, e) * w2[e * 64 + lane];
        H2[((size_t)i * 2304 + row) * 64 + lane] = fsin_(fq[lane] * a2);
    }
}

__device__ __forceinline__ void cvt_tile(const float* W, int N, int K, bf16_t* WT, int n0, int k0, int mapmode) {
    float* tl = (float*)dyn_lds;
    const int tid = tid_l(), nl = tid & 63, kb = tid >> 6;
    const int n = n0 + nl; int sc = n;
    if (mapmode == 1) sc = n < 2048 ? n : (n < 3584 ? n + 16 : (n < 3600 ? n - 3584 + 2048 : -1));
#pragma unroll
    for (int i = 0; i < 8; ++i) { const int kl = kb + 8 * i; tl[kl * 65 + nl] = sc >= 0 ? W[(size_t)(k0 + kl) * N + sc] : 0.f; }
    __syncthreads();
    const int nn = tid >> 3, kc = tid & 7;
    float f[8];
#pragma unroll
    for (int j = 0; j < 8; ++j) f[j] = tl[(kc * 8 + j) * 65 + nn];
    *(u32x4*)(WT + (size_t)(n0 + nn) * K + k0 + kc * 8) = pack8(f);
    __syncthreads();
}

__device__ __forceinline__ void convert_weights(const Params& p, int l, bool first_part, bool second_part, int bstart, int bcount) {
    const int blk = (int)blockIdx.x - bstart, nb = bcount, li = l >> 1; const bool even = !(l & 1);
    if (blk < 0 || blk >= bcount) return;
    const int nin = even ? 60 : 48;
    const int t_in = nin * 16, t_out = 256, t_m1 = 1024, t_m2 = 1024;
    const int it0 = first_part ? 0 : t_in + t_out + t_m1, it1 = second_part ? t_in + t_out + t_m1 + t_m2 : t_in + t_out + t_m1;
    for (int it = it0 + blk; it < it1; it += nb) {
        int r = it;
        if (r < t_in) {
            const int nt = r / 16, kt = r % 16;
            if (even) cvt_tile(p.in[8] + (size_t)li * 1024 * 3600, 3600, 1024, (bf16_t*)(p.ws + WS_WIN), nt * 64, kt * 64, 1);
            else cvt_tile(p.in[21] + (size_t)li * 1024 * 3072, 3072, 1024, (bf16_t*)(p.ws + WS_WIN), nt * 64, kt * 64, 0);
            continue;
        }
        r -= t_in;
        if (r < t_out) {
            const int nt = r / 16, kt = r % 16;
            cvt_tile((even ? p.in[20] : p.in[25]) + (size_t)li * 1024 * 1024, 1024, 1024, (bf16_t*)(p.ws + WS_WOUT), nt * 64, kt * 64, 0);
            continue;
        }
        r -= t_out;
        if (r < t_m1) {
            const int nt = r / 16, kt = r % 16;
            cvt_tile(p.in[6] + (size_t)l * 1024 * 4096, 4096, 1024, (bf16_t*)(p.ws + WS_WM1), nt * 64, kt * 64, 0);
            continue;
        }
        r -= t_m1;
        { const int nt = r / 64, kt = r % 64;
          cvt_tile(p.in[7] + (size_t)l * 4096 * 1024, 1024, 4096, (bf16_t*)(p.ws + WS_WM2), nt * 64, kt * 64, 0); }
    }
}

__device__ __forceinline__ void norm_phase(const Params& p, int l, const float* xlat, const float* xctx, int shoff, int scoff, int M) {
    const int tid = tid_l(), lane = tid & 63, gw = blockIdx.x * 8 + (tid >> 6), ngw = gridDim.x * 8;
    const float* MOD = (const float*)(p.ws + WS_MOD) + (size_t)l * 17 * 6144;
    bf16_t* ACT = (bf16_t*)(p.ws + WS_ACT);
    for (int row = gw; row < M; row += ngw) {
        const float* xr = row < NLAT ? xlat + (size_t)row * 1024 : xctx + (size_t)(row - NLAT) * 1024;
        const int mrow = row < NLAT ? row >> 11 : 16;
        const float* mod = MOD + (size_t)mrow * 6144;
        f32x4 v[4]; float ss = 0.f;
#pragma unroll
        for (int j = 0; j < 4; ++j) { v[j] = *(const f32x4*)(xr + 4 * lane + 256 * j); ss += v[j][0] * v[j][0] + v[j][1] * v[j][1] + v[j][2] * v[j][2] + v[j][3] * v[j][3]; }
        ss = wave_sum(ss);
        const float rstd = rsqrtf(ss * (1.f / 1024.f) + EPS);
#pragma unroll
        for (int j = 0; j < 4; ++j) {
            const int col = 4 * lane + 256 * j;
            const f32x4 sh = *(const f32x4*)(mod + shoff + col), sc = *(const f32x4*)(mod + scoff + col);
            const f32x4 y = v[j] * rstd * (sc + 1.f) + sh;
            u32x2 o; o.x = pk2(y[0], y[1]); o.y = pk2(y[2], y[3]);
            *(u32x2*)(ACT + (size_t)row * 1024 + col) = o;
        }
    }
}

__device__ __forceinline__ void filter_gen(const Params& p, int li) {
    const int tid = tid_l(), lane = tid & 63, w = tid >> 6;
    float* wf = (float*)dyn_lds; float* wb = wf + 64; float* red = wb + 64;
    const float* H2 = (const float*)(p.ws + WS_H2);
    for (int it = blockIdx.x; it < 2048; it += gridDim.x) {
        const int ltype = it >> 10, o = (it >> 9) & 1, c = it & 511;
        const int L = ltype ? 256 : 2048;
        const float* H2r = H2 + ((size_t)li * 2304 + (ltype ? 2048 : 0)) * 64;
        const float* w3 = p.in[17] + (size_t)li * 64 * 2048;
        if (tid < 64) wf[tid] = w3[tid * 2048 + (o * 2 + 0) * 512 + c];
        else if (tid < 128) wb[tid - 64] = w3[(tid - 64) * 2048 + (o * 2 + 1) * 512 + c];
        __syncthreads();
        const float lo = -4.605170185988091f / 1.5f, hi = -4.605170185988091f / 0.3f;
        const float delta = fabsf(lo + (hi - lo) * (float)c / 511.f);
        float vf[4], vb[4]; float ssf = 0.f, ssb = 0.f;
#pragma unroll
        for (int q = 0; q < 4; ++q) {
            const int t = tid + 512 * q; vf[q] = 0.f; vb[q] = 0.f;
            if (t < L) {
                float df = 0.f, db = 0.f;
                const f32x4* hr = (const f32x4*)(H2r + (size_t)t * 64);
#pragma unroll
                for (int j = 0; j < 16; ++j) { const f32x4 hv = hr[j];
                    df += hv[0] * wf[4 * j] + hv[1] * wf[4 * j + 1] + hv[2] * wf[4 * j + 2] + hv[3] * wf[4 * j + 3];
                    db += hv[0] * wb[4 * j] + hv[1] * wb[4 * j + 1] + hv[2] * wb[4 * j + 2] + hv[3] * wb[4 * j + 3]; }
                const float dec = __expf(-((float)t / (float)(L - 1)) * delta);
                vf[q] = df * dec; vb[q] = db * dec; ssf += vf[q] * vf[q]; ssb += vb[q] * vb[q];
            }
        }
        ssf = wave_sum(ssf); ssb = wave_sum(ssb);
        if (lane == 0) { red[w] = ssf; red[8 + w] = ssb; }
        __syncthreads();
        float tf = 0.f, tb = 0.f;
#pragma unroll
        for (int i = 0; i < 8; ++i) { tf += red[i]; tb += red[8 + i]; }
        const float nf = rsqrtf(tf + EPS), nbk = rsqrtf(tb + EPS);
        bf16_t* dst = ltype ? (bf16_t*)(p.ws + WS_FCTX) + ((size_t)o * 512 + c) * 512 : (bf16_t*)(p.ws + WS_FLAT) + ((size_t)o * 512 + c) * 4096;
#pragma unroll
        for (int q = 0; q < 4; ++q) {
            const int t = tid + 512 * q;
            if (t < L) {
                if (t == 0) { dst[L] = f2b(vf[q] * nf + vb[q] * nbk); dst[0] = 0; }
                else { dst[L + t] = f2b(vf[q] * nf); dst[L - t] = f2b(vb[q] * nbk); }
            }
        }
        __syncthreads();
    }
}

__device__ __forceinline__ void mlstm_item(const Params& p, int li, int it) {
    const int tid = tid_l(), w = tid >> 6, lane = tid & 63, fr = lane & 15, fq = lane >> 4;
    const int b = it >> 3, h = (it >> 1) & 3, dir = it & 1;
    bf16_t* Qs = (bf16_t*)dyn_lds;
    bf16_t* Ks = Qs + 64 * 136;
    bf16_t* KT = Ks + 64 * 136;
    bf16_t* VT = KT + 128 * 72;
    bf16_t* Cb = VT + 144 * 72;
    bf16_t* Ps = Cb + 144 * 136;
    float* fl = (float*)(Ps + 64 * 72);
    float* a_s = fl; float* Mt = fl + 64; float* scs = fl + 128; float* emt = fl + 192; float* den = fl + 256; float* lfs = fl + 320; float* igs = fl + 384; float* scal = fl + 448;
    const bf16_t* QKVO = (const bf16_t*)(p.ws + WS_BIG);
    const float* GATES = (const float*)(p.ws + WS_GATES);
    bf16_t* HFB = (bf16_t*)(p.ws + WS_HFB) + (size_t)dir * MTOT * 512;
    const float* ROPE = (const float*)(p.ws + WS_ROPE);
    const float* gate_b = p.in[9] + li * 16;
    for (int i = tid; i < 144 * 136 / 2; i += NT) ((unsigned*)Cb)[i] = 0u;
    for (int i = tid; i < 16 * 72; i += NT) { const int r = i / 72, ci = i % 72; VT[(128 + r) * 72 + ci] = (r == 0 && ci < 64) ? (bf16_t)0x3F80 : (bf16_t)0; }
    f32x4 cacc[9];
#pragma unroll
    for (int i = 0; i < 9; ++i) cacc[i] = (f32x4){0.f, 0.f, 0.f, 0.f};
    float m = 0.f;
    const int pr_r = tid >> 3, pr_seg = tid & 7, pr_tl = dir ? 63 - pr_r : pr_r, pr_tl2 = dir ? 63 - (tid & 63) : (tid & 63);
    const int pr_d1 = (pr_seg >> 2) * 64 + (pr_seg & 3) * 8;
    u32x4 pf_q1, pf_q2, pf_k1, pf_k2, pf_v1, pf_v2; float pgi = 0.f, pgf = 0.f;
#define MLSTM_ISSUE(ST_) do { const int st_ = (ST_); const bool ic_ = st_ < 4; const int cjn_ = ic_ ? (dir ? 3 - st_ : st_) : (dir ? 35 - st_ : st_ - 4); \
        const int rb_ = ic_ ? NLAT + b * 256 + cjn_ * 64 : b * 2048 + cjn_ * 64; \
        const bf16_t* sp_ = QKVO + (size_t)(rb_ + pr_tl) * 2048 + h * 128; \
        pf_q1 = *(const u32x4*)(sp_ + pr_d1); pf_q2 = *(const u32x4*)(sp_ + pr_d1 + 32); pf_k1 = *(const u32x4*)(sp_ + 512 + pr_d1); pf_k2 = *(const u32x4*)(sp_ + 512 + pr_d1 + 32); \
        pf_v1 = *(const u32x4*)(sp_ + 1024 + pr_seg * 16); pf_v2 = *(const u32x4*)(sp_ + 1024 + pr_seg * 16 + 8); \
        if (tid < 64) { const float* g_ = GATES + (size_t)(rb_ + pr_tl2) * 16; pgi = g_[dir * 8 + h]; pgf = g_[dir * 8 + 4 + h]; } } while (0)
    MLSTM_ISSUE(0);
    __syncthreads();
    for (int step = 0; step < 36; ++step) {
        const bool isctx = step < 4;
        const int cj = isctx ? (dir ? 3 - step : step) : (dir ? 35 - step : step - 4);
        const int rowbase = isctx ? NLAT + b * 256 + cj * 64 : b * 2048 + cj * 64;
        {
            const int r = tid >> 3, seg = tid & 7; const int tl = dir ? 63 - r : r;
            const int hb = seg >> 2, jb = (seg & 3) * 8, d1 = hb * 64 + jb, d2 = d1 + 32;
            const u32x4 q1 = pf_q1, q2 = pf_q2, k1 = pf_k1, k2 = pf_k2, v1 = pf_v1, v2 = pf_v2;
            const float cgi = pgi, cgf = pgf;
            if (step + 1 < 36) MLSTM_ISSUE(step + 1);
            float cs[8], sn[8];
            if (!isctx) {
                const int pos = hb ? tl : cj;
                const f32x4 c0 = *(const f32x4*)(ROPE + pos * 32 + jb), c1 = *(const f32x4*)(ROPE + pos * 32 + jb + 4);
                const f32x4 s0 = *(const f32x4*)(ROPE + 2048 + pos * 32 + jb), s1 = *(const f32x4*)(ROPE + 2048 + pos * 32 + jb + 4);
#pragma unroll
                for (int e = 0; e < 4; ++e) { cs[e] = c0[e]; cs[4 + e] = c1[e]; sn[e] = s0[e]; sn[4 + e] = s1[e]; }
            } else {
#pragma unroll
                for (int e = 0; e < 8; ++e) { cs[e] = 1.f; sn[e] = 0.f; }
            }
            float x1[8], x2[8], o1[8], o2[8];
            unpack8(q1, x1); unpack8(q2, x2);
#pragma unroll
            for (int e = 0; e < 8; ++e) { o1[e] = x1[e] * cs[e] - x2[e] * sn[e]; o2[e] = x1[e] * sn[e] + x2[e] * cs[e]; }
            *(u32x4*)(Qs + r * 136 + d1) = pack8(o1); *(u32x4*)(Qs + r * 136 + d2) = pack8(o2);
            unpack8(k1, x1); unpack8(k2, x2);
            const float ksc = 0.08838834764831845f;
#pragma unroll
            for (int e = 0; e < 8; ++e) { o1[e] = (x1[e] * cs[e] - x2[e] * sn[e]) * ksc; o2[e] = (x1[e] * sn[e] + x2[e] * cs[e]) * ksc; }
            const u32x4 ko1 = pack8(o1), ko2 = pack8(o2);
            *(u32x4*)(Ks + r * 136 + d1) = ko1; *(u32x4*)(Ks + r * 136 + d2) = ko2;
            {
                const unsigned kw1[4] = {ko1.x, ko1.y, ko1.z, ko1.w}, kw2[4] = {ko2.x, ko2.y, ko2.z, ko2.w};
#pragma unroll
                for (int e = 0; e < 4; ++e) {
                    KT[(d1 + 2 * e) * 72 + r] = (bf16_t)(kw1[e] & 0xffffu); KT[(d1 + 2 * e + 1) * 72 + r] = (bf16_t)(kw1[e] >> 16);
                    KT[(d2 + 2 * e) * 72 + r] = (bf16_t)(kw2[e] & 0xffffu); KT[(d2 + 2 * e + 1) * 72 + r] = (bf16_t)(kw2[e] >> 16);
                }
                const unsigned vw1[4] = {v1.x, v1.y, v1.z, v1.w}, vw2[4] = {v2.x, v2.y, v2.z, v2.w};
#pragma unroll
                for (int e = 0; e < 4; ++e) {
                    VT[(seg * 16 + 2 * e) * 72 + r] = (bf16_t)(vw1[e] & 0xffffu); VT[(seg * 16 + 2 * e + 1) * 72 + r] = (bf16_t)(vw1[e] >> 16);
                    VT[(seg * 16 + 8 + 2 * e) * 72 + r] = (bf16_t)(vw2[e] & 0xffffu); VT[(seg * 16 + 8 + 2 * e + 1) * 72 + r] = (bf16_t)(vw2[e] >> 16);
                }
            }
            if (tid < 64) {
                const int rr = tid;
                const float ig = cgi + gate_b[dir * 8 + h];
                const float fg = cgf + gate_b[dir * 8 + 4 + h];
                igs[rr] = ig; lfs[rr] = fminf(fg, 0.f) - __logf(1.f + __expf(-fabsf(fg)));
            }
        }
        __syncthreads();
        if (w == 0) {
            float bcs = lfs[lane];
#pragma unroll
            for (int o = 1; o < 64; o <<= 1) { const float t = __shfl_up(bcs, o); if (lane >= o) bcs += t; }
            const float a = igs[lane] - bcs;
            float pm = a;
#pragma unroll
            for (int o = 1; o < 64; o <<= 1) { const float t = __shfl_up(pm, o); if (lane >= o) pm = fmaxf(pm, t); }
            const float Mx = fmaxf(m, pm);
            a_s[lane] = a; Mt[lane] = Mx; scs[lane] = __expf(m - Mx); emt[lane] = __expf(-bcs - Mx);
            if (lane == 63) { scal[0] = bcs; scal[1] = Mx; }
        }
        {
            const int st = w & 3, tt0 = (w >> 2) * 2;
            f32x4 sacc[2];
#pragma unroll
            for (int u = 0; u < 2; ++u) {
                sacc[u] = (f32x4){0.f, 0.f, 0.f, 0.f};
#pragma unroll
                for (int kk = 0; kk < 4; ++kk) {
                    const bf16x8 Ak = *(const bf16x8*)(Ks + (st * 16 + fr) * 136 + kk * 32 + fq * 8);
                    const bf16x8 Bq = *(const bf16x8*)(Qs + ((tt0 + u) * 16 + fr) * 136 + kk * 32 + fq * 8);
                    sacc[u] = mfma16(Ak, Bq, sacc[u]);
                }
            }
            __syncthreads();
#pragma unroll
            for (int u = 0; u < 2; ++u) {
                const int t = (tt0 + u) * 16 + fr, sb = st * 16 + fq * 4;
                const float Mv = Mt[t];
                float pv[4];
#pragma unroll
                for (int j = 0; j < 4; ++j) { const int s = sb + j; pv[j] = (s <= t) ? sacc[u][j] * __expf(a_s[s] - Mv) : 0.f; }
                u32x2 o; o.x = pk2(pv[0], pv[1]); o.y = pk2(pv[2], pv[3]);
                *(u32x2*)(Ps + t * 72 + sb) = o;
            }
        }
        __syncthreads();
        {
            const int tt = w & 3, up = w >> 2, vt0 = up ? 5 : 0, nvt = up ? 4 : 5;
            bf16x8 qf[4], pf[2];
#pragma unroll
            for (int kk = 0; kk < 4; ++kk) qf[kk] = *(const bf16x8*)(Qs + (tt * 16 + fr) * 136 + kk * 32 + fq * 8);
#pragma unroll
            for (int kk = 0; kk < 2; ++kk) pf[kk] = *(const bf16x8*)(Ps + (tt * 16 + fr) * 72 + kk * 32 + fq * 8);
            const float sct = scs[tt * 16 + fr];
            f32x4 hacc[5];
#pragma unroll
            for (int vi = 0; vi < 5; ++vi) {
                hacc[vi] = (f32x4){0.f, 0.f, 0.f, 0.f};
                if (vi < nvt) {
                    const int v0 = (vt0 + vi) * 16;
                    f32x4 ac = (f32x4){0.f, 0.f, 0.f, 0.f};
#pragma unroll
                    for (int kk = 0; kk < 4; ++kk) ac = mfma16(*(const bf16x8*)(Cb + (v0 + fr) * 136 + kk * 32 + fq * 8), qf[kk], ac);
                    ac = ac * sct;
#pragma unroll
                    for (int kk = 0; kk < 2; ++kk) ac = mfma16(*(const bf16x8*)(VT + (v0 + fr) * 72 + kk * 32 + fq * 8), pf[kk], ac);
                    hacc[vi] = ac;
                }
            }
            if (up && fq == 0) den[tt * 16 + fr] = hacc[3][0];
            __syncthreads();
            const int t = tt * 16 + fr, tl = dir ? 63 - t : t;
            const float dn = den[t];
            const float inv = 1.f / fmaxf(fabsf(dn), emt[t]);
            bf16_t* orow = HFB + (size_t)(rowbase + tl) * 512 + h * 128;
#pragma unroll
            for (int vi = 0; vi < 5; ++vi) {
                if (vi < nvt && (vt0 + vi) < 8) {
                    const int v0 = (vt0 + vi) * 16 + fq * 4;
                    u32x2 o; o.x = pk2(hacc[vi][0] * inv, hacc[vi][1] * inv); o.y = pk2(hacc[vi][2] * inv, hacc[vi][3] * inv);
                    *(u32x2*)(orow + v0) = o;
                }
            }
        }
        {
            const float bl = scal[0], M63 = scal[1];
            const float decay = __expf(m - M63);
            bf16x8 ka[2];
#pragma unroll
            for (int kk = 0; kk < 2; ++kk) {
                const u32x4 raw = *(const u32x4*)(KT + (w * 16 + fr) * 72 + kk * 32 + fq * 8);
                float f[8]; unpack8(raw, f);
#pragma unroll
                for (int j = 0; j < 8; ++j) f[j] *= __expf(a_s[kk * 32 + fq * 8 + j] - M63);
                ka[kk] = as_bf8(pack8(f));
            }
#pragma unroll
            for (int vt = 0; vt < 9; ++vt) {
                f32x4 ac = cacc[vt] * decay;
#pragma unroll
                for (int kk = 0; kk < 2; ++kk) ac = mfma16(ka[kk], *(const bf16x8*)(VT + (vt * 16 + fr) * 72 + kk * 32 + fq * 8), ac);
                cacc[vt] = ac;
                u32x2 o; o.x = pk2(ac[0], ac[1]); o.y = pk2(ac[2], ac[3]);
                *(u32x2*)(Cb + (vt * 16 + fr) * 136 + w * 16 + fq * 4) = o;
            }
            m = bl + M63;
        }
        __syncthreads();
    }
}

__device__ __forceinline__ void combine_phase(const Params& p, int li) {
    const int tid = tid_l(), lane = tid & 63, gw = blockIdx.x * 8 + (tid >> 6), ngw = gridDim.x * 8;
    const bf16_t* HF = (const bf16_t*)(p.ws + WS_HFB); const bf16_t* HB = HF + (size_t)MTOT * 512;
    const bf16_t* QKVO = (const bf16_t*)(p.ws + WS_BIG);
    bf16_t* MIX = (bf16_t*)(p.ws + WS_ACT);
    const float* hn = p.in[10] + li * 512 + lane * 8;
    float g[8];
#pragma unroll
    for (int e = 0; e < 8; ++e) g[e] = hn[e];
    for (int row = gw; row < MTOT; row += ngw) {
        float a[8], bq[8], og[8], y[8];
        unpack8(*(const u32x4*)(HF + (size_t)row * 512 + lane * 8), a);
        unpack8(*(const u32x4*)(HB + (size_t)row * 512 + lane * 8), bq);
        unpack8(*(const u32x4*)(QKVO + (size_t)row * 2048 + 1536 + lane * 8), og);
        float ss = 0.f;
#pragma unroll
        for (int e = 0; e < 8; ++e) { a[e] += bq[e]; ss += a[e] * a[e]; }
        ss += __shfl_xor(ss, 1); ss += __shfl_xor(ss, 2); ss += __shfl_xor(ss, 4); ss += __shfl_xor(ss, 8);
        const float rstd = rsqrtf(ss * (1.f / 128.f) + EPS);
#pragma unroll
        for (int e = 0; e < 8; ++e) y[e] = a[e] * rstd * g[e] / (1.f + __expf(-og[e]));
        *(u32x4*)(MIX + (size_t)row * 1024 + lane * 8) = pack8(y);
    }
}

__device__ __forceinline__ bf16x8 hy_afrag(const bf16_t* HRp, int q, int m, int o4, int hsh) {
    const bf16_t* ap = HRp + (q + 8 - m);
    const u32x4 lo = *(const u32x4*)ap, hi = *(const u32x4*)(ap + 8);
    const bool b0 = (o4 & 1) != 0, b1 = (o4 & 2) != 0;
#define HYSEL(A_, B_, C_, D_) (b1 ? (b0 ? (D_) : (C_)) : (b0 ? (B_) : (A_)))
    const unsigned w0 = HYSEL(lo.x, lo.y, lo.z, lo.w), w1 = HYSEL(lo.y, lo.z, lo.w, hi.x), w2 = HYSEL(lo.z, lo.w, hi.x, hi.y),
                   w3 = HYSEL(lo.w, hi.x, hi.y, hi.z), w4 = HYSEL(hi.x, hi.y, hi.z, hi.w);
#undef HYSEL
    u32x4 o;
    o.x = __builtin_amdgcn_alignbit(w1, w0, hsh); o.y = __builtin_amdgcn_alignbit(w2, w1, hsh);
    o.z = __builtin_amdgcn_alignbit(w3, w2, hsh); o.w = __builtin_amdgcn_alignbit(w4, w3, hsh);
    return as_bf8(o);
}

template <int L>
__device__ __forceinline__ void hyena_item(const Params& p, int li, int c, bool dry = false) {
    constexpr int ZS = L + 8, NI = L / 128, NS = L / 32;
    const int tid = tid_l(), w = tid >> 6, lane = tid & 63, fr = lane & 15, fq = lane >> 4;
    bf16_t* ZA = (bf16_t*)dyn_lds; bf16_t* ZB = ZA + 16 * ZS; bf16_t* HFl = ZB + 16 * ZS;
    const int segbase = (L == 2048) ? 0 : NLAT;
    const bf16_t* HYT = (const bf16_t*)(p.ws + WS_P2);
    bf16_t* MIX = (bf16_t*)(p.ws + WS_ACT);
    const float* cw = p.in[11] + (size_t)li * 3 * 1536; const float* cb = p.in[12] + (size_t)li * 1536; const float* hd = p.in[19] + (size_t)li * 2 * 512;
    const bf16_t* FIL = (L == 2048) ? (const bf16_t*)(p.ws + WS_FLAT) : (const bf16_t*)(p.ws + WS_FCTX);
    {
        const float w0 = cw[c], w1 = cw[1536 + c], w2 = cw[2 * 1536 + c], bb = cb[c];
        const bf16_t* src = HYT + (size_t)c * MTOT + segbase;
#pragma unroll
        for (int ci = 0; ci < (16 * L / 8 + NT - 1) / NT; ++ci) {
            const int ch = tid + ci * NT; if (ch >= 16 * L / 8) break;
            const int b = ch / (L / 8), t0 = (ch % (L / 8)) * 8;
            const bf16_t* s = src + b * L + t0;
            float x[10], y[8];
            const float xl = b2f(s[t0 > 0 ? -1 : 0]), xr = b2f(s[(t0 + 8 < L) ? 8 : 7]);
            unpack8(*(const u32x4*)s, x + 1);
            x[0] = t0 > 0 ? xl : 0.f; x[9] = (t0 + 8 < L) ? xr : 0.f;
#pragma unroll
            for (int e = 0; e < 8; ++e) y[e] = bb + w0 * x[e] + w1 * x[e + 1] + w2 * x[e + 2];
            *(u32x4*)(ZA + b * ZS + t0) = pack8(y);
        }
    }
#pragma unroll 1
    for (int o = 0; o < 2; ++o) {
        for (int i = tid; i < 2 * L / 8; i += NT) {
            const u32x4 v = *(const u32x4*)(FIL + ((size_t)o * 512 + c) * 2 * L + i * 8);
            u32x4 rv; rv.x = (v.w >> 16) | (v.w << 16); rv.y = (v.z >> 16) | (v.z << 16); rv.z = (v.y >> 16) | (v.y << 16); rv.w = (v.x >> 16) | (v.x << 16);
            *(u32x4*)(HFl + 8 + 2 * L - 8 - 8 * i) = rv;
        }
        if (tid < 8) HFl[tid] = 0; else if (tid < 24) HFl[2 * L + tid] = 0;
        __syncthreads();
        const bf16_t* Zin = o ? ZB : ZA;
        const int gc = (o + 1) * 512 + c;
        const float gw0 = cw[gc], gw1 = cw[1536 + gc], gw2 = cw[2 * 1536 + gc], gb = cb[gc], dsk = hd[o * 512 + c];
        const bf16_t* gs = HYT + (size_t)gc * MTOT + segbase + fr * L;
        constexpr int NIB = NI < 8 ? NI : 8;
#pragma unroll 1
        for (int hp = 0; hp < NI; hp += NIB) {
            f32x4 acc[NIB];
#pragma unroll
            for (int i = 0; i < NIB; ++i) acc[i] = (f32x4){0.f, 0.f, 0.f, 0.f};
            constexpr int NQ = NS / 4;
            const int am = (7 - fr) & 7, ao4 = am >> 1, ahs = (am & 1) * 16;
            u32x2 pgv[NIB]; bf16_t pxl[NIB], pxr[NIB];
#pragma unroll
            for (int i = 0; i < NIB; ++i) {
                const int t0 = 16 * (w + 8 * (hp + i)) + fq * 4;
                pxl[i] = gs[t0 > 0 ? t0 - 1 : 0]; pxr[i] = gs[(t0 + 4 < L) ? t0 + 4 : L - 1];
                pgv[i] = *(const u32x2*)(gs + t0);
            }
#pragma unroll 1
            for (int r = 0; r < 4; ++r) {
                bf16x8 Aw[NIB];
#pragma unroll
                for (int i = 0; i < NIB; ++i) {
                    Aw[i] = hy_afrag(HFl, (L - 1) - 16 * w - 32 * (4 * (hp + i) - r) - fr + fq * 8, am, ao4, ahs);
                }
#pragma unroll 1
                for (int qc = 0; qc < NQ; qc += NIB) {
#pragma unroll
                    for (int qq = 0; qq < NIB; ++qq) {
                        const int q = qc + qq;
                        const bf16x8 Bz = *(const bf16x8*)(Zin + fr * ZS + (4 * q + r) * 32 + fq * 8);
#pragma unroll
                        for (int i = 0; i < NIB; ++i) acc[i] = mfma16(Aw[(i - qq + NIB) % NIB], Bz, acc[i]);
                        if (q + 1 < NQ) {
                            Aw[(NIB - 1 - qq) % NIB] = hy_afrag(HFl, (L - 1) - 16 * w - 32 * (4 * (hp - q - 1) - r) - fr + fq * 8, am, ao4, ahs);
                        }
                    }
                }
            }
#pragma unroll
            for (int i = 0; i < NIB; ++i) {
                const int t0 = 16 * (w + 8 * (hp + i)) + fq * 4;
                float x[6];
                const float xl = b2f(pxl[i]), xr = b2f(pxr[i]);
                const u32x2 gv = pgv[i];
                x[0] = t0 > 0 ? xl : 0.f;
                x[1] = blo(gv.x); x[2] = bhi(gv.x); x[3] = blo(gv.y); x[4] = bhi(gv.y);
                x[5] = (t0 + 4 < L) ? xr : 0.f;
                const u32x2 zv = *(const u32x2*)(Zin + fr * ZS + t0);
                const float z[4] = {blo(zv.x), bhi(zv.x), blo(zv.y), bhi(zv.y)};
                float val[4];
#pragma unroll
                for (int j = 0; j < 4; ++j) val[j] = (gb + gw0 * x[j] + gw1 * x[j + 1] + gw2 * x[j + 2]) * (acc[i][j] + dsk * z[j]);
                { u32x2 ov; ov.x = pk2(val[0], val[1]); ov.y = pk2(val[2], val[3]); *(u32x2*)((o == 0 ? ZB : ZA) + fr * ZS + t0) = ov; }
            }
        }
        __syncthreads();
    }
    if (!dry) {
        bf16_t* dstp = (bf16_t*)(p.ws + WS_P2) + (size_t)c * MTOT + segbase;
#pragma unroll
        for (int ci = 0; ci < (16 * L / 8 + NT - 1) / NT; ++ci) {
            const int ch = tid + ci * NT; if (ch >= 16 * L / 8) break;
            const int b = ch / (L / 8), t0 = (ch % (L / 8)) * 8;
            *(u32x4*)(dstp + b * L + t0) = *(const u32x4*)(ZA + b * ZS + t0);
        }
        __syncthreads();
    }
}

__device__ __forceinline__ void hy_transpose(const Params& p) {
    const int tid = tid_l();
    bf16_t* T = (bf16_t*)dyn_lds;
    const bf16_t* HYO = (const bf16_t*)(p.ws + WS_P2);
    bf16_t* MIX = (bf16_t*)(p.ws + WS_ACT);
    for (int it = blockIdx.x; it < (MTOT / 64) * 8; it += gridDim.x) {
        const int tt = it >> 3, cg_ = it & 7, tok0 = tt * 64, c0 = cg_ * 64;
        {
            const int ch = tid >> 3, t8 = (tid & 7) * 8;
            const u32x4 v = *(const u32x4*)(HYO + (size_t)(c0 + ch) * MTOT + tok0 + t8);
            const unsigned wv[4] = {v.x, v.y, v.z, v.w};
#pragma unroll
            for (int e = 0; e < 4; ++e) { T[(t8 + 2 * e) * 72 + ch] = (bf16_t)(wv[e] & 0xffffu); T[(t8 + 2 * e + 1) * 72 + ch] = (bf16_t)(wv[e] >> 16); }
        }
        __syncthreads();
        {
            const int tk = tid >> 3, c8 = (tid & 7) * 8;
            *(u32x4*)(MIX + (size_t)(tok0 + tk) * 1024 + 512 + c0 + c8) = *(const u32x4*)(T + tk * 72 + c8);
        }
        __syncthreads();
    }
}

__device__ __forceinline__ void qknorm_phase(const Params& p, int li) {
    const int tid = tid_l(), lane = tid & 63, gw = blockIdx.x * 8 + (tid >> 6), ngw = gridDim.x * 8;
    bf16_t* QK = (bf16_t*)(p.ws + WS_BIG);
    float gq[8], gk[8];
#pragma unroll
    for (int e = 0; e < 8; ++e) { gq[e] = p.in[22][li * 64 + (lane & 7) * 8 + e] * 0.125f; gk[e] = p.in[23][li * 64 + (lane & 7) * 8 + e]; }
    for (int row = gw; row < MTOT; row += ngw) {
        bf16_t* rp = QK + (size_t)row * QK_LD + lane * 8;
        u32x4 v[4];
#pragma unroll
        for (int j = 0; j < 4; ++j) v[j] = *(const u32x4*)(rp + j * 512);
#pragma unroll
        for (int j = 0; j < 4; ++j) {
            float f[8]; unpack8(v[j], f);
            float ss = 0.f;
#pragma unroll
            for (int e = 0; e < 8; ++e) ss += f[e] * f[e];
            ss += __shfl_xor(ss, 1); ss += __shfl_xor(ss, 2); ss += __shfl_xor(ss, 4);
            const float rstd = rsqrtf(ss * (1.f / 64.f) + EPS);
#pragma unroll
            for (int e = 0; e < 8; ++e) f[e] *= rstd * (j < 2 ? gq[e] : gk[e]);
            *(u32x4*)(rp + j * 512) = pack8(f);
        }
    }
}

template <bool LAT>
__device__ __forceinline__ void attn_item(const Params& p, int li, int b, int h, int sub, bool stage = true) {
    const int tid = tid_l(), w = tid >> 6, lane = tid & 63, fr = lane & 15, fq = lane >> 4;
    bf16_t* Pw = (bf16_t*)dyn_lds + w * (16 * 264);
    bf16_t* KC = (bf16_t*)(dyn_lds + 67584);
    bf16_t* VC = (bf16_t*)(dyn_lds + 67584 + 36864);
    float* rpbs = (float*)(dyn_lds + 67584 + 36864 + 33792);
    const bf16_t* QK = (const bf16_t*)(p.ws + WS_BIG);
    const bf16_t* VTg = (const bf16_t*)(p.ws + WS_P2ODD);
    bf16_t* MIX = (bf16_t*)(p.ws + WS_ACT);
    if (stage) {
    if (LAT) { const float* rp = p.in[24] + ((size_t)li * 16 + h) * 465; for (int i = tid; i < 465; i += NT) rpbs[i] = rp[i]; }
    {
        u32x4 kv[4], vv[4];
#pragma unroll
        for (int i = 0; i < 4; ++i) {
            const int c = tid + i * NT;
            kv[i] = *(const u32x4*)(QK + (size_t)(NLAT + b * 256 + (c >> 3)) * QK_LD + 1024 + h * 64 + (c & 7) * 8);
            vv[i] = *(const u32x4*)(VTg + (size_t)(h * 64 + (c >> 5)) * VT_LD + NLAT + b * 256 + (c & 31) * 8);
        }
#pragma unroll
        for (int i = 0; i < 4; ++i) {
            const int c = tid + i * NT;
            *(u32x4*)(KC + (c >> 3) * 72 + (c & 7) * 8) = kv[i];
            *(u32x4*)(VC + (c >> 5) * 264 + (c & 31) * 8) = vv[i];
        }
    }
    __syncthreads();
    }
    int r = 0, c0 = 0, rs = 0, cw0 = 0, qtok0;
    if (LAT) { r = sub * 2 + (w >> 2); const int qt = w & 3; c0 = qt * 16; qtok0 = b * 2048 + r * 64 + c0; rs = min(max(r - 4, 0), 24); cw0 = (qt == 0) ? 0 : (qt == 1) ? 8 : (qt == 2) ? 24 : 32; }
    else { qtok0 = NLAT + b * 256 + (sub * 8 + w) * 16; }
    bf16x8 qf[2];
    {
        const bf16_t* qp = QK + (size_t)(qtok0 + fr) * QK_LD + h * 64 + fq * 8;
        qf[0] = *(const bf16x8*)qp; qf[1] = *(const bf16x8*)(qp + 32);
    }
    f32x4 o1[4], o2[4];
    float m1 = -1e30f, l1 = 0.f, m2, l2 = 0.f;
#pragma unroll
    for (int dt = 0; dt < 4; ++dt) { o1[dt] = (f32x4){0.f, 0.f, 0.f, 0.f}; o2[dt] = (f32x4){0.f, 0.f, 0.f, 0.f}; }
    if (LAT) {
        f32x4 sreg[16];
        const int qc = c0 + fr; const int cstart = min(max(qc - 8, 0), 48);
#pragma unroll
        for (int kt = 0; kt < 16; ++kt) {
            const int kr = kt >> 1, kcb = cw0 + (kt & 1) * 16;
            const bf16_t* kp = QK + (size_t)(b * 2048 + (rs + kr) * 64 + kcb + fr) * QK_LD + 1024 + h * 64 + fq * 8;
            f32x4 sa = (f32x4){0.f, 0.f, 0.f, 0.f};
            sa = mfma16(*(const bf16x8*)kp, qf[0], sa); sa = mfma16(*(const bf16x8*)(kp + 32), qf[1], sa);
            const int dri = (rs + kr - r + 7) * 31;
#pragma unroll
            for (int j = 0; j < 4; ++j) {
                const int kc = kcb + fq * 4 + j;
                const bool valid = (kc >= cstart) && (kc < cstart + 16);
                const int dci = min(max(kc - qc + 15, 0), 30);
                sa[j] = valid ? sa[j] + rpbs[dri + dci] : -1e30f;
            }
            sreg[kt] = sa;
            if ((kt & 7) == 7) __builtin_amdgcn_sched_barrier(0);
        }
#pragma unroll
        for (int kt = 0; kt < 16; ++kt)
#pragma unroll
            for (int j = 0; j < 4; ++j) m1 = fmaxf(m1, sreg[kt][j]);
        m1 = fmaxf(m1, __shfl_xor(m1, 16)); m1 = fmaxf(m1, __shfl_xor(m1, 32));
#pragma unroll
        for (int kt = 0; kt < 16; ++kt) {
            float pj[4];
#pragma unroll
            for (int j = 0; j < 4; ++j) { pj[j] = __expf(sreg[kt][j] - m1); l1 += pj[j]; }
            u32x2 o; o.x = pk2(pj[0], pj[1]); o.y = pk2(pj[2], pj[3]);
            *(u32x2*)(Pw + fr * 264 + kt * 16 + fq * 4) = o;
        }
        l1 += __shfl_xor(l1, 16); l1 += __shfl_xor(l1, 32);
#pragma unroll
        for (int kb = 0; kb < 8; kb += 4) {
            bf16x8 vf[4][4], pf[4];
#pragma unroll
            for (int u = 0; u < 4; ++u) {
                const int ks = kb + u;
                const int vtok0 = b * 2048 + (rs + ks) * 64 + cw0;
#pragma unroll
                for (int dt = 0; dt < 4; ++dt) vf[u][dt] = *(const bf16x8*)(VTg + (size_t)(h * 64 + dt * 16 + fr) * VT_LD + vtok0 + fq * 8);
                pf[u] = *(const bf16x8*)(Pw + fr * 264 + ks * 32 + fq * 8);
            }
#pragma unroll
            for (int u = 0; u < 4; ++u)
#pragma unroll
                for (int dt = 0; dt < 4; ++dt) o1[dt] = mfma16(vf[u][dt], pf[u], o1[dt]);
            __builtin_amdgcn_sched_barrier(0);
        }
    }
    {
        f32x4 sreg[16];
#pragma unroll
        for (int kt = 0; kt < 16; ++kt) {
            const bf16_t* kp = KC + (kt * 16 + fr) * 72 + fq * 8;
            f32x4 sa = (f32x4){0.f, 0.f, 0.f, 0.f};
            sa = mfma16(*(const bf16x8*)kp, qf[0], sa); sa = mfma16(*(const bf16x8*)(kp + 32), qf[1], sa);
            sreg[kt] = sa;
        }
        m2 = -1e30f;
#pragma unroll
        for (int kt = 0; kt < 16; ++kt)
#pragma unroll
            for (int j = 0; j < 4; ++j) m2 = fmaxf(m2, sreg[kt][j]);
        m2 = fmaxf(m2, __shfl_xor(m2, 16)); m2 = fmaxf(m2, __shfl_xor(m2, 32));
#pragma unroll
        for (int kt = 0; kt < 16; ++kt) {
            float pj[4];
#pragma unroll
            for (int j = 0; j < 4; ++j) { pj[j] = __expf(sreg[kt][j] - m2); l2 += pj[j]; }
            u32x2 o; o.x = pk2(pj[0], pj[1]); o.y = pk2(pj[2], pj[3]);
            *(u32x2*)(Pw + fr * 264 + kt * 16 + fq * 4) = o;
        }
        l2 += __shfl_xor(l2, 16); l2 += __shfl_xor(l2, 32);
#pragma unroll
        for (int ks = 0; ks < 8; ++ks) {
            const bf16x8 pf = *(const bf16x8*)(Pw + fr * 264 + ks * 32 + fq * 8);
#pragma unroll
            for (int dt = 0; dt < 4; ++dt) o2[dt] = mfma16(*(const bf16x8*)(VC + (dt * 16 + fr) * 264 + ks * 32 + fq * 8), pf, o2[dt]);
        }
    }
    const float mm = fmaxf(m1, m2);
    const float a1 = LAT ? __expf(m1 - mm) : 0.f, a2 = __expf(m2 - mm);
    const float inv = 1.f / (l1 * a1 + l2 * a2);
    const float s1 = a1 * inv, s2 = a2 * inv;
#pragma unroll
    for (int dt = 0; dt < 4; ++dt) {
        const f32x4 ov = o1[dt] * s1 + o2[dt] * s2;
        u32x2 o; o.x = pk2(ov[0], ov[1]); o.y = pk2(ov[2], ov[3]);
        *(u32x2*)(MIX + (size_t)(qtok0 + fr) * 1024 + h * 64 + dt * 16 + fq * 4) = o;
    }
    __syncthreads();
}


#ifdef DBG_NAN
__device__ __forceinline__ bool bad16(bf16_t v) { return ((v >> 7) & 0xFF) >= 227; }
__device__ __forceinline__ bool bad32(float f) { return !(fabsf(f) < 1e30f); }
__device__ __forceinline__ void scan16(const bf16_t* p, size_t n, unsigned* flags, unsigned bit) {
    bool bad = false;
    for (size_t i = (size_t)blockIdx.x * NT + threadIdx.x; i < n; i += (size_t)gridDim.x * NT) bad |= bad16(p[i]);
    if (bad) atomicOr(flags, bit);
}
__device__ __forceinline__ void scan32(const float* p, size_t n, unsigned* flags, unsigned bit) {
    bool bad = false;
    for (size_t i = (size_t)blockIdx.x * NT + threadIdx.x; i < n; i += (size_t)gridDim.x * NT) bad |= bad32(p[i]);
    if (bad) atomicOr(flags, bit);
}
#endif

#define XB_TMO      128
#define XB_XCNT(j)  (256  + 64 * (j))
#define XB_XSUB(j)  (1280 + 64 * (j))
#define XB_XGEN(j)  (2304 + 64 * (j))
#define XB_TOP      3328
#define XB_TOPGEN   3392
#define XCD_BAR_WORDS 3456
#define XB_SPIN_CAP (1u << 20)
#define LAS __attribute__((address_space(3)))
__device__ __forceinline__ unsigned xb_ld(unsigned* p)              { return __hip_atomic_load(p, __ATOMIC_RELAXED, __HIP_MEMORY_SCOPE_AGENT); }
__device__ __forceinline__ unsigned xb_add(unsigned* p, unsigned v) { return __hip_atomic_fetch_add(p, v, __ATOMIC_RELAXED, __HIP_MEMORY_SCOPE_AGENT); }
__device__ __forceinline__ unsigned xb_xcc_id() { return (unsigned)__builtin_amdgcn_s_getreg((3 << 11) | 20) & 0xFu; }
#define XB_SPIN(cond, bar) do { unsigned _sp = 0; while (cond) { __builtin_amdgcn_s_sleep(1); \
    if ((++_sp & 255u) == 0u) { if (xb_ld(&(bar)[XB_TMO])) break; if (_sp > XB_SPIN_CAP) { atomicAdd(&(bar)[XB_TMO], 1u); break; } } } } while (0)
struct XcdBarrier { unsigned* bar; unsigned x; volatile LAS unsigned* st; };
__device__ __forceinline__ XcdBarrier xcd_barrier_post(unsigned* bar, volatile LAS unsigned* st) {
    XcdBarrier b; b.bar = bar; b.x = xb_xcc_id(); b.st = st;
    if (threadIdx.x == 0) (void)xb_add(&bar[XB_XCNT(b.x)], 1u);
    return b;
}
__device__ __forceinline__ void xcd_barrier_complete(unsigned* bar, unsigned x, unsigned& nloc, unsigned& nx) {
    const unsigned G = gridDim.x * gridDim.y * gridDim.z;
    unsigned sum, cnt, mine, sp = 0u;
    for (;;) {
        sum = 0u; cnt = 0u; mine = 0u;
#pragma unroll
        for (unsigned j = 0; j < 16; ++j) { const unsigned c = xb_ld(&bar[XB_XCNT(j)]); sum += c; cnt += (c > 0u) ? 1u : 0u; mine = (j == x) ? c : mine; }
        if (sum == G) break;
        __builtin_amdgcn_s_sleep(1);
        if ((++sp & 255u) == 0u) { if (xb_ld(&bar[XB_TMO])) break; if (sp > XB_SPIN_CAP) { atomicAdd(&bar[XB_TMO], 1u); break; } }
    }
    nloc = mine > 0u ? mine : 1u; nx = cnt > 0u ? cnt : 1u;
}
__device__ __forceinline__ void xcd_barrier(const XcdBarrier& b) {
    asm volatile("s_waitcnt vmcnt(0)" ::: "memory");
    __syncthreads();
    if (threadIdx.x == 0) {
        unsigned* bar = b.bar;
        __builtin_amdgcn_s_waitcnt(0);
        unsigned nloc = b.st[0], nx = b.st[1];
        if (nloc == 0u) { xcd_barrier_complete(bar, b.x, nloc, nx); b.st[0] = nloc; b.st[1] = nx; }
        const unsigned old = xb_add(&bar[XB_XSUB(b.x)], 1u);
        const unsigned gen = old / nloc;
        if (old + 1u == (gen + 1u) * nloc) {
            __builtin_amdgcn_fence(__ATOMIC_RELEASE, "agent");
            asm volatile("s_waitcnt vmcnt(0)" ::: "memory");
            const unsigned og = xb_add(&bar[XB_TOP], 1u);
            const unsigned tg = og / nx;
            if (og + 1u == (tg + 1u) * nx) xb_add(&bar[XB_TOPGEN], 1u);
            else XB_SPIN(xb_ld(&bar[XB_TOPGEN]) == tg, bar);
            __builtin_amdgcn_fence(__ATOMIC_ACQUIRE, "agent");
            xb_add(&bar[XB_XGEN(b.x)], 1u);
            asm volatile("s_waitcnt vmcnt(0)" ::: "memory");
        } else {
            XB_SPIN(xb_ld(&bar[XB_XGEN(b.x)]) == gen, bar);
            __builtin_amdgcn_fence(__ATOMIC_ACQUIRE, "agent");
            asm volatile("s_waitcnt vmcnt(0)" ::: "memory");
        }
    }
    __syncthreads();
}
constexpr size_t WS_BAR = WS_END + 32768;

#ifdef TPROBE_A
#define GSYNC() do { asm volatile("s_waitcnt vmcnt(0) lgkmcnt(0)" ::: "memory"); grid.sync(); ++nsync_; if (nsync_ == TPROBE_A) t0_ = wall_clock64(); if (nsync_ == TPROBE_B) t1_ = wall_clock64(); } while (0)
#else
#define GSYNC() xcd_barrier(xbar_)
#endif
#define GSYNC_CG() do { asm volatile("s_waitcnt vmcnt(0) lgkmcnt(0)" ::: "memory"); grid.sync(); } while (0)
__global__ void __launch_bounds__(NT) fwd_megakernel(Params p) {
    cg::grid_group grid = cg::this_grid();
#ifdef TPROBE_A
    int nsync_ = 0; long long t0_ = 0, t1_ = 0;
#endif
    const int blk = blockIdx.x, G = gridDim.x;
    bf16_t* WIN = (bf16_t*)(p.ws + WS_WIN); bf16_t* WOUT = (bf16_t*)(p.ws + WS_WOUT); bf16_t* WM1 = (bf16_t*)(p.ws + WS_WM1); bf16_t* WM2 = (bf16_t*)(p.ws + WS_WM2);
    bf16_t* ACT = (bf16_t*)(p.ws + WS_ACT); bf16_t* BIG = (bf16_t*)(p.ws + WS_BIG);
    float* XC = (float*)(p.ws + WS_XC);
    const float* MOD = (const float*)(p.ws + WS_MOD);
    volatile LAS unsigned* xst_ = (volatile LAS unsigned*)(dyn_lds + LDS_BYTES - 16);
    if (threadIdx.x == 0) { xst_[0] = 0u; xst_[1] = 0u; }
    __syncthreads();
    const XcdBarrier xbar_ = xcd_barrier_post((unsigned*)(p.ws + WS_BAR), xst_);
    REP(64) if (PHMASK & 1) phase0(p);
#ifdef DBG_NAN
    unsigned* dflags = (unsigned*)(p.ws + WS_END);
    if (blk == 0 && threadIdx.x < 64) dflags[threadIdx.x] = 0u;
#endif
    GSYNC_CG();
#pragma unroll 1
    for (int l = 0; l < 4; ++l) {
        const bool even = !(l & 1), last = (l == 3); const int li = l >> 1;
        const float* xlat = (l == 0) ? p.in[0] : p.out; const float* xctx = (l == 0) ? p.in[2] : XC;
        const int Mtail = last ? NLAT : MTOT;
        REP(1) {
        if (PHMASK & 2) convert_weights(p, l, l == 0 || G < 256, true, 0, G);
        if (PHMASK & 4) norm_phase(p, l, xlat, xctx, 0, 1024, MTOT);
        if ((PHMASK & 8) && even) filter_gen(p, li);
        }
        GSYNC();
        {
            EpiArgs ea{}; ea.o_rm = BIG; ea.ld_rm = even ? 2048 : QK_LD; ea.o_cm = (bf16_t*)(p.ws + (even ? WS_P2 : WS_P2ODD)); ea.ld_cm = even ? MTOT : VT_LD; ea.gates = (float*)(p.ws + WS_GATES); ea.gate_pn = even ? 14 : -1; ea.o_dbg = (bf16_t*)(p.ws + WS_HFB);
            REP(2) if (PHMASK & 16) gemm_phase<EPI_INPROJ>(ACT, WIN, MTOT, even ? 3840 : 3072, 1024, ea);
        }
        GSYNC();
#ifdef DBG_NAN
        if (l == DBG_LAYER) {
            {
                const unsigned gid = blk * NT + threadIdx.x;
                unsigned hsh = gid * 2654435761u + 12345u; hsh ^= hsh >> 13; hsh *= 2246822519u; hsh ^= hsh >> 16;
                const int row = hsh % MTOT; const int col = (hsh >> 8) % 2048; const int ch = (hsh >> 4) % 1536;
                const bf16_t* ar = ACT + (size_t)row * 1024; const bf16_t* wq = WIN + (size_t)col * 1024; const bf16_t* wh = WIN + (size_t)(2048 + ch) * 1024;
                float sq = 0.f, sh_ = 0.f;
                for (int k = 0; k < 1024; ++k) { const float av = b2f(ar[k]); sq += av * b2f(wq[k]); sh_ += av * b2f(wh[k]); }
                const float gq = b2f(BIG[(size_t)row * 2048 + col]);
                const float gh = b2f(((const bf16_t*)(p.ws + WS_P2))[(size_t)ch * MTOT + row]);
                (void)gq; (void)sq;

                { const int cls = DBG_CLS; atomicAdd(dflags + 16 + cls, 1u);
                  if (!(fabsf(gh - sh_) <= 0.05f + 0.02f * fabsf(sh_))) { atomicAdd(dflags + 2, 1u); atomicAdd(dflags + 32 + cls, 1u); } }
            }
            GSYNC();
            if (blk == 0 && threadIdx.x == 0) {
                const float fQ = (float)__hip_atomic_load(dflags + 1, __ATOMIC_RELAXED, __HIP_MEMORY_SCOPE_AGENT) / (float)(G * NT);
                const float fH = (float)__hip_atomic_load(dflags + 2, __ATOMIC_RELAXED, __HIP_MEMORY_SCOPE_AGENT) / (float)(G * NT);
                unsigned mask = 0;
                for (int q_ = 0; q_ < 8; ++q_) { const unsigned tot = __hip_atomic_load(dflags + 16 + q_, __ATOMIC_RELAXED, __HIP_MEMORY_SCOPE_AGENT), bad = __hip_atomic_load(dflags + 32 + q_, __ATOMIC_RELAXED, __HIP_MEMORY_SCOPE_AGENT); if (bad * 4 > tot) mask |= 1u << q_; }
                float code = 1e5f; for (unsigned q_ = 0; q_ < (mask >> 4); ++q_) code *= 10.f;
                const unsigned n3 = __hip_atomic_load(dflags + 3, __ATOMIC_RELAXED, __HIP_MEMORY_SCOPE_AGENT), b1 = __hip_atomic_load(dflags + 1, __ATOMIC_RELAXED, __HIP_MEMORY_SCOPE_AGENT), b4 = __hip_atomic_load(dflags + 4, __ATOMIC_RELAXED, __HIP_MEMORY_SCOPE_AGENT);
                p.out[0] = code * (1.f + 0.5f * (float)(mask & 15)) + 0.f * (fQ + fH + (float)(n3 + b1 + b4));
            }
            return;
        }
#endif
        if (!even) { qknorm_phase(p, li); GSYNC(); }
        if (even) {
            REP(4) if (G >= 256) {
                if (blk < 128) { REP(512) if (PHMASK & 32) mlstm_item(p, li, blk);
                    if (DUPMASK & 1024) { hyena_item<2048>(p, li, 384 + blk, true); hyena_item<256>(p, li, 384 + blk, true); }
                    if (PHMASK & 64) { hyena_item<2048>(p, li, 384 + blk); } }
                else { const int hb = blk - 128;
                    if (DUPMASK & 1024) for (int it = hb; it < 384; it += 128) { hyena_item<2048>(p, li, it, true); hyena_item<256>(p, li, it, true); }
                    if (PHMASK & 64) { for (int it = hb; it < 384; it += 128) { hyena_item<2048>(p, li, it); hyena_item<256>(p, li, it); } hyena_item<256>(p, li, 384 + hb); } }
            } else {
            }
            GSYNC();
            if (PHMASK & 128) { combine_phase(p, li); hy_transpose(p); }
        } else {
            const int x = blk & 7, y = blk >> 3, ny = (G + 7) >> 3;
            REP(256) for (int i = 0; ; ++i) {
                const int slot = i * ny + y;
                if (slot >= 512) break;
                const int bh = x * 32 + 4 * (i >> 1) + (y >> 3), rp = (y & 7) * 2 + (i & 1);
                if (PHMASK & 256) attn_item<true>(p, li, bh >> 4, bh & 15, rp, (i & 1) == 0 || ny != 32);
            }
            if ((PHMASK & 512) && !last) for (int it = blk; it < 512; it += G) attn_item<false>(p, li, it >> 5, (it >> 1) & 15, it & 1);
        }
        GSYNC();
        {
            EpiArgs ea{}; ea.res_lat = xlat; ea.res_ctx = xctx; ea.out_lat = p.out; ea.out_ctx = XC; ea.modg = MOD + (size_t)l * 17 * 6144 + 2048;
            if (DUPMASK & 32) gemm_phase<EPI_DRY>(ACT, WOUT, Mtail, 1024, 1024, ea);
            if (PHMASK & 1024) gemm_phase<EPI_RESID>(ACT, WOUT, Mtail, 1024, 1024, ea);
        }
        GSYNC();
        REP(8) norm_phase(p, l, p.out, XC, 3072, 4096, Mtail);
        GSYNC();
        { EpiArgs ea{}; ea.o_rm = BIG; ea.ld_rm = 4096; ea.gate_pn = -1; REP(16) if (PHMASK & 2048) gemm_phase<EPI_RELU2>(ACT, WM1, Mtail, 4096, 1024, ea); }
        GSYNC();
        {
            EpiArgs ea{}; ea.res_lat = p.out; ea.res_ctx = XC; ea.out_lat = p.out; ea.out_ctx = XC; ea.modg = MOD + (size_t)l * 17 * 6144 + 5120;
            if (DUPMASK & 32) gemm_phase<EPI_DRY>(BIG, WM2, Mtail, 1024, 4096, ea);
            if (PHMASK & 4096) gemm_phase<EPI_RESID>(BIG, WM2, Mtail, 1024, 4096, ea);
            if (!last && G >= 256) convert_weights(p, l + 1, true, false, 128, G - 128);
        }
        GSYNC();
    }
#ifdef TPROBE_A
    if (blk == 0 && threadIdx.x == 0) p.out[0] = (float)(t1_ - t0_) * 10.f;
#endif
}

extern "C" void kernel_launch(void* const* d_in, const int* in_sizes, int n_in, void* d_out, int out_size, void* d_ws, size_t ws_size, hipStream_t stream) {
    static int grid_blocks = 0;
    if (grid_blocks == 0) {
        if (n_in != 26 || ws_size < WS_BAR + XCD_BAR_WORDS * 4) { fprintf(stderr, "kernel_launch: unexpected n_in %d or ws_size %zu (< %zu)\n", n_in, ws_size, (size_t)WS_END); grid_blocks = -1; return; }
        int dev = 0, cus = 0, per_cu = 0;
        hipGetDevice(&dev);
        hipDeviceGetAttribute(&cus, hipDeviceAttributeMultiprocessorCount, dev);
        if (hipFuncSetAttribute((const void*)fwd_megakernel, hipFuncAttributeMaxDynamicSharedMemorySize, LDS_BYTES) != hipSuccess) fprintf(stderr, "kernel_launch: hipFuncSetAttribute failed\n");
        if (hipOccupancyMaxActiveBlocksPerMultiprocessor(&per_cu, (const void*)fwd_megakernel, NT, LDS_BYTES) != hipSuccess || per_cu < 1) { fprintf(stderr, "kernel_launch: occupancy query gave %d\n", per_cu); per_cu = 1; }
        (void)hipGetLastError();
        grid_blocks = cus * 1;
        fprintf(stderr, "kernel_launch: cus %d per_cu %d grid %d\n", cus, per_cu, grid_blocks);
    }
    if (grid_blocks < 0) return;
    if (hipMemsetAsync((char*)d_ws + WS_BAR, 0, XCD_BAR_WORDS * 4, stream) != hipSuccess) { fprintf(stderr, "kernel_launch: memset of barrier words failed\n"); return; }
    Params p{};
    for (int i = 0; i < 26; ++i) p.in[i] = (const float*)d_in[i];
    p.out = (float*)d_out; p.ws = (unsigned char*)d_ws;
    void* args[] = {&p};
    hipError_t e = hipLaunchCooperativeKernel((void*)fwd_megakernel, dim3(grid_blocks), dim3(NT), args, LDS_BYTES, stream);
    if (e != hipSuccess) fprintf(stderr, "cooperative launch failed: %s (grid %d)\n", hipGetErrorString(e), grid_blocks);
}
```

```cpp
#include <hip/hip_runtime.h>
#include <hip/hip_cooperative_groups.h>
#include <cstdio>
#include <cstdint>
namespace cg = cooperative_groups;

typedef unsigned short bf16_t;
typedef short bf16x8 __attribute__((ext_vector_type(8)));
typedef float f32x4 __attribute__((ext_vector_type(4)));
typedef unsigned u32x4 __attribute__((ext_vector_type(4)));
typedef unsigned u32x2 __attribute__((ext_vector_type(2)));

#define NT 512
#define DBG_LAYER 0
#define DBG_CLS ((((row % 64) / 16) * 2) + ((ch % 32) / 16))
#ifndef PHMASK
#define PHMASK 0xFFFF
#endif
#ifndef DUPMASK
#define DUPMASK 0
#endif
#define REP(bit) for (int rep_ = 0; rep_ < (((DUPMASK) & (bit)) ? 2 : 1); ++rep_)
constexpr int BATCH = 16, SEQ = 2048, DM = 1024, CTXL = 256;
constexpr int NLAT = BATCH * SEQ, NCTX = BATCH * CTXL, MTOT = NLAT + NCTX;
constexpr int DFF = 4096;
constexpr float EPS = 1e-6f;
constexpr int LDS_BYTES = 147456;

constexpr size_t al256(size_t x) { return (x + 255) & ~(size_t)255; }
constexpr size_t WS_WIN = 0;
constexpr size_t WS_WOUT = al256(WS_WIN + (size_t)3840 * 1024 * 2);
constexpr size_t WS_WM1 = al256(WS_WOUT + (size_t)1024 * 1024 * 2);
constexpr size_t WS_WM2 = al256(WS_WM1 + (size_t)4096 * 1024 * 2);
constexpr size_t WS_MOD = al256(WS_WM2 + (size_t)4096 * 1024 * 2);
constexpr size_t WS_XC = al256(WS_MOD + (size_t)4 * 17 * 6144 * 4);
constexpr size_t WS_ACT = al256(WS_XC + (size_t)NCTX * 1024 * 4);
constexpr size_t WS_BIG = al256(WS_ACT + (size_t)MTOT * 1024 * 2);
constexpr size_t WS_P2 = WS_BIG + (size_t)MTOT * 2048 * 2;
constexpr int QK_LD = 2048 + 64;
constexpr int VT_LD = MTOT + 64;
constexpr size_t WS_P2ODD = WS_BIG + (size_t)MTOT * QK_LD * 2;
constexpr size_t WS_GATES = WS_P2 + (size_t)1536 * MTOT * 2;
constexpr size_t WS_HFB = al256(WS_BIG + (size_t)MTOT * 4096 * 2);
constexpr size_t WS_FLAT = al256(WS_HFB + (size_t)2 * MTOT * 512 * 2);
constexpr size_t WS_FCTX = al256(WS_FLAT + (size_t)2 * 512 * 4096 * 2);
constexpr size_t WS_H2 = al256(WS_FCTX + (size_t)2 * 512 * 512 * 2);
constexpr size_t WS_ROPE = al256(WS_H2 + (size_t)2 * 2304 * 64 * 4);
constexpr size_t WS_END = al256(WS_ROPE + (size_t)2 * 64 * 32 * 4);
static_assert(WS_GATES + (size_t)MTOT * 16 * 4 <= WS_HFB, "projection overlay too large");
static_assert(WS_P2ODD + (size_t)1024 * VT_LD * 2 <= WS_HFB, "odd projection overlay too large");

struct Params { const float* in[26]; float* out; unsigned char* ws; };

typedef float f32x2_ __attribute__((ext_vector_type(2)));
typedef __bf16 bf16x2_ __attribute__((ext_vector_type(2)));
__device__ __forceinline__ unsigned pk2(float lo, float hi) { f32x2_ v = {lo, hi}; bf16x2_ b = __builtin_convertvector(v, bf16x2_); return __builtin_bit_cast(unsigned, b); }
__device__ __forceinline__ bf16_t f2b(float x) { return (bf16_t)(pk2(x, 0.f) & 0xffffu); }
__device__ __forceinline__ float b2f(bf16_t b) { return __uint_as_float(((unsigned)b) << 16); }
__device__ __forceinline__ float blo(unsigned w) { return __uint_as_float(w << 16); }
__device__ __forceinline__ float bhi(unsigned w) { return __uint_as_float(w & 0xffff0000u); }
__device__ __forceinline__ void unpack8(u32x4 v, float* f) {
    f[0] = blo(v.x); f[1] = bhi(v.x); f[2] = blo(v.y); f[3] = bhi(v.y); f[4] = blo(v.z); f[5] = bhi(v.z); f[6] = blo(v.w); f[7] = bhi(v.w);
}
__device__ __forceinline__ u32x4 pack8(const float* f) { u32x4 r; r.x = pk2(f[0], f[1]); r.y = pk2(f[2], f[3]); r.z = pk2(f[4], f[5]); r.w = pk2(f[6], f[7]); return r; }
__device__ __forceinline__ float fsin_(float x) { float r = x * 0.15915494309189535f; r -= floorf(r); return __builtin_amdgcn_sinf(r); }
__device__ __forceinline__ float fcos_(float x) { float r = x * 0.15915494309189535f; r -= floorf(r); return __builtin_amdgcn_cosf(r); }
__device__ __forceinline__ float wave_sum(float v) {
#pragma unroll
    for (int o = 1; o < 64; o <<= 1) v += __shfl_xor(v, o);
    return v;
}
__device__ __forceinline__ f32x4 mfma16(bf16x8 a, bf16x8 b, f32x4 c) { return __builtin_amdgcn_mfma_f32_16x16x32_bf16(a, b, c, 0, 0, 0); }
__device__ __forceinline__ bf16x8 as_bf8(u32x4 v) { return __builtin_bit_cast(bf16x8, v); }

extern __shared__ __attribute__((aligned(16))) unsigned char dyn_lds[];
__device__ __forceinline__ int tid_l() { int t = threadIdx.x; asm volatile("" : "+v"(t)); return t; }

constexpr int G_BM = 256, G_BK = 64, G_HALF = 128, G_HT = G_HALF * G_BK;
__device__ __forceinline__ int lds_byte(int r, int c) {
    int st = (r >> 4) * 2 + (c >> 5), rr = r & 15, cc = c & 31, ob = rr * 64 + cc * 2;
    return st * 1024 + (ob ^ (((ob >> 9) & 1) << 5));
}
__device__ __forceinline__ void stage_rc(int b, int& R, int& C) {
    int st = b / 1024, sb = b % 1024, swz = sb ^ (((sb >> 9) & 1) << 5);
    R = (st >> 1) * 16 + swz / 64; C = (st & 1) * 32 + (swz % 64) / 2;
}

enum { EPI_INPROJ = 0, EPI_RESID = 1, EPI_RELU2 = 2, EPI_DRY = 3 };
struct EpiArgs {
    bf16_t* o_rm; int ld_rm;
    bf16_t* o_dbg;
    int ld_cm;
    bf16_t* o_cm;
    float* gates; int gate_pn;
    const float* res_lat; const float* res_ctx; float* out_lat; float* out_ctx; const float* modg;
};

#define WAIT_V_(n) asm volatile("s_waitcnt vmcnt(" #n ")" ::: "memory")
#define WAIT_V(n) WAIT_V_(n)
#ifndef GEMM_SGB
#define GEMM_SGB 0
#endif
#ifndef GEMM_VM
#define GEMM_VM 8
#endif
#define WAIT_L(n) asm volatile("s_waitcnt lgkmcnt(" #n ")" ::: "memory")
#define BAR __builtin_amdgcn_s_barrier()
#define CFENCE asm volatile("" ::: "memory")

template <bool TR, int NAI>
__device__ __forceinline__ void gemm_kloop(const bf16_t* __restrict__ A, const bf16_t* __restrict__ Bt, int K, int brow, int bcol, f32x4 (&acc)[NAI][2][4][2], int kt0, int nt) {
    bf16_t* shm = (bf16_t*)dyn_lds;
#define SA(b, h) (shm + ((b) * 2 + (h)) * G_HT)
#define SB(b, h) (shm + (4 + (b) * 2 + (h)) * G_HT)
    const int tidx = tid_l();
    const int wid = tidx >> 6, lane = tidx & 63, wr = wid >> 2, wc = wid & 3, fr = lane & 15, fq = lane >> 4;
    int goff[2];
#pragma unroll
    for (int i = 0; i < 2; ++i) { int r_, c_; stage_rc(tidx * 16 + i * 8192, r_, c_); goff[i] = r_ * K + c_; }
    const bf16_t* Ab = A + (long)brow * K + kt0 * G_BK; const bf16_t* Bb = Bt + (long)bcol * K + kt0 * G_BK;
#define STAGE2(P, BASEP, kt) do { _Pragma("unroll") for (int _i = 0; _i < 2; ++_i) \
      __builtin_amdgcn_global_load_lds((const unsigned*)((BASEP) + (kt) * G_BK + goff[_i]), (unsigned*)((char*)(P) + tidx * 16 + _i * 8192), 16, 0, 0); } while (0)
    STAGE2(SA(0, 0), Ab, 0); if (NAI == 2) STAGE2(SA(0, 1), Ab + (long)G_HALF * K, 0); STAGE2(SB(0, 0), Bb, 0); STAGE2(SB(0, 1), Bb + (long)G_HALF * K, 0);
    for (int kt = 0; kt < nt; ++kt) {
        const int cur = kt & 1, nxt = cur ^ 1;
        WAIT_V(0); WAIT_L(0);
        BAR; CFENCE;
#define LDBF(dst, k) _Pragma("unroll") for (int bj = 0; bj < 2; ++bj) _Pragma("unroll") for (int n = 0; n < 2; ++n) \
            dst[bj][n] = *reinterpret_cast<const bf16x8*>((char*)SB(cur, bj) + lds_byte(wc * 32 + n * 16 + fr, (k) * 32 + fq * 8))
#define LDAF(dst, ai, k) _Pragma("unroll") for (int m = 0; m < 4; ++m) \
            dst[m] = *reinterpret_cast<const bf16x8*>((char*)SA(cur, ai) + lds_byte(wr * 64 + m * 16 + fr, (k) * 32 + fq * 8))
#define MMAG(ai, Af_, Bf_) _Pragma("unroll") for (int m = 0; m < 4; ++m) _Pragma("unroll") for (int bj = 0; bj < 2; ++bj) _Pragma("unroll") for (int n = 0; n < 2; ++n) \
            acc[ai][bj][m][n] = TR ? mfma16(Bf_[bj][n], Af_[m], acc[ai][bj][m][n]) : mfma16(Af_[m], Bf_[bj][n], acc[ai][bj][m][n])
        bf16x8 B0[2][2], B1[2][2], A0[4], A1[4];
        LDBF(B0, 0); LDAF(A0, 0, 0); if (NAI == 2) { LDAF(A1, 1, 0); }
        if (kt + 1 < nt) {
            STAGE2(SA(nxt, 0), Ab, kt + 1); if (NAI == 2) STAGE2(SA(nxt, 1), Ab + (long)G_HALF * K, kt + 1);
            STAGE2(SB(nxt, 0), Bb, kt + 1); STAGE2(SB(nxt, 1), Bb + (long)G_HALF * K, kt + 1);
        }
        MMAG(0, A0, B0);
        LDBF(B1, 1); LDAF(A0, 0, 1);
        if (NAI == 2) { MMAG(NAI - 1, A1, B0); LDAF(A1, 1, 1); }
        MMAG(0, A0, B1);
        if (NAI == 2) { MMAG(NAI - 1, A1, B1); }
#if GEMM_SGB
        __builtin_amdgcn_sched_group_barrier(0x100, 12, 0);
        __builtin_amdgcn_sched_group_barrier(0x020, 8, 0);
        __builtin_amdgcn_sched_group_barrier(0x008, 16, 0);
        __builtin_amdgcn_sched_group_barrier(0x100, 8, 0);
        __builtin_amdgcn_sched_group_barrier(0x008, 16, 0);
        __builtin_amdgcn_sched_group_barrier(0x100, 4, 0);
        __builtin_amdgcn_sched_group_barrier(0x008, 32, 0);
#endif
    }
    WAIT_L(0); BAR; CFENCE;
}

template <int EPI, int NAI>
__device__ __forceinline__ void gemm_tile(const bf16_t* A, const bf16_t* Bt, int K, int brow, int bcol, int pn, const EpiArgs& ea, int wr, int wc, int fr, int fq) {
        constexpr bool SPLITTAIL = false; const int kq = -1, kt0 = 0, ntl = K / G_BK; (void)kq;
        f32x4 acc[NAI][2][4][2];
#pragma unroll
        for (int a = 0; a < NAI; ++a)
#pragma unroll
            for (int b = 0; b < 2; ++b)
#pragma unroll
                for (int m = 0; m < 4; ++m)
#pragma unroll
                    for (int n = 0; n < 2; ++n) acc[a][b][m][n] = (f32x4){0.f, 0.f, 0.f, 0.f};
        const bool colmajor = (EPI == EPI_INPROJ) && pn >= 8 && pn != ea.gate_pn;
        if (colmajor) {
            gemm_kloop<true, NAI>(A, Bt, K, brow, bcol, acc, kt0, ntl);
#pragma unroll
            for (int ai = 0; ai < NAI; ++ai)
#pragma unroll
                for (int bj = 0; bj < 2; ++bj)
#pragma unroll
                    for (int m = 0; m < 4; ++m)
#pragma unroll
                        for (int n = 0; n < 2; ++n) {
                            const int row = brow + ai * 128 + wr * 64 + m * 16 + fr, col = bcol + bj * 128 + wc * 32 + n * 16 + fq * 4;
                            const f32x4 v = acc[ai][bj][m][n];
#pragma unroll
                            for (int j = 0; j < 4; ++j) ea.o_cm[(size_t)(col + j - 2048) * ea.ld_cm + row] = f2b(v[j]);
                        }
        } else if (EPI == EPI_RELU2) {
            gemm_kloop<true, NAI>(A, Bt, K, brow, bcol, acc, kt0, ntl);
            bf16_t* T = (bf16_t*)dyn_lds;
#pragma unroll
            for (int ai = 0; ai < NAI; ++ai)
#pragma unroll
                for (int m = 0; m < 4; ++m)
#pragma unroll
                    for (int bj = 0; bj < 2; ++bj)
#pragma unroll
                        for (int n = 0; n < 2; ++n) {
                            const f32x4 v = acc[ai][bj][m][n];
                            const float r0 = fmaxf(v[0], 0.f), r1 = fmaxf(v[1], 0.f), r2 = fmaxf(v[2], 0.f), r3 = fmaxf(v[3], 0.f);
                            u32x2 o; o.x = pk2(r0 * r0, r1 * r1); o.y = pk2(r2 * r2, r3 * r3);
                            *(u32x2*)(T + (ai * 128 + wr * 64 + m * 16 + fr) * 264 + bj * 128 + wc * 32 + n * 16 + fq * 4) = o;
                        }
            __syncthreads();
            {
                const int tt = tid_l();
#pragma unroll
                for (int i = 0; i < NAI * 8; ++i) {
                    const int c = tt + i * NT, row = c >> 5, cc = c & 31;
                    *(u32x4*)(ea.o_rm + (size_t)(brow + row) * ea.ld_rm + bcol + cc * 8) = *(const u32x4*)(T + row * 264 + cc * 8);
                }
            }
        } else if (EPI == EPI_RESID) {
            gemm_kloop<true, NAI>(A, Bt, K, brow, bcol, acc, kt0, ntl);
            const bool lat = brow < NLAT;
            const int mrow = lat ? brow >> 11 : 16;
            const float* rbase = lat ? ea.res_lat + (size_t)brow * 1024 : ea.res_ctx + (size_t)(brow - NLAT) * 1024;
            float* obase = lat ? ea.out_lat + (size_t)brow * 1024 : ea.out_ctx + (size_t)(brow - NLAT) * 1024;
            f32x4 g[2][2];
#pragma unroll
            for (int bj = 0; bj < 2; ++bj)
#pragma unroll
                for (int n = 0; n < 2; ++n) g[bj][n] = *(const f32x4*)(ea.modg + (size_t)mrow * 6144 + bcol + bj * 128 + wc * 32 + n * 16 + fq * 4);
            if (SPLITTAIL && kq >= 0) {
#pragma unroll
                for (int ai = 0; ai < NAI; ++ai)
#pragma unroll
                    for (int m = 0; m < 4; ++m)
#pragma unroll
                        for (int bj = 0; bj < 2; ++bj)
#pragma unroll
                            for (int n = 0; n < 2; ++n) {
                                float* op = obase + (size_t)(ai * 128 + wr * 64 + m * 16 + fr) * 1024 + bcol + bj * 128 + wc * 32 + n * 16 + fq * 4;
                                const f32x4 dv = g[bj][n] * acc[ai][bj][m][n];
#pragma unroll
                                for (int j = 0; j < 4; ++j) unsafeAtomicAdd(op + j, dv[j]);
                            }
            } else
#pragma unroll
            for (int ai = 0; ai < NAI; ++ai) {
                f32x4 xv[4][2][2];
#pragma unroll
                for (int m = 0; m < 4; ++m)
#pragma unroll
                    for (int bj = 0; bj < 2; ++bj)
#pragma unroll
                        for (int n = 0; n < 2; ++n)
                            xv[m][bj][n] = *(const f32x4*)(rbase + (size_t)(ai * 128 + wr * 64 + m * 16 + fr) * 1024 + bcol + bj * 128 + wc * 32 + n * 16 + fq * 4);
#pragma unroll
                for (int m = 0; m < 4; ++m)
#pragma unroll
                    for (int bj = 0; bj < 2; ++bj)
#pragma unroll
                        for (int n = 0; n < 2; ++n)
                            *(f32x4*)(obase + (size_t)(ai * 128 + wr * 64 + m * 16 + fr) * 1024 + bcol + bj * 128 + wc * 32 + n * 16 + fq * 4) = xv[m][bj][n] + g[bj][n] * acc[ai][bj][m][n];
            }
        } else {
            gemm_kloop<true, NAI>(A, Bt, K, brow, bcol, acc, kt0, ntl);
#pragma unroll
            for (int ai = 0; ai < NAI; ++ai)
#pragma unroll
                for (int m = 0; m < 4; ++m) {
                    const int row = brow + ai * 128 + wr * 64 + m * 16 + fr;
#pragma unroll
                    for (int bj = 0; bj < 2; ++bj)
#pragma unroll
                        for (int n = 0; n < 2; ++n) {
                            const int col = bcol + bj * 128 + wc * 32 + n * 16 + fq * 4;
                            const f32x4 v = acc[ai][bj][m][n];
                            if (EPI == EPI_INPROJ) {
                                if (pn == ea.gate_pn) {
                                    if (bj == 0 && wc == 0 && n == 0) *(f32x4*)(ea.gates + (size_t)row * 16 + fq * 4) = v;
                                } else {
                                    u32x2 o; o.x = pk2(v[0], v[1]); o.y = pk2(v[2], v[3]);
                                    *(u32x2*)(ea.o_rm + (size_t)row * ea.ld_rm + col) = o;
                                }
                            } else if (EPI == EPI_DRY) {
                                if (v[0] == 123456.789f && v[1] == 3.25f) *(f32x4*)(ea.out_lat + (size_t)row * 1024 + (col & 1023)) = v;
                            } else if (EPI == EPI_RELU2) {
                                float r0 = fmaxf(v[0], 0.f), r1 = fmaxf(v[1], 0.f), r2 = fmaxf(v[2], 0.f), r3 = fmaxf(v[3], 0.f);
                                u32x2 o; o.x = pk2(r0 * r0, r1 * r1); o.y = pk2(r2 * r2, r3 * r3);
                                *(u32x2*)(ea.o_rm + (size_t)row * ea.ld_rm + col) = o;
                            } else {
                                const float* rp; float* op; int mrow;
                                if (row < NLAT) { rp = ea.res_lat + (size_t)row * 1024 + col; op = ea.out_lat + (size_t)row * 1024 + col; mrow = row >> 11; }
                                else { rp = ea.res_ctx + (size_t)(row - NLAT) * 1024 + col; op = ea.out_ctx + (size_t)(row - NLAT) * 1024 + col; mrow = 16; }
                                const f32x4 g = *(const f32x4*)(ea.modg + (size_t)mrow * 6144 + col);
                                const f32x4 x = *(const f32x4*)rp;
                                f32x4 rr = x + g * v;
#ifdef SANITIZE
#pragma unroll
                                for (int q_ = 0; q_ < 4; ++q_) if (!(fabsf(rr[q_]) < 1e30f)) rr[q_] = 0.f;
#endif
                                *(f32x4*)op = rr;
                            }
                        }
                }
        }
        asm volatile("s_waitcnt vmcnt(0)" ::: "memory");
        __syncthreads();
}

template <int EPI, bool HALFTAIL = true>
__device__ __forceinline__ void gemm_phase(const bf16_t* A, const bf16_t* Bt, int M, int N, int K, const EpiArgs& ea) {
    const int nM = M / G_BM, nN = N / G_BM, nwg = nM * nN, G_ = gridDim.x;
    const int tidx = tid_l(); const int wid = tidx >> 6, lane = tidx & 63, wr = wid >> 2, wc = wid & 3, fr = lane & 15, fq = lane >> 4;
    int nfull = nwg;
    if (HALFTAIL) { const int rem = nwg % G_; if (rem > 0 && rem * 2 <= G_) nfull = nwg - rem; }
    const int nunits = nfull + (nwg - nfull) * 2;
    for (int U = blockIdx.x; U < nunits; U += G_) {
        const int L = U < nfull ? U : nfull + ((U - nfull) >> 1);
        const int half = U < nfull ? -1 : ((U - nfull) & 1);
        int wgid = L;
        { int q = nwg / 8, r = nwg % 8, xcd = wgid % 8, off = wgid / 8; wgid = (xcd < r ? xcd * (q + 1) : r * (q + 1) + (xcd - r) * q) + off; }
        const int nig = 4 * nN, gid = wgid / nig, fm = gid * 4, gsz = min(nM - fm, 4);
        const int pm = fm + ((wgid % nig) % gsz), pn = (wgid % nig) / gsz, bcol = pn * G_BM;
        if (half < 0) gemm_tile<EPI, 2>(A, Bt, K, pm * G_BM, bcol, pn, ea, wr, wc, fr, fq);
        else gemm_tile<EPI, 1>(A, Bt, K, pm * G_BM + half * 128, bcol, pn, ea, wr, wc, fr, fq);
    }
}

__device__ __forceinline__ void phase0(const Params& p) {
    const int tid = tid_l(), blk = blockIdx.x, nb = gridDim.x;
    float* MOD = (float*)(p.ws + WS_MOD);
    for (int it = blk; it < 193; it += nb) {
        if (it < 192) {
            float* sl = (float*)dyn_lds;
            float* red = sl + 17 * 1024;
            for (int i = tid; i < 17 * 1024; i += NT) { float v = (i < 16 * 1024) ? p.in[1][i] : p.in[3][i - 16 * 1024]; sl[i] = v / (1.f + __expf(-v)); }
            __syncthreads();
            const int l = it / 48, nc = it % 48, kp = tid >> 7, col = tid & 127;
            const float* W = p.in[4] + (size_t)l * 1024 * 6144 + nc * 128 + col;
            float acc[17];
#pragma unroll
            for (int r = 0; r < 17; ++r) acc[r] = 0.f;
            for (int k = kp * 256; k < kp * 256 + 256; ++k) {
                const float wv = W[(size_t)k * 6144];
#pragma unroll
                for (int r = 0; r < 17; ++r) acc[r] += sl[r * 1024 + k] * wv;
            }
#pragma unroll
            for (int r = 0; r < 17; ++r) red[(kp * 17 + r) * 128 + col] = acc[r];
            __syncthreads();
            for (int i = tid; i < 17 * 128; i += NT) {
                const int r = i >> 7, cc = i & 127;
                const float s = red[(0 * 17 + r) * 128 + cc] + red[(1 * 17 + r) * 128 + cc] + red[(2 * 17 + r) * 128 + cc] + red[(3 * 17 + r) * 128 + cc];
                MOD[((size_t)l * 17 + r) * 6144 + nc * 128 + cc] = s + p.in[5][l * 6144 + nc * 128 + cc];
            }
            __syncthreads();
        } else {
            float* ROPE = (float*)(p.ws + WS_ROPE);
            for (int i = tid; i < 2048; i += NT) {
                const int pos = i >> 5, j = i & 31;
                const float inv = exp2f(-(float)j * (13.287712379549449f / 32.f));
                const float ang = (float)pos * inv;
                ROPE[i] = fcos_(ang); ROPE[2048 + i] = fsin_(ang);
            }
        }
    }
    float* H2 = (float*)(p.ws + WS_H2);
    const int gw = blk * 8 + (tid >> 6), lane = tid & 63;
    for (int it = gw; it < 2 * 2304; it += nb * 8) {
        const int i = it / 2304, row = it % 2304;
        const int L = row < 2048 ? 2048 : 256, t = row < 2048 ? row : row - 2048;
        const float tn = (float)t / (float)(L - 1);
        const float wpos = 6.283185307179586f * (float)t / (float)L;
        float ev = 0.f;
        if (lane == 0) ev = tn;
        else if (lane <= 16) { const float fr = 1e-4f + (float)(lane - 1) * ((15.f - 1e-4f) / 15.f); ev = fcos_(wpos * fr); }
        else if (lane <= 32) { const float fr = 1e-4f + (float)(lane - 17) * ((15.f - 1e-4f) / 15.f); ev = -fsin_(wpos * fr); }
        const float* w1 = p.in[13] + i * 33 * 64; const float* b1 = p.in[14] + i * 64;
        const float* w2 = p.in[15] + i * 64 * 64; const float* b2 = p.in[16] + i * 64; const float* fq = p.in[18] + i * 64;
        float a = b1[lane];
        for (int e = 0; e < 33; ++e) a += __shfl(ev, e) * w1[e * 64 + lane];
        const float h1 = fsin_(fq[lane] * a);
        float a2 = b2[lane];
        for (int e = 0; e < 64; ++e) a2 += __shfl(h1, e) * w2[e * 64 + lane];
        H2[((size_t)i * 2304 + row) * 64 + lane] = fsin_(fq[lane] * a2);
    }
}

__device__ __forceinline__ void cvt_tile(const float* W, int N, int K, bf16_t* WT, int n0, int k0, int mapmode) {
    float* tl = (float*)dyn_lds;
    const int tid = tid_l(), nl = tid & 63, kb = tid >> 6;
    const int n = n0 + nl; int sc = n;
    if (mapmode == 1) sc = n < 2048 ? n : (n < 3584 ? n + 16 : (n < 3600 ? n - 3584 + 2048 : -1));
#pragma unroll
    for (int i = 0; i < 8; ++i) { const int kl = kb + 8 * i; tl[kl * 65 + nl] = sc >= 0 ? W[(size_t)(k0 + kl) * N + sc] : 0.f; }
    __syncthreads();
    const int nn = tid >> 3, kc = tid & 7;
    float f[8];
#pragma unroll
    for (int j = 0; j < 8; ++j) f[j] = tl[(kc * 8 + j) * 65 + nn];
    *(u32x4*)(WT + (size_t)(n0 + nn) * K + k0 + kc * 8) = pack8(f);
    __syncthreads();
}

__device__ __forceinline__ void convert_weights(const Params& p, int l, bool first_part, bool second_part, int bstart, int bcount) {
    const int blk = (int)blockIdx.x - bstart, nb = bcount, li = l >> 1; const bool even = !(l & 1);
    if (blk < 0 || blk >= bcount) return;
    const int nin = even ? 60 : 48;
    const int t_in = nin * 16, t_out = 256, t_m1 = 1024, t_m2 = 1024;
    const int it0 = first_part ? 0 : t_in + t_out + t_m1, it1 = second_part ? t_in + t_out + t_m1 + t_m2 : t_in + t_out + t_m1;
    for (int it = it0 + blk; it < it1; it += nb) {
        int r = it;
        if (r < t_in) {
            const int nt = r / 16, kt = r % 16;
            if (even) cvt_tile(p.in[8] + (size_t)li * 1024 * 3600, 3600, 1024, (bf16_t*)(p.ws + WS_WIN), nt * 64, kt * 64, 1);
            else cvt_tile(p.in[21] + (size_t)li * 1024 * 3072, 3072, 1024, (bf16_t*)(p.ws + WS_WIN), nt * 64, kt * 64, 0);
            continue;
        }
        r -= t_in;
        if (r < t_out) {
            const int nt = r / 16, kt = r % 16;
            cvt_tile((even ? p.in[20] : p.in[25]) + (size_t)li * 1024 * 1024, 1024, 1024, (bf16_t*)(p.ws + WS_WOUT), nt * 64, kt * 64, 0);
            continue;
        }
        r -= t_out;
        if (r < t_m1) {
            const int nt = r / 16, kt = r % 16;
            cvt_tile(p.in[6] + (size_t)l * 1024 * 4096, 4096, 1024, (bf16_t*)(p.ws + WS_WM1), nt * 64, kt * 64, 0);
            continue;
        }
        r -= t_m1;
        { const int nt = r / 64, kt = r % 64;
          cvt_tile(p.in[7] + (size_t)l * 4096 * 1024, 1024, 4096, (bf16_t*)(p.ws + WS_WM2), nt * 64, kt * 64, 0); }
    }
}

__device__ __forceinline__ void norm_phase(const Params& p, int l, const float* xlat, const float* xctx, int shoff, int scoff, int M) {
    const int tid = tid_l(), lane = tid & 63, gw = blockIdx.x * 8 + (tid >> 6), ngw = gridDim.x * 8;
    const float* MOD = (const float*)(p.ws + WS_MOD) + (size_t)l * 17 * 6144;
    bf16_t* ACT = (bf16_t*)(p.ws + WS_ACT);
    for (int row = gw; row < M; row += ngw) {
        const float* xr = row < NLAT ? xlat + (size_t)row * 1024 : xctx + (size_t)(row - NLAT) * 1024;
        const int mrow = row < NLAT ? row >> 11 : 16;
        const float* mod = MOD + (size_t)mrow * 6144;
        f32x4 v[4]; float ss = 0.f;
#pragma unroll
        for (int j = 0; j < 4; ++j) { v[j] = *(const f32x4*)(xr + 4 * lane + 256 * j); ss += v[j][0] * v[j][0] + v[j][1] * v[j][1] + v[j][2] * v[j][2] + v[j][3] * v[j][3]; }
        ss = wave_sum(ss);
        const float rstd = rsqrtf(ss * (1.f / 1024.f) + EPS);
#pragma unroll
        for (int j = 0; j < 4; ++j) {
            const int col = 4 * lane + 256 * j;
            const f32x4 sh = *(const f32x4*)(mod + shoff + col), sc = *(const f32x4*)(mod + scoff + col);
            const f32x4 y = v[j] * rstd * (sc + 1.f) + sh;
            u32x2 o; o.x = pk2(y[0], y[1]); o.y = pk2(y[2], y[3]);
            *(u32x2*)(ACT + (size_t)row * 1024 + col) = o;
        }
    }
}

__device__ __forceinline__ void filter_gen(const Params& p, int li) {
    const int tid = tid_l(), lane = tid & 63, w = tid >> 6;
    float* wf = (float*)dyn_lds; float* wb = wf + 64; float* red = wb + 64;
    const float* H2 = (const float*)(p.ws + WS_H2);
    for (int it = blockIdx.x; it < 2048; it += gridDim.x) {
        const int ltype = it >> 10, o = (it >> 9) & 1, c = it & 511;
        const int L = ltype ? 256 : 2048;
        const float* H2r = H2 + ((size_t)li * 2304 + (ltype ? 2048 : 0)) * 64;
        const float* w3 = p.in[17] + (size_t)li * 64 * 2048;
        if (tid < 64) wf[tid] = w3[tid * 2048 + (o * 2 + 0) * 512 + c];
        else if (tid < 128) wb[tid - 64] = w3[(tid - 64) * 2048 + (o * 2 + 1) * 512 + c];
        __syncthreads();
        const float lo = -4.605170185988091f / 1.5f, hi = -4.605170185988091f / 0.3f;
        const float delta = fabsf(lo + (hi - lo) * (float)c / 511.f);
        float vf[4], vb[4]; float ssf = 0.f, ssb = 0.f;
#pragma unroll
        for (int q = 0; q < 4; ++q) {
            const int t = tid + 512 * q; vf[q] = 0.f; vb[q] = 0.f;
            if (t < L) {
                float df = 0.f, db = 0.f;
                const f32x4* hr = (const f32x4*)(H2r + (size_t)t * 64);
#pragma unroll
                for (int j = 0; j < 16; ++j) { const f32x4 hv = hr[j];
                    df += hv[0] * wf[4 * j] + hv[1] * wf[4 * j + 1] + hv[2] * wf[4 * j + 2] + hv[3] * wf[4 * j + 3];
                    db += hv[0] * wb[4 * j] + hv[1] * wb[4 * j + 1] + hv[2] * wb[4 * j + 2] + hv[3] * wb[4 * j + 3]; }
                const float dec = __expf(-((float)t / (float)(L - 1)) * delta);
                vf[q] = df * dec; vb[q] = db * dec; ssf += vf[q] * vf[q]; ssb += vb[q] * vb[q];
            }
        }
        ssf = wave_sum(ssf); ssb = wave_sum(ssb);
        if (lane == 0) { red[w] = ssf; red[8 + w] = ssb; }
        __syncthreads();
        float tf = 0.f, tb = 0.f;
#pragma unroll
        for (int i = 0; i < 8; ++i) { tf += red[i]; tb += red[8 + i]; }
        const float nf = rsqrtf(tf + EPS), nbk = rsqrtf(tb + EPS);
        bf16_t* dst = ltype ? (bf16_t*)(p.ws + WS_FCTX) + ((size_t)o * 512 + c) * 512 : (bf16_t*)(p.ws + WS_FLAT) + ((size_t)o * 512 + c) * 4096;
#pragma unroll
        for (int q = 0; q < 4; ++q) {
            const int t = tid + 512 * q;
            if (t < L) {
                if (t == 0) { dst[L] = f2b(vf[q] * nf + vb[q] * nbk); dst[0] = 0; }
                else { dst[L + t] = f2b(vf[q] * nf); dst[L - t] = f2b(vb[q] * nbk); }
            }
        }
        __syncthreads();
    }
}

__device__ __forceinline__ void mlstm_item(const Params& p, int li, int it) {
    const int tid = tid_l(), w = tid >> 6, lane = tid & 63, fr = lane & 15, fq = lane >> 4;
    const int b = it >> 3, h = (it >> 1) & 3, dir = it & 1;
    bf16_t* Qs = (bf16_t*)dyn_lds;
    bf16_t* Ks = Qs + 64 * 136;
    bf16_t* KT = Ks + 64 * 136;
    bf16_t* VT = KT + 128 * 72;
    bf16_t* Cb = VT + 144 * 72;
    bf16_t* Ps = Cb + 144 * 136;
    float* fl = (float*)(Ps + 64 * 72);
    float* a_s = fl; float* Mt = fl + 64; float* scs = fl + 128; float* emt = fl + 192; float* den = fl + 256; float* lfs = fl + 320; float* igs = fl + 384; float* scal = fl + 448;
    const bf16_t* QKVO = (const bf16_t*)(p.ws + WS_BIG);
    const float* GATES = (const float*)(p.ws + WS_GATES);
    bf16_t* HFB = (bf16_t*)(p.ws + WS_HFB) + (size_t)dir * MTOT * 512;
    const float* ROPE = (const float*)(p.ws + WS_ROPE);
    const float* gate_b = p.in[9] + li * 16;
    for (int i = tid; i < 144 * 136 / 2; i += NT) ((unsigned*)Cb)[i] = 0u;
    for (int i = tid; i < 16 * 72; i += NT) { const int r = i / 72, ci = i % 72; VT[(128 + r) * 72 + ci] = (r == 0 && ci < 64) ? (bf16_t)0x3F80 : (bf16_t)0; }
    f32x4 cacc[9];
#pragma unroll
    for (int i = 0; i < 9; ++i) cacc[i] = (f32x4){0.f, 0.f, 0.f, 0.f};
    float m = 0.f;
    const int pr_r = tid >> 3, pr_seg = tid & 7, pr_tl = dir ? 63 - pr_r : pr_r, pr_tl2 = dir ? 63 - (tid & 63) : (tid & 63);
    const int pr_d1 = (pr_seg >> 2) * 64 + (pr_seg & 3) * 8;
    u32x4 pf_q1, pf_q2, pf_k1, pf_k2, pf_v1, pf_v2; float pgi = 0.f, pgf = 0.f;
#define MLSTM_ISSUE(ST_) do { const int st_ = (ST_); const bool ic_ = st_ < 4; const int cjn_ = ic_ ? (dir ? 3 - st_ : st_) : (dir ? 35 - st_ : st_ - 4); \
        const int rb_ = ic_ ? NLAT + b * 256 + cjn_ * 64 : b * 2048 + cjn_ * 64; \
        const bf16_t* sp_ = QKVO + (size_t)(rb_ + pr_tl) * 2048 + h * 128; \
        pf_q1 = *(const u32x4*)(sp_ + pr_d1); pf_q2 = *(const u32x4*)(sp_ + pr_d1 + 32); pf_k1 = *(const u32x4*)(sp_ + 512 + pr_d1); pf_k2 = *(const u32x4*)(sp_ + 512 + pr_d1 + 32); \
        pf_v1 = *(const u32x4*)(sp_ + 1024 + pr_seg * 16); pf_v2 = *(const u32x4*)(sp_ + 1024 + pr_seg * 16 + 8); \
        if (tid < 64) { const float* g_ = GATES + (size_t)(rb_ + pr_tl2) * 16; pgi = g_[dir * 8 + h]; pgf = g_[dir * 8 + 4 + h]; } } while (0)
    MLSTM_ISSUE(0);
    __syncthreads();
    for (int step = 0; step < 36; ++step) {
        const bool isctx = step < 4;
        const int cj = isctx ? (dir ? 3 - step : step) : (dir ? 35 - step : step - 4);
        const int rowbase = isctx ? NLAT + b * 256 + cj * 64 : b * 2048 + cj * 64;
        {
            const int r = tid >> 3, seg = tid & 7; const int tl = dir ? 63 - r : r;
            const int hb = seg >> 2, jb = (seg & 3) * 8, d1 = hb * 64 + jb, d2 = d1 + 32;
            const u32x4 q1 = pf_q1, q2 = pf_q2, k1 = pf_k1, k2 = pf_k2, v1 = pf_v1, v2 = pf_v2;
            const float cgi = pgi, cgf = pgf;
            if (step + 1 < 36) MLSTM_ISSUE(step + 1);
            float cs[8], sn[8];
            if (!isctx) {
                const int pos = hb ? tl : cj;
                const f32x4 c0 = *(const f32x4*)(ROPE + pos * 32 + jb), c1 = *(const f32x4*)(ROPE + pos * 32 + jb + 4);
                const f32x4 s0 = *(const f32x4*)(ROPE + 2048 + pos * 32 + jb), s1 = *(const f32x4*)(ROPE + 2048 + pos * 32 + jb + 4);
#pragma unroll
                for (int e = 0; e < 4; ++e) { cs[e] = c0[e]; cs[4 + e] = c1[e]; sn[e] = s0[e]; sn[4 + e] = s1[e]; }
            } else {
#pragma unroll
                for (int e = 0; e < 8; ++e) { cs[e] = 1.f; sn[e] = 0.f; }
            }
            float x1[8], x2[8], o1[8], o2[8];
            unpack8(q1, x1); unpack8(q2, x2);
#pragma unroll
            for (int e = 0; e < 8; ++e) { o1[e] = x1[e] * cs[e] - x2[e] * sn[e]; o2[e] = x1[e] * sn[e] + x2[e] * cs[e]; }
            *(u32x4*)(Qs + r * 136 + d1) = pack8(o1); *(u32x4*)(Qs + r * 136 + d2) = pack8(o2);
            unpack8(k1, x1); unpack8(k2, x2);
            const float ksc = 0.08838834764831845f;
#pragma unroll
            for (int e = 0; e < 8; ++e) { o1[e] = (x1[e] * cs[e] - x2[e] * sn[e]) * ksc; o2[e] = (x1[e] * sn[e] + x2[e] * cs[e]) * ksc; }
            const u32x4 ko1 = pack8(o1), ko2 = pack8(o2);
            *(u32x4*)(Ks + r * 136 + d1) = ko1; *(u32x4*)(Ks + r * 136 + d2) = ko2;
            {
                const unsigned kw1[4] = {ko1.x, ko1.y, ko1.z, ko1.w}, kw2[4] = {ko2.x, ko2.y, ko2.z, ko2.w};
#pragma unroll
                for (int e = 0; e < 4; ++e) {
                    KT[(d1 + 2 * e) * 72 + r] = (bf16_t)(kw1[e] & 0xffffu); KT[(d1 + 2 * e + 1) * 72 + r] = (bf16_t)(kw1[e] >> 16);
                    KT[(d2 + 2 * e) * 72 + r] = (bf16_t)(kw2[e] & 0xffffu); KT[(d2 + 2 * e + 1) * 72 + r] = (bf16_t)(kw2[e] >> 16);
                }
                const unsigned vw1[4] = {v1.x, v1.y, v1.z, v1.w}, vw2[4] = {v2.x, v2.y, v2.z, v2.w};
#pragma unroll
                for (int e = 0; e < 4; ++e) {
                    VT[(seg * 16 + 2 * e) * 72 + r] = (bf16_t)(vw1[e] & 0xffffu); VT[(seg * 16 + 2 * e + 1) * 72 + r] = (bf16_t)(vw1[e] >> 16);
                    VT[(seg * 16 + 8 + 2 * e) * 72 + r] = (bf16_t)(vw2[e] & 0xffffu); VT[(seg * 16 + 8 + 2 * e + 1) * 72 + r] = (bf16_t)(vw2[e] >> 16);
                }
            }
            if (tid < 64) {
                const int rr = tid;
                const float ig = cgi + gate_b[dir * 8 + h];
                const float fg = cgf + gate_b[dir * 8 + 4 + h];
                igs[rr] = ig; lfs[rr] = fminf(fg, 0.f) - __logf(1.f + __expf(-fabsf(fg)));
            }
        }
        __syncthreads();
        if (w == 0) {
            float bcs = lfs[lane];
#pragma unroll
            for (int o = 1; o < 64; o <<= 1) { const float t = __shfl_up(bcs, o); if (lane >= o) bcs += t; }
            const float a = igs[lane] - bcs;
            float pm = a;
#pragma unroll
            for (int o = 1; o < 64; o <<= 1) { const float t = __shfl_up(pm, o); if (lane >= o) pm = fmaxf(pm, t); }
            const float Mx = fmaxf(m, pm);
            a_s[lane] = a; Mt[lane] = Mx; scs[lane] = __expf(m - Mx); emt[lane] = __expf(-bcs - Mx);
            if (lane == 63) { scal[0] = bcs; scal[1] = Mx; }
        }
        {
            const int st = w & 3, tt0 = (w >> 2) * 2;
            f32x4 sacc[2];
#pragma unroll
            for (int u = 0; u < 2; ++u) {
                sacc[u] = (f32x4){0.f, 0.f, 0.f, 0.f};
#pragma unroll
                for (int kk = 0; kk < 4; ++kk) {
                    const bf16x8 Ak = *(const bf16x8*)(Ks + (st * 16 + fr) * 136 + kk * 32 + fq * 8);
                    const bf16x8 Bq = *(const bf16x8*)(Qs + ((tt0 + u) * 16 + fr) * 136 + kk * 32 + fq * 8);
                    sacc[u] = mfma16(Ak, Bq, sacc[u]);
                }
            }
            __syncthreads();
#pragma unroll
            for (int u = 0; u < 2; ++u) {
                const int t = (tt0 + u) * 16 + fr, sb = st * 16 + fq * 4;
                const float Mv = Mt[t];
                float pv[4];
#pragma unroll
                for (int j = 0; j < 4; ++j) { const int s = sb + j; pv[j] = (s <= t) ? sacc[u][j] * __expf(a_s[s] - Mv) : 0.f; }
                u32x2 o; o.x = pk2(pv[0], pv[1]); o.y = pk2(pv[2], pv[3]);
                *(u32x2*)(Ps + t * 72 + sb) = o;
            }
        }
        __syncthreads();
        {
            const int tt = w & 3, up = w >> 2, vt0 = up ? 5 : 0, nvt = up ? 4 : 5;
            bf16x8 qf[4], pf[2];
#pragma unroll
            for (int kk = 0; kk < 4; ++kk) qf[kk] = *(const bf16x8*)(Qs + (tt * 16 + fr) * 136 + kk * 32 + fq * 8);
#pragma unroll
            for (int kk = 0; kk < 2; ++kk) pf[kk] = *(const bf16x8*)(Ps + (tt * 16 + fr) * 72 + kk * 32 + fq * 8);
            const float sct = scs[tt * 16 + fr];
            f32x4 hacc[5];
#pragma unroll
            for (int vi = 0; vi < 5; ++vi) {
                hacc[vi] = (f32x4){0.f, 0.f, 0.f, 0.f};
                if (vi < nvt) {
                    const int v0 = (vt0 + vi) * 16;
                    f32x4 ac = (f32x4){0.f, 0.f, 0.f, 0.f};
#pragma unroll
                    for (int kk = 0; kk < 4; ++kk) ac = mfma16(*(const bf16x8*)(Cb + (v0 + fr) * 136 + kk * 32 + fq * 8), qf[kk], ac);
                    ac = ac * sct;
#pragma unroll
                    for (int kk = 0; kk < 2; ++kk) ac = mfma16(*(const bf16x8*)(VT + (v0 + fr) * 72 + kk * 32 + fq * 8), pf[kk], ac);
                    hacc[vi] = ac;
                }
            }
            if (up && fq == 0) den[tt * 16 + fr] = hacc[3][0];
            __syncthreads();
            const int t = tt * 16 + fr, tl = dir ? 63 - t : t;
            const float dn = den[t];
            const float inv = 1.f / fmaxf(fabsf(dn), emt[t]);
            bf16_t* orow = HFB + (size_t)(rowbase + tl) * 512 + h * 128;
#pragma unroll
            for (int vi = 0; vi < 5; ++vi) {
                if (vi < nvt && (vt0 + vi) < 8) {
                    const int v0 = (vt0 + vi) * 16 + fq * 4;
                    u32x2 o; o.x = pk2(hacc[vi][0] * inv, hacc[vi][1] * inv); o.y = pk2(hacc[vi][2] * inv, hacc[vi][3] * inv);
                    *(u32x2*)(orow + v0) = o;
                }
            }
        }
        {
            const float bl = scal[0], M63 = scal[1];
            const float decay = __expf(m - M63);
            bf16x8 ka[2];
#pragma unroll
            for (int kk = 0; kk < 2; ++kk) {
                const u32x4 raw = *(const u32x4*)(KT + (w * 16 + fr) * 72 + kk * 32 + fq * 8);
                float f[8]; unpack8(raw, f);
#pragma unroll
                for (int j = 0; j < 8; ++j) f[j] *= __expf(a_s[kk * 32 + fq * 8 + j] - M63);
                ka[kk] = as_bf8(pack8(f));
            }
#pragma unroll
            for (int vt = 0; vt < 9; ++vt) {
                f32x4 ac = cacc[vt] * decay;
#pragma unroll
                for (int kk = 0; kk < 2; ++kk) ac = mfma16(ka[kk], *(const bf16x8*)(VT + (vt * 16 + fr) * 72 + kk * 32 + fq * 8), ac);
                cacc[vt] = ac;
                u32x2 o; o.x = pk2(ac[0], ac[1]); o.y = pk2(ac[2], ac[3]);
                *(u32x2*)(Cb + (vt * 16 + fr) * 136 + w * 16 + fq * 4) = o;
            }
            m = bl + M63;
        }
        __syncthreads();
    }
}

__device__ __forceinline__ void combine_phase(const Params& p, int li) {
    const int tid = tid_l(), lane = tid & 63, gw = blockIdx.x * 8 + (tid >> 6), ngw = gridDim.x * 8;
    const bf16_t* HF = (const bf16_t*)(p.ws + WS_HFB); const bf16_t* HB = HF + (size_t)MTOT * 512;
    const bf16_t* QKVO = (const bf16_t*)(p.ws + WS_BIG);
    bf16_t* MIX = (bf16_t*)(p.ws + WS_ACT);
    const float* hn = p.in[10] + li * 512 + lane * 8;
    float g[8];
#pragma unroll
    for (int e = 0; e < 8; ++e) g[e] = hn[e];
    for (int row = gw; row < MTOT; row += ngw) {
        float a[8], bq[8], og[8], y[8];
        unpack8(*(const u32x4*)(HF + (size_t)row * 512 + lane * 8), a);
        unpack8(*(const u32x4*)(HB + (size_t)row * 512 + lane * 8), bq);
        unpack8(*(const u32x4*)(QKVO + (size_t)row * 2048 + 1536 + lane * 8), og);
        float ss = 0.f;
#pragma unroll
        for (int e = 0; e < 8; ++e) { a[e] += bq[e]; ss += a[e] * a[e]; }
        ss += __shfl_xor(ss, 1); ss += __shfl_xor(ss, 2); ss += __shfl_xor(ss, 4); ss += __shfl_xor(ss, 8);
        const float rstd = rsqrtf(ss * (1.f / 128.f) + EPS);
#pragma unroll
        for (int e = 0; e < 8; ++e) y[e] = a[e] * rstd * g[e] / (1.f + __expf(-og[e]));
        *(u32x4*)(MIX + (size_t)row * 1024 + lane * 8) = pack8(y);
    }
}

__device__ __forceinline__ bf16x8 hy_afrag(const bf16_t* HRp, int q, int m, int o4, int hsh) {
    const bf16_t* ap = HRp + (q + 8 - m);
    const u32x4 lo = *(const u32x4*)ap, hi = *(const u32x4*)(ap + 8);
    const bool b0 = (o4 & 1) != 0, b1 = (o4 & 2) != 0;
#define HYSEL(A_, B_, C_, D_) (b1 ? (b0 ? (D_) : (C_)) : (b0 ? (B_) : (A_)))
    const unsigned w0 = HYSEL(lo.x, lo.y, lo.z, lo.w), w1 = HYSEL(lo.y, lo.z, lo.w, hi.x), w2 = HYSEL(lo.z, lo.w, hi.x, hi.y),
                   w3 = HYSEL(lo.w, hi.x, hi.y, hi.z), w4 = HYSEL(hi.x, hi.y, hi.z, hi.w);
#undef HYSEL
    u32x4 o;
    o.x = __builtin_amdgcn_alignbit(w1, w0, hsh); o.y = __builtin_amdgcn_alignbit(w2, w1, hsh);
    o.z = __builtin_amdgcn_alignbit(w3, w2, hsh); o.w = __builtin_amdgcn_alignbit(w4, w3, hsh);
    return as_bf8(o);
}

template <int L>
__device__ __forceinline__ void hyena_item(const Params& p, int li, int c, bool dry = false) {
    constexpr int ZS = L + 8, NI = L / 128, NS = L / 32;
    const int tid = tid_l(), w = tid >> 6, lane = tid & 63, fr = lane & 15, fq = lane >> 4;
    bf16_t* ZA = (bf16_t*)dyn_lds; bf16_t* ZB = ZA + 16 * ZS; bf16_t* HFl = ZB + 16 * ZS;
    const int segbase = (L == 2048) ? 0 : NLAT;
    const bf16_t* HYT = (const bf16_t*)(p.ws + WS_P2);
    bf16_t* MIX = (bf16_t*)(p.ws + WS_ACT);
    const float* cw = p.in[11] + (size_t)li * 3 * 1536; const float* cb = p.in[12] + (size_t)li * 1536; const float* hd = p.in[19] + (size_t)li * 2 * 512;
    const bf16_t* FIL = (L == 2048) ? (const bf16_t*)(p.ws + WS_FLAT) : (const bf16_t*)(p.ws + WS_FCTX);
    {
        const float w0 = cw[c], w1 = cw[1536 + c], w2 = cw[2 * 1536 + c], bb = cb[c];
        const bf16_t* src = HYT + (size_t)c * MTOT + segbase;
#pragma unroll
        for (int ci = 0; ci < (16 * L / 8 + NT - 1) / NT; ++ci) {
            const int ch = tid + ci * NT; if (ch >= 16 * L / 8) break;
            const int b = ch / (L / 8), t0 = (ch % (L / 8)) * 8;
            const bf16_t* s = src + b * L + t0;
            float x[10], y[8];
            const float xl = b2f(s[t0 > 0 ? -1 : 0]), xr = b2f(s[(t0 + 8 < L) ? 8 : 7]);
            unpack8(*(const u32x4*)s, x + 1);
            x[0] = t0 > 0 ? xl : 0.f; x[9] = (t0 + 8 < L) ? xr : 0.f;
#pragma unroll
            for (int e = 0; e < 8; ++e) y[e] = bb + w0 * x[e] + w1 * x[e + 1] + w2 * x[e + 2];
            *(u32x4*)(ZA + b * ZS + t0) = pack8(y);
        }
    }
#pragma unroll 1
    for (int o = 0; o < 2; ++o) {
        for (int i = tid; i < 2 * L / 8; i += NT) {
            const u32x4 v = *(const u32x4*)(FIL + ((size_t)o * 512 + c) * 2 * L + i * 8);
            u32x4 rv; rv.x = (v.w >> 16) | (v.w << 16); rv.y = (v.z >> 16) | (v.z << 16); rv.z = (v.y >> 16) | (v.y << 16); rv.w = (v.x >> 16) | (v.x << 16);
            *(u32x4*)(HFl + 8 + 2 * L - 8 - 8 * i) = rv;
        }
        if (tid < 8) HFl[tid] = 0; else if (tid < 24) HFl[2 * L + tid] = 0;
        __syncthreads();
        const bf16_t* Zin = o ? ZB : ZA;
        const int gc = (o + 1) * 512 + c;
        const float gw0 = cw[gc], gw1 = cw[1536 + gc], gw2 = cw[2 * 1536 + gc], gb = cb[gc], dsk = hd[o * 512 + c];
        const bf16_t* gs = HYT + (size_t)gc * MTOT + segbase + fr * L;
        constexpr int NIB = NI < 8 ? NI : 8;
#pragma unroll 1
        for (int hp = 0; hp < NI; hp += NIB) {
            f32x4 acc[NIB];
#pragma unroll
            for (int i = 0; i < NIB; ++i) acc[i] = (f32x4){0.f, 0.f, 0.f, 0.f};
            constexpr int NQ = NS / 4;
            const int am = (7 - fr) & 7, ao4 = am >> 1, ahs = (am & 1) * 16;
            u32x2 pgv[NIB]; bf16_t pxl[NIB], pxr[NIB];
#pragma unroll
            for (int i = 0; i < NIB; ++i) {
                const int t0 = 16 * (w + 8 * (hp + i)) + fq * 4;
                pxl[i] = gs[t0 > 0 ? t0 - 1 : 0]; pxr[i] = gs[(t0 + 4 < L) ? t0 + 4 : L - 1];
                pgv[i] = *(const u32x2*)(gs + t0);
            }
#pragma unroll 1
            for (int r = 0; r < 4; ++r) {
                bf16x8 Aw[NIB];
#pragma unroll
                for (int i = 0; i < NIB; ++i) {
                    Aw[i] = hy_afrag(HFl, (L - 1) - 16 * w - 32 * (4 * (hp + i) - r) - fr + fq * 8, am, ao4, ahs);
                }
#pragma unroll 1
                for (int qc = 0; qc < NQ; qc += NIB) {
#pragma unroll
                    for (int qq = 0; qq < NIB; ++qq) {
                        const int q = qc + qq;
                        const bf16x8 Bz = *(const bf16x8*)(Zin + fr * ZS + (4 * q + r) * 32 + fq * 8);
#pragma unroll
                        for (int i = 0; i < NIB; ++i) acc[i] = mfma16(Aw[(i - qq + NIB) % NIB], Bz, acc[i]);
                        if (q + 1 < NQ) {
                            Aw[(NIB - 1 - qq) % NIB] = hy_afrag(HFl, (L - 1) - 16 * w - 32 * (4 * (hp - q - 1) - r) - fr + fq * 8, am, ao4, ahs);
                        }
                    }
                }
            }
#pragma unroll
            for (int i = 0; i < NIB; ++i) {
                const int t0 = 16 * (w + 8 * (hp + i)) + fq * 4;
                float x[6];
                const float xl = b2f(pxl[i]), xr = b2f(pxr[i]);
                const u32x2 gv = pgv[i];
                x[0] = t0 > 0 ? xl : 0.f;
                x[1] = blo(gv.x); x[2] = bhi(gv.x); x[3] = blo(gv.y); x[4] = bhi(gv.y);
                x[5] = (t0 + 4 < L) ? xr : 0.f;
                const u32x2 zv = *(const u32x2*)(Zin + fr * ZS + t0);
                const float z[4] = {blo(zv.x), bhi(zv.x), blo(zv.y), bhi(zv.y)};
                float val[4];
#pragma unroll
                for (int j = 0; j < 4; ++j) val[j] = (gb + gw0 * x[j] + gw1 * x[j + 1] + gw2 * x[j + 2]) * (acc[i][j] + dsk * z[j]);
                { u32x2 ov; ov.x = pk2(val[0], val[1]); ov.y = pk2(val[2], val[3]); *(u32x2*)((o == 0 ? ZB : ZA) + fr * ZS + t0) = ov; }
            }
        }
        __syncthreads();
    }
    if (!dry) {
        bf16_t* dstp = (bf16_t*)(p.ws + WS_P2) + (size_t)c * MTOT + segbase;
#pragma unroll
        for (int ci = 0; ci < (16 * L / 8 + NT - 1) / NT; ++ci) {
            const int ch = tid + ci * NT; if (ch >= 16 * L / 8) break;
            const int b = ch / (L / 8), t0 = (ch % (L / 8)) * 8;
            *(u32x4*)(dstp + b * L + t0) = *(const u32x4*)(ZA + b * ZS + t0);
        }
        __syncthreads();
    }
}

__device__ __forceinline__ void hy_transpose(const Params& p) {
    const int tid = tid_l();
    bf16_t* T = (bf16_t*)dyn_lds;
    const bf16_t* HYO = (const bf16_t*)(p.ws + WS_P2);
    bf16_t* MIX = (bf16_t*)(p.ws + WS_ACT);
    for (int it = blockIdx.x; it < (MTOT / 64) * 8; it += gridDim.x) {
        const int tt = it >> 3, cg_ = it & 7, tok0 = tt * 64, c0 = cg_ * 64;
        {
            const int ch = tid >> 3, t8 = (tid & 7) * 8;
            const u32x4 v = *(const u32x4*)(HYO + (size_t)(c0 + ch) * MTOT + tok0 + t8);
            const unsigned wv[4] = {v.x, v.y, v.z, v.w};
#pragma unroll
            for (int e = 0; e < 4; ++e) { T[(t8 + 2 * e) * 72 + ch] = (bf16_t)(wv[e] & 0xffffu); T[(t8 + 2 * e + 1) * 72 + ch] = (bf16_t)(wv[e] >> 16); }
        }
        __syncthreads();
        {
            const int tk = tid >> 3, c8 = (tid & 7) * 8;
            *(u32x4*)(MIX + (size_t)(tok0 + tk) * 1024 + 512 + c0 + c8) = *(const u32x4*)(T + tk * 72 + c8);
        }
        __syncthreads();
    }
}

__device__ __forceinline__ void qknorm_phase(const Params& p, int li) {
    const int tid = tid_l(), lane = tid & 63, gw = blockIdx.x * 8 + (tid >> 6), ngw = gridDim.x * 8;
    bf16_t* QK = (bf16_t*)(p.ws + WS_BIG);
    float gq[8], gk[8];
#pragma unroll
    for (int e = 0; e < 8; ++e) { gq[e] = p.in[22][li * 64 + (lane & 7) * 8 + e] * 0.125f; gk[e] = p.in[23][li * 64 + (lane & 7) * 8 + e]; }
    for (int row = gw; row < MTOT; row += ngw) {
        bf16_t* rp = QK + (size_t)row * QK_LD + lane * 8;
        u32x4 v[4];
#pragma unroll
        for (int j = 0; j < 4; ++j) v[j] = *(const u32x4*)(rp + j * 512);
#pragma unroll
        for (int j = 0; j < 4; ++j) {
            float f[8]; unpack8(v[j], f);
            float ss = 0.f;
#pragma unroll
            for (int e = 0; e < 8; ++e) ss += f[e] * f[e];
            ss += __shfl_xor(ss, 1); ss += __shfl_xor(ss, 2); ss += __shfl_xor(ss, 4);
            const float rstd = rsqrtf(ss * (1.f / 64.f) + EPS);
#pragma unroll
            for (int e = 0; e < 8; ++e) f[e] *= rstd * (j < 2 ? gq[e] : gk[e]);
            *(u32x4*)(rp + j * 512) = pack8(f);
        }
    }
}

template <bool LAT>
__device__ __forceinline__ void attn_item(const Params& p, int li, int b, int h, int sub, bool stage = true) {
    const int tid = tid_l(), w = tid >> 6, lane = tid & 63, fr = lane & 15, fq = lane >> 4;
    bf16_t* Pw = (bf16_t*)dyn_lds + w * (16 * 264);
    bf16_t* KC = (bf16_t*)(dyn_lds + 67584);
    bf16_t* VC = (bf16_t*)(dyn_lds + 67584 + 36864);
    float* rpbs = (float*)(dyn_lds + 67584 + 36864 + 33792);
    const bf16_t* QK = (const bf16_t*)(p.ws + WS_BIG);
    const bf16_t* VTg = (const bf16_t*)(p.ws + WS_P2ODD);
    bf16_t* MIX = (bf16_t*)(p.ws + WS_ACT);
    if (stage) {
    if (LAT) { const float* rp = p.in[24] + ((size_t)li * 16 + h) * 465; for (int i = tid; i < 465; i += NT) rpbs[i] = rp[i]; }
    {
        u32x4 kv[4], vv[4];
#pragma unroll
        for (int i = 0; i < 4; ++i) {
            const int c = tid + i * NT;
            kv[i] = *(const u32x4*)(QK + (size_t)(NLAT + b * 256 + (c >> 3)) * QK_LD + 1024 + h * 64 + (c & 7) * 8);
            vv[i] = *(const u32x4*)(VTg + (size_t)(h * 64 + (c >> 5)) * VT_LD + NLAT + b * 256 + (c & 31) * 8);
        }
#pragma unroll
        for (int i = 0; i < 4; ++i) {
            const int c = tid + i * NT;
            *(u32x4*)(KC + (c >> 3) * 72 + (c & 7) * 8) = kv[i];
            *(u32x4*)(VC + (c >> 5) * 264 + (c & 31) * 8) = vv[i];
        }
    }
    __syncthreads();
    }
    int r = 0, c0 = 0, rs = 0, cw0 = 0, qtok0;
    if (LAT) { r = sub * 2 + (w >> 2); const int qt = w & 3; c0 = qt * 16; qtok0 = b * 2048 + r * 64 + c0; rs = min(max(r - 4, 0), 24); cw0 = (qt == 0) ? 0 : (qt == 1) ? 8 : (qt == 2) ? 24 : 32; }
    else { qtok0 = NLAT + b * 256 + (sub * 8 + w) * 16; }
    bf16x8 qf[2];
    {
        const bf16_t* qp = QK + (size_t)(qtok0 + fr) * QK_LD + h * 64 + fq * 8;
        qf[0] = *(const bf16x8*)qp; qf[1] = *(const bf16x8*)(qp + 32);
    }
    f32x4 o1[4], o2[4];
    float m1 = -1e30f, l1 = 0.f, m2, l2 = 0.f;
#pragma unroll
    for (int dt = 0; dt < 4; ++dt) { o1[dt] = (f32x4){0.f, 0.f, 0.f, 0.f}; o2[dt] = (f32x4){0.f, 0.f, 0.f, 0.f}; }
    if (LAT) {
        f32x4 sreg[16];
        const int qc = c0 + fr; const int cstart = min(max(qc - 8, 0), 48);
#pragma unroll
        for (int kt = 0; kt < 16; ++kt) {
            const int kr = kt >> 1, kcb = cw0 + (kt & 1) * 16;
            const bf16_t* kp = QK + (size_t)(b * 2048 + (rs + kr) * 64 + kcb + fr) * QK_LD + 1024 + h * 64 + fq * 8;
            f32x4 sa = (f32x4){0.f, 0.f, 0.f, 0.f};
            sa = mfma16(*(const bf16x8*)kp, qf[0], sa); sa = mfma16(*(const bf16x8*)(kp + 32), qf[1], sa);
            const int dri = (rs + kr - r + 7) * 31;
#pragma unroll
            for (int j = 0; j < 4; ++j) {
                const int kc = kcb + fq * 4 + j;
                const bool valid = (kc >= cstart) && (kc < cstart + 16);
                const int dci = min(max(kc - qc + 15, 0), 30);
                sa[j] = valid ? sa[j] + rpbs[dri + dci] : -1e30f;
            }
            sreg[kt] = sa;
            if ((kt & 7) == 7) __builtin_amdgcn_sched_barrier(0);
        }
#pragma unroll
        for (int kt = 0; kt < 16; ++kt)
#pragma unroll
            for (int j = 0; j < 4; ++j) m1 = fmaxf(m1, sreg[kt][j]);
        m1 = fmaxf(m1, __shfl_xor(m1, 16)); m1 = fmaxf(m1, __shfl_xor(m1, 32));
#pragma unroll
        for (int kt = 0; kt < 16; ++kt) {
            float pj[4];
#pragma unroll
            for (int j = 0; j < 4; ++j) { pj[j] = __expf(sreg[kt][j] - m1); l1 += pj[j]; }
            u32x2 o; o.x = pk2(pj[0], pj[1]); o.y = pk2(pj[2], pj[3]);
            *(u32x2*)(Pw + fr * 264 + kt * 16 + fq * 4) = o;
        }
        l1 += __shfl_xor(l1, 16); l1 += __shfl_xor(l1, 32);
#pragma unroll
        for (int kb = 0; kb < 8; kb += 4) {
            bf16x8 vf[4][4], pf[4];
#pragma unroll
            for (int u = 0; u < 4; ++u) {
                const int ks = kb + u;
                const int vtok0 = b * 2048 + (rs + ks) * 64 + cw0;
#pragma unroll
                for (int dt = 0; dt < 4; ++dt) vf[u][dt] = *(const bf16x8*)(VTg + (size_t)(h * 64 + dt * 16 + fr) * VT_LD + vtok0 + fq * 8);
                pf[u] = *(const bf16x8*)(Pw + fr * 264 + ks * 32 + fq * 8);
            }
#pragma unroll
            for (int u = 0; u < 4; ++u)
#pragma unroll
                for (int dt = 0; dt < 4; ++dt) o1[dt] = mfma16(vf[u][dt], pf[u], o1[dt]);
            __builtin_amdgcn_sched_barrier(0);
        }
    }
    {
        f32x4 sreg[16];
#pragma unroll
        for (int kt = 0; kt < 16; ++kt) {
            const bf16_t* kp = KC + (kt * 16 + fr) * 72 + fq * 8;
            f32x4 sa = (f32x4){0.f, 0.f, 0.f, 0.f};
            sa = mfma16(*(const bf16x8*)kp, qf[0], sa); sa = mfma16(*(const bf16x8*)(kp + 32), qf[1], sa);
            sreg[kt] = sa;
        }
        m2 = -1e30f;
#pragma unroll
        for (int kt = 0; kt < 16; ++kt)
#pragma unroll
            for (int j = 0; j < 4; ++j) m2 = fmaxf(m2, sreg[kt][j]);
        m2 = fmaxf(m2, __shfl_xor(m2, 16)); m2 = fmaxf(m2, __shfl_xor(m2, 32));
#pragma unroll
        for (int kt = 0; kt < 16; ++kt) {
            float pj[4];
#pragma unroll
            for (int j = 0; j < 4; ++j) { pj[j] = __expf(sreg[kt][j] - m2); l2 += pj[j]; }
            u32x2 o; o.x = pk2(pj[0], pj[1]); o.y = pk2(pj[2], pj[3]);
            *(u32x2*)(Pw + fr * 264 + kt * 16 + fq * 4) = o;
        }
        l2 += __shfl_xor(l2, 16); l2 += __shfl_xor(l2, 32);
#pragma unroll
        for (int ks = 0; ks < 8; ++ks) {
            const bf16x8 pf = *(const bf16x8*)(Pw + fr * 264 + ks * 32 + fq * 8);
#pragma unroll
            for (int dt = 0; dt < 4; ++dt) o2[dt] = mfma16(*(const bf16x8*)(VC + (dt * 16 + fr) * 264 + ks * 32 + fq * 8), pf, o2[dt]);
        }
    }
    const float mm = fmaxf(m1, m2);
    const float a1 = LAT ? __expf(m1 - mm) : 0.f, a2 = __expf(m2 - mm);
    const float inv = 1.f / (l1 * a1 + l2 * a2);
    const float s1 = a1 * inv, s2 = a2 * inv;
#pragma unroll
    for (int dt = 0; dt < 4; ++dt) {
        const f32x4 ov = o1[dt] * s1 + o2[dt] * s2;
        u32x2 o; o.x = pk2(ov[0], ov[1]); o.y = pk2(ov[2], ov[3]);
        *(u32x2*)(MIX + (size_t)(qtok0 + fr) * 1024 + h * 64 + dt * 16 + fq * 4) = o;
    }
    __syncthreads();
}


#ifdef DBG_NAN
__device__ __forceinline__ bool bad16(bf16_t v) { return ((v >> 7) & 0xFF) >= 227; }
__device__ __forceinline__ bool bad32(float f) { return !(fabsf(f) < 1e30f); }
__device__ __forceinline__ void scan16(const bf16_t* p, size_t n, unsigned* flags, unsigned bit) {
    bool bad = false;
    for (size_t i = (size_t)blockIdx.x * NT + threadIdx.x; i < n; i += (size_t)gridDim.x * NT) bad |= bad16(p[i]);
    if (bad) atomicOr(flags, bit);
}
__device__ __forceinline__ void scan32(const float* p, size_t n, unsigned* flags, unsigned bit) {
    bool bad = false;
    for (size_t i = (size_t)blockIdx.x * NT + threadIdx.x; i < n; i += (size_t)gridDim.x * NT) bad |= bad32(p[i]);
    if (bad) atomicOr(flags, bit);
}
#endif

#define XB_TMO      128
#define XB_XCNT(j)  (256  + 64 * (j))
#define XB_XSUB(j)  (1280 + 64 * (j))
#define XB_XGEN(j)  (2304 + 64 * (j))
#define XB_TOP      3328
#define XB_TOPGEN   3392
#define XCD_BAR_WORDS 3456
#define XB_SPIN_CAP (1u << 20)
#define LAS __attribute__((address_space(3)))
__device__ __forceinline__ unsigned xb_ld(unsigned* p)              { return __hip_atomic_load(p, __ATOMIC_RELAXED, __HIP_MEMORY_SCOPE_AGENT); }
__device__ __forceinline__ unsigned xb_add(unsigned* p, unsigned v) { return __hip_atomic_fetch_add(p, v, __ATOMIC_RELAXED, __HIP_MEMORY_SCOPE_AGENT); }
__device__ __forceinline__ unsigned xb_xcc_id() { return (unsigned)__builtin_amdgcn_s_getreg((3 << 11) | 20) & 0xFu; }
#define XB_SPIN(cond, bar) do { unsigned _sp = 0; while (cond) { __builtin_amdgcn_s_sleep(1); \
    if ((++_sp & 255u) == 0u) { if (xb_ld(&(bar)[XB_TMO])) break; if (_sp > XB_SPIN_CAP) { atomicAdd(&(bar)[XB_TMO], 1u); break; } } } } while (0)
struct XcdBarrier { unsigned* bar; unsigned x; volatile LAS unsigned* st; };
__device__ __forceinline__ XcdBarrier xcd_barrier_post(unsigned* bar, volatile LAS unsigned* st) {
    XcdBarrier b; b.bar = bar; b.x = xb_xcc_id(); b.st = st;
    if (threadIdx.x == 0) (void)xb_add(&bar[XB_XCNT(b.x)], 1u);
    return b;
}
__device__ __forceinline__ void xcd_barrier_complete(unsigned* bar, unsigned x, unsigned& nloc, unsigned& nx) {
    const unsigned G = gridDim.x * gridDim.y * gridDim.z;
    unsigned sum, cnt, mine, sp = 0u;
    for (;;) {
        sum = 0u; cnt = 0u; mine = 0u;
#pragma unroll
        for (unsigned j = 0; j < 16; ++j) { const unsigned c = xb_ld(&bar[XB_XCNT(j)]); sum += c; cnt += (c > 0u) ? 1u : 0u; mine = (j == x) ? c : mine; }
        if (sum == G) break;
        __builtin_amdgcn_s_sleep(1);
        if ((++sp & 255u) == 0u) { if (xb_ld(&bar[XB_TMO])) break; if (sp > XB_SPIN_CAP) { atomicAdd(&bar[XB_TMO], 1u); break; } }
    }
    nloc = mine > 0u ? mine : 1u; nx = cnt > 0u ? cnt : 1u;
}
__device__ __forceinline__ void xcd_barrier(const XcdBarrier& b) {
    asm volatile("s_waitcnt vmcnt(0)" ::: "memory");
    __syncthreads();
    if (threadIdx.x == 0) {
        unsigned* bar = b.bar;
        __builtin_amdgcn_s_waitcnt(0);
        unsigned nloc = b.st[0], nx = b.st[1];
        if (nloc == 0u) { xcd_barrier_complete(bar, b.x, nloc, nx); b.st[0] = nloc; b.st[1] = nx; }
        const unsigned old = xb_add(&bar[XB_XSUB(b.x)], 1u);
        const unsigned gen = old / nloc;
        if (old + 1u == (gen + 1u) * nloc) {
            __builtin_amdgcn_fence(__ATOMIC_RELEASE, "agent");
            asm volatile("s_waitcnt vmcnt(0)" ::: "memory");
            const unsigned og = xb_add(&bar[XB_TOP], 1u);
            const unsigned tg = og / nx;
            if (og + 1u == (tg + 1u) * nx) xb_add(&bar[XB_TOPGEN], 1u);
            else XB_SPIN(xb_ld(&bar[XB_TOPGEN]) == tg, bar);
            __builtin_amdgcn_fence(__ATOMIC_ACQUIRE, "agent");
            xb_add(&bar[XB_XGEN(b.x)], 1u);
            asm volatile("s_waitcnt vmcnt(0)" ::: "memory");
        } else {
            XB_SPIN(xb_ld(&bar[XB_XGEN(b.x)]) == gen, bar);
            __builtin_amdgcn_fence(__ATOMIC_ACQUIRE, "agent");
            asm volatile("s_waitcnt vmcnt(0)" ::: "memory");
        }
    }
    __syncthreads();
}
constexpr size_t WS_BAR = WS_END + 32768;

#ifdef TPROBE_A
#define GSYNC() do { asm volatile("s_waitcnt vmcnt(0) lgkmcnt(0)" ::: "memory"); grid.sync(); ++nsync_; if (nsync_ == TPROBE_A) t0_ = wall_clock64(); if (nsync_ == TPROBE_B) t1_ = wall_clock64(); } while (0)
#else
#define GSYNC() xcd_barrier(xbar_)
#endif
#define GSYNC_CG() do { asm volatile("s_waitcnt vmcnt(0) lgkmcnt(0)" ::: "memory"); grid.sync(); } while (0)
__global__ void __launch_bounds__(NT) fwd_megakernel(Params p) {
    cg::grid_group grid = cg::this_grid();
#ifdef TPROBE_A
    int nsync_ = 0; long long t0_ = 0, t1_ = 0;
#endif
    const int blk = blockIdx.x, G = gridDim.x;
    bf16_t* WIN = (bf16_t*)(p.ws + WS_WIN); bf16_t* WOUT = (bf16_t*)(p.ws + WS_WOUT); bf16_t* WM1 = (bf16_t*)(p.ws + WS_WM1); bf16_t* WM2 = (bf16_t*)(p.ws + WS_WM2);
    bf16_t* ACT = (bf16_t*)(p.ws + WS_ACT); bf16_t* BIG = (bf16_t*)(p.ws + WS_BIG);
    float* XC = (float*)(p.ws + WS_XC);
    const float* MOD = (const float*)(p.ws + WS_MOD);
    volatile LAS unsigned* xst_ = (volatile LAS unsigned*)(dyn_lds + LDS_BYTES - 16);
    if (threadIdx.x == 0) { xst_[0] = 0u; xst_[1] = 0u; }
    __syncthreads();
    const XcdBarrier xbar_ = xcd_barrier_post((unsigned*)(p.ws + WS_BAR), xst_);
    REP(64) if (PHMASK & 1) phase0(p);
#ifdef DBG_NAN
    unsigned* dflags = (unsigned*)(p.ws + WS_END);
    if (blk == 0 && threadIdx.x < 64) dflags[threadIdx.x] = 0u;
#endif
    GSYNC_CG();
#pragma unroll 1
    for (int l = 0; l < 4; ++l) {
        const bool even = !(l & 1), last = (l == 3); const int li = l >> 1;
        const float* xlat = (l == 0) ? p.in[0] : p.out; const float* xctx = (l == 0) ? p.in[2] : XC;
        const int Mtail = last ? NLAT : MTOT;
        REP(1) {
        if (PHMASK & 2) convert_weights(p, l, l == 0 || G < 256, true, 0, G);
        if (PHMASK & 4) norm_phase(p, l, xlat, xctx, 0, 1024, MTOT);
        if ((PHMASK & 8) && even) filter_gen(p, li);
        }
        GSYNC();
        {
            EpiArgs ea{}; ea.o_rm = BIG; ea.ld_rm = even ? 2048 : QK_LD; ea.o_cm = (bf16_t*)(p.ws + (even ? WS_P2 : WS_P2ODD)); ea.ld_cm = even ? MTOT : VT_LD; ea.gates = (float*)(p.ws + WS_GATES); ea.gate_pn = even ? 14 : -1; ea.o_dbg = (bf16_t*)(p.ws + WS_HFB);
            REP(2) if (PHMASK & 16) gemm_phase<EPI_INPROJ>(ACT, WIN, MTOT, even ? 3840 : 3072, 1024, ea);
        }
        GSYNC();
#ifdef DBG_NAN
        if (l == DBG_LAYER) {
            {
                const unsigned gid = blk * NT + threadIdx.x;
                unsigned hsh = gid * 2654435761u + 12345u; hsh ^= hsh >> 13; hsh *= 2246822519u; hsh ^= hsh >> 16;
                const int row = hsh % MTOT; const int col = (hsh >> 8) % 2048; const int ch = (hsh >> 4) % 1536;
                const bf16_t* ar = ACT + (size_t)row * 1024; const bf16_t* wq = WIN + (size_t)col * 1024; const bf16_t* wh = WIN + (size_t)(2048 + ch) * 1024;
                float sq = 0.f, sh_ = 0.f;
                for (int k = 0; k < 1024; ++k) { const float av = b2f(ar[k]); sq += av * b2f(wq[k]); sh_ += av * b2f(wh[k]); }
                const float gq = b2f(BIG[(size_t)row * 2048 + col]);
                const float gh = b2f(((const bf16_t*)(p.ws + WS_P2))[(size_t)ch * MTOT + row]);
                (void)gq; (void)sq;

                { const int cls = DBG_CLS; atomicAdd(dflags + 16 + cls, 1u);
                  if (!(fabsf(gh - sh_) <= 0.05f + 0.02f * fabsf(sh_))) { atomicAdd(dflags + 2, 1u); atomicAdd(dflags + 32 + cls, 1u); } }
            }
            GSYNC();
            if (blk == 0 && threadIdx.x == 0) {
                const float fQ = (float)__hip_atomic_load(dflags + 1, __ATOMIC_RELAXED, __HIP_MEMORY_SCOPE_AGENT) / (float)(G * NT);
                const float fH = (float)__hip_atomic_load(dflags + 2, __ATOMIC_RELAXED, __HIP_MEMORY_SCOPE_AGENT) / (float)(G * NT);
                unsigned mask = 0;
                for (int q_ = 0; q_ < 8; ++q_) { const unsigned tot = __hip_atomic_load(dflags + 16 + q_, __ATOMIC_RELAXED, __HIP_MEMORY_SCOPE_AGENT), bad = __hip_atomic_load(dflags + 32 + q_, __ATOMIC_RELAXED, __HIP_MEMORY_SCOPE_AGENT); if (bad * 4 > tot) mask |= 1u << q_; }
                float code = 1e5f; for (unsigned q_ = 0; q_ < (mask >> 4); ++q_) code *= 10.f;
                const unsigned n3 = __hip_atomic_load(dflags + 3, __ATOMIC_RELAXED, __HIP_MEMORY_SCOPE_AGENT), b1 = __hip_atomic_load(dflags + 1, __ATOMIC_RELAXED, __HIP_MEMORY_SCOPE_AGENT), b4 = __hip_atomic_load(dflags + 4, __ATOMIC_RELAXED, __HIP_MEMORY_SCOPE_AGENT);
                p.out[0] = code * (1.f + 0.5f * (float)(mask & 15)) + 0.f * (fQ + fH + (float)(n3 + b1 + b4));
            }
            return;
        }
#endif
        if (!even) { qknorm_phase(p, li); GSYNC(); }
        if (even) {
            REP(4) if (G >= 256) {
                if (blk < 128) { REP(512) if (PHMASK & 32) mlstm_item(p, li, blk);
                    if (DUPMASK & 1024) { hyena_item<2048>(p, li, 384 + blk, true); hyena_item<256>(p, li, 384 + blk, true); }
                    if (PHMASK & 64) { hyena_item<2048>(p, li, 384 + blk); } }
                else { const int hb = blk - 128;
                    if (DUPMASK & 1024) for (int it = hb; it < 384; it += 128) { hyena_item<2048>(p, li, it, true); hyena_item<256>(p, li, it, true); }
                    if (PHMASK & 64) { for (int it = hb; it < 384; it += 128) { hyena_item<2048>(p, li, it); hyena_item<256>(p, li, it); } hyena_item<256>(p, li, 384 + hb); } }
            } else {
            }
            GSYNC();
            if (PHMASK & 128) { combine_phase(p, li); hy_transpose(p); }
        } else {
            const int x = blk & 7, y = blk >> 3, ny = (G + 7) >> 3;
            REP(256) for (int i = 0; ; ++i) {
                const int slot = i * ny + y;
                if (slot >= 512) break;
                const int bh = x * 32 + 4 * (i >> 1) + (y >> 3), rp = (y & 7) * 2 + (i & 1);
                if (PHMASK & 256) attn_item<true>(p, li, bh >> 4, bh & 15, rp, (i & 1) == 0 || ny != 32);
            }
            if ((PHMASK & 512) && !last) for (int it = blk; it < 512; it += G) attn_item<false>(p, li, it >> 5, (it >> 1) & 15, it & 1);
        }
        GSYNC();
        {
            EpiArgs ea{}; ea.res_lat = xlat; ea.res_ctx = xctx; ea.out_lat = p.out; ea.out_ctx = XC; ea.modg = MOD + (size_t)l * 17 * 6144 + 2048;
            if (DUPMASK & 32) gemm_phase<EPI_DRY>(ACT, WOUT, Mtail, 1024, 1024, ea);
            if (PHMASK & 1024) gemm_phase<EPI_RESID>(ACT, WOUT, Mtail, 1024, 1024, ea);
        }
        GSYNC();
        REP(8) norm_phase(p, l, p.out, XC, 3072, 4096, Mtail);
        GSYNC();
        { EpiArgs ea{}; ea.o_rm = BIG; ea.ld_rm = 4096; ea.gate_pn = -1; REP(16) if (PHMASK & 2048) gemm_phase<EPI_RELU2>(ACT, WM1, Mtail, 4096, 1024, ea); }
        GSYNC();
        {
            EpiArgs ea{}; ea.res_lat = p.out; ea.res_ctx = XC; ea.out_lat = p.out; ea.out_ctx = XC; ea.modg = MOD + (size_t)l * 17 * 6144 + 5120;
            if (DUPMASK & 32) gemm_phase<EPI_DRY>(BIG, WM2, Mtail, 1024, 4096, ea);
            if (PHMASK & 4096) gemm_phase<EPI_RESID>(BIG, WM2, Mtail, 1024, 4096, ea);
            if (!last && G >= 256) convert_weights(p, l + 1, true, false, 128, G - 128);
        }
        GSYNC();
    }
#ifdef TPROBE_A
    if (blk == 0 && threadIdx.x == 0) p.out[0] = (float)(t1_ - t0_) * 10.f;
#endif
}

extern "C" void kernel_launch(void* const* d_in, const int* in_sizes, int n_in, void* d_out, int out_size, void* d_ws, size_t ws_size, hipStream_t stream) {
    static int grid_blocks = 0;
    if (grid_blocks == 0) {
        if (n_in != 26 || ws_size < WS_BAR + XCD_BAR_WORDS * 4) { fprintf(stderr, "kernel_launch: unexpected n_in %d or ws_size %zu (< %zu)\n", n_in, ws_size, (size_t)WS_END); grid_blocks = -1; return; }
        int dev = 0, cus = 0, per_cu = 0;
        hipGetDevice(&dev);
        hipDeviceGetAttribute(&cus, hipDeviceAttributeMultiprocessorCount, dev);
        if (hipFuncSetAttribute((const void*)fwd_megakernel, hipFuncAttributeMaxDynamicSharedMemorySize, LDS_BYTES) != hipSuccess) fprintf(stderr, "kernel_launch: hipFuncSetAttribute failed\n");
        if (hipOccupancyMaxActiveBlocksPerMultiprocessor(&per_cu, (const void*)fwd_megakernel, NT, LDS_BYTES) != hipSuccess || per_cu < 1) { fprintf(stderr, "kernel_launch: occupancy query gave %d\n", per_cu); per_cu = 1; }
        (void)hipGetLastError();
        grid_blocks = cus * 1;
        fprintf(stderr, "kernel_launch: cus %d per_cu %d grid %d\n", cus, per_cu, grid_blocks);
    }
    if (grid_blocks < 0) return;
    if (hipMemsetAsync((char*)d_ws + WS_BAR, 0, XCD_BAR_WORDS * 4, stream) != hipSuccess) { fprintf(stderr, "kernel_launch: memset of barrier words failed\n"); return; }
    Params p{};
    for (int i = 0; i < 26; ++i) p.in[i] = (const float*)d_in[i];
    p.out = (float*)d_out; p.ws = (unsigned char*)d_ws;
    void* args[] = {&p};
    hipError_t e = hipLaunchCooperativeKernel((void*)fwd_megakernel, dim3(grid_blocks), dim3(NT), args, LDS_BYTES, stream);
    if (e != hipSuccess) fprintf(stderr, "cooperative launch failed: %s (grid %d)\n", hipGetErrorString(e), grid_blocks);
}
```

```cpp
#include <hip/hip_runtime.h>
#include <hip/hip_cooperative_groups.h>
#include <cstdio>
#include <cstdint>
namespace cg = cooperative_groups;

typedef unsigned short bf16_t;
typedef short bf16x8 __attribute__((ext_vector_type(8)));
typedef float f32x4 __attribute__((ext_vector_type(4)));
typedef unsigned u32x4 __attribute__((ext_vector_type(4)));
typedef unsigned u32x2 __attribute__((ext_vector_type(2)));

#define NT 512
#define DBG_LAYER 0
#define DBG_CLS ((((row % 64) / 16) * 2) + ((ch % 32) / 16))
#ifndef PHMASK
#define PHMASK 0xFFFF
#endif
#ifndef DUPMASK
#define DUPMASK 0
#endif
#define REP(bit) for (int rep_ = 0; rep_ < (((DUPMASK) & (bit)) ? 2 : 1); ++rep_)
constexpr int BATCH = 16, SEQ = 2048, DM = 1024, CTXL = 256;
constexpr int NLAT = BATCH * SEQ, NCTX = BATCH * CTXL, MTOT = NLAT + NCTX;
constexpr int DFF = 4096;
constexpr float EPS = 1e-6f;
constexpr int LDS_BYTES = 147456;

constexpr size_t al256(size_t x) { return (x + 255) & ~(size_t)255; }
constexpr size_t WS_WIN = 0;
constexpr size_t WS_WOUT = al256(WS_WIN + (size_t)3840 * 1024 * 2);
constexpr size_t WS_WM1 = al256(WS_WOUT + (size_t)1024 * 1024 * 2);
constexpr size_t WS_WM2 = al256(WS_WM1 + (size_t)4096 * 1024 * 2);
constexpr size_t WS_MOD = al256(WS_WM2 + (size_t)4096 * 1024 * 2);
constexpr size_t WS_XC = al256(WS_MOD + (size_t)4 * 17 * 6144 * 4);
constexpr size_t WS_ACT = al256(WS_XC + (size_t)NCTX * 1024 * 4);
constexpr size_t WS_BIG = al256(WS_ACT + (size_t)MTOT * 1024 * 2);
constexpr size_t WS_P2 = WS_BIG + (size_t)MTOT * 2048 * 2;
constexpr int QK_LD = 2048 + 64;
constexpr int VT_LD = MTOT + 64;
constexpr size_t WS_P2ODD = WS_BIG + (size_t)MTOT * QK_LD * 2;
constexpr size_t WS_GATES = WS_P2 + (size_t)1536 * MTOT * 2;
constexpr size_t WS_HFB = al256(WS_BIG + (size_t)MTOT * 4096 * 2);
constexpr size_t WS_FLAT = al256(WS_HFB + (size_t)2 * MTOT * 512 * 2);
constexpr size_t WS_FCTX = al256(WS_FLAT + (size_t)2 * 512 * 4096 * 2);
constexpr size_t WS_H2 = al256(WS_FCTX + (size_t)2 * 512 * 512 * 2);
constexpr size_t WS_ROPE = al256(WS_H2 + (size_t)2 * 2304 * 64 * 4);
constexpr size_t WS_END = al256(WS_ROPE + (size_t)2 * 64 * 32 * 4);
static_assert(WS_GATES + (size_t)MTOT * 16 * 4 <= WS_HFB, "projection overlay too large");
static_assert(WS_P2ODD + (size_t)1024 * VT_LD * 2 <= WS_HFB, "odd projection overlay too large");

struct Params { const float* in[26]; float* out; unsigned char* ws; };

typedef float f32x2_ __attribute__((ext_vector_type(2)));
typedef __bf16 bf16x2_ __attribute__((ext_vector_type(2)));
__device__ __forceinline__ unsigned pk2(float lo, float hi) { f32x2_ v = {lo, hi}; bf16x2_ b = __builtin_convertvector(v, bf16x2_); return __builtin_bit_cast(unsigned, b); }
__device__ __forceinline__ bf16_t f2b(float x) { return (bf16_t)(pk2(x, 0.f) & 0xffffu); }
__device__ __forceinline__ float b2f(bf16_t b) { return __uint_as_float(((unsigned)b) << 16); }
__device__ __forceinline__ float blo(unsigned w) { return __uint_as_float(w << 16); }
__device__ __forceinline__ float bhi(unsigned w) { return __uint_as_float(w & 0xffff0000u); }
__device__ __forceinline__ void unpack8(u32x4 v, float* f) {
    f[0] = blo(v.x); f[1] = bhi(v.x); f[2] = blo(v.y); f[3] = bhi(v.y); f[4] = blo(v.z); f[5] = bhi(v.z); f[6] = blo(v.w); f[7] = bhi(v.w);
}
__device__ __forceinline__ u32x4 pack8(const float* f) { u32x4 r; r.x = pk2(f[0], f[1]); r.y = pk2(f[2], f[3]); r.z = pk2(f[4], f[5]); r.w = pk2(f[6], f[7]); return r; }
__device__ __forceinline__ float fsin_(float x) { float r = x * 0.15915494309189535f; r -= floorf(r); return __builtin_amdgcn_sinf(r); }
__device__ __forceinline__ float fcos_(float x) { float r = x * 0.15915494309189535f; r -= floorf(r); return __builtin_amdgcn_cosf(r); }
__device__ __forceinline__ float wave_sum(float v) {
#pragma unroll
    for (int o = 1; o < 64; o <<= 1) v += __shfl_xor(v, o);
    return v;
}
__device__ __forceinline__ f32x4 mfma16(bf16x8 a, bf16x8 b, f32x4 c) { return __builtin_amdgcn_mfma_f32_16x16x32_bf16(a, b, c, 0, 0, 0); }
__device__ __forceinline__ bf16x8 as_bf8(u32x4 v) { return __builtin_bit_cast(bf16x8, v); }

extern __shared__ __attribute__((aligned(16))) unsigned char dyn_lds[];
__device__ __forceinline__ int tid_l() { int t = threadIdx.x; asm volatile("" : "+v"(t)); return t; }

constexpr int G_BM = 256, G_BK = 64, G_HALF = 128, G_HT = G_HALF * G_BK;
__device__ __forceinline__ int lds_byte(int r, int c) {
    int st = (r >> 4) * 2 + (c >> 5), rr = r & 15, cc = c & 31, ob = rr * 64 + cc * 2;
    return st * 1024 + (ob ^ (((ob >> 9) & 1) << 5));
}
__device__ __forceinline__ void stage_rc(int b, int& R, int& C) {
    int st = b / 1024, sb = b % 1024, swz = sb ^ (((sb >> 9) & 1) << 5);
    R = (st >> 1) * 16 + swz / 64; C = (st & 1) * 32 + (swz % 64) / 2;
}

enum { EPI_INPROJ = 0, EPI_RESID = 1, EPI_RELU2 = 2, EPI_DRY = 3 };
struct EpiArgs {
    bf16_t* o_rm; int ld_rm;
    bf16_t* o_dbg;
    int ld_cm;
    bf16_t* o_cm;
    float* gates; int gate_pn;
    const float* res_lat; const float* res_ctx; float* out_lat; float* out_ctx; const float* modg;
};

#define WAIT_V_(n) asm volatile("s_waitcnt vmcnt(" #n ")" ::: "memory")
#define WAIT_V(n) WAIT_V_(n)
#ifndef GEMM_SGB
#define GEMM_SGB 0
#endif
#ifndef GEMM_VM
#define GEMM_VM 8
#endif
#define WAIT_L(n) asm volatile("s_waitcnt lgkmcnt(" #n ")" ::: "memory")
#define BAR __builtin_amdgcn_s_barrier()
#define CFENCE asm volatile("" ::: "memory")

template <bool TR, int NAI>
__device__ __forceinline__ void gemm_kloop(const bf16_t* __restrict__ A, const bf16_t* __restrict__ Bt, int K, int brow, int bcol, f32x4 (&acc)[NAI][2][4][2], int kt0, int nt) {
    bf16_t* shm = (bf16_t*)dyn_lds;
#define SA(b, h) (shm + ((b) * 2 + (h)) * G_HT)
#define SB(b, h) (shm + (4 + (b) * 2 + (h)) * G_HT)
    const int tidx = tid_l();
    const int wid = tidx >> 6, lane = tidx & 63, wr = wid >> 2, wc = wid & 3, fr = lane & 15, fq = lane >> 4;
    int goff[2];
#pragma unroll
    for (int i = 0; i < 2; ++i) { int r_, c_; stage_rc(tidx * 16 + i * 8192, r_, c_); goff[i] = r_ * K + c_; }
    const bf16_t* Ab = A + (long)brow * K + kt0 * G_BK; const bf16_t* Bb = Bt + (long)bcol * K + kt0 * G_BK;
#define STAGE2(P, BASEP, kt) do { _Pragma("unroll") for (int _i = 0; _i < 2; ++_i) \
      __builtin_amdgcn_global_load_lds((const unsigned*)((BASEP) + (kt) * G_BK + goff[_i]), (unsigned*)((char*)(P) + tidx * 16 + _i * 8192), 16, 0, 0); } while (0)
    STAGE2(SA(0, 0), Ab, 0); if (NAI == 2) STAGE2(SA(0, 1), Ab + (long)G_HALF * K, 0); STAGE2(SB(0, 0), Bb, 0); STAGE2(SB(0, 1), Bb + (long)G_HALF * K, 0);
    for (int kt = 0; kt < nt; ++kt) {
        const int cur = kt & 1, nxt = cur ^ 1;
        WAIT_V(0); WAIT_L(0);
        BAR; CFENCE;
#define LDBF(dst, k) _Pragma("unroll") for (int bj = 0; bj < 2; ++bj) _Pragma("unroll") for (int n = 0; n < 2; ++n) \
            dst[bj][n] = *reinterpret_cast<const bf16x8*>((char*)SB(cur, bj) + lds_byte(wc * 32 + n * 16 + fr, (k) * 32 + fq * 8))
#define LDAF(dst, ai, k) _Pragma("unroll") for (int m = 0; m < 4; ++m) \
            dst[m] = *reinterpret_cast<const bf16x8*>((char*)SA(cur, ai) + lds_byte(wr * 64 + m * 16 + fr, (k) * 32 + fq * 8))
#define MMAG(ai, Af_, Bf_) _Pragma("unroll") for (int m = 0; m < 4; ++m) _Pragma("unroll") for (int bj = 0; bj < 2; ++bj) _Pragma("unroll") for (int n = 0; n < 2; ++n) \
            acc[ai][bj][m][n] = TR ? mfma16(Bf_[bj][n], Af_[m], acc[ai][bj][m][n]) : mfma16(Af_[m], Bf_[bj][n], acc[ai][bj][m][n])
        bf16x8 B0[2][2], B1[2][2], A0[4], A1[4];
        LDBF(B0, 0); LDAF(A0, 0, 0); if (NAI == 2) { LDAF(A1, 1, 0); }
        if (kt + 1 < nt) {
            STAGE2(SA(nxt, 0), Ab, kt + 1); if (NAI == 2) STAGE2(SA(nxt, 1), Ab + (long)G_HALF * K, kt + 1);
            STAGE2(SB(nxt, 0), Bb, kt + 1); STAGE2(SB(nxt, 1), Bb + (long)G_HALF * K, kt + 1);
        }
        MMAG(0, A0, B0);
        LDBF(B1, 1); LDAF(A0, 0, 1);
        if (NAI == 2) { MMAG(NAI - 1, A1, B0); LDAF(A1, 1, 1); }
        MMAG(0, A0, B1);
        if (NAI == 2) { MMAG(NAI - 1, A1, B1); }
#if GEMM_SGB
        __builtin_amdgcn_sched_group_barrier(0x100, 12, 0);
        __builtin_amdgcn_sched_group_barrier(0x020, 8, 0);
        __builtin_amdgcn_sched_group_barrier(0x008, 16, 0);
        __builtin_amdgcn_sched_group_barrier(0x100, 8, 0);
        __builtin_amdgcn_sched_group_barrier(0x008, 16, 0);
        __builtin_amdgcn_sched_group_barrier(0x100, 4, 0);
        __builtin_amdgcn_sched_group_barrier(0x008, 32, 0);
#endif
    }
    WAIT_L(0); BAR; CFENCE;
}

template <int EPI, int NAI>
__device__ __forceinline__ void gemm_tile(const bf16_t* A, const bf16_t* Bt, int K, int brow, int bcol, int pn, const EpiArgs& ea, int wr, int wc, int fr, int fq) {
        constexpr bool SPLITTAIL = false; const int kq = -1, kt0 = 0, ntl = K / G_BK; (void)kq;
        f32x4 acc[NAI][2][4][2];
#pragma unroll
        for (int a = 0; a < NAI; ++a)
#pragma unroll
            for (int b = 0; b < 2; ++b)
#pragma unroll
                for (int m = 0; m < 4; ++m)
#pragma unroll
                    for (int n = 0; n < 2; ++n) acc[a][b][m][n] = (f32x4){0.f, 0.f, 0.f, 0.f};
        const bool colmajor = (EPI == EPI_INPROJ) && pn >= 8 && pn != ea.gate_pn;
        if (colmajor) {
            gemm_kloop<true, NAI>(A, Bt, K, brow, bcol, acc, kt0, ntl);
#pragma unroll
            for (int ai = 0; ai < NAI; ++ai)
#pragma unroll
                for (int bj = 0; bj < 2; ++bj)
#pragma unroll
                    for (int m = 0; m < 4; ++m)
#pragma unroll
                        for (int n = 0; n < 2; ++n) {
                            const int row = brow + ai * 128 + wr * 64 + m * 16 + fr, col = bcol + bj * 128 + wc * 32 + n * 16 + fq * 4;
                            const f32x4 v = acc[ai][bj][m][n];
#pragma unroll
                            for (int j = 0; j < 4; ++j) ea.o_cm[(size_t)(col + j - 2048) * ea.ld_cm + row] = f2b(v[j]);
                        }
        } else if (EPI == EPI_RELU2 || (EPI == EPI_INPROJ && pn != ea.gate_pn)) {
            gemm_kloop<true, NAI>(A, Bt, K, brow, bcol, acc, kt0, ntl);
            bf16_t* T = (bf16_t*)dyn_lds;
#pragma unroll
            for (int ai = 0; ai < NAI; ++ai)
#pragma unroll
                for (int m = 0; m < 4; ++m)
#pragma unroll
                    for (int bj = 0; bj < 2; ++bj)
#pragma unroll
                        for (int n = 0; n < 2; ++n) {
                            const f32x4 v = acc[ai][bj][m][n];
                            const float r0 = fmaxf(v[0], 0.f), r1 = fmaxf(v[1], 0.f), r2 = fmaxf(v[2], 0.f), r3 = fmaxf(v[3], 0.f);
                            u32x2 o;
                            if (EPI == EPI_RELU2) { o.x = pk2(r0 * r0, r1 * r1); o.y = pk2(r2 * r2, r3 * r3); }
                            else { o.x = pk2(v[0], v[1]); o.y = pk2(v[2], v[3]); }
                            *(u32x2*)(T + (ai * 128 + wr * 64 + m * 16 + fr) * 264 + bj * 128 + wc * 32 + n * 16 + fq * 4) = o;
                        }
            __syncthreads();
            {
                const int tt = tid_l();
#pragma unroll
                for (int i = 0; i < NAI * 8; ++i) {
                    const int c = tt + i * NT, row = c >> 5, cc = c & 31;
                    *(u32x4*)(ea.o_rm + (size_t)(brow + row) * ea.ld_rm + bcol + cc * 8) = *(const u32x4*)(T + row * 264 + cc * 8);
                }
            }
        } else if (EPI == EPI_RESID) {
            gemm_kloop<true, NAI>(A, Bt, K, brow, bcol, acc, kt0, ntl);
            const bool lat = brow < NLAT;
            const int mrow = lat ? brow >> 11 : 16;
            const float* rbase = lat ? ea.res_lat + (size_t)brow * 1024 : ea.res_ctx + (size_t)(brow - NLAT) * 1024;
            float* obase = lat ? ea.out_lat + (size_t)brow * 1024 : ea.out_ctx + (size_t)(brow - NLAT) * 1024;
            f32x4 g[2][2];
#pragma unroll
            for (int bj = 0; bj < 2; ++bj)
#pragma unroll
                for (int n = 0; n < 2; ++n) g[bj][n] = *(const f32x4*)(ea.modg + (size_t)mrow * 6144 + bcol + bj * 128 + wc * 32 + n * 16 + fq * 4);
            if (SPLITTAIL && kq >= 0) {
#pragma unroll
                for (int ai = 0; ai < NAI; ++ai)
#pragma unroll
                    for (int m = 0; m < 4; ++m)
#pragma unroll
                        for (int bj = 0; bj < 2; ++bj)
#pragma unroll
                            for (int n = 0; n < 2; ++n) {
                                float* op = obase + (size_t)(ai * 128 + wr * 64 + m * 16 + fr) * 1024 + bcol + bj * 128 + wc * 32 + n * 16 + fq * 4;
                                const f32x4 dv = g[bj][n] * acc[ai][bj][m][n];
#pragma unroll
                                for (int j = 0; j < 4; ++j) unsafeAtomicAdd(op + j, dv[j]);
                            }
            } else
#pragma unroll
            for (int ai = 0; ai < NAI; ++ai) {
                f32x4 xv[4][2][2];
#pragma unroll
                for (int m = 0; m < 4; ++m)
#pragma unroll
                    for (int bj = 0; bj < 2; ++bj)
#pragma unroll
                        for (int n = 0; n < 2; ++n)
                            xv[m][bj][n] = *(const f32x4*)(rbase + (size_t)(ai * 128 + wr * 64 + m * 16 + fr) * 1024 + bcol + bj * 128 + wc * 32 + n * 16 + fq * 4);
#pragma unroll
                for (int m = 0; m < 4; ++m)
#pragma unroll
                    for (int bj = 0; bj < 2; ++bj)
#pragma unroll
                        for (int n = 0; n < 2; ++n)
                            *(f32x4*)(obase + (size_t)(ai * 128 + wr * 64 + m * 16 + fr) * 1024 + bcol + bj * 128 + wc * 32 + n * 16 + fq * 4) = xv[m][bj][n] + g[bj][n] * acc[ai][bj][m][n];
            }
        } else {
            gemm_kloop<true, NAI>(A, Bt, K, brow, bcol, acc, kt0, ntl);
#pragma unroll
            for (int ai = 0; ai < NAI; ++ai)
#pragma unroll
                for (int m = 0; m < 4; ++m) {
                    const int row = brow + ai * 128 + wr * 64 + m * 16 + fr;
#pragma unroll
                    for (int bj = 0; bj < 2; ++bj)
#pragma unroll
                        for (int n = 0; n < 2; ++n) {
                            const int col = bcol + bj * 128 + wc * 32 + n * 16 + fq * 4;
                            const f32x4 v = acc[ai][bj][m][n];
                            if (EPI == EPI_INPROJ) {
                                if (pn == ea.gate_pn) {
                                    if (bj == 0 && wc == 0 && n == 0) *(f32x4*)(ea.gates + (size_t)row * 16 + fq * 4) = v;
                                } else {
                                    u32x2 o; o.x = pk2(v[0], v[1]); o.y = pk2(v[2], v[3]);
                                    *(u32x2*)(ea.o_rm + (size_t)row * ea.ld_rm + col) = o;
                                }
                            } else if (EPI == EPI_DRY) {
                                if (v[0] == 123456.789f && v[1] == 3.25f) *(f32x4*)(ea.out_lat + (size_t)row * 1024 + (col & 1023)) = v;
                            } else if (EPI == EPI_RELU2) {
                                float r0 = fmaxf(v[0], 0.f), r1 = fmaxf(v[1], 0.f), r2 = fmaxf(v[2], 0.f), r3 = fmaxf(v[3], 0.f);
                                u32x2 o; o.x = pk2(r0 * r0, r1 * r1); o.y = pk2(r2 * r2, r3 * r3);
                                *(u32x2*)(ea.o_rm + (size_t)row * ea.ld_rm + col) = o;
                            } else {
                                const float* rp; float* op; int mrow;
                                if (row < NLAT) { rp = ea.res_lat + (size_t)row * 1024 + col; op = ea.out_lat + (size_t)row * 1024 + col; mrow = row >> 11; }
                                else { rp = ea.res_ctx + (size_t)(row - NLAT) * 1024 + col; op = ea.out_ctx + (size_t)(row - NLAT) * 1024 + col; mrow = 16; }
                                const f32x4 g = *(const f32x4*)(ea.modg + (size_t)mrow * 6144 + col);
                                const f32x4 x = *(const f32x4*)rp;
                                f32x4 rr = x + g * v;
#ifdef SANITIZE
#pragma unroll
                                for (int q_ = 0; q_ < 4; ++q_) if (!(fabsf(rr[q_]) < 1e30f)) rr[q_] = 0.f;
#endif
                                *(f32x4*)op = rr;
                            }
                        }
                }
        }
        asm volatile("s_waitcnt vmcnt(0)" ::: "memory");
        __syncthreads();
}

template <int EPI, bool HALFTAIL = true>
__device__ __forceinline__ void gemm_phase(const bf16_t* A, const bf16_t* Bt, int M, int N, int K, const EpiArgs& ea) {
    const int nM = M / G_BM, nN = N / G_BM, nwg = nM * nN, G_ = gridDim.x;
    const int tidx = tid_l(); const int wid = tidx >> 6, lane = tidx & 63, wr = wid >> 2, wc = wid & 3, fr = lane & 15, fq = lane >> 4;
    int nfull = nwg;
    if (HALFTAIL) { const int rem = nwg % G_; if (rem > 0 && rem * 2 <= G_) nfull = nwg - rem; }
    const int nunits = nfull + (nwg - nfull) * 2;
    for (int U = blockIdx.x; U < nunits; U += G_) {
        const int L = U < nfull ? U : nfull + ((U - nfull) >> 1);
        const int half = U < nfull ? -1 : ((U - nfull) & 1);
        int wgid = L;
        { int q = nwg / 8, r = nwg % 8, xcd = wgid % 8, off = wgid / 8; wgid = (xcd < r ? xcd * (q + 1) : r * (q + 1) + (xcd - r) * q) + off; }
        const int nig = 4 * nN, gid = wgid / nig, fm = gid * 4, gsz = min(nM - fm, 4);
        const int pm = fm + ((wgid % nig) % gsz), pn = (wgid % nig) / gsz, bcol = pn * G_BM;
        if (half < 0) gemm_tile<EPI, 2>(A, Bt, K, pm * G_BM, bcol, pn, ea, wr, wc, fr, fq);
        else gemm_tile<EPI, 1>(A, Bt, K, pm * G_BM + half * 128, bcol, pn, ea, wr, wc, fr, fq);
    }
}

__device__ __forceinline__ void phase0(const Params& p) {
    const int tid = tid_l(), blk = blockIdx.x, nb = gridDim.x;
    float* MOD = (float*)(p.ws + WS_MOD);
    for (int it = blk; it < 193; it += nb) {
        if (it < 192) {
            float* sl = (float*)dyn_lds;
            float* red = sl + 17 * 1024;
            for (int i = tid; i < 17 * 1024; i += NT) { float v = (i < 16 * 1024) ? p.in[1][i] : p.in[3][i - 16 * 1024]; sl[i] = v / (1.f + __expf(-v)); }
            __syncthreads();
            const int l = it / 48, nc = it % 48, kp = tid >> 7, col = tid & 127;
            const float* W = p.in[4] + (size_t)l * 1024 * 6144 + nc * 128 + col;
            float acc[17];
#pragma unroll
            for (int r = 0; r < 17; ++r) acc[r] = 0.f;
            for (int k = kp * 256; k < kp * 256 + 256; ++k) {
                const float wv = W[(size_t)k * 6144];
#pragma unroll
                for (int r = 0; r < 17; ++r) acc[r] += sl[r * 1024 + k] * wv;
            }
#pragma unroll
            for (int r = 0; r < 17; ++r) red[(kp * 17 + r) * 128 + col] = acc[r];
            __syncthreads();
            for (int i = tid; i < 17 * 128; i += NT) {
                const int r = i >> 7, cc = i & 127;
                const float s = red[(0 * 17 + r) * 128 + cc] + red[(1 * 17 + r) * 128 + cc] + red[(2 * 17 + r) * 128 + cc] + red[(3 * 17 + r) * 128 + cc];
                MOD[((size_t)l * 17 + r) * 6144 + nc * 128 + cc] = s + p.in[5][l * 6144 + nc * 128 + cc];
            }
            __syncthreads();
        } else {
            float* ROPE = (float*)(p.ws + WS_ROPE);
            for (int i = tid; i < 2048; i += NT) {
                const int pos = i >> 5, j = i & 31;
                const float inv = exp2f(-(float)j * (13.287712379549449f / 32.f));
                const float ang = (float)pos * inv;
                ROPE[i] = fcos_(ang); ROPE[2048 + i] = fsin_(ang);
            }
        }
    }
    float* H2 = (float*)(p.ws + WS_H2);
    const int gw = blk * 8 + (tid >> 6), lane = tid & 63;
    for (int it = gw; it < 2 * 2304; it += nb * 8) {
        const int i = it / 2304, row = it % 2304;
        const int L = row < 2048 ? 2048 : 256, t = row < 2048 ? row : row - 2048;
        const float tn = (float)t / (float)(L - 1);
        const float wpos = 6.283185307179586f * (float)t / (float)L;
        float ev = 0.f;
        if (lane == 0) ev = tn;
        else if (lane <= 16) { const float fr = 1e-4f + (float)(lane - 1) * ((15.f - 1e-4f) / 15.f); ev = fcos_(wpos * fr); }
        else if (lane <= 32) { const float fr = 1e-4f + (float)(lane - 17) * ((15.f - 1e-4f) / 15.f); ev = -fsin_(wpos * fr); }
        const float* w1 = p.in[13] + i * 33 * 64; const float* b1 = p.in[14] + i * 64;
        const float* w2 = p.in[15] + i * 64 * 64; const float* b2 = p.in[16] + i * 64; const float* fq = p.in[18] + i * 64;
        float a = b1[lane];
        for (int e = 0; e < 33; ++e) a += __shfl(ev, e) * w1[e * 64 + lane];
        const float h1 = fsin_(fq[lane] * a);
        float a2 = b2[lane];
        for (int e = 0; e < 64; ++e) a2 += __shfl(h1, e) * w2[e * 64 + lane];
        H2[((size_t)i * 2304 + row) * 64 + lane] = fsin_(fq[lane] * a2);
    }
}

__device__ __forceinline__ void cvt_tile(const float* W, int N, int K, bf16_t* WT, int n0, int k0, int mapmode) {
    float* tl = (float*)dyn_lds;
    const int tid = tid_l(), nl = tid & 63, kb = tid >> 6;
    const int n = n0 + nl; int sc = n;
    if (mapmode == 1) sc = n < 2048 ? n : (n < 3584 ? n + 16 : (n < 3600 ? n - 3584 + 2048 : -1));
#pragma unroll
    for (int i = 0; i < 8; ++i) { const int kl = kb + 8 * i; tl[kl * 65 + nl] = sc >= 0 ? W[(size_t)(k0 + kl) * N + sc] : 0.f; }
    __syncthreads();
    const int nn = tid >> 3, kc = tid & 7;
    float f[8];
#pragma unroll
    for (int j = 0; j < 8; ++j) f[j] = tl[(kc * 8 + j) * 65 + nn];
    *(u32x4*)(WT + (size_t)(n0 + nn) * K + k0 + kc * 8) = pack8(f);
    __syncthreads();
}

__device__ __forceinline__ void convert_weights(const Params& p, int l, bool first_part, bool second_part, int bstart, int bcount) {
    const int blk = (int)blockIdx.x - bstart, nb = bcount, li = l >> 1; const bool even = !(l & 1);
    if (blk < 0 || blk >= bcount) return;
    const int nin = even ? 60 : 48;
    const int t_in = nin * 16, t_out = 256, t_m1 = 1024, t_m2 = 1024;
    const int it0 = first_part ? 0 : t_in + t_out + t_m1, it1 = second_part ? t_in + t_out + t_m1 + t_m2 : t_in + t_out + t_m1;
    for (int it = it0 + blk; it < it1; it += nb) {
        int r = it;
        if (r < t_in) {
            const int nt = r / 16, kt = r % 16;
            if (even) cvt_tile(p.in[8] + (size_t)li * 1024 * 3600, 3600, 1024, (bf16_t*)(p.ws + WS_WIN), nt * 64, kt * 64, 1);
            else cvt_tile(p.in[21] + (size_t)li * 1024 * 3072, 3072, 1024, (bf16_t*)(p.ws + WS_WIN), nt * 64, kt * 64, 0);
            continue;
        }
        r -= t_in;
        if (r < t_out) {
            const int nt = r / 16, kt = r % 16;
            cvt_tile((even ? p.in[20] : p.in[25]) + (size_t)li * 1024 * 1024, 1024, 1024, (bf16_t*)(p.ws + WS_WOUT), nt * 64, kt * 64, 0);
            continue;
        }
        r -= t_out;
        if (r < t_m1) {
            const int nt = r / 16, kt = r % 16;
            cvt_tile(p.in[6] + (size_t)l * 1024 * 4096, 4096, 1024, (bf16_t*)(p.ws + WS_WM1), nt * 64, kt * 64, 0);
            continue;
        }
        r -= t_m1;
        { const int nt = r / 64, kt = r % 64;
          cvt_tile(p.in[7] + (size_t)l * 4096 * 1024, 1024, 4096, (bf16_t*)(p.ws + WS_WM2), nt * 64, kt * 64, 0); }
    }
}

__device__ __forceinline__ void norm_phase(const Params& p, int l, const float* xlat, const float* xctx, int shoff, int scoff, int M) {
    const int tid = tid_l(), lane = tid & 63, gw = blockIdx.x * 8 + (tid >> 6), ngw = gridDim.x * 8;
    const float* MOD = (const float*)(p.ws + WS_MOD) + (size_t)l * 17 * 6144;
    bf16_t* ACT = (bf16_t*)(p.ws + WS_ACT);
    for (int row = gw; row < M; row += ngw) {
        const float* xr = row < NLAT ? xlat + (size_t)row * 1024 : xctx + (size_t)(row - NLAT) * 1024;
        const int mrow = row < NLAT ? row >> 11 : 16;
        const float* mod = MOD + (size_t)mrow * 6144;
        f32x4 v[4]; float ss = 0.f;
#pragma unroll
        for (int j = 0; j < 4; ++j) { v[j] = *(const f32x4*)(xr + 4 * lane + 256 * j); ss += v[j][0] * v[j][0] + v[j][1] * v[j][1] + v[j][2] * v[j][2] + v[j][3] * v[j][3]; }
        ss = wave_sum(ss);
        const float rstd = rsqrtf(ss * (1.f / 1024.f) + EPS);
#pragma unroll
        for (int j = 0; j < 4; ++j) {
            const int col = 4 * lane + 256 * j;
            const f32x4 sh = *(const f32x4*)(mod + shoff + col), sc = *(const f32x4*)(mod + scoff + col);
            const f32x4 y = v[j] * rstd * (sc + 1.f) + sh;
            u32x2 o; o.x = pk2(y[0], y[1]); o.y = pk2(y[2], y[3]);
            *(u32x2*)(ACT + (size_t)row * 1024 + col) = o;
        }
    }
}

__device__ __forceinline__ void filter_gen(const Params& p, int li) {
    const int tid = tid_l(), lane = tid & 63, w = tid >> 6;
    float* wf = (float*)dyn_lds; float* wb = wf + 64; float* red = wb + 64;
    const float* H2 = (const float*)(p.ws + WS_H2);
    for (int it = blockIdx.x; it < 2048; it += gridDim.x) {
        const int ltype = it >> 10, o = (it >> 9) & 1, c = it & 511;
        const int L = ltype ? 256 : 2048;
        const float* H2r = H2 + ((size_t)li * 2304 + (ltype ? 2048 : 0)) * 64;
        const float* w3 = p.in[17] + (size_t)li * 64 * 2048;
        if (tid < 64) wf[tid] = w3[tid * 2048 + (o * 2 + 0) * 512 + c];
        else if (tid < 128) wb[tid - 64] = w3[(tid - 64) * 2048 + (o * 2 + 1) * 512 + c];
        __syncthreads();
        const float lo = -4.605170185988091f / 1.5f, hi = -4.605170185988091f / 0.3f;
        const float delta = fabsf(lo + (hi - lo) * (float)c / 511.f);
        float vf[4], vb[4]; float ssf = 0.f, ssb = 0.f;
#pragma unroll
        for (int q = 0; q < 4; ++q) {
            const int t = tid + 512 * q; vf[q] = 0.f; vb[q] = 0.f;
            if (t < L) {
                float df = 0.f, db = 0.f;
                const f32x4* hr = (const f32x4*)(H2r + (size_t)t * 64);
#pragma unroll
                for (int j = 0; j < 16; ++j) { const f32x4 hv = hr[j];
                    df += hv[0] * wf[4 * j] + hv[1] * wf[4 * j + 1] + hv[2] * wf[4 * j + 2] + hv[3] * wf[4 * j + 3];
                    db += hv[0] * wb[4 * j] + hv[1] * wb[4 * j + 1] + hv[2] * wb[4 * j + 2] + hv[3] * wb[4 * j + 3]; }
                const float dec = __expf(-((float)t / (float)(L - 1)) * delta);
                vf[q] = df * dec; vb[q] = db * dec; ssf += vf[q] * vf[q]; ssb += vb[q] * vb[q];
            }
        }
        ssf = wave_sum(ssf); ssb = wave_sum(ssb);
        if (lane == 0) { red[w] = ssf; red[8 + w] = ssb; }
        __syncthreads();
        float tf = 0.f, tb = 0.f;
#pragma unroll
        for (int i = 0; i < 8; ++i) { tf += red[i]; tb += red[8 + i]; }
        const float nf = rsqrtf(tf + EPS), nbk = rsqrtf(tb + EPS);
        bf16_t* dst = ltype ? (bf16_t*)(p.ws + WS_FCTX) + ((size_t)o * 512 + c) * 512 : (bf16_t*)(p.ws + WS_FLAT) + ((size_t)o * 512 + c) * 4096;
#pragma unroll
        for (int q = 0; q < 4; ++q) {
            const int t = tid + 512 * q;
            if (t < L) {
                if (t == 0) { dst[L] = f2b(vf[q] * nf + vb[q] * nbk); dst[0] = 0; }
                else { dst[L + t] = f2b(vf[q] * nf); dst[L - t] = f2b(vb[q] * nbk); }
            }
        }
        __syncthreads();
    }
}

__device__ __forceinline__ void mlstm_item(const Params& p, int li, int it) {
    const int tid = tid_l(), w = tid >> 6, lane = tid & 63, fr = lane & 15, fq = lane >> 4;
    const int b = it >> 3, h = (it >> 1) & 3, dir = it & 1;
    bf16_t* Qs = (bf16_t*)dyn_lds;
    bf16_t* Ks = Qs + 64 * 136;
    bf16_t* KT = Ks + 64 * 136;
    bf16_t* VT = KT + 128 * 72;
    bf16_t* Cb = VT + 144 * 72;
    bf16_t* Ps = Cb + 144 * 136;
    float* fl = (float*)(Ps + 64 * 72);
    float* a_s = fl; float* Mt = fl + 64; float* scs = fl + 128; float* emt = fl + 192; float* den = fl + 256; float* lfs = fl + 320; float* igs = fl + 384; float* scal = fl + 448;
    const bf16_t* QKVO = (const bf16_t*)(p.ws + WS_BIG);
    const float* GATES = (const float*)(p.ws + WS_GATES);
    bf16_t* HFB = (bf16_t*)(p.ws + WS_HFB) + (size_t)dir * MTOT * 512;
    const float* ROPE = (const float*)(p.ws + WS_ROPE);
    const float* gate_b = p.in[9] + li * 16;
    for (int i = tid; i < 144 * 136 / 2; i += NT) ((unsigned*)Cb)[i] = 0u;
    for (int i = tid; i < 16 * 72; i += NT) { const int r = i / 72, ci = i % 72; VT[(128 + r) * 72 + ci] = (r == 0 && ci < 64) ? (bf16_t)0x3F80 : (bf16_t)0; }
    f32x4 cacc[9];
#pragma unroll
    for (int i = 0; i < 9; ++i) cacc[i] = (f32x4){0.f, 0.f, 0.f, 0.f};
    float m = 0.f;
    const int pr_r = tid >> 3, pr_seg = tid & 7, pr_tl = dir ? 63 - pr_r : pr_r, pr_tl2 = dir ? 63 - (tid & 63) : (tid & 63);
    const int pr_d1 = (pr_seg >> 2) * 64 + (pr_seg & 3) * 8;
    u32x4 pf_q1, pf_q2, pf_k1, pf_k2, pf_v1, pf_v2; float pgi = 0.f, pgf = 0.f;
#define MLSTM_ISSUE(ST_) do { const int st_ = (ST_); const bool ic_ = st_ < 4; const int cjn_ = ic_ ? (dir ? 3 - st_ : st_) : (dir ? 35 - st_ : st_ - 4); \
        const int rb_ = ic_ ? NLAT + b * 256 + cjn_ * 64 : b * 2048 + cjn_ * 64; \
        const bf16_t* sp_ = QKVO + (size_t)(rb_ + pr_tl) * 2048 + h * 128; \
        pf_q1 = *(const u32x4*)(sp_ + pr_d1); pf_q2 = *(const u32x4*)(sp_ + pr_d1 + 32); pf_k1 = *(const u32x4*)(sp_ + 512 + pr_d1); pf_k2 = *(const u32x4*)(sp_ + 512 + pr_d1 + 32); \
        pf_v1 = *(const u32x4*)(sp_ + 1024 + pr_seg * 16); pf_v2 = *(const u32x4*)(sp_ + 1024 + pr_seg * 16 + 8); \
        if (tid < 64) { const float* g_ = GATES + (size_t)(rb_ + pr_tl2) * 16; pgi = g_[dir * 8 + h]; pgf = g_[dir * 8 + 4 + h]; } } while (0)
    MLSTM_ISSUE(0);
    __syncthreads();
    for (int step = 0; step < 36; ++step) {
        const bool isctx = step < 4;
        const int cj = isctx ? (dir ? 3 - step : step) : (dir ? 35 - step : step - 4);
        const int rowbase = isctx ? NLAT + b * 256 + cj * 64 : b * 2048 + cj * 64;
        {
            const int r = tid >> 3, seg = tid & 7; const int tl = dir ? 63 - r : r;
            const int hb = seg >> 2, jb = (seg & 3) * 8, d1 = hb * 64 + jb, d2 = d1 + 32;
            const u32x4 q1 = pf_q1, q2 = pf_q2, k1 = pf_k1, k2 = pf_k2, v1 = pf_v1, v2 = pf_v2;
            const float cgi = pgi, cgf = pgf;
            if (step + 1 < 36) MLSTM_ISSUE(step + 1);
            float cs[8], sn[8];
            if (!isctx) {
                const int pos = hb ? tl : cj;
                const f32x4 c0 = *(const f32x4*)(ROPE + pos * 32 + jb), c1 = *(const f32x4*)(ROPE + pos * 32 + jb + 4);
                const f32x4 s0 = *(const f32x4*)(ROPE + 2048 + pos * 32 + jb), s1 = *(const f32x4*)(ROPE + 2048 + pos * 32 + jb + 4);
#pragma unroll
                for (int e = 0; e < 4; ++e) { cs[e] = c0[e]; cs[4 + e] = c1[e]; sn[e] = s0[e]; sn[4 + e] = s1[e]; }
            } else {
#pragma unroll
                for (int e = 0; e < 8; ++e) { cs[e] = 1.f; sn[e] = 0.f; }
            }
            float x1[8], x2[8], o1[8], o2[8];
            unpack8(q1, x1); unpack8(q2, x2);
#pragma unroll
            for (int e = 0; e < 8; ++e) { o1[e] = x1[e] * cs[e] - x2[e] * sn[e]; o2[e] = x1[e] * sn[e] + x2[e] * cs[e]; }
            *(u32x4*)(Qs + r * 136 + d1) = pack8(o1); *(u32x4*)(Qs + r * 136 + d2) = pack8(o2);
            unpack8(k1, x1); unpack8(k2, x2);
            const float ksc = 0.08838834764831845f;
#pragma unroll
            for (int e = 0; e < 8; ++e) { o1[e] = (x1[e] * cs[e] - x2[e] * sn[e]) * ksc; o2[e] = (x1[e] * sn[e] + x2[e] * cs[e]) * ksc; }
            const u32x4 ko1 = pack8(o1), ko2 = pack8(o2);
            *(u32x4*)(Ks + r * 136 + d1) = ko1; *(u32x4*)(Ks + r * 136 + d2) = ko2;
            {
                const unsigned kw1[4] = {ko1.x, ko1.y, ko1.z, ko1.w}, kw2[4] = {ko2.x, ko2.y, ko2.z, ko2.w};
#pragma unroll
                for (int e = 0; e < 4; ++e) {
                    KT[(d1 + 2 * e) * 72 + r] = (bf16_t)(kw1[e] & 0xffffu); KT[(d1 + 2 * e + 1) * 72 + r] = (bf16_t)(kw1[e] >> 16);
                    KT[(d2 + 2 * e) * 72 + r] = (bf16_t)(kw2[e] & 0xffffu); KT[(d2 + 2 * e + 1) * 72 + r] = (bf16_t)(kw2[e] >> 16);
                }
                const unsigned vw1[4] = {v1.x, v1.y, v1.z, v1.w}, vw2[4] = {v2.x, v2.y, v2.z, v2.w};
#pragma unroll
                for (int e = 0; e < 4; ++e) {
                    VT[(seg * 16 + 2 * e) * 72 + r] = (bf16_t)(vw1[e] & 0xffffu); VT[(seg * 16 + 2 * e + 1) * 72 + r] = (bf16_t)(vw1[e] >> 16);
                    VT[(seg * 16 + 8 + 2 * e) * 72 + r] = (bf16_t)(vw2[e] & 0xffffu); VT[(seg * 16 + 8 + 2 * e + 1) * 72 + r] = (bf16_t)(vw2[e] >> 16);
                }
            }
            if (tid < 64) {
                const int rr = tid;
                const float ig = cgi + gate_b[dir * 8 + h];
                const float fg = cgf + gate_b[dir * 8 + 4 + h];
                igs[rr] = ig; lfs[rr] = fminf(fg, 0.f) - __logf(1.f + __expf(-fabsf(fg)));
            }
        }
        __syncthreads();
        if (w == 0) {
            float bcs = lfs[lane];
#pragma unroll
            for (int o = 1; o < 64; o <<= 1) { const float t = __shfl_up(bcs, o); if (lane >= o) bcs += t; }
            const float a = igs[lane] - bcs;
            float pm = a;
#pragma unroll
            for (int o = 1; o < 64; o <<= 1) { const float t = __shfl_up(pm, o); if (lane >= o) pm = fmaxf(pm, t); }
            const float Mx = fmaxf(m, pm);
            a_s[lane] = a; Mt[lane] = Mx; scs[lane] = __expf(m - Mx); emt[lane] = __expf(-bcs - Mx);
            if (lane == 63) { scal[0] = bcs; scal[1] = Mx; }
        }
        {
            const int st = w & 3, tt0 = (w >> 2) * 2;
            f32x4 sacc[2];
#pragma unroll
            for (int u = 0; u < 2; ++u) {
                sacc[u] = (f32x4){0.f, 0.f, 0.f, 0.f};
#pragma unroll
                for (int kk = 0; kk < 4; ++kk) {
                    const bf16x8 Ak = *(const bf16x8*)(Ks + (st * 16 + fr) * 136 + kk * 32 + fq * 8);
                    const bf16x8 Bq = *(const bf16x8*)(Qs + ((tt0 + u) * 16 + fr) * 136 + kk * 32 + fq * 8);
                    sacc[u] = mfma16(Ak, Bq, sacc[u]);
                }
            }
            __syncthreads();
#pragma unroll
            for (int u = 0; u < 2; ++u) {
                const int t = (tt0 + u) * 16 + fr, sb = st * 16 + fq * 4;
                const float Mv = Mt[t];
                float pv[4];
#pragma unroll
                for (int j = 0; j < 4; ++j) { const int s = sb + j; pv[j] = (s <= t) ? sacc[u][j] * __expf(a_s[s] - Mv) : 0.f; }
                u32x2 o; o.x = pk2(pv[0], pv[1]); o.y = pk2(pv[2], pv[3]);
                *(u32x2*)(Ps + t * 72 + sb) = o;
            }
        }
        __syncthreads();
        {
            const int tt = w & 3, up = w >> 2, vt0 = up ? 5 : 0, nvt = up ? 4 : 5;
            bf16x8 qf[4], pf[2];
#pragma unroll
            for (int kk = 0; kk < 4; ++kk) qf[kk] = *(const bf16x8*)(Qs + (tt * 16 + fr) * 136 + kk * 32 + fq * 8);
#pragma unroll
            for (int kk = 0; kk < 2; ++kk) pf[kk] = *(const bf16x8*)(Ps + (tt * 16 + fr) * 72 + kk * 32 + fq * 8);
            const float sct = scs[tt * 16 + fr];
            f32x4 hacc[5];
#pragma unroll
            for (int vi = 0; vi < 5; ++vi) {
                hacc[vi] = (f32x4){0.f, 0.f, 0.f, 0.f};
                if (vi < nvt) {
                    const int v0 = (vt0 + vi) * 16;
                    f32x4 ac = (f32x4){0.f, 0.f, 0.f, 0.f};
#pragma unroll
                    for (int kk = 0; kk < 4; ++kk) ac = mfma16(*(const bf16x8*)(Cb + (v0 + fr) * 136 + kk * 32 + fq * 8), qf[kk], ac);
                    ac = ac * sct;
#pragma unroll
                    for (int kk = 0; kk < 2; ++kk) ac = mfma16(*(const bf16x8*)(VT + (v0 + fr) * 72 + kk * 32 + fq * 8), pf[kk], ac);
                    hacc[vi] = ac;
                }
            }
            if (up && fq == 0) den[tt * 16 + fr] = hacc[3][0];
            __syncthreads();
            const int t = tt * 16 + fr, tl = dir ? 63 - t : t;
            const float dn = den[t];
            const float inv = 1.f / fmaxf(fabsf(dn), emt[t]);
            bf16_t* orow = HFB + (size_t)(rowbase + tl) * 512 + h * 128;
#pragma unroll
            for (int vi = 0; vi < 5; ++vi) {
                if (vi < nvt && (vt0 + vi) < 8) {
                    const int v0 = (vt0 + vi) * 16 + fq * 4;
                    u32x2 o; o.x = pk2(hacc[vi][0] * inv, hacc[vi][1] * inv); o.y = pk2(hacc[vi][2] * inv, hacc[vi][3] * inv);
                    *(u32x2*)(orow + v0) = o;
                }
            }
        }
        {
            const float bl = scal[0], M63 = scal[1];
            const float decay = __expf(m - M63);
            bf16x8 ka[2];
#pragma unroll
            for (int kk = 0; kk < 2; ++kk) {
                const u32x4 raw = *(const u32x4*)(KT + (w * 16 + fr) * 72 + kk * 32 + fq * 8);
                float f[8]; unpack8(raw, f);
#pragma unroll
                for (int j = 0; j < 8; ++j) f[j] *= __expf(a_s[kk * 32 + fq * 8 + j] - M63);
                ka[kk] = as_bf8(pack8(f));
            }
#pragma unroll
            for (int vt = 0; vt < 9; ++vt) {
                f32x4 ac = cacc[vt] * decay;
#pragma unroll
                for (int kk = 0; kk < 2; ++kk) ac = mfma16(ka[kk], *(const bf16x8*)(VT + (vt * 16 + fr) * 72 + kk * 32 + fq * 8), ac);
                cacc[vt] = ac;
                u32x2 o; o.x = pk2(ac[0], ac[1]); o.y = pk2(ac[2], ac[3]);
                *(u32x2*)(Cb + (vt * 16 + fr) * 136 + w * 16 + fq * 4) = o;
            }
            m = bl + M63;
        }
        __syncthreads();
    }
}

__device__ __forceinline__ void combine_phase(const Params& p, int li) {
    const int tid = tid_l(), lane = tid & 63, gw = blockIdx.x * 8 + (tid >> 6), ngw = gridDim.x * 8;
    const bf16_t* HF = (const bf16_t*)(p.ws + WS_HFB); const bf16_t* HB = HF + (size_t)MTOT * 512;
    const bf16_t* QKVO = (const bf16_t*)(p.ws + WS_BIG);
    bf16_t* MIX = (bf16_t*)(p.ws + WS_ACT);
    const float* hn = p.in[10] + li * 512 + lane * 8;
    float g[8];
#pragma unroll
    for (int e = 0; e < 8; ++e) g[e] = hn[e];
    for (int row = gw; row < MTOT; row += ngw) {
        float a[8], bq[8], og[8], y[8];
        unpack8(*(const u32x4*)(HF + (size_t)row * 512 + lane * 8), a);
        unpack8(*(const u32x4*)(HB + (size_t)row * 512 + lane * 8), bq);
        unpack8(*(const u32x4*)(QKVO + (size_t)row * 2048 + 1536 + lane * 8), og);
        float ss = 0.f;
#pragma unroll
        for (int e = 0; e < 8; ++e) { a[e] += bq[e]; ss += a[e] * a[e]; }
        ss += __shfl_xor(ss, 1); ss += __shfl_xor(ss, 2); ss += __shfl_xor(ss, 4); ss += __shfl_xor(ss, 8);
        const float rstd = rsqrtf(ss * (1.f / 128.f) + EPS);
#pragma unroll
        for (int e = 0; e < 8; ++e) y[e] = a[e] * rstd * g[e] / (1.f + __expf(-og[e]));
        *(u32x4*)(MIX + (size_t)row * 1024 + lane * 8) = pack8(y);
    }
}

__device__ __forceinline__ bf16x8 hy_afrag(const bf16_t* HRp, int q, int m, int o4, int hsh) {
    const bf16_t* ap = HRp + (q + 8 - m);
    const u32x4 lo = *(const u32x4*)ap, hi = *(const u32x4*)(ap + 8);
    const bool b0 = (o4 & 1) != 0, b1 = (o4 & 2) != 0;
#define HYSEL(A_, B_, C_, D_) (b1 ? (b0 ? (D_) : (C_)) : (b0 ? (B_) : (A_)))
    const unsigned w0 = HYSEL(lo.x, lo.y, lo.z, lo.w), w1 = HYSEL(lo.y, lo.z, lo.w, hi.x), w2 = HYSEL(lo.z, lo.w, hi.x, hi.y),
                   w3 = HYSEL(lo.w, hi.x, hi.y, hi.z), w4 = HYSEL(hi.x, hi.y, hi.z, hi.w);
#undef HYSEL
    u32x4 o;
    o.x = __builtin_amdgcn_alignbit(w1, w0, hsh); o.y = __builtin_amdgcn_alignbit(w2, w1, hsh);
    o.z = __builtin_amdgcn_alignbit(w3, w2, hsh); o.w = __builtin_amdgcn_alignbit(w4, w3, hsh);
    return as_bf8(o);
}

template <int L>
__device__ __forceinline__ void hyena_item(const Params& p, int li, int c, bool dry = false) {
    constexpr int ZS = L + 8, NI = L / 128, NS = L / 32;
    const int tid = tid_l(), w = tid >> 6, lane = tid & 63, fr = lane & 15, fq = lane >> 4;
    bf16_t* ZA = (bf16_t*)dyn_lds; bf16_t* ZB = ZA + 16 * ZS; bf16_t* HFl = ZB + 16 * ZS;
    const int segbase = (L == 2048) ? 0 : NLAT;
    const bf16_t* HYT = (const bf16_t*)(p.ws + WS_P2);
    bf16_t* MIX = (bf16_t*)(p.ws + WS_ACT);
    const float* cw = p.in[11] + (size_t)li * 3 * 1536; const float* cb = p.in[12] + (size_t)li * 1536; const float* hd = p.in[19] + (size_t)li * 2 * 512;
    const bf16_t* FIL = (L == 2048) ? (const bf16_t*)(p.ws + WS_FLAT) : (const bf16_t*)(p.ws + WS_FCTX);
    {
        const float w0 = cw[c], w1 = cw[1536 + c], w2 = cw[2 * 1536 + c], bb = cb[c];
        const bf16_t* src = HYT + (size_t)c * MTOT + segbase;
#pragma unroll
        for (int ci = 0; ci < (16 * L / 8 + NT - 1) / NT; ++ci) {
            const int ch = tid + ci * NT; if (ch >= 16 * L / 8) break;
            const int b = ch / (L / 8), t0 = (ch % (L / 8)) * 8;
            const bf16_t* s = src + b * L + t0;
            float x[10], y[8];
            const float xl = b2f(s[t0 > 0 ? -1 : 0]), xr = b2f(s[(t0 + 8 < L) ? 8 : 7]);
            unpack8(*(const u32x4*)s, x + 1);
            x[0] = t0 > 0 ? xl : 0.f; x[9] = (t0 + 8 < L) ? xr : 0.f;
#pragma unroll
            for (int e = 0; e < 8; ++e) y[e] = bb + w0 * x[e] + w1 * x[e + 1] + w2 * x[e + 2];
            *(u32x4*)(ZA + b * ZS + t0) = pack8(y);
        }
    }
#pragma unroll 1
    for (int o = 0; o < 2; ++o) {
        for (int i = tid; i < 2 * L / 8; i += NT) {
            const u32x4 v = *(const u32x4*)(FIL + ((size_t)o * 512 + c) * 2 * L + i * 8);
            u32x4 rv; rv.x = (v.w >> 16) | (v.w << 16); rv.y = (v.z >> 16) | (v.z << 16); rv.z = (v.y >> 16) | (v.y << 16); rv.w = (v.x >> 16) | (v.x << 16);
            *(u32x4*)(HFl + 8 + 2 * L - 8 - 8 * i) = rv;
        }
        if (tid < 8) HFl[tid] = 0; else if (tid < 24) HFl[2 * L + tid] = 0;
        __syncthreads();
        const bf16_t* Zin = o ? ZB : ZA;
        const int gc = (o + 1) * 512 + c;
        const float gw0 = cw[gc], gw1 = cw[1536 + gc], gw2 = cw[2 * 1536 + gc], gb = cb[gc], dsk = hd[o * 512 + c];
        const bf16_t* gs = HYT + (size_t)gc * MTOT + segbase + fr * L;
        constexpr int NIB = NI < 8 ? NI : 8;
#pragma unroll 1
        for (int hp = 0; hp < NI; hp += NIB) {
            f32x4 acc[NIB];
#pragma unroll
            for (int i = 0; i < NIB; ++i) acc[i] = (f32x4){0.f, 0.f, 0.f, 0.f};
            constexpr int NQ = NS / 4;
            const int am = (7 - fr) & 7, ao4 = am >> 1, ahs = (am & 1) * 16;
            u32x2 pgv[NIB]; bf16_t pxl[NIB], pxr[NIB];
#pragma unroll
            for (int i = 0; i < NIB; ++i) {
                const int t0 = 16 * (w + 8 * (hp + i)) + fq * 4;
                pxl[i] = gs[t0 > 0 ? t0 - 1 : 0]; pxr[i] = gs[(t0 + 4 < L) ? t0 + 4 : L - 1];
                pgv[i] = *(const u32x2*)(gs + t0);
            }
#pragma unroll 1
            for (int r = 0; r < 4; ++r) {
                bf16x8 Aw[NIB];
#pragma unroll
                for (int i = 0; i < NIB; ++i) {
                    Aw[i] = hy_afrag(HFl, (L - 1) - 16 * w - 32 * (4 * (hp + i) - r) - fr + fq * 8, am, ao4, ahs);
                }
#pragma unroll 1
                for (int qc = 0; qc < NQ; qc += NIB) {
#pragma unroll
                    for (int qq = 0; qq < NIB; ++qq) {
                        const int q = qc + qq;
                        const bf16x8 Bz = *(const bf16x8*)(Zin + fr * ZS + (4 * q + r) * 32 + fq * 8);
#pragma unroll
                        for (int i = 0; i < NIB; ++i) acc[i] = mfma16(Aw[(i - qq + NIB) % NIB], Bz, acc[i]);
                        if (q + 1 < NQ) {
                            Aw[(NIB - 1 - qq) % NIB] = hy_afrag(HFl, (L - 1) - 16 * w - 32 * (4 * (hp - q - 1) - r) - fr + fq * 8, am, ao4, ahs);
                        }
                    }
                }
            }
#pragma unroll
            for (int i = 0; i < NIB; ++i) {
                const int t0 = 16 * (w + 8 * (hp + i)) + fq * 4;
                float x[6];
                const float xl = b2f(pxl[i]), xr = b2f(pxr[i]);
                const u32x2 gv = pgv[i];
                x[0] = t0 > 0 ? xl : 0.f;
                x[1] = blo(gv.x); x[2] = bhi(gv.x); x[3] = blo(gv.y); x[4] = bhi(gv.y);
                x[5] = (t0 + 4 < L) ? xr : 0.f;
                const u32x2 zv = *(const u32x2*)(Zin + fr * ZS + t0);
                const float z[4] = {blo(zv.x), bhi(zv.x), blo(zv.y), bhi(zv.y)};
                float val[4];
#pragma unroll
                for (int j = 0; j < 4; ++j) val[j] = (gb + gw0 * x[j] + gw1 * x[j + 1] + gw2 * x[j + 2]) * (acc[i][j] + dsk * z[j]);
                { u32x2 ov; ov.x = pk2(val[0], val[1]); ov.y = pk2(val[2], val[3]); *(u32x2*)((o == 0 ? ZB : ZA) + fr * ZS + t0) = ov; }
            }
        }
        __syncthreads();
    }
    if (!dry) {
        bf16_t* dstp = (bf16_t*)(p.ws + WS_P2) + (size_t)c * MTOT + segbase;
#pragma unroll
        for (int ci = 0; ci < (16 * L / 8 + NT - 1) / NT; ++ci) {
            const int ch = tid + ci * NT; if (ch >= 16 * L / 8) break;
            const int b = ch / (L / 8), t0 = (ch % (L / 8)) * 8;
            *(u32x4*)(dstp + b * L + t0) = *(const u32x4*)(ZA + b * ZS + t0);
        }
        __syncthreads();
    }
}

__device__ __forceinline__ void hy_transpose(const Params& p) {
    const int tid = tid_l();
    bf16_t* T = (bf16_t*)dyn_lds;
    const bf16_t* HYO = (const bf16_t*)(p.ws + WS_P2);
    bf16_t* MIX = (bf16_t*)(p.ws + WS_ACT);
    for (int it = blockIdx.x; it < (MTOT / 64) * 8; it += gridDim.x) {
        const int tt = it >> 3, cg_ = it & 7, tok0 = tt * 64, c0 = cg_ * 64;
        {
            const int ch = tid >> 3, t8 = (tid & 7) * 8;
            const u32x4 v = *(const u32x4*)(HYO + (size_t)(c0 + ch) * MTOT + tok0 + t8);
            const unsigned wv[4] = {v.x, v.y, v.z, v.w};
#pragma unroll
            for (int e = 0; e < 4; ++e) { T[(t8 + 2 * e) * 72 + ch] = (bf16_t)(wv[e] & 0xffffu); T[(t8 + 2 * e + 1) * 72 + ch] = (bf16_t)(wv[e] >> 16); }
        }
        __syncthreads();
        {
            const int tk = tid >> 3, c8 = (tid & 7) * 8;
            *(u32x4*)(MIX + (size_t)(tok0 + tk) * 1024 + 512 + c0 + c8) = *(const u32x4*)(T + tk * 72 + c8);
        }
        __syncthreads();
    }
}

__device__ __forceinline__ void qknorm_phase(const Params& p, int li) {
    const int tid = tid_l(), lane = tid & 63, gw = blockIdx.x * 8 + (tid >> 6), ngw = gridDim.x * 8;
    bf16_t* QK = (bf16_t*)(p.ws + WS_BIG);
    float gq[8], gk[8];
#pragma unroll
    for (int e = 0; e < 8; ++e) { gq[e] = p.in[22][li * 64 + (lane & 7) * 8 + e] * 0.125f; gk[e] = p.in[23][li * 64 + (lane & 7) * 8 + e]; }
    for (int row = gw; row < MTOT; row += ngw) {
        bf16_t* rp = QK + (size_t)row * QK_LD + lane * 8;
        u32x4 v[4];
#pragma unroll
        for (int j = 0; j < 4; ++j) v[j] = *(const u32x4*)(rp + j * 512);
#pragma unroll
        for (int j = 0; j < 4; ++j) {
            float f[8]; unpack8(v[j], f);
            float ss = 0.f;
#pragma unroll
            for (int e = 0; e < 8; ++e) ss += f[e] * f[e];
            ss += __shfl_xor(ss, 1); ss += __shfl_xor(ss, 2); ss += __shfl_xor(ss, 4);
            const float rstd = rsqrtf(ss * (1.f / 64.f) + EPS);
#pragma unroll
            for (int e = 0; e < 8; ++e) f[e] *= rstd * (j < 2 ? gq[e] : gk[e]);
            *(u32x4*)(rp + j * 512) = pack8(f);
        }
    }
}

template <bool LAT>
__device__ __forceinline__ void attn_item(const Params& p, int li, int b, int h, int sub, bool stage = true) {
    const int tid = tid_l(), w = tid >> 6, lane = tid & 63, fr = lane & 15, fq = lane >> 4;
    bf16_t* Pw = (bf16_t*)dyn_lds + w * (16 * 264);
    bf16_t* KC = (bf16_t*)(dyn_lds + 67584);
    bf16_t* VC = (bf16_t*)(dyn_lds + 67584 + 36864);
    float* rpbs = (float*)(dyn_lds + 67584 + 36864 + 33792);
    const bf16_t* QK = (const bf16_t*)(p.ws + WS_BIG);
    const bf16_t* VTg = (const bf16_t*)(p.ws + WS_P2ODD);
    bf16_t* MIX = (bf16_t*)(p.ws + WS_ACT);
    if (stage) {
    if (LAT) { const float* rp = p.in[24] + ((size_t)li * 16 + h) * 465; for (int i = tid; i < 465; i += NT) rpbs[i] = rp[i]; }
    {
        u32x4 kv[4], vv[4];
#pragma unroll
        for (int i = 0; i < 4; ++i) {
            const int c = tid + i * NT;
            kv[i] = *(const u32x4*)(QK + (size_t)(NLAT + b * 256 + (c >> 3)) * QK_LD + 1024 + h * 64 + (c & 7) * 8);
            vv[i] = *(const u32x4*)(VTg + (size_t)(h * 64 + (c >> 5)) * VT_LD + NLAT + b * 256 + (c & 31) * 8);
        }
#pragma unroll
        for (int i = 0; i < 4; ++i) {
            const int c = tid + i * NT;
            *(u32x4*)(KC + (c >> 3) * 72 + (c & 7) * 8) = kv[i];
            *(u32x4*)(VC + (c >> 5) * 264 + (c & 31) * 8) = vv[i];
        }
    }
    __syncthreads();
    }
    int r = 0, c0 = 0, rs = 0, cw0 = 0, qtok0;
    if (LAT) { r = sub * 2 + (w >> 2); const int qt = w & 3; c0 = qt * 16; qtok0 = b * 2048 + r * 64 + c0; rs = min(max(r - 4, 0), 24); cw0 = (qt == 0) ? 0 : (qt == 1) ? 8 : (qt == 2) ? 24 : 32; }
    else { qtok0 = NLAT + b * 256 + (sub * 8 + w) * 16; }
    bf16x8 qf[2];
    {
        const bf16_t* qp = QK + (size_t)(qtok0 + fr) * QK_LD + h * 64 + fq * 8;
        qf[0] = *(const bf16x8*)qp; qf[1] = *(const bf16x8*)(qp + 32);
    }
    f32x4 o1[4], o2[4];
    float m1 = -1e30f, l1 = 0.f, m2, l2 = 0.f;
#pragma unroll
    for (int dt = 0; dt < 4; ++dt) { o1[dt] = (f32x4){0.f, 0.f, 0.f, 0.f}; o2[dt] = (f32x4){0.f, 0.f, 0.f, 0.f}; }
    if (LAT) {
        f32x4 sreg[16];
        const int qc = c0 + fr; const int cstart = min(max(qc - 8, 0), 48);
#pragma unroll
        for (int kt = 0; kt < 16; ++kt) {
            const int kr = kt >> 1, kcb = cw0 + (kt & 1) * 16;
            const bf16_t* kp = QK + (size_t)(b * 2048 + (rs + kr) * 64 + kcb + fr) * QK_LD + 1024 + h * 64 + fq * 8;
            f32x4 sa = (f32x4){0.f, 0.f, 0.f, 0.f};
            sa = mfma16(*(const bf16x8*)kp, qf[0], sa); sa = mfma16(*(const bf16x8*)(kp + 32), qf[1], sa);
            const int dri = (rs + kr - r + 7) * 31;
#pragma unroll
            for (int j = 0; j < 4; ++j) {
                const int kc = kcb + fq * 4 + j;
                const bool valid = (kc >= cstart) && (kc < cstart + 16);
                const int dci = min(max(kc - qc + 15, 0), 30);
                sa[j] = valid ? sa[j] + rpbs[dri + dci] : -1e30f;
            }
            sreg[kt] = sa;
            if ((kt & 7) == 7) __builtin_amdgcn_sched_barrier(0);
        }
#pragma unroll
        for (int kt = 0; kt < 16; ++kt)
#pragma unroll
            for (int j = 0; j < 4; ++j) m1 = fmaxf(m1, sreg[kt][j]);
        m1 = fmaxf(m1, __shfl_xor(m1, 16)); m1 = fmaxf(m1, __shfl_xor(m1, 32));
#pragma unroll
        for (int kt = 0; kt < 16; ++kt) {
            float pj[4];
#pragma unroll
            for (int j = 0; j < 4; ++j) { pj[j] = __expf(sreg[kt][j] - m1); l1 += pj[j]; }
            u32x2 o; o.x = pk2(pj[0], pj[1]); o.y = pk2(pj[2], pj[3]);
            *(u32x2*)(Pw + fr * 264 + kt * 16 + fq * 4) = o;
        }
        l1 += __shfl_xor(l1, 16); l1 += __shfl_xor(l1, 32);
#pragma unroll
        for (int kb = 0; kb < 8; kb += 4) {
            bf16x8 vf[4][4], pf[4];
#pragma unroll
            for (int u = 0; u < 4; ++u) {
                const int ks = kb + u;
                const int vtok0 = b * 2048 + (rs + ks) * 64 + cw0;
#pragma unroll
                for (int dt = 0; dt < 4; ++dt) vf[u][dt] = *(const bf16x8*)(VTg + (size_t)(h * 64 + dt * 16 + fr) * VT_LD + vtok0 + fq * 8);
                pf[u] = *(const bf16x8*)(Pw + fr * 264 + ks * 32 + fq * 8);
            }
#pragma unroll
            for (int u = 0; u < 4; ++u)
#pragma unroll
                for (int dt = 0; dt < 4; ++dt) o1[dt] = mfma16(vf[u][dt], pf[u], o1[dt]);
            __builtin_amdgcn_sched_barrier(0);
        }
    }
    {
        f32x4 sreg[16];
#pragma unroll
        for (int kt = 0; kt < 16; ++kt) {
            const bf16_t* kp = KC + (kt * 16 + fr) * 72 + fq * 8;
            f32x4 sa = (f32x4){0.f, 0.f, 0.f, 0.f};
            sa = mfma16(*(const bf16x8*)kp, qf[0], sa); sa = mfma16(*(const bf16x8*)(kp + 32), qf[1], sa);
            sreg[kt] = sa;
        }
        m2 = -1e30f;
#pragma unroll
        for (int kt = 0; kt < 16; ++kt)
#pragma unroll
            for (int j = 0; j < 4; ++j) m2 = fmaxf(m2, sreg[kt][j]);
        m2 = fmaxf(m2, __shfl_xor(m2, 16)); m2 = fmaxf(m2, __shfl_xor(m2, 32));
#pragma unroll
        for (int kt = 0; kt < 16; ++kt) {
            float pj[4];
#pragma unroll
            for (int j = 0; j < 4; ++j) { pj[j] = __expf(sreg[kt][j] - m2); l2 += pj[j]; }
            u32x2 o; o.x = pk2(pj[0], pj[1]); o.y = pk2(pj[2], pj[3]);
            *(u32x2*)(Pw + fr * 264 + kt * 16 + fq * 4) = o;
        }
        l2 += __shfl_xor(l2, 16); l2 += __shfl_xor(l2, 32);
#pragma unroll
        for (int ks = 0; ks < 8; ++ks) {
            const bf16x8 pf = *(const bf16x8*)(Pw + fr * 264 + ks * 32 + fq * 8);
#pragma unroll
            for (int dt = 0; dt < 4; ++dt) o2[dt] = mfma16(*(const bf16x8*)(VC + (dt * 16 + fr) * 264 + ks * 32 + fq * 8), pf, o2[dt]);
        }
    }
    const float mm = fmaxf(m1, m2);
    const float a1 = LAT ? __expf(m1 - mm) : 0.f, a2 = __expf(m2 - mm);
    const float inv = 1.f / (l1 * a1 + l2 * a2);
    const float s1 = a1 * inv, s2 = a2 * inv;
#pragma unroll
    for (int dt = 0; dt < 4; ++dt) {
        const f32x4 ov = o1[dt] * s1 + o2[dt] * s2;
        u32x2 o; o.x = pk2(ov[0], ov[1]); o.y = pk2(ov[2], ov[3]);
        *(u32x2*)(MIX + (size_t)(qtok0 + fr) * 1024 + h * 64 + dt * 16 + fq * 4) = o;
    }
    __syncthreads();
}


#ifdef DBG_NAN
__device__ __forceinline__ bool bad16(bf16_t v) { return ((v >> 7) & 0xFF) >= 227; }
__device__ __forceinline__ bool bad32(float f) { return !(fabsf(f) < 1e30f); }
__device__ __forceinline__ void scan16(const bf16_t* p, size_t n, unsigned* flags, unsigned bit) {
    bool bad = false;
    for (size_t i = (size_t)blockIdx.x * NT + threadIdx.x; i < n; i += (size_t)gridDim.x * NT) bad |= bad16(p[i]);
    if (bad) atomicOr(flags, bit);
}
__device__ __forceinline__ void scan32(const float* p, size_t n, unsigned* flags, unsigned bit) {
    bool bad = false;
    for (size_t i = (size_t)blockIdx.x * NT + threadIdx.x; i < n; i += (size_t)gridDim.x * NT) bad |= bad32(p[i]);
    if (bad) atomicOr(flags, bit);
}
#endif

#define XB_TMO      128
#define XB_XCNT(j)  (256  + 64 * (j))
#define XB_XSUB(j)  (1280 + 64 * (j))
#define XB_XGEN(j)  (2304 + 64 * (j))
#define XB_TOP      3328
#define XB_TOPGEN   3392
#define XCD_BAR_WORDS 3456
#define XB_SPIN_CAP (1u << 20)
#define LAS __attribute__((address_space(3)))
__device__ __forceinline__ unsigned xb_ld(unsigned* p)              { return __hip_atomic_load(p, __ATOMIC_RELAXED, __HIP_MEMORY_SCOPE_AGENT); }
__device__ __forceinline__ unsigned xb_add(unsigned* p, unsigned v) { return __hip_atomic_fetch_add(p, v, __ATOMIC_RELAXED, __HIP_MEMORY_SCOPE_AGENT); }
__device__ __forceinline__ unsigned xb_xcc_id() { return (unsigned)__builtin_amdgcn_s_getreg((3 << 11) | 20) & 0xFu; }
#define XB_SPIN(cond, bar) do { unsigned _sp = 0; while (cond) { __builtin_amdgcn_s_sleep(1); \
    if ((++_sp & 255u) == 0u) { if (xb_ld(&(bar)[XB_TMO])) break; if (_sp > XB_SPIN_CAP) { atomicAdd(&(bar)[XB_TMO], 1u); break; } } } } while (0)
struct XcdBarrier { unsigned* bar; unsigned x; volatile LAS unsigned* st; };
__device__ __forceinline__ XcdBarrier xcd_barrier_post(unsigned* bar, volatile LAS unsigned* st) {
    XcdBarrier b; b.bar = bar; b.x = xb_xcc_id(); b.st = st;
    if (threadIdx.x == 0) (void)xb_add(&bar[XB_XCNT(b.x)], 1u);
    return b;
}
__device__ __forceinline__ void xcd_barrier_complete(unsigned* bar, unsigned x, unsigned& nloc, unsigned& nx) {
    const unsigned G = gridDim.x * gridDim.y * gridDim.z;
    unsigned sum, cnt, mine, sp = 0u;
    for (;;) {
        sum = 0u; cnt = 0u; mine = 0u;
#pragma unroll
        for (unsigned j = 0; j < 16; ++j) { const unsigned c = xb_ld(&bar[XB_XCNT(j)]); sum += c; cnt += (c > 0u) ? 1u : 0u; mine = (j == x) ? c : mine; }
        if (sum == G) break;
        __builtin_amdgcn_s_sleep(1);
        if ((++sp & 255u) == 0u) { if (xb_ld(&bar[XB_TMO])) break; if (sp > XB_SPIN_CAP) { atomicAdd(&bar[XB_TMO], 1u); break; } }
    }
    nloc = mine > 0u ? mine : 1u; nx = cnt > 0u ? cnt : 1u;
}
__device__ __forceinline__ void xcd_barrier(const XcdBarrier& b) {
    asm volatile("s_waitcnt vmcnt(0)" ::: "memory");
    __syncthreads();
    if (threadIdx.x == 0) {
        unsigned* bar = b.bar;
        __builtin_amdgcn_s_waitcnt(0);
        unsigned nloc = b.st[0], nx = b.st[1];
        if (nloc == 0u) { xcd_barrier_complete(bar, b.x, nloc, nx); b.st[0] = nloc; b.st[1] = nx; }
        const unsigned old = xb_add(&bar[XB_XSUB(b.x)], 1u);
        const unsigned gen = old / nloc;
        if (old + 1u == (gen + 1u) * nloc) {
            __builtin_amdgcn_fence(__ATOMIC_RELEASE, "agent");
            asm volatile("s_waitcnt vmcnt(0)" ::: "memory");
            const unsigned og = xb_add(&bar[XB_TOP], 1u);
            const unsigned tg = og / nx;
            if (og + 1u == (tg + 1u) * nx) xb_add(&bar[XB_TOPGEN], 1u);
            else XB_SPIN(xb_ld(&bar[XB_TOPGEN]) == tg, bar);
            __builtin_amdgcn_fence(__ATOMIC_ACQUIRE, "agent");
            xb_add(&bar[XB_XGEN(b.x)], 1u);
            asm volatile("s_waitcnt vmcnt(0)" ::: "memory");
        } else {
            XB_SPIN(xb_ld(&bar[XB_XGEN(b.x)]) == gen, bar);
            __builtin_amdgcn_fence(__ATOMIC_ACQUIRE, "agent");
            asm volatile("s_waitcnt vmcnt(0)" ::: "memory");
        }
    }
    __syncthreads();
}
constexpr size_t WS_BAR = WS_END + 32768;

#ifdef TPROBE_A
#define GSYNC() do { asm volatile("s_waitcnt vmcnt(0) lgkmcnt(0)" ::: "memory"); grid.sync(); ++nsync_; if (nsync_ == TPROBE_A) t0_ = wall_clock64(); if (nsync_ == TPROBE_B) t1_ = wall_clock64(); } while (0)
#else
#define GSYNC() xcd_barrier(xbar_)
#endif
#define GSYNC_CG() do { asm volatile("s_waitcnt vmcnt(0) lgkmcnt(0)" ::: "memory"); grid.sync(); } while (0)
__global__ void __launch_bounds__(NT) fwd_megakernel(Params p) {
    cg::grid_group grid = cg::this_grid();
#ifdef TPROBE_A
    int nsync_ = 0; long long t0_ = 0, t1_ = 0;
#endif
    const int blk = blockIdx.x, G = gridDim.x;
    bf16_t* WIN = (bf16_t*)(p.ws + WS_WIN); bf16_t* WOUT = (bf16_t*)(p.ws + WS_WOUT); bf16_t* WM1 = (bf16_t*)(p.ws + WS_WM1); bf16_t* WM2 = (bf16_t*)(p.ws + WS_WM2);
    bf16_t* ACT = (bf16_t*)(p.ws + WS_ACT); bf16_t* BIG = (bf16_t*)(p.ws + WS_BIG);
    float* XC = (float*)(p.ws + WS_XC);
    const float* MOD = (const float*)(p.ws + WS_MOD);
    volatile LAS unsigned* xst_ = (volatile LAS unsigned*)(dyn_lds + LDS_BYTES - 16);
    if (threadIdx.x == 0) { xst_[0] = 0u; xst_[1] = 0u; }
    __syncthreads();
    const XcdBarrier xbar_ = xcd_barrier_post((unsigned*)(p.ws + WS_BAR), xst_);
    REP(64) if (PHMASK & 1) phase0(p);
#ifdef DBG_NAN
    unsigned* dflags = (unsigned*)(p.ws + WS_END);
    if (blk == 0 && threadIdx.x < 64) dflags[threadIdx.x] = 0u;
#endif
    GSYNC_CG();
#pragma unroll 1
    for (int l = 0; l < 4; ++l) {
        const bool even = !(l & 1), last = (l == 3); const int li = l >> 1;
        const float* xlat = (l == 0) ? p.in[0] : p.out; const float* xctx = (l == 0) ? p.in[2] : XC;
        const int Mtail = last ? NLAT : MTOT;
        REP(1) {
        if (PHMASK & 2) convert_weights(p, l, l == 0 || G < 256, true, 0, G);
        if (PHMASK & 4) norm_phase(p, l, xlat, xctx, 0, 1024, MTOT);
        if ((PHMASK & 8) && even) filter_gen(p, li);
        }
        GSYNC();
        {
            EpiArgs ea{}; ea.o_rm = BIG; ea.ld_rm = even ? 2048 : QK_LD; ea.o_cm = (bf16_t*)(p.ws + (even ? WS_P2 : WS_P2ODD)); ea.ld_cm = even ? MTOT : VT_LD; ea.gates = (float*)(p.ws + WS_GATES); ea.gate_pn = even ? 14 : -1; ea.o_dbg = (bf16_t*)(p.ws + WS_HFB);
            REP(2) if (PHMASK & 16) gemm_phase<EPI_INPROJ>(ACT, WIN, MTOT, even ? 3840 : 3072, 1024, ea);
        }
        GSYNC();
#ifdef DBG_NAN
        if (l == DBG_LAYER) {
            {
                const unsigned gid = blk * NT + threadIdx.x;
                unsigned hsh = gid * 2654435761u + 12345u; hsh ^= hsh >> 13; hsh *= 2246822519u; hsh ^= hsh >> 16;
                const int row = hsh % MTOT; const int col = (hsh >> 8) % 2048; const int ch = (hsh >> 4) % 1536;
                const bf16_t* ar = ACT + (size_t)row * 1024; const bf16_t* wq = WIN + (size_t)col * 1024; const bf16_t* wh = WIN + (size_t)(2048 + ch) * 1024;
                float sq = 0.f, sh_ = 0.f;
                for (int k = 0; k < 1024; ++k) { const float av = b2f(ar[k]); sq += av * b2f(wq[k]); sh_ += av * b2f(wh[k]); }
                const float gq = b2f(BIG[(size_t)row * 2048 + col]);
                const float gh = b2f(((const bf16_t*)(p.ws + WS_P2))[(size_t)ch * MTOT + row]);
                (void)gq; (void)sq;

                { const int cls = DBG_CLS; atomicAdd(dflags + 16 + cls, 1u);
                  if (!(fabsf(gh - sh_) <= 0.05f + 0.02f * fabsf(sh_))) { atomicAdd(dflags + 2, 1u); atomicAdd(dflags + 32 + cls, 1u); } }
            }
            GSYNC();
            if (blk == 0 && threadIdx.x == 0) {
                const float fQ = (float)__hip_atomic_load(dflags + 1, __ATOMIC_RELAXED, __HIP_MEMORY_SCOPE_AGENT) / (float)(G * NT);
                const float fH = (float)__hip_atomic_load(dflags + 2, __ATOMIC_RELAXED, __HIP_MEMORY_SCOPE_AGENT) / (float)(G * NT);
                unsigned mask = 0;
                for (int q_ = 0; q_ < 8; ++q_) { const unsigned tot = __hip_atomic_load(dflags + 16 + q_, __ATOMIC_RELAXED, __HIP_MEMORY_SCOPE_AGENT), bad = __hip_atomic_load(dflags + 32 + q_, __ATOMIC_RELAXED, __HIP_MEMORY_SCOPE_AGENT); if (bad * 4 > tot) mask |= 1u << q_; }
                float code = 1e5f; for (unsigned q_ = 0; q_ < (mask >> 4); ++q_) code *= 10.f;
                const unsigned n3 = __hip_atomic_load(dflags + 3, __ATOMIC_RELAXED, __HIP_MEMORY_SCOPE_AGENT), b1 = __hip_atomic_load(dflags + 1, __ATOMIC_RELAXED, __HIP_MEMORY_SCOPE_AGENT), b4 = __hip_atomic_load(dflags + 4, __ATOMIC_RELAXED, __HIP_MEMORY_SCOPE_AGENT);
                p.out[0] = code * (1.f + 0.5f * (float)(mask & 15)) + 0.f * (fQ + fH + (float)(n3 + b1 + b4));
            }
            return;
        }
#endif
        if (!even) { qknorm_phase(p, li); GSYNC(); }
        if (even) {
            REP(4) if (G >= 256) {
                if (blk < 128) { REP(512) if (PHMASK & 32) mlstm_item(p, li, blk);
                    if (DUPMASK & 1024) { hyena_item<2048>(p, li, 384 + blk, true); hyena_item<256>(p, li, 384 + blk, true); }
                    if (PHMASK & 64) { hyena_item<2048>(p, li, 384 + blk); } }
                else { const int hb = blk - 128;
                    if (DUPMASK & 1024) for (int it = hb; it < 384; it += 128) { hyena_item<2048>(p, li, it, true); hyena_item<256>(p, li, it, true); }
                    if (PHMASK & 64) { for (int it = hb; it < 384; it += 128) { hyena_item<2048>(p, li, it); hyena_item<256>(p, li, it); } hyena_item<256>(p, li, 384 + hb); } }
            } else {
            }
            GSYNC();
            if (PHMASK & 128) { combine_phase(p, li); hy_transpose(p); }
        } else {
            const int x = blk & 7, y = blk >> 3, ny = (G + 7) >> 3;
            REP(256) for (int i = 0; ; ++i) {
                const int slot = i * ny + y;
                if (slot >= 512) break;
                const int bh = x * 32 + 4 * (i >> 1) + (y >> 3), rp = (y & 7) * 2 + (i & 1);
                if (PHMASK & 256) attn_item<true>(p, li, bh >> 4, bh & 15, rp, (i & 1) == 0 || ny != 32);
            }
            if ((PHMASK & 512) && !last) for (int it = blk; it < 512; it += G) attn_item<false>(p, li, it >> 5, (it >> 1) & 15, it & 1);
        }
        GSYNC();
        {
            EpiArgs ea{}; ea.res_lat = xlat; ea.res_ctx = xctx; ea.out_lat = p.out; ea.out_ctx = XC; ea.modg = MOD + (size_t)l * 17 * 6144 + 2048;
            if (DUPMASK & 32) gemm_phase<EPI_DRY>(ACT, WOUT, Mtail, 1024, 1024, ea);
            if (PHMASK & 1024) gemm_phase<EPI_RESID>(ACT, WOUT, Mtail, 1024, 1024, ea);
        }
        GSYNC();
        REP(8) norm_phase(p, l, p.out, XC, 3072, 4096, Mtail);
        GSYNC();
        { EpiArgs ea{}; ea.o_rm = BIG; ea.ld_rm = 4096; ea.gate_pn = -1; REP(16) if (PHMASK & 2048) gemm_phase<EPI_RELU2>(ACT, WM1, Mtail, 4096, 1024, ea); }
        GSYNC();
        {
            EpiArgs ea{}; ea.res_lat = p.out; ea.res_ctx = XC; ea.out_lat = p.out; ea.out_ctx = XC; ea.modg = MOD + (size_t)l * 17 * 6144 + 5120;
            if (DUPMASK & 32) gemm_phase<EPI_DRY>(BIG, WM2, Mtail, 1024, 4096, ea);
            if (PHMASK & 4096) gemm_phase<EPI_RESID>(BIG, WM2, Mtail, 1024, 4096, ea);
            if (!last && G >= 256) convert_weights(p, l + 1, true, false, 128, G - 128);
        }
        GSYNC();
    }
#ifdef TPROBE_A
    if (blk == 0 && threadIdx.x == 0) p.out[0] = (float)(t1_ - t0_) * 10.f;
#endif
}

extern "C" void kernel_launch(void* const* d_in, const int* in_sizes, int n_in, void* d_out, int out_size, void* d_ws, size_t ws_size, hipStream_t stream) {
    static int grid_blocks = 0;
    if (grid_blocks == 0) {
        if (n_in != 26 || ws_size < WS_BAR + XCD_BAR_WORDS * 4) { fprintf(stderr, "kernel_launch: unexpected n_in %d or ws_size %zu (< %zu)\n", n_in, ws_size, (size_t)WS_END); grid_blocks = -1; return; }
        int dev = 0, cus = 0, per_cu = 0;
        hipGetDevice(&dev);
        hipDeviceGetAttribute(&cus, hipDeviceAttributeMultiprocessorCount, dev);
        if (hipFuncSetAttribute((const void*)fwd_megakernel, hipFuncAttributeMaxDynamicSharedMemorySize, LDS_BYTES) != hipSuccess) fprintf(stderr, "kernel_launch: hipFuncSetAttribute failed\n");
        if (hipOccupancyMaxActiveBlocksPerMultiprocessor(&per_cu, (const void*)fwd_megakernel, NT, LDS_BYTES) != hipSuccess || per_cu < 1) { fprintf(stderr, "kernel_launch: occupancy query gave %d\n", per_cu); per_cu = 1; }
        (void)hipGetLastError();
        grid_blocks = cus * 1;
        fprintf(stderr, "kernel_launch: cus %d per_cu %d grid %d\n", cus, per_cu, grid_blocks);
    }
    if (grid_blocks < 0) return;
    if (hipMemsetAsync((char*)d_ws + WS_BAR, 0, XCD_BAR_WORDS * 4, stream) != hipSuccess) { fprintf(stderr, "kernel_launch: memset of barrier words failed\n"); return; }
    Params p{};
    for (int i = 0; i < 26; ++i) p.in[i] = (const float*)d_in[i];
    p.out = (float*)d_out; p.ws = (unsigned char*)d_ws;
    void* args[] = {&p};
    hipError_t e = hipLaunchCooperativeKernel((void*)fwd_megakernel, dim3(grid_blocks), dim3(NT), args, LDS_BYTES, stream);
    if (e != hipSuccess) fprintf(stderr, "cooperative launch failed: %s (grid %d)\n", hipGetErrorString(e), grid_blocks);
}
```

```cpp
#include <hip/hip_runtime.h>
#include <hip/hip_cooperative_groups.h>
#include <cstdio>
#include <cstdint>
namespace cg = cooperative_groups;

typedef unsigned short bf16_t;
typedef short bf16x8 __attribute__((ext_vector_type(8)));
typedef float f32x4 __attribute__((ext_vector_type(4)));
typedef unsigned u32x4 __attribute__((ext_vector_type(4)));
typedef unsigned u32x2 __attribute__((ext_vector_type(2)));

#define NT 512
#define DBG_LAYER 0
#define DBG_CLS ((((row % 64) / 16) * 2) + ((ch % 32) / 16))
#ifndef PHMASK
#define PHMASK 0xFFFF
#endif
#ifndef DUPMASK
#define DUPMASK 0
#endif
#define REP(bit) for (int rep_ = 0; rep_ < (((DUPMASK) & (bit)) ? 2 : 1); ++rep_)
constexpr int BATCH = 16, SEQ = 2048, DM = 1024, CTXL = 256;
constexpr int NLAT = BATCH * SEQ, NCTX = BATCH * CTXL, MTOT = NLAT + NCTX;
constexpr int DFF = 4096;
constexpr float EPS = 1e-6f;
constexpr int LDS_BYTES = 147456;

constexpr size_t al256(size_t x) { return (x + 255) & ~(size_t)255; }
constexpr size_t WS_WIN = 0;
constexpr size_t WS_WOUT = al256(WS_WIN + (size_t)3840 * 1024 * 2);
constexpr size_t WS_WM1 = al256(WS_WOUT + (size_t)1024 * 1024 * 2);
constexpr size_t WS_WM2 = al256(WS_WM1 + (size_t)4096 * 1024 * 2);
constexpr size_t WS_MOD = al256(WS_WM2 + (size_t)4096 * 1024 * 2);
constexpr size_t WS_XC = al256(WS_MOD + (size_t)4 * 17 * 6144 * 4);
constexpr size_t WS_ACT = al256(WS_XC + (size_t)NCTX * 1024 * 4);
constexpr size_t WS_BIG = al256(WS_ACT + (size_t)MTOT * 1024 * 2);
constexpr size_t WS_P2 = WS_BIG + (size_t)MTOT * 2048 * 2;
constexpr int QK_LD = 2048 + 64;
constexpr int VT_LD = MTOT + 64;
constexpr size_t WS_P2ODD = WS_BIG + (size_t)MTOT * QK_LD * 2;
constexpr size_t WS_GATES = WS_P2 + (size_t)1536 * MTOT * 2;
constexpr size_t WS_HFB = al256(WS_BIG + (size_t)MTOT * 4096 * 2);
constexpr size_t WS_FLAT = al256(WS_HFB + (size_t)2 * MTOT * 512 * 2);
constexpr size_t WS_FCTX = al256(WS_FLAT + (size_t)2 * 512 * 4096 * 2);
constexpr size_t WS_H2 = al256(WS_FCTX + (size_t)2 * 512 * 512 * 2);
constexpr size_t WS_ROPE = al256(WS_H2 + (size_t)2 * 2304 * 64 * 4);
constexpr size_t WS_END = al256(WS_ROPE + (size_t)2 * 64 * 32 * 4);
static_assert(WS_GATES + (size_t)MTOT * 16 * 4 <= WS_HFB, "projection overlay too large");
static_assert(WS_P2ODD + (size_t)1024 * VT_LD * 2 <= WS_HFB, "odd projection overlay too large");

struct Params { const float* in[26]; float* out; unsigned char* ws; };

typedef float f32x2_ __attribute__((ext_vector_type(2)));
typedef __bf16 bf16x2_ __attribute__((ext_vector_type(2)));
__device__ __forceinline__ unsigned pk2(float lo, float hi) { f32x2_ v = {lo, hi}; bf16x2_ b = __builtin_convertvector(v, bf16x2_); return __builtin_bit_cast(unsigned, b); }
__device__ __forceinline__ bf16_t f2b(float x) { return (bf16_t)(pk2(x, 0.f) & 0xffffu); }
__device__ __forceinline__ float b2f(bf16_t b) { return __uint_as_float(((unsigned)b) << 16); }
__device__ __forceinline__ float blo(unsigned w) { return __uint_as_float(w << 16); }
__device__ __forceinline__ float bhi(unsigned w) { return __uint_as_float(w & 0xffff0000u); }
__device__ __forceinline__ void unpack8(u32x4 v, float* f) {
    f[0] = blo(v.x); f[1] = bhi(v.x); f[2] = blo(v.y); f[3] = bhi(v.y); f[4] = blo(v.z); f[5] = bhi(v.z); f[6] = blo(v.w); f[7] = bhi(v.w);
}
__device__ __forceinline__ u32x4 pack8(const float* f) { u32x4 r; r.x = pk2(f[0], f[1]); r.y = pk2(f[2], f[3]); r.z = pk2(f[4], f[5]); r.w = pk2(f[6], f[7]); return r; }
__device__ __forceinline__ float fsin_(float x) { float r = x * 0.15915494309189535f; r -= floorf(r); return __builtin_amdgcn_sinf(r); }
__device__ __forceinline__ float fcos_(float x) { float r = x * 0.15915494309189535f; r -= floorf(r); return __builtin_amdgcn_cosf(r); }
__device__ __forceinline__ float wave_sum(float v) {
#pragma unroll
    for (int o = 1; o < 64; o <<= 1) v += __shfl_xor(v, o);
    return v;
}
__device__ __forceinline__ f32x4 mfma16(bf16x8 a, bf16x8 b, f32x4 c) { return __builtin_amdgcn_mfma_f32_16x16x32_bf16(a, b, c, 0, 0, 0); }
__device__ __forceinline__ bf16x8 as_bf8(u32x4 v) { return __builtin_bit_cast(bf16x8, v); }

extern __shared__ __attribute__((aligned(16))) unsigned char dyn_lds[];
__device__ __forceinline__ int tid_l() { int t = threadIdx.x; asm volatile("" : "+v"(t)); return t; }

constexpr int G_BM = 256, G_BK = 64, G_HALF = 128, G_HT = G_HALF * G_BK;
__device__ __forceinline__ int lds_byte(int r, int c) {
    int st = (r >> 4) * 2 + (c >> 5), rr = r & 15, cc = c & 31, ob = rr * 64 + cc * 2;
    return st * 1024 + (ob ^ (((ob >> 9) & 1) << 5));
}
__device__ __forceinline__ void stage_rc(int b, int& R, int& C) {
    int st = b / 1024, sb = b % 1024, swz = sb ^ (((sb >> 9) & 1) << 5);
    R = (st >> 1) * 16 + swz / 64; C = (st & 1) * 32 + (swz % 64) / 2;
}

enum { EPI_INPROJ = 0, EPI_RESID = 1, EPI_RELU2 = 2, EPI_DRY = 3 };
struct EpiArgs {
    bf16_t* o_rm; int ld_rm;
    bf16_t* o_dbg;
    int ld_cm;
    bf16_t* o_cm;
    float* gates; int gate_pn;
    const float* res_lat; const float* res_ctx; float* out_lat; float* out_ctx; const float* modg;
};

#define WAIT_V_(n) asm volatile("s_waitcnt vmcnt(" #n ")" ::: "memory")
#define WAIT_V(n) WAIT_V_(n)
#ifndef GEMM_SGB
#define GEMM_SGB 0
#endif
#ifndef GEMM_VM
#define GEMM_VM 8
#endif
#define WAIT_L(n) asm volatile("s_waitcnt lgkmcnt(" #n ")" ::: "memory")
#define BAR __builtin_amdgcn_s_barrier()
#define CFENCE asm volatile("" ::: "memory")

template <bool TR, int NAI>
__device__ __forceinline__ void gemm_kloop(const bf16_t* __restrict__ A, const bf16_t* __restrict__ Bt, int K, int brow, int bcol, f32x4 (&acc)[NAI][2][4][2], int kt0, int nt) {
    bf16_t* shm = (bf16_t*)dyn_lds;
#define SA(b, h) (shm + ((b) * 2 + (h)) * G_HT)
#define SB(b, h) (shm + (4 + (b) * 2 + (h)) * G_HT)
    const int tidx = tid_l();
    const int wid = tidx >> 6, lane = tidx & 63, wr = wid >> 2, wc = wid & 3, fr = lane & 15, fq = lane >> 4;
    int goff[2];
#pragma unroll
    for (int i = 0; i < 2; ++i) { int r_, c_; stage_rc(tidx * 16 + i * 8192, r_, c_); goff[i] = r_ * K + c_; }
    const bf16_t* Ab = A + (long)brow * K + kt0 * G_BK; const bf16_t* Bb = Bt + (long)bcol * K + kt0 * G_BK;
#define STAGE2(P, BASEP, kt) do { _Pragma("unroll") for (int _i = 0; _i < 2; ++_i) \
      __builtin_amdgcn_global_load_lds((const unsigned*)((BASEP) + (kt) * G_BK + goff[_i]), (unsigned*)((char*)(P) + tidx * 16 + _i * 8192), 16, 0, 0); } while (0)
    STAGE2(SA(0, 0), Ab, 0); if (NAI == 2) STAGE2(SA(0, 1), Ab + (long)G_HALF * K, 0); STAGE2(SB(0, 0), Bb, 0); STAGE2(SB(0, 1), Bb + (long)G_HALF * K, 0);
    for (int kt = 0; kt < nt; ++kt) {
        const int cur = kt & 1, nxt = cur ^ 1;
        WAIT_V(0); WAIT_L(0);
        BAR; CFENCE;
#define LDBF(dst, k) _Pragma("unroll") for (int bj = 0; bj < 2; ++bj) _Pragma("unroll") for (int n = 0; n < 2; ++n) \
            dst[bj][n] = *reinterpret_cast<const bf16x8*>((char*)SB(cur, bj) + lds_byte(wc * 32 + n * 16 + fr, (k) * 32 + fq * 8))
#define LDAF(dst, ai, k) _Pragma("unroll") for (int m = 0; m < 4; ++m) \
            dst[m] = *reinterpret_cast<const bf16x8*>((char*)SA(cur, ai) + lds_byte(wr * 64 + m * 16 + fr, (k) * 32 + fq * 8))
#define MMAG(ai, Af_, Bf_) _Pragma("unroll") for (int m = 0; m < 4; ++m) _Pragma("unroll") for (int bj = 0; bj < 2; ++bj) _Pragma("unroll") for (int n = 0; n < 2; ++n) \
            acc[ai][bj][m][n] = TR ? mfma16(Bf_[bj][n], Af_[m], acc[ai][bj][m][n]) : mfma16(Af_[m], Bf_[bj][n], acc[ai][bj][m][n])
        bf16x8 B0[2][2], B1[2][2], A0[4], A1[4];
        LDBF(B0, 0); LDAF(A0, 0, 0); if (NAI == 2) { LDAF(A1, 1, 0); }
        if (kt + 1 < nt) {
            STAGE2(SA(nxt, 0), Ab, kt + 1); if (NAI == 2) STAGE2(SA(nxt, 1), Ab + (long)G_HALF * K, kt + 1);
            STAGE2(SB(nxt, 0), Bb, kt + 1); STAGE2(SB(nxt, 1), Bb + (long)G_HALF * K, kt + 1);
        }
        MMAG(0, A0, B0);
        LDBF(B1, 1); LDAF(A0, 0, 1);
        if (NAI == 2) { MMAG(NAI - 1, A1, B0); LDAF(A1, 1, 1); }
        MMAG(0, A0, B1);
        if (NAI == 2) { MMAG(NAI - 1, A1, B1); }
#if GEMM_SGB
        __builtin_amdgcn_sched_group_barrier(0x100, 12, 0);
        __builtin_amdgcn_sched_group_barrier(0x020, 8, 0);
        __builtin_amdgcn_sched_group_barrier(0x008, 16, 0);
        __builtin_amdgcn_sched_group_barrier(0x100, 8, 0);
        __builtin_amdgcn_sched_group_barrier(0x008, 16, 0);
        __builtin_amdgcn_sched_group_barrier(0x100, 4, 0);
        __builtin_amdgcn_sched_group_barrier(0x008, 32, 0);
#endif
    }
    WAIT_L(0); BAR; CFENCE;
}

template <int EPI, int NAI>
__device__ __forceinline__ void gemm_tile(const bf16_t* A, const bf16_t* Bt, int K, int brow, int bcol, int pn, const EpiArgs& ea, int wr, int wc, int fr, int fq) {
        constexpr bool SPLITTAIL = false; const int kq = -1, kt0 = 0, ntl = K / G_BK; (void)kq;
        f32x4 acc[NAI][2][4][2];
#pragma unroll
        for (int a = 0; a < NAI; ++a)
#pragma unroll
            for (int b = 0; b < 2; ++b)
#pragma unroll
                for (int m = 0; m < 4; ++m)
#pragma unroll
                    for (int n = 0; n < 2; ++n) acc[a][b][m][n] = (f32x4){0.f, 0.f, 0.f, 0.f};
        const bool colmajor = (EPI == EPI_INPROJ) && pn >= 8 && pn != ea.gate_pn;
        if (colmajor) {
            gemm_kloop<true, NAI>(A, Bt, K, brow, bcol, acc, kt0, ntl);
#pragma unroll
            for (int ai = 0; ai < NAI; ++ai)
#pragma unroll
                for (int bj = 0; bj < 2; ++bj)
#pragma unroll
                    for (int m = 0; m < 4; ++m)
#pragma unroll
                        for (int n = 0; n < 2; ++n) {
                            const int row = brow + ai * 128 + wr * 64 + m * 16 + fr, col = bcol + bj * 128 + wc * 32 + n * 16 + fq * 4;
                            const f32x4 v = acc[ai][bj][m][n];
#pragma unroll
                            for (int j = 0; j < 4; ++j) ea.o_cm[(size_t)(col + j - 2048) * ea.ld_cm + row] = f2b(v[j]);
                        }
        } else if (EPI == EPI_RELU2 || (EPI == EPI_INPROJ && pn != ea.gate_pn)) {
            gemm_kloop<true, NAI>(A, Bt, K, brow, bcol, acc, kt0, ntl);
            bf16_t* T = (bf16_t*)dyn_lds;
#pragma unroll
            for (int ai = 0; ai < NAI; ++ai)
#pragma unroll
                for (int m = 0; m < 4; ++m)
#pragma unroll
                    for (int bj = 0; bj < 2; ++bj)
#pragma unroll
                        for (int n = 0; n < 2; ++n) {
                            const f32x4 v = acc[ai][bj][m][n];
                            const float r0 = fmaxf(v[0], 0.f), r1 = fmaxf(v[1], 0.f), r2 = fmaxf(v[2], 0.f), r3 = fmaxf(v[3], 0.f);
                            u32x2 o;
                            if (EPI == EPI_RELU2) { o.x = pk2(r0 * r0, r1 * r1); o.y = pk2(r2 * r2, r3 * r3); }
                            else { o.x = pk2(v[0], v[1]); o.y = pk2(v[2], v[3]); }
                            *(u32x2*)(T + (ai * 128 + wr * 64 + m * 16 + fr) * 264 + bj * 128 + wc * 32 + n * 16 + fq * 4) = o;
                        }
            __syncthreads();
            {
                const int tt = tid_l();
#pragma unroll
                for (int i = 0; i < NAI * 8; ++i) {
                    const int c = tt + i * NT, row = c >> 5, cc = c & 31;
                    *(u32x4*)(ea.o_rm + (size_t)(brow + row) * ea.ld_rm + bcol + cc * 8) = *(const u32x4*)(T + row * 264 + cc * 8);
                }
            }
        } else if (EPI == EPI_RESID) {
            gemm_kloop<true, NAI>(A, Bt, K, brow, bcol, acc, kt0, ntl);
            const bool lat = brow < NLAT;
            const int mrow = lat ? brow >> 11 : 16;
            const float* rbase = lat ? ea.res_lat + (size_t)brow * 1024 : ea.res_ctx + (size_t)(brow - NLAT) * 1024;
            float* obase = lat ? ea.out_lat + (size_t)brow * 1024 : ea.out_ctx + (size_t)(brow - NLAT) * 1024;
            f32x4 g[2][2];
#pragma unroll
            for (int bj = 0; bj < 2; ++bj)
#pragma unroll
                for (int n = 0; n < 2; ++n) g[bj][n] = *(const f32x4*)(ea.modg + (size_t)mrow * 6144 + bcol + bj * 128 + wc * 32 + n * 16 + fq * 4);
            if (SPLITTAIL && kq >= 0) {
#pragma unroll
                for (int ai = 0; ai < NAI; ++ai)
#pragma unroll
                    for (int m = 0; m < 4; ++m)
#pragma unroll
                        for (int bj = 0; bj < 2; ++bj)
#pragma unroll
                            for (int n = 0; n < 2; ++n) {
                                float* op = obase + (size_t)(ai * 128 + wr * 64 + m * 16 + fr) * 1024 + bcol + bj * 128 + wc * 32 + n * 16 + fq * 4;
                                const f32x4 dv = g[bj][n] * acc[ai][bj][m][n];
#pragma unroll
                                for (int j = 0; j < 4; ++j) unsafeAtomicAdd(op + j, dv[j]);
                            }
            } else {
            float* Tf = (float*)dyn_lds;
            const int tt = tid_l();
#pragma unroll
            for (int ai = 0; ai < NAI; ++ai) {
#pragma unroll
                for (int m = 0; m < 4; ++m)
#pragma unroll
                    for (int bj = 0; bj < 2; ++bj)
#pragma unroll
                        for (int n = 0; n < 2; ++n)
                            *(f32x4*)(Tf + (wr * 64 + m * 16 + fr) * 260 + bj * 128 + wc * 32 + n * 16 + fq * 4) = g[bj][n] * acc[ai][bj][m][n];
                __syncthreads();
#pragma unroll
                for (int ib = 0; ib < 16; ib += 8) {
                    f32x4 xv[8];
#pragma unroll
                    for (int i = 0; i < 8; ++i) { const int c = tt + (ib + i) * NT, row = c >> 6, cc = c & 63;
                        xv[i] = *(const f32x4*)(rbase + (size_t)(ai * 128 + row) * 1024 + bcol + cc * 4); }
#pragma unroll
                    for (int i = 0; i < 8; ++i) { const int c = tt + (ib + i) * NT, row = c >> 6, cc = c & 63;
                        *(f32x4*)(obase + (size_t)(ai * 128 + row) * 1024 + bcol + cc * 4) = xv[i] + *(const f32x4*)(Tf + row * 260 + cc * 4); }
                }
                if (NAI == 2 && ai == 0) __syncthreads();
            }
            }
        } else {
            gemm_kloop<true, NAI>(A, Bt, K, brow, bcol, acc, kt0, ntl);
#pragma unroll
            for (int ai = 0; ai < NAI; ++ai)
#pragma unroll
                for (int m = 0; m < 4; ++m) {
                    const int row = brow + ai * 128 + wr * 64 + m * 16 + fr;
#pragma unroll
                    for (int bj = 0; bj < 2; ++bj)
#pragma unroll
                        for (int n = 0; n < 2; ++n) {
                            const int col = bcol + bj * 128 + wc * 32 + n * 16 + fq * 4;
                            const f32x4 v = acc[ai][bj][m][n];
                            if (EPI == EPI_INPROJ) {
                                if (pn == ea.gate_pn) {
                                    if (bj == 0 && wc == 0 && n == 0) *(f32x4*)(ea.gates + (size_t)row * 16 + fq * 4) = v;
                                } else {
                                    u32x2 o; o.x = pk2(v[0], v[1]); o.y = pk2(v[2], v[3]);
                                    *(u32x2*)(ea.o_rm + (size_t)row * ea.ld_rm + col) = o;
                                }
                            } else if (EPI == EPI_DRY) {
                                if (v[0] == 123456.789f && v[1] == 3.25f) *(f32x4*)(ea.out_lat + (size_t)row * 1024 + (col & 1023)) = v;
                            } else if (EPI == EPI_RELU2) {
                                float r0 = fmaxf(v[0], 0.f), r1 = fmaxf(v[1], 0.f), r2 = fmaxf(v[2], 0.f), r3 = fmaxf(v[3], 0.f);
                                u32x2 o; o.x = pk2(r0 * r0, r1 * r1); o.y = pk2(r2 * r2, r3 * r3);
                                *(u32x2*)(ea.o_rm + (size_t)row * ea.ld_rm + col) = o;
                            } else {
                                const float* rp; float* op; int mrow;
                                if (row < NLAT) { rp = ea.res_lat + (size_t)row * 1024 + col; op = ea.out_lat + (size_t)row * 1024 + col; mrow = row >> 11; }
                                else { rp = ea.res_ctx + (size_t)(row - NLAT) * 1024 + col; op = ea.out_ctx + (size_t)(row - NLAT) * 1024 + col; mrow = 16; }
                                const f32x4 g = *(const f32x4*)(ea.modg + (size_t)mrow * 6144 + col);
                                const f32x4 x = *(const f32x4*)rp;
                                f32x4 rr = x + g * v;
#ifdef SANITIZE
#pragma unroll
                                for (int q_ = 0; q_ < 4; ++q_) if (!(fabsf(rr[q_]) < 1e30f)) rr[q_] = 0.f;
#endif
                                *(f32x4*)op = rr;
                            }
                        }
                }
        }
        asm volatile("s_waitcnt vmcnt(0)" ::: "memory");
        __syncthreads();
}

template <int EPI, bool HALFTAIL = true>
__device__ __forceinline__ void gemm_phase(const bf16_t* A, const bf16_t* Bt, int M, int N, int K, const EpiArgs& ea) {
    const int nM = M / G_BM, nN = N / G_BM, nwg = nM * nN, G_ = gridDim.x;
    const int tidx = tid_l(); const int wid = tidx >> 6, lane = tidx & 63, wr = wid >> 2, wc = wid & 3, fr = lane & 15, fq = lane >> 4;
    int nfull = nwg;
    if (HALFTAIL) { const int rem = nwg % G_; if (rem > 0 && rem * 2 <= G_) nfull = nwg - rem; }
    const int nunits = nfull + (nwg - nfull) * 2;
    for (int U = blockIdx.x; U < nunits; U += G_) {
        const int L = U < nfull ? U : nfull + ((U - nfull) >> 1);
        const int half = U < nfull ? -1 : ((U - nfull) & 1);
        int wgid = L;
        { int q = nwg / 8, r = nwg % 8, xcd = wgid % 8, off = wgid / 8; wgid = (xcd < r ? xcd * (q + 1) : r * (q + 1) + (xcd - r) * q) + off; }
        const int nig = 4 * nN, gid = wgid / nig, fm = gid * 4, gsz = min(nM - fm, 4);
        const int pm = fm + ((wgid % nig) % gsz), pn = (wgid % nig) / gsz, bcol = pn * G_BM;
        if (half < 0) gemm_tile<EPI, 2>(A, Bt, K, pm * G_BM, bcol, pn, ea, wr, wc, fr, fq);
        else gemm_tile<EPI, 1>(A, Bt, K, pm * G_BM + half * 128, bcol, pn, ea, wr, wc, fr, fq);
    }
}

__device__ __forceinline__ void phase0(const Params& p) {
    const int tid = tid_l(), blk = blockIdx.x, nb = gridDim.x;
    float* MOD = (float*)(p.ws + WS_MOD);
    for (int it = blk; it < 193; it += nb) {
        if (it < 192) {
            float* sl = (float*)dyn_lds;
            float* red = sl + 17 * 1024;
            for (int i = tid; i < 17 * 1024; i += NT) { float v = (i < 16 * 1024) ? p.in[1][i] : p.in[3][i - 16 * 1024]; sl[i] = v / (1.f + __expf(-v)); }
            __syncthreads();
            const int l = it / 48, nc = it % 48, kp = tid >> 7, col = tid & 127;
            const float* W = p.in[4] + (size_t)l * 1024 * 6144 + nc * 128 + col;
            float acc[17];
#pragma unroll
            for (int r = 0; r < 17; ++r) acc[r] = 0.f;
            for (int k = kp * 256; k < kp * 256 + 256; ++k) {
                const float wv = W[(size_t)k * 6144];
#pragma unroll
                for (int r = 0; r < 17; ++r) acc[r] += sl[r * 1024 + k] * wv;
            }
#pragma unroll
            for (int r = 0; r < 17; ++r) red[(kp * 17 + r) * 128 + col] = acc[r];
            __syncthreads();
            for (int i = tid; i < 17 * 128; i += NT) {
                const int r = i >> 7, cc = i & 127;
                const float s = red[(0 * 17 + r) * 128 + cc] + red[(1 * 17 + r) * 128 + cc] + red[(2 * 17 + r) * 128 + cc] + red[(3 * 17 + r) * 128 + cc];
                MOD[((size_t)l * 17 + r) * 6144 + nc * 128 + cc] = s + p.in[5][l * 6144 + nc * 128 + cc];
            }
            __syncthreads();
        } else {
            float* ROPE = (float*)(p.ws + WS_ROPE);
            for (int i = tid; i < 2048; i += NT) {
                const int pos = i >> 5, j = i & 31;
                const float inv = exp2f(-(float)j * (13.287712379549449f / 32.f));
                const float ang = (float)pos * inv;
                ROPE[i] = fcos_(ang); ROPE[2048 + i] = fsin_(ang);
            }
        }
    }
    float* H2 = (float*)(p.ws + WS_H2);
    const int gw = blk * 8 + (tid >> 6), lane = tid & 63;
    for (int it = gw; it < 2 * 2304; it += nb * 8) {
        const int i = it / 2304, row = it % 2304;
        const int L = row < 2048 ? 2048 : 256, t = row < 2048 ? row : row - 2048;
        const float tn = (float)t / (float)(L - 1);
        const float wpos = 6.283185307179586f * (float)t / (float)L;
        float ev = 0.f;
        if (lane == 0) ev = tn;
        else if (lane <= 16) { const float fr = 1e-4f + (float)(lane - 1) * ((15.f - 1e-4f) / 15.f); ev = fcos_(wpos * fr); }
        else if (lane <= 32) { const float fr = 1e-4f + (float)(lane - 17) * ((15.f - 1e-4f) / 15.f); ev = -fsin_(wpos * fr); }
        const float* w1 = p.in[13] + i * 33 * 64; const float* b1 = p.in[14] + i * 64;
        const float* w2 = p.in[15] + i * 64 * 64; const float* b2 = p.in[16] + i * 64; const float* fq = p.in[18] + i * 64;
        float a = b1[lane];
        for (int e = 0; e < 33; ++e) a += __shfl(ev, e) * w1[e * 64 + lane];
        const float h1 = fsin_(fq[lane] * a);
        float a2 = b2[lane];
        for (int e = 0; e < 64; ++e) a2 += __shfl(h1, e) * w2[e * 64 + lane];
        H2[((size_t)i * 2304 + row) * 64 + lane] = fsin_(fq[lane] * a2);
    }
}

__device__ __forceinline__ void cvt_tile(const float* W, int N, int K, bf16_t* WT, int n0, int k0, int mapmode) {
    float* tl = (float*)dyn_lds;
    const int tid = tid_l(), nl = tid & 63, kb = tid >> 6;
    const int n = n0 + nl; int sc = n;
    if (mapmode == 1) sc = n < 2048 ? n : (n < 3584 ? n + 16 : (n < 3600 ? n - 3584 + 2048 : -1));
#pragma unroll
    for (int i = 0; i < 8; ++i) { const int kl = kb + 8 * i; tl[kl * 65 + nl] = sc >= 0 ? W[(size_t)(k0 + kl) * N + sc] : 0.f; }
    __syncthreads();
    const int nn = tid >> 3, kc = tid & 7;
    float f[8];
#pragma unroll
    for (int j = 0; j < 8; ++j) f[j] = tl[(kc * 8 + j) * 65 + nn];
    *(u32x4*)(WT + (size_t)(n0 + nn) * K + k0 + kc * 8) = pack8(f);
    __syncthreads();
}

__device__ __forceinline__ void convert_weights(const Params& p, int l, bool first_part, bool second_part, int bstart, int bcount) {
    const int blk = (int)blockIdx.x - bstart, nb = bcount, li = l >> 1; const bool even = !(l & 1);
    if (blk < 0 || blk >= bcount) return;
    const int nin = even ? 60 : 48;
    const int t_in = nin * 16, t_out = 256, t_m1 = 1024, t_m2 = 1024;
    const int it0 = first_part ? 0 : t_in + t_out + t_m1, it1 = second_part ? t_in + t_out + t_m1 + t_m2 : t_in + t_out + t_m1;
    for (int it = it0 + blk; it < it1; it += nb) {
        int r = it;
        if (r < t_in) {
            const int nt = r / 16, kt = r % 16;
            if (even) cvt_tile(p.in[8] + (size_t)li * 1024 * 3600, 3600, 1024, (bf16_t*)(p.ws + WS_WIN), nt * 64, kt * 64, 1);
            else cvt_tile(p.in[21] + (size_t)li * 1024 * 3072, 3072, 1024, (bf16_t*)(p.ws + WS_WIN), nt * 64, kt * 64, 0);
            continue;
        }
        r -= t_in;
        if (r < t_out) {
            const int nt = r / 16, kt = r % 16;
            cvt_tile((even ? p.in[20] : p.in[25]) + (size_t)li * 1024 * 1024, 1024, 1024, (bf16_t*)(p.ws + WS_WOUT), nt * 64, kt * 64, 0);
            continue;
        }
        r -= t_out;
        if (r < t_m1) {
            const int nt = r / 16, kt = r % 16;
            cvt_tile(p.in[6] + (size_t)l * 1024 * 4096, 4096, 1024, (bf16_t*)(p.ws + WS_WM1), nt * 64, kt * 64, 0);
            continue;
        }
        r -= t_m1;
        { const int nt = r / 64, kt = r % 64;
          cvt_tile(p.in[7] + (size_t)l * 4096 * 1024, 1024, 4096, (bf16_t*)(p.ws + WS_WM2), nt * 64, kt * 64, 0); }
    }
}

__device__ __forceinline__ void norm_phase(const Params& p, int l, const float* xlat, const float* xctx, int shoff, int scoff, int M) {
    const int tid = tid_l(), lane = tid & 63, gw = blockIdx.x * 8 + (tid >> 6), ngw = gridDim.x * 8;
    const float* MOD = (const float*)(p.ws + WS_MOD) + (size_t)l * 17 * 6144;
    bf16_t* ACT = (bf16_t*)(p.ws + WS_ACT);
    for (int row = gw; row < M; row += ngw) {
        const float* xr = row < NLAT ? xlat + (size_t)row * 1024 : xctx + (size_t)(row - NLAT) * 1024;
        const int mrow = row < NLAT ? row >> 11 : 16;
        const float* mod = MOD + (size_t)mrow * 6144;
        f32x4 v[4]; float ss = 0.f;
#pragma unroll
        for (int j = 0; j < 4; ++j) { v[j] = *(const f32x4*)(xr + 4 * lane + 256 * j); ss += v[j][0] * v[j][0] + v[j][1] * v[j][1] + v[j][2] * v[j][2] + v[j][3] * v[j][3]; }
        ss = wave_sum(ss);
        const float rstd = rsqrtf(ss * (1.f / 1024.f) + EPS);
#pragma unroll
        for (int j = 0; j < 4; ++j) {
            const int col = 4 * lane + 256 * j;
            const f32x4 sh = *(const f32x4*)(mod + shoff + col), sc = *(const f32x4*)(mod + scoff + col);
            const f32x4 y = v[j] * rstd * (sc + 1.f) + sh;
            u32x2 o; o.x = pk2(y[0], y[1]); o.y = pk2(y[2], y[3]);
            *(u32x2*)(ACT + (size_t)row * 1024 + col) = o;
        }
    }
}

__device__ __forceinline__ void filter_gen(const Params& p, int li) {
    const int tid = tid_l(), lane = tid & 63, w = tid >> 6;
    float* wf = (float*)dyn_lds; float* wb = wf + 64; float* red = wb + 64;
    const float* H2 = (const float*)(p.ws + WS_H2);
    for (int it = blockIdx.x; it < 2048; it += gridDim.x) {
        const int ltype = it >> 10, o = (it >> 9) & 1, c = it & 511;
        const int L = ltype ? 256 : 2048;
        const float* H2r = H2 + ((size_t)li * 2304 + (ltype ? 2048 : 0)) * 64;
        const float* w3 = p.in[17] + (size_t)li * 64 * 2048;
        if (tid < 64) wf[tid] = w3[tid * 2048 + (o * 2 + 0) * 512 + c];
        else if (tid < 128) wb[tid - 64] = w3[(tid - 64) * 2048 + (o * 2 + 1) * 512 + c];
        __syncthreads();
        const float lo = -4.605170185988091f / 1.5f, hi = -4.605170185988091f / 0.3f;
        const float delta = fabsf(lo + (hi - lo) * (float)c / 511.f);
        float vf[4], vb[4]; float ssf = 0.f, ssb = 0.f;
#pragma unroll
        for (int q = 0; q < 4; ++q) {
            const int t = tid + 512 * q; vf[q] = 0.f; vb[q] = 0.f;
            if (t < L) {
                float df = 0.f, db = 0.f;
                const f32x4* hr = (const f32x4*)(H2r + (size_t)t * 64);
#pragma unroll
                for (int j = 0; j < 16; ++j) { const f32x4 hv = hr[j];
                    df += hv[0] * wf[4 * j] + hv[1] * wf[4 * j + 1] + hv[2] * wf[4 * j + 2] + hv[3] * wf[4 * j + 3];
                    db += hv[0] * wb[4 * j] + hv[1] * wb[4 * j + 1] + hv[2] * wb[4 * j + 2] + hv[3] * wb[4 * j + 3]; }
                const float dec = __expf(-((float)t / (float)(L - 1)) * delta);
                vf[q] = df * dec; vb[q] = db * dec; ssf += vf[q] * vf[q]; ssb += vb[q] * vb[q];
            }
        }
        ssf = wave_sum(ssf); ssb = wave_sum(ssb);
        if (lane == 0) { red[w] = ssf; red[8 + w] = ssb; }
        __syncthreads();
        float tf = 0.f, tb = 0.f;
#pragma unroll
        for (int i = 0; i < 8; ++i) { tf += red[i]; tb += red[8 + i]; }
        const float nf = rsqrtf(tf + EPS), nbk = rsqrtf(tb + EPS);
        bf16_t* dst = ltype ? (bf16_t*)(p.ws + WS_FCTX) + ((size_t)o * 512 + c) * 512 : (bf16_t*)(p.ws + WS_FLAT) + ((size_t)o * 512 + c) * 4096;
#pragma unroll
        for (int q = 0; q < 4; ++q) {
            const int t = tid + 512 * q;
            if (t < L) {
                if (t == 0) { dst[L] = f2b(vf[q] * nf + vb[q] * nbk); dst[0] = 0; }
                else { dst[L + t] = f2b(vf[q] * nf); dst[L - t] = f2b(vb[q] * nbk); }
            }
        }
        __syncthreads();
    }
}

__device__ __forceinline__ void mlstm_item(const Params& p, int li, int it) {
    const int tid = tid_l(), w = tid >> 6, lane = tid & 63, fr = lane & 15, fq = lane >> 4;
    const int b = it >> 3, h = (it >> 1) & 3, dir = it & 1;
    bf16_t* Qs = (bf16_t*)dyn_lds;
    bf16_t* Ks = Qs + 64 * 136;
    bf16_t* KT = Ks + 64 * 136;
    bf16_t* VT = KT + 128 * 72;
    bf16_t* Cb = VT + 144 * 72;
    bf16_t* Ps = Cb + 144 * 136;
    float* fl = (float*)(Ps + 64 * 72);
    float* a_s = fl; float* Mt = fl + 64; float* scs = fl + 128; float* emt = fl + 192; float* den = fl + 256; float* lfs = fl + 320; float* igs = fl + 384; float* scal = fl + 448;
    const bf16_t* QKVO = (const bf16_t*)(p.ws + WS_BIG);
    const float* GATES = (const float*)(p.ws + WS_GATES);
    bf16_t* HFB = (bf16_t*)(p.ws + WS_HFB) + (size_t)dir * MTOT * 512;
    const float* ROPE = (const float*)(p.ws + WS_ROPE);
    const float* gate_b = p.in[9] + li * 16;
    for (int i = tid; i < 144 * 136 / 2; i += NT) ((unsigned*)Cb)[i] = 0u;
    for (int i = tid; i < 16 * 72; i += NT) { const int r = i / 72, ci = i % 72; VT[(128 + r) * 72 + ci] = (r == 0 && ci < 64) ? (bf16_t)0x3F80 : (bf16_t)0; }
    f32x4 cacc[9];
#pragma unroll
    for (int i = 0; i < 9; ++i) cacc[i] = (f32x4){0.f, 0.f, 0.f, 0.f};
    float m = 0.f;
    const int pr_r = tid >> 3, pr_seg = tid & 7, pr_tl = dir ? 63 - pr_r : pr_r, pr_tl2 = dir ? 63 - (tid & 63) : (tid & 63);
    const int pr_d1 = (pr_seg >> 2) * 64 + (pr_seg & 3) * 8;
    u32x4 pf_q1, pf_q2, pf_k1, pf_k2, pf_v1, pf_v2; float pgi = 0.f, pgf = 0.f;
#define MLSTM_ISSUE(ST_) do { const int st_ = (ST_); const bool ic_ = st_ < 4; const int cjn_ = ic_ ? (dir ? 3 - st_ : st_) : (dir ? 35 - st_ : st_ - 4); \
        const int rb_ = ic_ ? NLAT + b * 256 + cjn_ * 64 : b * 2048 + cjn_ * 64; \
        const bf16_t* sp_ = QKVO + (size_t)(rb_ + pr_tl) * 2048 + h * 128; \
        pf_q1 = *(const u32x4*)(sp_ + pr_d1); pf_q2 = *(const u32x4*)(sp_ + pr_d1 + 32); pf_k1 = *(const u32x4*)(sp_ + 512 + pr_d1); pf_k2 = *(const u32x4*)(sp_ + 512 + pr_d1 + 32); \
        pf_v1 = *(const u32x4*)(sp_ + 1024 + pr_seg * 16); pf_v2 = *(const u32x4*)(sp_ + 1024 + pr_seg * 16 + 8); \
        if (tid < 64) { const float* g_ = GATES + (size_t)(rb_ + pr_tl2) * 16; pgi = g_[dir * 8 + h]; pgf = g_[dir * 8 + 4 + h]; } } while (0)
    MLSTM_ISSUE(0);
    __syncthreads();
    for (int step = 0; step < 36; ++step) {
        const bool isctx = step < 4;
        const int cj = isctx ? (dir ? 3 - step : step) : (dir ? 35 - step : step - 4);
        const int rowbase = isctx ? NLAT + b * 256 + cj * 64 : b * 2048 + cj * 64;
        {
            const int r = tid >> 3, seg = tid & 7; const int tl = dir ? 63 - r : r;
            const int hb = seg >> 2, jb = (seg & 3) * 8, d1 = hb * 64 + jb, d2 = d1 + 32;
            const u32x4 q1 = pf_q1, q2 = pf_q2, k1 = pf_k1, k2 = pf_k2, v1 = pf_v1, v2 = pf_v2;
            const float cgi = pgi, cgf = pgf;
            if (step + 1 < 36) MLSTM_ISSUE(step + 1);
            float cs[8], sn[8];
            if (!isctx) {
                const int pos = hb ? tl : cj;
                const f32x4 c0 = *(const f32x4*)(ROPE + pos * 32 + jb), c1 = *(const f32x4*)(ROPE + pos * 32 + jb + 4);
                const f32x4 s0 = *(const f32x4*)(ROPE + 2048 + pos * 32 + jb), s1 = *(const f32x4*)(ROPE + 2048 + pos * 32 + jb + 4);
#pragma unroll
                for (int e = 0; e < 4; ++e) { cs[e] = c0[e]; cs[4 + e] = c1[e]; sn[e] = s0[e]; sn[4 + e] = s1[e]; }
            } else {
#pragma unroll
                for (int e = 0; e < 8; ++e) { cs[e] = 1.f; sn[e] = 0.f; }
            }
            float x1[8], x2[8], o1[8], o2[8];
            unpack8(q1, x1); unpack8(q2, x2);
#pragma unroll
            for (int e = 0; e < 8; ++e) { o1[e] = x1[e] * cs[e] - x2[e] * sn[e]; o2[e] = x1[e] * sn[e] + x2[e] * cs[e]; }
            *(u32x4*)(Qs + r * 136 + d1) = pack8(o1); *(u32x4*)(Qs + r * 136 + d2) = pack8(o2);
            unpack8(k1, x1); unpack8(k2, x2);
            const float ksc = 0.08838834764831845f;
#pragma unroll
            for (int e = 0; e < 8; ++e) { o1[e] = (x1[e] * cs[e] - x2[e] * sn[e]) * ksc; o2[e] = (x1[e] * sn[e] + x2[e] * cs[e]) * ksc; }
            const u32x4 ko1 = pack8(o1), ko2 = pack8(o2);
            *(u32x4*)(Ks + r * 136 + d1) = ko1; *(u32x4*)(Ks + r * 136 + d2) = ko2;
            {
                const unsigned kw1[4] = {ko1.x, ko1.y, ko1.z, ko1.w}, kw2[4] = {ko2.x, ko2.y, ko2.z, ko2.w};
#pragma unroll
                for (int e = 0; e < 4; ++e) {
                    KT[(d1 + 2 * e) * 72 + r] = (bf16_t)(kw1[e] & 0xffffu); KT[(d1 + 2 * e + 1) * 72 + r] = (bf16_t)(kw1[e] >> 16);
                    KT[(d2 + 2 * e) * 72 + r] = (bf16_t)(kw2[e] & 0xffffu); KT[(d2 + 2 * e + 1) * 72 + r] = (bf16_t)(kw2[e] >> 16);
                }
                const unsigned vw1[4] = {v1.x, v1.y, v1.z, v1.w}, vw2[4] = {v2.x, v2.y, v2.z, v2.w};
#pragma unroll
                for (int e = 0; e < 4; ++e) {
                    VT[(seg * 16 + 2 * e) * 72 + r] = (bf16_t)(vw1[e] & 0xffffu); VT[(seg * 16 + 2 * e + 1) * 72 + r] = (bf16_t)(vw1[e] >> 16);
                    VT[(seg * 16 + 8 + 2 * e) * 72 + r] = (bf16_t)(vw2[e] & 0xffffu); VT[(seg * 16 + 8 + 2 * e + 1) * 72 + r] = (bf16_t)(vw2[e] >> 16);
                }
            }
            if (tid < 64) {
                const int rr = tid;
                const float ig = cgi + gate_b[dir * 8 + h];
                const float fg = cgf + gate_b[dir * 8 + 4 + h];
                igs[rr] = ig; lfs[rr] = fminf(fg, 0.f) - __logf(1.f + __expf(-fabsf(fg)));
            }
        }
        __syncthreads();
        if (w == 0) {
            float bcs = lfs[lane];
#pragma unroll
            for (int o = 1; o < 64; o <<= 1) { const float t = __shfl_up(bcs, o); if (lane >= o) bcs += t; }
            const float a = igs[lane] - bcs;
            float pm = a;
#pragma unroll
            for (int o = 1; o < 64; o <<= 1) { const float t = __shfl_up(pm, o); if (lane >= o) pm = fmaxf(pm, t); }
            const float Mx = fmaxf(m, pm);
            a_s[lane] = a; Mt[lane] = Mx; scs[lane] = __expf(m - Mx); emt[lane] = __expf(-bcs - Mx);
            if (lane == 63) { scal[0] = bcs; scal[1] = Mx; }
        }
        {
            const int st = w & 3, tt0 = (w >> 2) * 2;
            f32x4 sacc[2];
#pragma unroll
            for (int u = 0; u < 2; ++u) {
                sacc[u] = (f32x4){0.f, 0.f, 0.f, 0.f};
#pragma unroll
                for (int kk = 0; kk < 4; ++kk) {
                    const bf16x8 Ak = *(const bf16x8*)(Ks + (st * 16 + fr) * 136 + kk * 32 + fq * 8);
                    const bf16x8 Bq = *(const bf16x8*)(Qs + ((tt0 + u) * 16 + fr) * 136 + kk * 32 + fq * 8);
                    sacc[u] = mfma16(Ak, Bq, sacc[u]);
                }
            }
            __syncthreads();
#pragma unroll
            for (int u = 0; u < 2; ++u) {
                const int t = (tt0 + u) * 16 + fr, sb = st * 16 + fq * 4;
                const float Mv = Mt[t];
                float pv[4];
#pragma unroll
                for (int j = 0; j < 4; ++j) { const int s = sb + j; pv[j] = (s <= t) ? sacc[u][j] * __expf(a_s[s] - Mv) : 0.f; }
                u32x2 o; o.x = pk2(pv[0], pv[1]); o.y = pk2(pv[2], pv[3]);
                *(u32x2*)(Ps + t * 72 + sb) = o;
            }
        }
        __syncthreads();
        {
            const int tt = w & 3, up = w >> 2, vt0 = up ? 5 : 0, nvt = up ? 4 : 5;
            bf16x8 qf[4], pf[2];
#pragma unroll
            for (int kk = 0; kk < 4; ++kk) qf[kk] = *(const bf16x8*)(Qs + (tt * 16 + fr) * 136 + kk * 32 + fq * 8);
#pragma unroll
            for (int kk = 0; kk < 2; ++kk) pf[kk] = *(const bf16x8*)(Ps + (tt * 16 + fr) * 72 + kk * 32 + fq * 8);
            const float sct = scs[tt * 16 + fr];
            f32x4 hacc[5];
#pragma unroll
            for (int vi = 0; vi < 5; ++vi) {
                hacc[vi] = (f32x4){0.f, 0.f, 0.f, 0.f};
                if (vi < nvt) {
                    const int v0 = (vt0 + vi) * 16;
                    f32x4 ac = (f32x4){0.f, 0.f, 0.f, 0.f};
#pragma unroll
                    for (int kk = 0; kk < 4; ++kk) ac = mfma16(*(const bf16x8*)(Cb + (v0 + fr) * 136 + kk * 32 + fq * 8), qf[kk], ac);
                    ac = ac * sct;
#pragma unroll
                    for (int kk = 0; kk < 2; ++kk) ac = mfma16(*(const bf16x8*)(VT + (v0 + fr) * 72 + kk * 32 + fq * 8), pf[kk], ac);
                    hacc[vi] = ac;
                }
            }
            if (up && fq == 0) den[tt * 16 + fr] = hacc[3][0];
            __syncthreads();
            const int t = tt * 16 + fr, tl = dir ? 63 - t : t;
            const float dn = den[t];
            const float inv = 1.f / fmaxf(fabsf(dn), emt[t]);
            bf16_t* orow = HFB + (size_t)(rowbase + tl) * 512 + h * 128;
#pragma unroll
            for (int vi = 0; vi < 5; ++vi) {
                if (vi < nvt && (vt0 + vi) < 8) {
                    const int v0 = (vt0 + vi) * 16 + fq * 4;
                    u32x2 o; o.x = pk2(hacc[vi][0] * inv, hacc[vi][1] * inv); o.y = pk2(hacc[vi][2] * inv, hacc[vi][3] * inv);
                    *(u32x2*)(orow + v0) = o;
                }
            }
        }
        {
            const float bl = scal[0], M63 = scal[1];
            const float decay = __expf(m - M63);
            bf16x8 ka[2];
#pragma unroll
            for (int kk = 0; kk < 2; ++kk) {
                const u32x4 raw = *(const u32x4*)(KT + (w * 16 + fr) * 72 + kk * 32 + fq * 8);
                float f[8]; unpack8(raw, f);
#pragma unroll
                for (int j = 0; j < 8; ++j) f[j] *= __expf(a_s[kk * 32 + fq * 8 + j] - M63);
                ka[kk] = as_bf8(pack8(f));
            }
#pragma unroll
            for (int vt = 0; vt < 9; ++vt) {
                f32x4 ac = cacc[vt] * decay;
#pragma unroll
                for (int kk = 0; kk < 2; ++kk) ac = mfma16(ka[kk], *(const bf16x8*)(VT + (vt * 16 + fr) * 72 + kk * 32 + fq * 8), ac);
                cacc[vt] = ac;
                u32x2 o; o.x = pk2(ac[0], ac[1]); o.y = pk2(ac[2], ac[3]);
                *(u32x2*)(Cb + (vt * 16 + fr) * 136 + w * 16 + fq * 4) = o;
            }
            m = bl + M63;
        }
        __syncthreads();
    }
}

__device__ __forceinline__ void combine_phase(const Params& p, int li) {
    const int tid = tid_l(), lane = tid & 63, gw = blockIdx.x * 8 + (tid >> 6), ngw = gridDim.x * 8;
    const bf16_t* HF = (const bf16_t*)(p.ws + WS_HFB); const bf16_t* HB = HF + (size_t)MTOT * 512;
    const bf16_t* QKVO = (const bf16_t*)(p.ws + WS_BIG);
    bf16_t* MIX = (bf16_t*)(p.ws + WS_ACT);
    const float* hn = p.in[10] + li * 512 + lane * 8;
    float g[8];
#pragma unroll
    for (int e = 0; e < 8; ++e) g[e] = hn[e];
    for (int row = gw; row < MTOT; row += ngw) {
        float a[8], bq[8], og[8], y[8];
        unpack8(*(const u32x4*)(HF + (size_t)row * 512 + lane * 8), a);
        unpack8(*(const u32x4*)(HB + (size_t)row * 512 + lane * 8), bq);
        unpack8(*(const u32x4*)(QKVO + (size_t)row * 2048 + 1536 + lane * 8), og);
        float ss = 0.f;
#pragma unroll
        for (int e = 0; e < 8; ++e) { a[e] += bq[e]; ss += a[e] * a[e]; }
        ss += __shfl_xor(ss, 1); ss += __shfl_xor(ss, 2); ss += __shfl_xor(ss, 4); ss += __shfl_xor(ss, 8);
        const float rstd = rsqrtf(ss * (1.f / 128.f) + EPS);
#pragma unroll
        for (int e = 0; e < 8; ++e) y[e] = a[e] * rstd * g[e] / (1.f + __expf(-og[e]));
        *(u32x4*)(MIX + (size_t)row * 1024 + lane * 8) = pack8(y);
    }
}

__device__ __forceinline__ bf16x8 hy_afrag(const bf16_t* HRp, int q, int m, int o4, int hsh) {
    const bf16_t* ap = HRp + (q + 8 - m);
    const u32x4 lo = *(const u32x4*)ap, hi = *(const u32x4*)(ap + 8);
    const bool b0 = (o4 & 1) != 0, b1 = (o4 & 2) != 0;
#define HYSEL(A_, B_, C_, D_) (b1 ? (b0 ? (D_) : (C_)) : (b0 ? (B_) : (A_)))
    const unsigned w0 = HYSEL(lo.x, lo.y, lo.z, lo.w), w1 = HYSEL(lo.y, lo.z, lo.w, hi.x), w2 = HYSEL(lo.z, lo.w, hi.x, hi.y),
                   w3 = HYSEL(lo.w, hi.x, hi.y, hi.z), w4 = HYSEL(hi.x, hi.y, hi.z, hi.w);
#undef HYSEL
    u32x4 o;
    o.x = __builtin_amdgcn_alignbit(w1, w0, hsh); o.y = __builtin_amdgcn_alignbit(w2, w1, hsh);
    o.z = __builtin_amdgcn_alignbit(w3, w2, hsh); o.w = __builtin_amdgcn_alignbit(w4, w3, hsh);
    return as_bf8(o);
}

template <int L>
__device__ __forceinline__ void hyena_item(const Params& p, int li, int c, bool dry = false) {
    constexpr int ZS = L + 8, NI = L / 128, NS = L / 32;
    const int tid = tid_l(), w = tid >> 6, lane = tid & 63, fr = lane & 15, fq = lane >> 4;
    bf16_t* ZA = (bf16_t*)dyn_lds; bf16_t* ZB = ZA + 16 * ZS; bf16_t* HFl = ZB + 16 * ZS;
    const int segbase = (L == 2048) ? 0 : NLAT;
    const bf16_t* HYT = (const bf16_t*)(p.ws + WS_P2);
    bf16_t* MIX = (bf16_t*)(p.ws + WS_ACT);
    const float* cw = p.in[11] + (size_t)li * 3 * 1536; const float* cb = p.in[12] + (size_t)li * 1536; const float* hd = p.in[19] + (size_t)li * 2 * 512;
    const bf16_t* FIL = (L == 2048) ? (const bf16_t*)(p.ws + WS_FLAT) : (const bf16_t*)(p.ws + WS_FCTX);
    {
        const float w0 = cw[c], w1 = cw[1536 + c], w2 = cw[2 * 1536 + c], bb = cb[c];
        const bf16_t* src = HYT + (size_t)c * MTOT + segbase;
#pragma unroll
        for (int ci = 0; ci < (16 * L / 8 + NT - 1) / NT; ++ci) {
            const int ch = tid + ci * NT; if (ch >= 16 * L / 8) break;
            const int b = ch / (L / 8), t0 = (ch % (L / 8)) * 8;
            const bf16_t* s = src + b * L + t0;
            float x[10], y[8];
            const float xl = b2f(s[t0 > 0 ? -1 : 0]), xr = b2f(s[(t0 + 8 < L) ? 8 : 7]);
            unpack8(*(const u32x4*)s, x + 1);
            x[0] = t0 > 0 ? xl : 0.f; x[9] = (t0 + 8 < L) ? xr : 0.f;
#pragma unroll
            for (int e = 0; e < 8; ++e) y[e] = bb + w0 * x[e] + w1 * x[e + 1] + w2 * x[e + 2];
            *(u32x4*)(ZA + b * ZS + t0) = pack8(y);
        }
    }
#pragma unroll 1
    for (int o = 0; o < 2; ++o) {
        for (int i = tid; i < 2 * L / 8; i += NT) {
            const u32x4 v = *(const u32x4*)(FIL + ((size_t)o * 512 + c) * 2 * L + i * 8);
            u32x4 rv; rv.x = (v.w >> 16) | (v.w << 16); rv.y = (v.z >> 16) | (v.z << 16); rv.z = (v.y >> 16) | (v.y << 16); rv.w = (v.x >> 16) | (v.x << 16);
            *(u32x4*)(HFl + 8 + 2 * L - 8 - 8 * i) = rv;
        }
        if (tid < 8) HFl[tid] = 0; else if (tid < 24) HFl[2 * L + tid] = 0;
        __syncthreads();
        const bf16_t* Zin = o ? ZB : ZA;
        const int gc = (o + 1) * 512 + c;
        const float gw0 = cw[gc], gw1 = cw[1536 + gc], gw2 = cw[2 * 1536 + gc], gb = cb[gc], dsk = hd[o * 512 + c];
        const bf16_t* gs = HYT + (size_t)gc * MTOT + segbase + fr * L;
        constexpr int NIB = NI < 8 ? NI : 8;
#pragma unroll 1
        for (int hp = 0; hp < NI; hp += NIB) {
            f32x4 acc[NIB];
#pragma unroll
            for (int i = 0; i < NIB; ++i) acc[i] = (f32x4){0.f, 0.f, 0.f, 0.f};
            constexpr int NQ = NS / 4;
            const int am = (7 - fr) & 7, ao4 = am >> 1, ahs = (am & 1) * 16;
            u32x2 pgv[NIB]; bf16_t pxl[NIB], pxr[NIB];
#pragma unroll
            for (int i = 0; i < NIB; ++i) {
                const int t0 = 16 * (w + 8 * (hp + i)) + fq * 4;
                pxl[i] = gs[t0 > 0 ? t0 - 1 : 0]; pxr[i] = gs[(t0 + 4 < L) ? t0 + 4 : L - 1];
                pgv[i] = *(const u32x2*)(gs + t0);
            }
#pragma unroll 1
            for (int r = 0; r < 4; ++r) {
                bf16x8 Aw[NIB];
#pragma unroll
                for (int i = 0; i < NIB; ++i) {
                    Aw[i] = hy_afrag(HFl, (L - 1) - 16 * w - 32 * (4 * (hp + i) - r) - fr + fq * 8, am, ao4, ahs);
                }
#pragma unroll 1
                for (int qc = 0; qc < NQ; qc += NIB) {
#pragma unroll
                    for (int qq = 0; qq < NIB; ++qq) {
                        const int q = qc + qq;
                        const bf16x8 Bz = *(const bf16x8*)(Zin + fr * ZS + (4 * q + r) * 32 + fq * 8);
#pragma unroll
                        for (int i = 0; i < NIB; ++i) acc[i] = mfma16(Aw[(i - qq + NIB) % NIB], Bz, acc[i]);
                        if (q + 1 < NQ) {
                            Aw[(NIB - 1 - qq) % NIB] = hy_afrag(HFl, (L - 1) - 16 * w - 32 * (4 * (hp - q - 1) - r) - fr + fq * 8, am, ao4, ahs);
                        }
                    }
                }
            }
#pragma unroll
            for (int i = 0; i < NIB; ++i) {
                const int t0 = 16 * (w + 8 * (hp + i)) + fq * 4;
                float x[6];
                const float xl = b2f(pxl[i]), xr = b2f(pxr[i]);
                const u32x2 gv = pgv[i];
                x[0] = t0 > 0 ? xl : 0.f;
                x[1] = blo(gv.x); x[2] = bhi(gv.x); x[3] = blo(gv.y); x[4] = bhi(gv.y);
                x[5] = (t0 + 4 < L) ? xr : 0.f;
                const u32x2 zv = *(const u32x2*)(Zin + fr * ZS + t0);
                const float z[4] = {blo(zv.x), bhi(zv.x), blo(zv.y), bhi(zv.y)};
                float val[4];
#pragma unroll
                for (int j = 0; j < 4; ++j) val[j] = (gb + gw0 * x[j] + gw1 * x[j + 1] + gw2 * x[j + 2]) * (acc[i][j] + dsk * z[j]);
                { u32x2 ov; ov.x = pk2(val[0], val[1]); ov.y = pk2(val[2], val[3]); *(u32x2*)((o == 0 ? ZB : ZA) + fr * ZS + t0) = ov; }
            }
        }
        __syncthreads();
    }
    if (!dry) {
        bf16_t* dstp = (bf16_t*)(p.ws + WS_P2) + (size_t)c * MTOT + segbase;
#pragma unroll
        for (int ci = 0; ci < (16 * L / 8 + NT - 1) / NT; ++ci) {
            const int ch = tid + ci * NT; if (ch >= 16 * L / 8) break;
            const int b = ch / (L / 8), t0 = (ch % (L / 8)) * 8;
            *(u32x4*)(dstp + b * L + t0) = *(const u32x4*)(ZA + b * ZS + t0);
        }
        __syncthreads();
    }
}

__device__ __forceinline__ void hy_transpose(const Params& p) {
    const int tid = tid_l();
    bf16_t* T = (bf16_t*)dyn_lds;
    const bf16_t* HYO = (const bf16_t*)(p.ws + WS_P2);
    bf16_t* MIX = (bf16_t*)(p.ws + WS_ACT);
    for (int it = blockIdx.x; it < (MTOT / 64) * 8; it += gridDim.x) {
        const int tt = it >> 3, cg_ = it & 7, tok0 = tt * 64, c0 = cg_ * 64;
        {
            const int ch = tid >> 3, t8 = (tid & 7) * 8;
            const u32x4 v = *(const u32x4*)(HYO + (size_t)(c0 + ch) * MTOT + tok0 + t8);
            const unsigned wv[4] = {v.x, v.y, v.z, v.w};
#pragma unroll
            for (int e = 0; e < 4; ++e) { T[(t8 + 2 * e) * 72 + ch] = (bf16_t)(wv[e] & 0xffffu); T[(t8 + 2 * e + 1) * 72 + ch] = (bf16_t)(wv[e] >> 16); }
        }
        __syncthreads();
        {
            const int tk = tid >> 3, c8 = (tid & 7) * 8;
            *(u32x4*)(MIX + (size_t)(tok0 + tk) * 1024 + 512 + c0 + c8) = *(const u32x4*)(T + tk * 72 + c8);
        }
        __syncthreads();
    }
}

__device__ __forceinline__ void qknorm_phase(const Params& p, int li) {
    const int tid = tid_l(), lane = tid & 63, gw = blockIdx.x * 8 + (tid >> 6), ngw = gridDim.x * 8;
    bf16_t* QK = (bf16_t*)(p.ws + WS_BIG);
    float gq[8], gk[8];
#pragma unroll
    for (int e = 0; e < 8; ++e) { gq[e] = p.in[22][li * 64 + (lane & 7) * 8 + e] * 0.125f; gk[e] = p.in[23][li * 64 + (lane & 7) * 8 + e]; }
    for (int row = gw; row < MTOT; row += ngw) {
        bf16_t* rp = QK + (size_t)row * QK_LD + lane * 8;
        u32x4 v[4];
#pragma unroll
        for (int j = 0; j < 4; ++j) v[j] = *(const u32x4*)(rp + j * 512);
#pragma unroll
        for (int j = 0; j < 4; ++j) {
            float f[8]; unpack8(v[j], f);
            float ss = 0.f;
#pragma unroll
            for (int e = 0; e < 8; ++e) ss += f[e] * f[e];
            ss += __shfl_xor(ss, 1); ss += __shfl_xor(ss, 2); ss += __shfl_xor(ss, 4);
            const float rstd = rsqrtf(ss * (1.f / 64.f) + EPS);
#pragma unroll
            for (int e = 0; e < 8; ++e) f[e] *= rstd * (j < 2 ? gq[e] : gk[e]);
            *(u32x4*)(rp + j * 512) = pack8(f);
        }
    }
}

template <bool LAT>
__device__ __forceinline__ void attn_item(const Params& p, int li, int b, int h, int sub, bool stage = true) {
    const int tid = tid_l(), w = tid >> 6, lane = tid & 63, fr = lane & 15, fq = lane >> 4;
    bf16_t* Pw = (bf16_t*)dyn_lds + w * (16 * 264);
    bf16_t* KC = (bf16_t*)(dyn_lds + 67584);
    bf16_t* VC = (bf16_t*)(dyn_lds + 67584 + 36864);
    float* rpbs = (float*)(dyn_lds + 67584 + 36864 + 33792);
    const bf16_t* QK = (const bf16_t*)(p.ws + WS_BIG);
    const bf16_t* VTg = (const bf16_t*)(p.ws + WS_P2ODD);
    bf16_t* MIX = (bf16_t*)(p.ws + WS_ACT);
    if (stage) {
    if (LAT) { const float* rp = p.in[24] + ((size_t)li * 16 + h) * 465; for (int i = tid; i < 465; i += NT) rpbs[i] = rp[i]; }
    {
        u32x4 kv[4], vv[4];
#pragma unroll
        for (int i = 0; i < 4; ++i) {
            const int c = tid + i * NT;
            kv[i] = *(const u32x4*)(QK + (size_t)(NLAT + b * 256 + (c >> 3)) * QK_LD + 1024 + h * 64 + (c & 7) * 8);
            vv[i] = *(const u32x4*)(VTg + (size_t)(h * 64 + (c >> 5)) * VT_LD + NLAT + b * 256 + (c & 31) * 8);
        }
#pragma unroll
        for (int i = 0; i < 4; ++i) {
            const int c = tid + i * NT;
            *(u32x4*)(KC + (c >> 3) * 72 + (c & 7) * 8) = kv[i];
            *(u32x4*)(VC + (c >> 5) * 264 + (c & 31) * 8) = vv[i];
        }
    }
    __syncthreads();
    }
    int r = 0, c0 = 0, rs = 0, cw0 = 0, qtok0;
    if (LAT) { r = sub * 2 + (w >> 2); const int qt = w & 3; c0 = qt * 16; qtok0 = b * 2048 + r * 64 + c0; rs = min(max(r - 4, 0), 24); cw0 = (qt == 0) ? 0 : (qt == 1) ? 8 : (qt == 2) ? 24 : 32; }
    else { qtok0 = NLAT + b * 256 + (sub * 8 + w) * 16; }
    bf16x8 qf[2];
    {
        const bf16_t* qp = QK + (size_t)(qtok0 + fr) * QK_LD + h * 64 + fq * 8;
        qf[0] = *(const bf16x8*)qp; qf[1] = *(const bf16x8*)(qp + 32);
    }
    f32x4 o1[4], o2[4];
    float m1 = -1e30f, l1 = 0.f, m2, l2 = 0.f;
#pragma unroll
    for (int dt = 0; dt < 4; ++dt) { o1[dt] = (f32x4){0.f, 0.f, 0.f, 0.f}; o2[dt] = (f32x4){0.f, 0.f, 0.f, 0.f}; }
    if (LAT) {
        f32x4 sreg[16];
        const int qc = c0 + fr; const int cstart = min(max(qc - 8, 0), 48);
#pragma unroll
        for (int kt = 0; kt < 16; ++kt) {
            const int kr = kt >> 1, kcb = cw0 + (kt & 1) * 16;
            const bf16_t* kp = QK + (size_t)(b * 2048 + (rs + kr) * 64 + kcb + fr) * QK_LD + 1024 + h * 64 + fq * 8;
            f32x4 sa = (f32x4){0.f, 0.f, 0.f, 0.f};
            sa = mfma16(*(const bf16x8*)kp, qf[0], sa); sa = mfma16(*(const bf16x8*)(kp + 32), qf[1], sa);
            const int dri = (rs + kr - r + 7) * 31;
#pragma unroll
            for (int j = 0; j < 4; ++j) {
                const int kc = kcb + fq * 4 + j;
                const bool valid = (kc >= cstart) && (kc < cstart + 16);
                const int dci = min(max(kc - qc + 15, 0), 30);
                sa[j] = valid ? sa[j] + rpbs[dri + dci] : -1e30f;
            }
            sreg[kt] = sa;
            if ((kt & 7) == 7) __builtin_amdgcn_sched_barrier(0);
        }
#pragma unroll
        for (int kt = 0; kt < 16; ++kt)
#pragma unroll
            for (int j = 0; j < 4; ++j) m1 = fmaxf(m1, sreg[kt][j]);
        m1 = fmaxf(m1, __shfl_xor(m1, 16)); m1 = fmaxf(m1, __shfl_xor(m1, 32));
#pragma unroll
        for (int kt = 0; kt < 16; ++kt) {
            float pj[4];
#pragma unroll
            for (int j = 0; j < 4; ++j) { pj[j] = __expf(sreg[kt][j] - m1); l1 += pj[j]; }
            u32x2 o; o.x = pk2(pj[0], pj[1]); o.y = pk2(pj[2], pj[3]);
            *(u32x2*)(Pw + fr * 264 + kt * 16 + fq * 4) = o;
        }
        l1 += __shfl_xor(l1, 16); l1 += __shfl_xor(l1, 32);
#pragma unroll
        for (int kb = 0; kb < 8; kb += 4) {
            bf16x8 vf[4][4], pf[4];
#pragma unroll
            for (int u = 0; u < 4; ++u) {
                const int ks = kb + u;
                const int vtok0 = b * 2048 + (rs + ks) * 64 + cw0;
#pragma unroll
                for (int dt = 0; dt < 4; ++dt) vf[u][dt] = *(const bf16x8*)(VTg + (size_t)(h * 64 + dt * 16 + fr) * VT_LD + vtok0 + fq * 8);
                pf[u] = *(const bf16x8*)(Pw + fr * 264 + ks * 32 + fq * 8);
            }
#pragma unroll
            for (int u = 0; u < 4; ++u)
#pragma unroll
                for (int dt = 0; dt < 4; ++dt) o1[dt] = mfma16(vf[u][dt], pf[u], o1[dt]);
            __builtin_amdgcn_sched_barrier(0);
        }
    }
    {
        f32x4 sreg[16];
#pragma unroll
        for (int kt = 0; kt < 16; ++kt) {
            const bf16_t* kp = KC + (kt * 16 + fr) * 72 + fq * 8;
            f32x4 sa = (f32x4){0.f, 0.f, 0.f, 0.f};
            sa = mfma16(*(const bf16x8*)kp, qf[0], sa); sa = mfma16(*(const bf16x8*)(kp + 32), qf[1], sa);
            sreg[kt] = sa;
        }
        m2 = -1e30f;
#pragma unroll
        for (int kt = 0; kt < 16; ++kt)
#pragma unroll
            for (int j = 0; j < 4; ++j) m2 = fmaxf(m2, sreg[kt][j]);
        m2 = fmaxf(m2, __shfl_xor(m2, 16)); m2 = fmaxf(m2, __shfl_xor(m2, 32));
#pragma unroll
        for (int kt = 0; kt < 16; ++kt) {
            float pj[4];
#pragma unroll
            for (int j = 0; j < 4; ++j) { pj[j] = __expf(sreg[kt][j] - m2); l2 += pj[j]; }
            u32x2 o; o.x = pk2(pj[0], pj[1]); o.y = pk2(pj[2], pj[3]);
            *(u32x2*)(Pw + fr * 264 + kt * 16 + fq * 4) = o;
        }
        l2 += __shfl_xor(l2, 16); l2 += __shfl_xor(l2, 32);
#pragma unroll
        for (int ks = 0; ks < 8; ++ks) {
            const bf16x8 pf = *(const bf16x8*)(Pw + fr * 264 + ks * 32 + fq * 8);
#pragma unroll
            for (int dt = 0; dt < 4; ++dt) o2[dt] = mfma16(*(const bf16x8*)(VC + (dt * 16 + fr) * 264 + ks * 32 + fq * 8), pf, o2[dt]);
        }
    }
    const float mm = fmaxf(m1, m2);
    const float a1 = LAT ? __expf(m1 - mm) : 0.f, a2 = __expf(m2 - mm);
    const float inv = 1.f / (l1 * a1 + l2 * a2);
    const float s1 = a1 * inv, s2 = a2 * inv;
#pragma unroll
    for (int dt = 0; dt < 4; ++dt) {
        const f32x4 ov = o1[dt] * s1 + o2[dt] * s2;
        u32x2 o; o.x = pk2(ov[0], ov[1]); o.y = pk2(ov[2], ov[3]);
        *(u32x2*)(MIX + (size_t)(qtok0 + fr) * 1024 + h * 64 + dt * 16 + fq * 4) = o;
    }
    __syncthreads();
}


#ifdef DBG_NAN
__device__ __forceinline__ bool bad16(bf16_t v) { return ((v >> 7) & 0xFF) >= 227; }
__device__ __forceinline__ bool bad32(float f) { return !(fabsf(f) < 1e30f); }
__device__ __forceinline__ void scan16(const bf16_t* p, size_t n, unsigned* flags, unsigned bit) {
    bool bad = false;
    for (size_t i = (size_t)blockIdx.x * NT + threadIdx.x; i < n; i += (size_t)gridDim.x * NT) bad |= bad16(p[i]);
    if (bad) atomicOr(flags, bit);
}
__device__ __forceinline__ void scan32(const float* p, size_t n, unsigned* flags, unsigned bit) {
    bool bad = false;
    for (size_t i = (size_t)blockIdx.x * NT + threadIdx.x; i < n; i += (size_t)gridDim.x * NT) bad |= bad32(p[i]);
    if (bad) atomicOr(flags, bit);
}
#endif

#define XB_TMO      128
#define XB_XCNT(j)  (256  + 64 * (j))
#define XB_XSUB(j)  (1280 + 64 * (j))
#define XB_XGEN(j)  (2304 + 64 * (j))
#define XB_TOP      3328
#define XB_TOPGEN   3392
#define XCD_BAR_WORDS 3456
#define XB_SPIN_CAP (1u << 20)
#define LAS __attribute__((address_space(3)))
__device__ __forceinline__ unsigned xb_ld(unsigned* p)              { return __hip_atomic_load(p, __ATOMIC_RELAXED, __HIP_MEMORY_SCOPE_AGENT); }
__device__ __forceinline__ unsigned xb_add(unsigned* p, unsigned v) { return __hip_atomic_fetch_add(p, v, __ATOMIC_RELAXED, __HIP_MEMORY_SCOPE_AGENT); }
__device__ __forceinline__ unsigned xb_xcc_id() { return (unsigned)__builtin_amdgcn_s_getreg((3 << 11) | 20) & 0xFu; }
#define XB_SPIN(cond, bar) do { unsigned _sp = 0; while (cond) { __builtin_amdgcn_s_sleep(1); \
    if ((++_sp & 255u) == 0u) { if (xb_ld(&(bar)[XB_TMO])) break; if (_sp > XB_SPIN_CAP) { atomicAdd(&(bar)[XB_TMO], 1u); break; } } } } while (0)
struct XcdBarrier { unsigned* bar; unsigned x; volatile LAS unsigned* st; };
__device__ __forceinline__ XcdBarrier xcd_barrier_post(unsigned* bar, volatile LAS unsigned* st) {
    XcdBarrier b; b.bar = bar; b.x = xb_xcc_id(); b.st = st;
    if (threadIdx.x == 0) (void)xb_add(&bar[XB_XCNT(b.x)], 1u);
    return b;
}
__device__ __forceinline__ void xcd_barrier_complete(unsigned* bar, unsigned x, unsigned& nloc, unsigned& nx) {
    const unsigned G = gridDim.x * gridDim.y * gridDim.z;
    unsigned sum, cnt, mine, sp = 0u;
    for (;;) {
        sum = 0u; cnt = 0u; mine = 0u;
#pragma unroll
        for (unsigned j = 0; j < 16; ++j) { const unsigned c = xb_ld(&bar[XB_XCNT(j)]); sum += c; cnt += (c > 0u) ? 1u : 0u; mine = (j == x) ? c : mine; }
        if (sum == G) break;
        __builtin_amdgcn_s_sleep(1);
        if ((++sp & 255u) == 0u) { if (xb_ld(&bar[XB_TMO])) break; if (sp > XB_SPIN_CAP) { atomicAdd(&bar[XB_TMO], 1u); break; } }
    }
    nloc = mine > 0u ? mine : 1u; nx = cnt > 0u ? cnt : 1u;
}
__device__ __forceinline__ void xcd_barrier(const XcdBarrier& b) {
    asm volatile("s_waitcnt vmcnt(0)" ::: "memory");
    __syncthreads();
    if (threadIdx.x == 0) {
        unsigned* bar = b.bar;
        __builtin_amdgcn_s_waitcnt(0);
        unsigned nloc = b.st[0], nx = b.st[1];
        if (nloc == 0u) { xcd_barrier_complete(bar, b.x, nloc, nx); b.st[0] = nloc; b.st[1] = nx; }
        const unsigned old = xb_add(&bar[XB_XSUB(b.x)], 1u);
        const unsigned gen = old / nloc;
        if (old + 1u == (gen + 1u) * nloc) {
            __builtin_amdgcn_fence(__ATOMIC_RELEASE, "agent");
            asm volatile("s_waitcnt vmcnt(0)" ::: "memory");
            const unsigned og = xb_add(&bar[XB_TOP], 1u);
            const unsigned tg = og / nx;
            if (og + 1u == (tg + 1u) * nx) xb_add(&bar[XB_TOPGEN], 1u);
            else XB_SPIN(xb_ld(&bar[XB_TOPGEN]) == tg, bar);
            __builtin_amdgcn_fence(__ATOMIC_ACQUIRE, "agent");
            xb_add(&bar[XB_XGEN(b.x)], 1u);
            asm volatile("s_waitcnt vmcnt(0)" ::: "memory");
        } else {
            XB_SPIN(xb_ld(&bar[XB_XGEN(b.x)]) == gen, bar);
            __builtin_amdgcn_fence(__ATOMIC_ACQUIRE, "agent");
            asm volatile("s_waitcnt vmcnt(0)" ::: "memory");
        }
    }
    __syncthreads();
}
constexpr size_t WS_BAR = WS_END + 32768;

#ifdef TPROBE_A
#define GSYNC() do { asm volatile("s_waitcnt vmcnt(0) lgkmcnt(0)" ::: "memory"); grid.sync(); ++nsync_; if (nsync_ == TPROBE_A) t0_ = wall_clock64(); if (nsync_ == TPROBE_B) t1_ = wall_clock64(); } while (0)
#else
#define GSYNC() xcd_barrier(xbar_)
#endif
#define GSYNC_CG() do { asm volatile("s_waitcnt vmcnt(0) lgkmcnt(0)" ::: "memory"); grid.sync(); } while (0)
__global__ void __launch_bounds__(NT) fwd_megakernel(Params p) {
    cg::grid_group grid = cg::this_grid();
#ifdef TPROBE_A
    int nsync_ = 0; long long t0_ = 0, t1_ = 0;
#endif
    const int blk = blockIdx.x, G = gridDim.x;
    bf16_t* WIN = (bf16_t*)(p.ws + WS_WIN); bf16_t* WOUT = (bf16_t*)(p.ws + WS_WOUT); bf16_t* WM1 = (bf16_t*)(p.ws + WS_WM1); bf16_t* WM2 = (bf16_t*)(p.ws + WS_WM2);
    bf16_t* ACT = (bf16_t*)(p.ws + WS_ACT); bf16_t* BIG = (bf16_t*)(p.ws + WS_BIG);
    float* XC = (float*)(p.ws + WS_XC);
    const float* MOD = (const float*)(p.ws + WS_MOD);
    volatile LAS unsigned* xst_ = (volatile LAS unsigned*)(dyn_lds + LDS_BYTES - 16);
    if (threadIdx.x == 0) { xst_[0] = 0u; xst_[1] = 0u; }
    __syncthreads();
    const XcdBarrier xbar_ = xcd_barrier_post((unsigned*)(p.ws + WS_BAR), xst_);
    REP(64) if (PHMASK & 1) phase0(p);
#ifdef DBG_NAN
    unsigned* dflags = (unsigned*)(p.ws + WS_END);
    if (blk == 0 && threadIdx.x < 64) dflags[threadIdx.x] = 0u;
#endif
    GSYNC_CG();
#pragma unroll 1
    for (int l = 0; l < 4; ++l) {
        const bool even = !(l & 1), last = (l == 3); const int li = l >> 1;
        const float* xlat = (l == 0) ? p.in[0] : p.out; const float* xctx = (l == 0) ? p.in[2] : XC;
        const int Mtail = last ? NLAT : MTOT;
        REP(1) {
        if (PHMASK & 2) convert_weights(p, l, l == 0 || G < 256, true, 0, G);
        if (PHMASK & 4) norm_phase(p, l, xlat, xctx, 0, 1024, MTOT);
        if ((PHMASK & 8) && even) filter_gen(p, li);
        }
        GSYNC();
        {
            EpiArgs ea{}; ea.o_rm = BIG; ea.ld_rm = even ? 2048 : QK_LD; ea.o_cm = (bf16_t*)(p.ws + (even ? WS_P2 : WS_P2ODD)); ea.ld_cm = even ? MTOT : VT_LD; ea.gates = (float*)(p.ws + WS_GATES); ea.gate_pn = even ? 14 : -1; ea.o_dbg = (bf16_t*)(p.ws + WS_HFB);
            REP(2) if (PHMASK & 16) gemm_phase<EPI_INPROJ>(ACT, WIN, MTOT, even ? 3840 : 3072, 1024, ea);
        }
        GSYNC();
#ifdef DBG_NAN
        if (l == DBG_LAYER) {
            {
                const unsigned gid = blk * NT + threadIdx.x;
                unsigned hsh = gid * 2654435761u + 12345u; hsh ^= hsh >> 13; hsh *= 2246822519u; hsh ^= hsh >> 16;
                const int row = hsh % MTOT; const int col = (hsh >> 8) % 2048; const int ch = (hsh >> 4) % 1536;
                const bf16_t* ar = ACT + (size_t)row * 1024; const bf16_t* wq = WIN + (size_t)col * 1024; const bf16_t* wh = WIN + (size_t)(2048 + ch) * 1024;
                float sq = 0.f, sh_ = 0.f;
                for (int k = 0; k < 1024; ++k) { const float av = b2f(ar[k]); sq += av * b2f(wq[k]); sh_ += av * b2f(wh[k]); }
                const float gq = b2f(BIG[(size_t)row * 2048 + col]);
                const float gh = b2f(((const bf16_t*)(p.ws + WS_P2))[(size_t)ch * MTOT + row]);
                (void)gq; (void)sq;

                { const int cls = DBG_CLS; atomicAdd(dflags + 16 + cls, 1u);
                  if (!(fabsf(gh - sh_) <= 0.05f + 0.02f * fabsf(sh_))) { atomicAdd(dflags + 2, 1u); atomicAdd(dflags + 32 + cls, 1u); } }
            }
            GSYNC();
            if (blk == 0 && threadIdx.x == 0) {
                const float fQ = (float)__hip_atomic_load(dflags + 1, __ATOMIC_RELAXED, __HIP_MEMORY_SCOPE_AGENT) / (float)(G * NT);
                const float fH = (float)__hip_atomic_load(dflags + 2, __ATOMIC_RELAXED, __HIP_MEMORY_SCOPE_AGENT) / (float)(G * NT);
                unsigned mask = 0;
                for (int q_ = 0; q_ < 8; ++q_) { const unsigned tot = __hip_atomic_load(dflags + 16 + q_, __ATOMIC_RELAXED, __HIP_MEMORY_SCOPE_AGENT), bad = __hip_atomic_load(dflags + 32 + q_, __ATOMIC_RELAXED, __HIP_MEMORY_SCOPE_AGENT); if (bad * 4 > tot) mask |= 1u << q_; }
                float code = 1e5f; for (unsigned q_ = 0; q_ < (mask >> 4); ++q_) code *= 10.f;
                const unsigned n3 = __hip_atomic_load(dflags + 3, __ATOMIC_RELAXED, __HIP_MEMORY_SCOPE_AGENT), b1 = __hip_atomic_load(dflags + 1, __ATOMIC_RELAXED, __HIP_MEMORY_SCOPE_AGENT), b4 = __hip_atomic_load(dflags + 4, __ATOMIC_RELAXED, __HIP_MEMORY_SCOPE_AGENT);
                p.out[0] = code * (1.f + 0.5f * (float)(mask & 15)) + 0.f * (fQ + fH + (float)(n3 + b1 + b4));
            }
            return;
        }
#endif
        if (!even) { qknorm_phase(p, li); GSYNC(); }
        if (even) {
            REP(4) if (G >= 256) {
                if (blk < 128) { REP(512) if (PHMASK & 32) mlstm_item(p, li, blk);
                    if (DUPMASK & 1024) { hyena_item<2048>(p, li, 384 + blk, true); hyena_item<256>(p, li, 384 + blk, true); }
                    if (PHMASK & 64) { hyena_item<2048>(p, li, 384 + blk); } }
                else { const int hb = blk - 128;
                    if (DUPMASK & 1024) for (int it = hb; it < 384; it += 128) { hyena_item<2048>(p, li, it, true); hyena_item<256>(p, li, it, true); }
                    if (PHMASK & 64) { for (int it = hb; it < 384; it += 128) { hyena_item<2048>(p, li, it); hyena_item<256>(p, li, it); } hyena_item<256>(p, li, 384 + hb); } }
            } else {
            }
            GSYNC();
            if (PHMASK & 128) { combine_phase(p, li); hy_transpose(p); }
        } else {
            const int x = blk & 7, y = blk >> 3, ny = (G + 7) >> 3;
            REP(256) for (int i = 0; ; ++i) {
                const int slot = i * ny + y;
                if (slot >= 512) break;
                const int bh = x * 32 + 4 * (i >> 1) + (y >> 3), rp = (y & 7) * 2 + (i & 1);
                if (PHMASK & 256) attn_item<true>(p, li, bh >> 4, bh & 15, rp, (i & 1) == 0 || ny != 32);
            }
            if ((PHMASK & 512) && !last) for (int it = blk; it < 512; it += G) attn_item<false>(p, li, it >> 5, (it >> 1) & 15, it & 1);
        }
        GSYNC();
        {
            EpiArgs ea{}; ea.res_lat = xlat; ea.res_ctx = xctx; ea.out_lat = p.out; ea.out_ctx = XC; ea.modg = MOD + (size_t)l * 17 * 6144 + 2048;
            if (DUPMASK & 32) gemm_phase<EPI_DRY>(ACT, WOUT, Mtail, 1024, 1024, ea);
            if (PHMASK & 1024) gemm_phase<EPI_RESID>(ACT, WOUT, Mtail, 1024, 1024, ea);
        }
        GSYNC();
        REP(8) norm_phase(p, l, p.out, XC, 3072, 4096, Mtail);
        GSYNC();
        { EpiArgs ea{}; ea.o_rm = BIG; ea.ld_rm = 4096; ea.gate_pn = -1; REP(16) if (PHMASK & 2048) gemm_phase<EPI_RELU2>(ACT, WM1, Mtail, 4096, 1024, ea); }
        GSYNC();
        {
            EpiArgs ea{}; ea.res_lat = p.out; ea.res_ctx = XC; ea.out_lat = p.out; ea.out_ctx = XC; ea.modg = MOD + (size_t)l * 17 * 6144 + 5120;
            if (DUPMASK & 32) gemm_phase<EPI_DRY>(BIG, WM2, Mtail, 1024, 4096, ea);
            if (PHMASK & 4096) gemm_phase<EPI_RESID>(BIG, WM2, Mtail, 1024, 4096, ea);
            if (!last && G >= 256) convert_weights(p, l + 1, true, false, 128, G - 128);
        }
        GSYNC();
    }
#ifdef TPROBE_A
    if (blk == 0 && threadIdx.x == 0) p.out[0] = (float)(t1_ - t0_) * 10.f;
#endif
}

extern "C" void kernel_launch(void* const* d_in, const int* in_sizes, int n_in, void* d_out, int out_size, void* d_ws, size_t ws_size, hipStream_t stream) {
    static int grid_blocks = 0;
    if (grid_blocks == 0) {
        if (n_in != 26 || ws_size < WS_BAR + XCD_BAR_WORDS * 4) { fprintf(stderr, "kernel_launch: unexpected n_in %d or ws_size %zu (< %zu)\n", n_in, ws_size, (size_t)WS_END); grid_blocks = -1; return; }
        int dev = 0, cus = 0, per_cu = 0;
        hipGetDevice(&dev);
        hipDeviceGetAttribute(&cus, hipDeviceAttributeMultiprocessorCount, dev);
        if (hipFuncSetAttribute((const void*)fwd_megakernel, hipFuncAttributeMaxDynamicSharedMemorySize, LDS_BYTES) != hipSuccess) fprintf(stderr, "kernel_launch: hipFuncSetAttribute failed\n");
        if (hipOccupancyMaxActiveBlocksPerMultiprocessor(&per_cu, (const void*)fwd_megakernel, NT, LDS_BYTES) != hipSuccess || per_cu < 1) { fprintf(stderr, "kernel_launch: occupancy query gave %d\n", per_cu); per_cu = 1; }
        (void)hipGetLastError();
        grid_blocks = cus * 1;
        fprintf(stderr, "kernel_launch: cus %d per_cu %d grid %d\n", cus, per_cu, grid_blocks);
    }
    if (grid_blocks < 0) return;
    if (hipMemsetAsync((char*)d_ws + WS_BAR, 0, XCD_BAR_WORDS * 4, stream) != hipSuccess) { fprintf(stderr, "kernel_launch: memset of barrier words failed\n"); return; }
    Params p{};
    for (int i = 0; i < 26; ++i) p.in[i] = (const float*)d_in[i];
    p.out = (float*)d_out; p.ws = (unsigned char*)d_ws;
    void* args[] = {&p};
    hipError_t e = hipLaunchCooperativeKernel((void*)fwd_megakernel, dim3(grid_blocks), dim3(NT), args, LDS_BYTES, stream);
    if (e != hipSuccess) fprintf(stderr, "cooperative launch failed: %s (grid %d)\n", hipGetErrorString(e), grid_blocks);
}
```
